# Optimizing an MI355X kernel written in HIP

```python
import math
import jax, jax.numpy as jnp
from jax import lax
import numpy as np

D_MODEL = 2048
BATCH = 16
SEQ = 256
DEPTH = 4
DEC_BATCH = 2
DEC_SEQ = 4096
PAST_LEN = 256

GRID_W = 64
DA_HEADS = D_MODEL // 512
DA_QK = 64
DA_V = 2 * DA_QK
HG_HEADS = D_MODEL // 512
HG_DK = 128
HG_DV = 128
HG_CHUNK = 16
SW_HEADS = D_MODEL // 256
SW_KV = SW_HEADS // 4
SW_GROUP = SW_HEADS // SW_KV
SW_HD = 128
SW_WINDOW = 128
SW_BLOCK = 128
Q_BLOCK = 128
D_MIX = DA_HEADS * DA_V + HG_HEADS * HG_DV + SW_HEADS * SW_HD
IN_WIDTHS = (DA_HEADS * 2 * DA_QK, DA_HEADS * 2 * DA_QK, DA_HEADS * DA_V,
             HG_HEADS * HG_DK, HG_HEADS * HG_DK, HG_HEADS * HG_DK, HG_HEADS * HG_DV, HG_HEADS * HG_DV,
             SW_HEADS * SW_HD, SW_KV * SW_HD, SW_KV * SW_HD)
D_IN = sum(IN_WIDTHS)
D_FF = ((8 * D_MODEL // 3 + 255) // 256) * 256
DEEPNORM_ALPHA = (2 * DEPTH) ** 0.25
DEEPNORM_BETA = (8 * DEPTH) ** -0.25
ROPE_BASE = 10000.0
LN_EPS = 1e-5
RMS_EPS = 1e-6
NEG_INF = -1e30
LB_FLOOR = 1e-30

kernel_name = 'hymba_diff_hgrn2_swa_flow_trunk'


def _layer_norm(x, g, b):
    xf = x.astype(jnp.float32)
    mu = jnp.mean(xf, axis=-1, keepdims=True)
    var = jnp.mean(jnp.square(xf - mu), axis=-1, keepdims=True)
    return ((xf - mu) * lax.rsqrt(var + LN_EPS)).astype(x.dtype) * g + b


def _rms_norm(x, g):
    xf = x.astype(jnp.float32)
    return (xf * lax.rsqrt(jnp.mean(xf * xf, axis=-1, keepdims=True) + RMS_EPS)).astype(x.dtype) * g


def _rope_1d(x, pos):
    h = x.shape[-1] // 2
    inv = ROPE_BASE ** (-jnp.arange(h, dtype=jnp.float32) / h)
    ang = pos.astype(jnp.float32)[:, None] * inv[None, :]
    cos = jnp.cos(ang).astype(x.dtype)
    sin = jnp.sin(ang).astype(x.dtype)
    x1, x2 = x[..., :h], x[..., h:]
    return jnp.concatenate([x1 * cos - x2 * sin, x2 * cos + x1 * sin], axis=-1)


def _rope_2d(x, row, col):
    half = x.shape[-1] // 2
    return jnp.concatenate([_rope_1d(x[..., :half], row), _rope_1d(x[..., half:], col)], axis=-1)


def _adaln(cond, w_mod, b_mod):
    m = (jax.nn.silu(cond) @ w_mod + b_mod)[:, None, :]
    return jnp.split(m, 6, axis=-1)


def _project(h, w_in, lb):
    b, n, _ = h.shape
    idx = np.cumsum(IN_WIDTHS)[:-1].tolist()
    aq, ak, av, bq, bff, bfb, bi, bg, cq, ck, cv = jnp.split(h @ w_in, idx, axis=-1)

    def heads(a, nh):
        return a.reshape(b, n, nh, -1).transpose(0, 2, 1, 3)

    def dual(a):
        return a.reshape(b, n, DA_HEADS, 2, DA_QK).transpose(0, 2, 3, 1, 4)

    dq, dk, dv = dual(aq), dual(ak), heads(av, DA_HEADS)
    hq = jax.nn.silu(heads(bq, HG_HEADS))
    z = jnp.stack([heads(bff, HG_HEADS), heads(bfb, HG_HEADS)], axis=0).astype(jnp.float32)
    lb = lb.reshape(2, 1, HG_HEADS, 1, HG_DK)
    hlogf = jnp.logaddexp(jnp.log(jnp.maximum(lb, LB_FLOOR)), jnp.log1p(-lb) + jax.nn.log_sigmoid(z))
    hk = (1.0 - lb) * jax.nn.sigmoid(-z)
    hv, hg = heads(bi, HG_HEADS), heads(bg, HG_HEADS)
    sq = heads(cq, SW_HEADS).reshape(b, SW_KV, SW_GROUP, n, SW_HD)
    sk, sv = heads(ck, SW_KV), heads(cv, SW_KV)
    return dq, dk, dv, hq, hk, hlogf, hv, hg, sq, sk, sv


def _diff_lambda(lam_p, layer):
    lam_init = 0.8 - 0.6 * math.exp(-0.3 * layer)
    lp = lam_p.astype(jnp.float32)
    lam = jnp.exp(jnp.sum(lp[0] * lp[1])) - jnp.exp(jnp.sum(lp[2] * lp[3])) + lam_init
    return lam, lam_init


def _diff_attention(q, k, v, lam):
    b, h, _, nq, dh = q.shape
    nb = nq // Q_BLOCK
    qb = jnp.moveaxis(q.reshape(b, h, 2, nb, Q_BLOCK, dh), 3, 0)
    scale = dh ** -0.5

    def block(qi):
        s = jnp.einsum('bhmqd,bhmkd->bhmqk', qi, k).astype(jnp.float32) * scale
        p = jax.nn.softmax(s, axis=-1)
        w = p[:, :, 0] - lam * p[:, :, 1]
        return jnp.einsum('bhqk,bhkv->bhqv', w.astype(v.dtype), v)

    o = lax.map(block, qb)
    return jnp.moveaxis(o, 0, 2).reshape(b, h, nq, v.shape[-1])


def _sink_attention(q, k, v, sink):
    b, kv, g, nq, d = q.shape
    nb = nq // Q_BLOCK
    qb = jnp.moveaxis(q.reshape(b, kv, g, nb, Q_BLOCK, d), 3, 0)
    scale = d ** -0.5

    def block(qi):
        s = jnp.einsum('bkgqd,bksd->bkgqs', qi, k).astype(jnp.float32) * scale
        s_sink = jnp.broadcast_to(sink.astype(jnp.float32)[None, :, :, None, None], s.shape[:-1] + (1,))
        p = jax.nn.softmax(jnp.concatenate([s, s_sink], axis=-1), axis=-1)[..., :-1]
        return jnp.einsum('bkgqs,bksd->bkgqd', p.astype(v.dtype), v)

    o = lax.map(block, qb)
    return jnp.moveaxis(o, 0, 3).reshape(b, kv, g, nq, d)


def _banded_sink_attention(q, k, v, kc, vc, sink):
    b, kv, g, n, d = q.shape
    nb = n // SW_BLOCK
    scale = d ** -0.5

    def band(a):
        pad = jnp.pad(a, ((0, 0), (0, 0), (SW_BLOCK, SW_BLOCK), (0, 0))).reshape(b, kv, nb + 2, SW_BLOCK, d)
        return jnp.concatenate([pad[:, :, 0:nb], pad[:, :, 1:nb + 1], pad[:, :, 2:nb + 2]], axis=3)

    kb, vb = band(k), band(v)
    qb = q.reshape(b, kv, g, nb, SW_BLOCK, d)
    s_band = jnp.einsum('bkgnqd,bknsd->bkgnqs', qb, kb).astype(jnp.float32) * scale
    qpos = jnp.arange(n).reshape(nb, SW_BLOCK)
    kpos = (jnp.arange(nb)[:, None] - 1) * SW_BLOCK + jnp.arange(3 * SW_BLOCK)[None, :]
    valid = ((jnp.abs(qpos[:, :, None] - kpos[:, None, :]) <= SW_WINDOW)
             & (kpos >= 0)[:, None, :] & (kpos < n)[:, None, :])
    s_band = jnp.where(valid, s_band, NEG_INF)
    s_ctx = jnp.einsum('bkgnqd,bksd->bkgnqs', qb, kc).astype(jnp.float32) * scale
    s_sink = jnp.broadcast_to(sink.astype(jnp.float32)[None, :, :, None, None, None], s_band.shape[:-1] + (1,))
    p = jax.nn.softmax(jnp.concatenate([s_band, s_ctx, s_sink], axis=-1), axis=-1)
    pb = p[..., :3 * SW_BLOCK].astype(v.dtype)
    pc = p[..., 3 * SW_BLOCK:-1].astype(v.dtype)
    o = jnp.einsum('bkgnqs,bknsd->bkgnqd', pb, vb) + jnp.einsum('bkgnqs,bksd->bkgnqd', pc, vc)
    return o.reshape(b, kv, g, n, d)


def _gla_scan(q, k, v, logf, s0):
    b, h, n, _ = q.shape
    dv = v.shape[-1]
    nc = n // HG_CHUNK

    def chunks(a):
        return jnp.moveaxis(a.astype(jnp.float32).reshape(b, h, nc, HG_CHUNK, a.shape[-1]), 2, 0)

    causal = jnp.tril(jnp.ones((HG_CHUNK, HG_CHUNK), dtype=bool))[:, :, None]

    def step(S, xs):
        qc, kc, vc, gc = xs
        cum = jnp.cumsum(gc, axis=2)
        rel = jnp.where(causal, cum[:, :, :, None, :] - cum[:, :, None, :, :], NEG_INF)
        att = jnp.einsum('bhtd,bhsd,bhtsd->bhts', qc, kc, jnp.exp(rel))
        last = cum[:, :, -1:, :]
        o = jnp.einsum('bhts,bhsv->bhtv', att, vc) + jnp.einsum('bhtd,bhdv->bhtv', qc * jnp.exp(cum), S)
        S = jnp.exp(last[:, :, 0, :])[..., None] * S + jnp.einsum('bhsd,bhsv->bhdv', kc * jnp.exp(last - cum), vc)
        return S, o

    S, o = lax.scan(step, s0.astype(jnp.float32), (chunks(q), chunks(k), chunks(v), chunks(logf)))
    return jnp.moveaxis(o, 0, 2).reshape(b, h, n, dv), S


def _bi_gla(q, k2, v, logf2, s0_f, s0_b):
    of, sf = _gla_scan(q, k2[0], v, logf2[0], s0_f)
    ob, sb = _gla_scan(jnp.flip(q, 2), jnp.flip(k2[1], 2), jnp.flip(v, 2), jnp.flip(logf2[1], 2), s0_b)
    return of + jnp.flip(ob, 2), sf, sb


def _merge(oa, ob, oc, hg, lp, lam_init):
    b, _, n, _ = oa.shape
    oa = _rms_norm(oa, lp['diff_g']) * (1.0 - lam_init)
    ob = _rms_norm(ob.astype(oa.dtype), lp['hgrn_g']) * jax.nn.silu(hg)
    oc = oc.reshape(b, SW_HEADS, n, SW_HD)

    def flat(a):
        return a.transpose(0, 2, 1, 3).reshape(b, n, -1)

    return jnp.concatenate([flat(oa), flat(ob), flat(oc)], axis=-1) @ lp['w_out']


def _post_block(x, mix, g1, sh2, sc2, g2, lp):
    x = _layer_norm(DEEPNORM_ALPHA * x + g1 * mix, lp['ln1_g'], lp['ln1_b'])
    h = x * (1.0 + sc2) + sh2
    a, u = jnp.split(h @ lp['w_gate_up'], 2, axis=-1)
    f = (jax.nn.silu(a) * u) @ lp['w_down']
    return _layer_norm(DEEPNORM_ALPHA * x + g2 * f, lp['ln2_g'], lp['ln2_b'])


def _context_layer(x, c_ctx, lp, layer):
    sh1, sc1, g1, sh2, sc2, g2 = _adaln(c_ctx[None, :], lp['w_mod'], lp['b_mod'])
    h = x * (1.0 + sc1) + sh1
    dq, dk, dv, hq, hk, hlogf, hv, hg, sq, sk, sv = _project(h, lp['w_in'], lp['lb'])
    lam, lam_init = _diff_lambda(lp['diff_lambda'], layer)
    oa = _diff_attention(dq, dk, dv, lam)
    zeros = jnp.zeros((x.shape[0], HG_HEADS, HG_DK, HG_DV), jnp.float32)
    ob, sf, sb = _bi_gla(hq, hk, hv, hlogf, zeros, zeros)
    oc = _sink_attention(sq, sk, sv, lp['sink'])
    x_new = _post_block(x, _merge(oa, ob, oc, hg, lp, lam_init), g1, sh2, sc2, g2, lp)
    b, _, _, n, _ = dk.shape
    k_pack = dk.transpose(0, 1, 3, 2, 4).reshape(b, DA_HEADS, n, 2 * DA_QK)
    st = jnp.stack([sf, sb], axis=1).astype(x.dtype)
    return x_new, k_pack, dv, sk, sv, st


def _latent_layer(x, c, ck_diff, cv_diff, ck_swa, cv_swa, st, lp, layer, row, col):
    sh1, sc1, g1, sh2, sc2, g2 = _adaln(c, lp['w_mod'], lp['b_mod'])
    h = x * (1.0 + sc1) + sh1
    dq, dk, dv, hq, hk, hlogf, hv, hg, sq, sk, sv = _project(h, lp['w_in'], lp['lb'])
    lam, lam_init = _diff_lambda(lp['diff_lambda'], layer)
    b, p_len = ck_diff.shape[0], ck_diff.shape[2]
    k_ctx = ck_diff.reshape(b, DA_HEADS, p_len, 2, DA_QK).transpose(0, 1, 3, 2, 4)
    dk_all = jnp.concatenate([_rope_2d(dk, row, col), k_ctx], axis=3)
    dv_all = jnp.concatenate([dv, cv_diff], axis=2)
    oa = _diff_attention(_rope_2d(dq, row, col), dk_all, dv_all, lam)
    ob, _, _ = _bi_gla(hq, hk, hv, hlogf, st[:, 0], st[:, 1])
    oc = _banded_sink_attention(_rope_2d(sq, row, col), _rope_2d(sk, row, col), sv, ck_swa, cv_swa, lp['sink'])
    return _post_block(x, _merge(oa, ob, oc, hg, lp, lam_init), g1, sh2, sc2, g2, lp)


def setup_inputs(seed: int = 0) -> dict:
    key = jax.random.key(seed)
    ks = jax.random.split(key, 24)

    def nrm(k, shape, scale):
        return jax.random.normal(k, shape, jnp.float32) * scale

    return {
        'x_prompt': nrm(ks[0], (BATCH, SEQ, D_MODEL), 1.0),
        'x_sample': nrm(ks[1], (DEC_BATCH, DEC_SEQ, D_MODEL), 1.0),
        'cache_diff_k': nrm(ks[2], (DEC_BATCH, DEPTH, DA_HEADS, PAST_LEN, 2 * DA_QK), 1.0),
        'cache_diff_v': nrm(ks[3], (DEC_BATCH, DEPTH, DA_HEADS, PAST_LEN, DA_V), 1.0),
        'cache_swa_k': nrm(ks[4], (DEC_BATCH, DEPTH, SW_KV, PAST_LEN, SW_HD), 1.0),
        'cache_swa_v': nrm(ks[5], (DEC_BATCH, DEPTH, SW_KV, PAST_LEN, SW_HD), 1.0),
        'state_hgrn': nrm(ks[6], (DEC_BATCH, DEPTH, 2, HG_HEADS, HG_DK, HG_DV), 0.5),
        'c': nrm(ks[7], (DEC_BATCH, D_MODEL), 1.0),
        'c_ctx': nrm(ks[8], (D_MODEL,), 1.0),
        'w_mod': nrm(ks[9], (DEPTH, D_MODEL, 6 * D_MODEL), 0.5 * D_MODEL ** -0.5),
        'b_mod': nrm(ks[10], (DEPTH, 6 * D_MODEL), 0.02),
        'w_in': nrm(ks[11], (DEPTH, D_MODEL, D_IN), D_MODEL ** -0.5),
        'w_out': nrm(ks[12], (DEPTH, D_MIX, D_MODEL), DEEPNORM_BETA * D_MIX ** -0.5),
        'diff_lambda': nrm(ks[13], (DEPTH, 4, DA_QK), 0.1),
        'diff_norm_g': 1.0 + nrm(ks[14], (DEPTH, DA_V), 0.02),
        'hgrn_lb_logits': nrm(ks[15], (DEPTH, 2, HG_HEADS * HG_DK), 0.1),
        'hgrn_norm_g': 1.0 + nrm(ks[16], (DEPTH, HG_DV), 0.02),
        'swa_sink': nrm(ks[17], (DEPTH, SW_HEADS), 0.5),
        'ln1_g': 1.0 + nrm(ks[18], (DEPTH, D_MODEL), 0.02),
        'ln1_b': nrm(ks[19], (DEPTH, D_MODEL), 0.02),
        'ln2_g': 1.0 + nrm(ks[20], (DEPTH, D_MODEL), 0.02),
        'ln2_b': nrm(ks[21], (DEPTH, D_MODEL), 0.02),
        'w_gate_up': nrm(ks[22], (DEPTH, D_MODEL, 2 * D_FF), D_MODEL ** -0.5),
        'w_down': nrm(ks[23], (DEPTH, D_FF, D_MODEL), DEEPNORM_BETA * D_FF ** -0.5),
    }


def reference(x_prompt, x_sample, cache_diff_k, cache_diff_v, cache_swa_k, cache_swa_v, state_hgrn,
              c, c_ctx, w_mod, b_mod, w_in, w_out, diff_lambda, diff_norm_g, hgrn_lb_logits, hgrn_norm_g,
              swa_sink, ln1_g, ln1_b, ln2_g, ln2_b, w_gate_up, w_down):
    lb_w = jax.nn.softmax(hgrn_lb_logits.astype(jnp.float32), axis=0)
    lb_all = jnp.cumsum(lb_w, axis=0) - lb_w[:1]
    n_lat = x_sample.shape[1]
    rows = n_lat // GRID_W
    row = jnp.repeat(jnp.arange(rows), GRID_W)
    col = jnp.tile(jnp.arange(GRID_W), rows)
    y_p, y_s = x_prompt, x_sample
    nk_d, nv_d, nk_s, nv_s, n_st = [], [], [], [], []
    for l in range(DEPTH):
        lp = {'w_mod': w_mod[l], 'b_mod': b_mod[l], 'w_in': w_in[l], 'w_out': w_out[l],
              'diff_lambda': diff_lambda[l], 'diff_g': diff_norm_g[l], 'lb': lb_all[l],
              'hgrn_g': hgrn_norm_g[l], 'sink': swa_sink[l].reshape(SW_KV, SW_GROUP),
              'ln1_g': ln1_g[l], 'ln1_b': ln1_b[l], 'ln2_g': ln2_g[l], 'ln2_b': ln2_b[l],
              'w_gate_up': w_gate_up[l], 'w_down': w_down[l]}
        y_p, kd, vd, ks_, vs_, st = _context_layer(y_p, c_ctx, lp, l)
        nk_d.append(kd)
        nv_d.append(vd)
        nk_s.append(ks_)
        nv_s.append(vs_)
        n_st.append(st)
        y_s = _latent_layer(y_s, c, cache_diff_k[:, l], cache_diff_v[:, l], cache_swa_k[:, l], cache_swa_v[:, l],
                            state_hgrn[:, l], lp, l, row, col)
    new_diff_k = jnp.stack(nk_d, axis=1)
    new_diff_v = jnp.stack(nv_d, axis=1)
    new_swa_k = jnp.stack(nk_s, axis=1)
    new_swa_v = jnp.stack(nv_s, axis=1)
    new_state_hgrn = jnp.stack(n_st, axis=1)
    return (y_p, y_s, new_diff_k, new_diff_v, new_swa_k, new_swa_v, new_state_hgrn)
```

```cpp
#include <hip/hip_runtime.h>
#include <cstdio>
#include <cstdint>
namespace pg8 {
#define PG8_LAS __attribute__((address_space(3)))
typedef unsigned short bf16_t;
typedef short bf16x8 __attribute__((ext_vector_type(8)));
typedef float f32x4 __attribute__((ext_vector_type(4)));
typedef unsigned u32x4 __attribute__((ext_vector_type(4)));
constexpr int BM = 256, BK = 64, HALF = 128, HTB = HALF * BK * 2  , STAGE_BYTES = 8 * HTB, NXCD = 8, WGM = 8;

__host__ __device__ __forceinline__ int lds_byte(int r, int c) { const int st = (r >> 4) * 2 + (c >> 5), rr = r & 15, cc = c & 31, ob = rr * 64 + cc * 2; return st * 1024 + (ob ^ (((ob >> 9) & 1) << 5)); }
__host__ __device__ __forceinline__ void stage_rc(int b, int& R, int& C) { const int st = b / 1024, sb = b % 1024, swz = sb ^ (((sb >> 9) & 1) << 5); R = (st >> 1) * 16 + swz / 64; C = (st & 1) * 32 + (swz % 64) / 2; }
__host__ __device__ __forceinline__ int perm32(int rho) { const int n = rho >> 4, i = rho & 15; return 8 * (i >> 2) + 4 * n + (i & 3); }

struct Unit { int pm, pn; };
struct Gemm { const bf16_t* A; const bf16_t* Bt; int M, N, K; };

struct StaticOrder {
    int nM, nN, nwg, G, c;
    __host__ __device__ void init(int M, int N, int G_, int c_) { nM = M / BM; nN = N / BM; nwg = nM * nN; G = G_; c = c_; }
    __host__ __device__ bool next(int i, Unit& u) const {
        const long L = (long)i * G + c; if (L >= nwg) return false;
        int wgid = (int)L; { const int q = nwg / NXCD, r = nwg % NXCD, xcd = wgid % NXCD, off = wgid / NXCD; wgid = (xcd < r ? xcd * (q + 1) : r * (q + 1) + (xcd - r) * q) + off; }
        const int nig = WGM * nN, gid = wgid / nig, fm = gid * WGM, gsz = (nM - fm) < WGM ? (nM - fm) : WGM;
        u.pm = fm + ((wgid % nig) % gsz); u.pn = (wgid % nig) / gsz; return true;
    }
    __device__ __forceinline__ void a_ready(const Unit&) const {}
    __device__ __forceinline__ void done(const Unit&) const {}
};
__device__ __forceinline__ unsigned cvt_pk_bf16(float lo, float hi) { unsigned r; asm volatile("v_cvt_pk_bf16_f32 %0, %1, %2" : "=v"(r) : "v"(lo), "v"(hi)); return r; }
typedef float f32x2 __attribute__((ext_vector_type(2)));
template <class Epi, class Sched, bool ALIGN_EPI = false, bool SP2 = false>
__device__ __forceinline__ void gemm_phase(PG8_LAS unsigned char* lds, const Gemm g, const Sched& S, const Epi& E, int wid_in) {
    int lane_ = (int)__builtin_amdgcn_mbcnt_hi(~0u, __builtin_amdgcn_mbcnt_lo(~0u, 0u)); asm volatile("" : "+v"(lane_)); asm volatile("" : "+s"(wid_in));
    const int wid = wid_in, lane = lane_, tid = wid * 64 + lane, wr = wid >> 2, wc = wid & 3, fr = lane & 15, fq = lane >> 4;
    const int K = g.K, nt = K / BK;
    unsigned voffA[2], voffB[2];
#pragma unroll
    for (int i = 0; i < 2; ++i) { int R, C; stage_rc(tid * 16 + i * 8192, R, C); const int Rb = Epi::PERM ? ((R & ~31) + perm32(R & 31)) : R;
        voffA[i] = (unsigned)(R * K + C) * 2u; voffB[i] = (unsigned)(Rb * K + C) * 2u; }
    const size_t kstep = (size_t)(BK * 2);
    const size_t hstep = (size_t)HALF * K * 2;
    const size_t tstep = 2 * hstep;
    const unsigned ldsw = (unsigned)wid * 1024u;
    const int aoff = lds_byte(wr * 64 + fr, fq * 8), boff = lds_byte(wc * 32 + fr, fq * 8);
#define PG8_SA(b, h) (((b) * 2 + (h)) * HTB)
#define PG8_SB(b, h) ((4 + (b) * 2 + (h)) * HTB)
#define PG8_STAGE(bufoff, gbase, voff) do { _Pragma("unroll") for (int _i = 0; _i < 2; ++_i) \
        __builtin_amdgcn_global_load_lds((const unsigned*)((const char*)(gbase) + (voff)[_i]), (PG8_LAS unsigned*)(lds + (bufoff) + ldsw + _i * 8192), 16, 0, 0); } while (0)
#define PG8_LDA(dst, b, h) do { _Pragma("unroll") for (int m = 0; m < 4; ++m) _Pragma("unroll") for (int k = 0; k < 2; ++k) dst[m][k] = *(const PG8_LAS bf16x8*)(lds + PG8_SA(b, h) + aoff + m * 2048 + k * 1024); } while (0)
#define PG8_LDB(dst, b, h) do { _Pragma("unroll") for (int n = 0; n < 2; ++n) _Pragma("unroll") for (int k = 0; k < 2; ++k) dst[n][k] = *(const PG8_LAS bf16x8*)(lds + PG8_SB(b, h) + boff + n * 2048 + k * 1024); } while (0)
#define PG8_MMA(ai, bj, At, Bt) do { __builtin_amdgcn_s_setprio(1); _Pragma("unroll") for (int m = 0; m < 4; ++m) _Pragma("unroll") for (int n = 0; n < 2; ++n) _Pragma("unroll") for (int k = 0; k < 2; ++k) \
        acc[ai][bj][m][n] = __builtin_amdgcn_mfma_f32_16x16x32_bf16(Bt[n][k], At[m][k], acc[ai][bj][m][n], 0, 0, 0); __builtin_amdgcn_s_setprio(0); } while (0)
#define PG8_WAIT_V(n) asm volatile("s_waitcnt vmcnt(" #n ")" ::: "memory")
#define PG8_WAIT_L(n) asm volatile("s_waitcnt lgkmcnt(" #n ")" ::: "memory")
#define PG8_BAR __builtin_amdgcn_s_barrier()
#define PG8_SCHED __builtin_amdgcn_sched_barrier(0)
    Unit cur, nxt; int ui = 0;
    if (!S.next(0, cur)) return;
    f32x4 acc[2][2][4][2];
#pragma unroll
    for (int a = 0; a < 2; ++a)
#pragma unroll
        for (int b = 0; b < 2; ++b)
#pragma unroll
            for (int m = 0; m < 4; ++m)
#pragma unroll
                for (int n = 0; n < 2; ++n) acc[a][b][m][n] = (f32x4){0.f, 0.f, 0.f, 0.f};
    bf16x8 At[4][2], B0[2][2], B1[2][2];
    const char* cA = (const char*)g.A + (size_t)cur.pm * tstep; const char* cB = (const char*)g.Bt + (size_t)cur.pn * tstep;
    S.a_ready(cur);
    if constexpr (SP2) {
        PG8_STAGE(PG8_SB(0, 0), cB, voffB); PG8_STAGE(PG8_SB(0, 1), cB + hstep, voffB); PG8_STAGE(PG8_SA(0, 0), cA, voffA); PG8_STAGE(PG8_SA(0, 1), cA + hstep, voffA);
        if (wr == 1) PG8_BAR;
        PG8_WAIT_V(2); PG8_BAR;
        PG8_STAGE(PG8_SB(1, 0), cB + kstep, voffB); PG8_STAGE(PG8_SA(1, 0), cA + kstep, voffA); PG8_STAGE(PG8_SB(1, 1), cB + hstep + kstep, voffB);
        PG8_WAIT_V(6); PG8_BAR;
    } else {
        PG8_STAGE(PG8_SB(0, 0), cB, voffB); PG8_STAGE(PG8_SA(0, 0), cA, voffA); PG8_STAGE(PG8_SB(0, 1), cB + hstep, voffB); PG8_STAGE(PG8_SA(0, 1), cA + hstep, voffA);
        if (wr == 1) PG8_BAR;
        PG8_WAIT_V(4); PG8_BAR;
        PG8_STAGE(PG8_SB(1, 0), cB + kstep, voffB); PG8_STAGE(PG8_SA(1, 0), cA + kstep, voffA); PG8_STAGE(PG8_SB(1, 1), cB + hstep + kstep, voffB);
        PG8_WAIT_V(6); PG8_BAR;
    }
    for (;;) {
        const bool has_next = S.next(ui + 1, nxt);
        const char* nA = has_next ? (const char*)g.A + (size_t)nxt.pm * tstep : cA; const char* nB = has_next ? (const char*)g.Bt + (size_t)nxt.pn * tstep : cB;
        for (int t = 0; t < nt; t += 2) {
            const bool last = (t == nt - 2);
            const char* a1 = cA + (size_t)(t + 1) * kstep;
            const char* a2 = last ? nA : cA + (size_t)(t + 2) * kstep; const char* b2 = last ? nB : cB + (size_t)(t + 2) * kstep;
            const char* a3 = a2 + kstep; const char* b3 = b2 + kstep;
            if (last && has_next) S.a_ready(nxt);
            if constexpr (SP2) {
            PG8_LDB(B0, 0, 0); PG8_LDB(B1, 0, 1); PG8_SCHED; PG8_LDA(At, 0, 0); PG8_STAGE(PG8_SA(1, 1), a1 + hstep, voffA);
            PG8_WAIT_V(8); PG8_WAIT_L(0); PG8_BAR; PG8_MMA(0, 0, At, B0); PG8_MMA(0, 1, At, B1); PG8_BAR; PG8_SCHED;
            PG8_LDA(At, 0, 1); PG8_STAGE(PG8_SB(0, 0), b2, voffB); PG8_STAGE(PG8_SB(0, 1), b2 + hstep, voffB); PG8_STAGE(PG8_SA(0, 0), a2, voffA);
            PG8_WAIT_V(8); PG8_WAIT_L(0); PG8_BAR; PG8_MMA(1, 0, At, B0); PG8_MMA(1, 1, At, B1); PG8_BAR; PG8_SCHED;
            PG8_LDB(B0, 1, 0); PG8_LDB(B1, 1, 1); PG8_SCHED; PG8_LDA(At, 1, 0); PG8_STAGE(PG8_SA(0, 1), a2 + hstep, voffA);
            PG8_WAIT_V(8); PG8_WAIT_L(0); PG8_BAR; PG8_MMA(0, 0, At, B0); PG8_MMA(0, 1, At, B1); PG8_BAR; PG8_SCHED;
            PG8_LDA(At, 1, 1); PG8_STAGE(PG8_SB(1, 0), b3, voffB); PG8_STAGE(PG8_SB(1, 1), b3 + hstep, voffB); PG8_STAGE(PG8_SA(1, 0), a3, voffA);
            PG8_WAIT_V(8); PG8_WAIT_L(0); PG8_BAR; PG8_MMA(1, 0, At, B0); PG8_MMA(1, 1, At, B1); PG8_BAR; PG8_SCHED;
            } else {
            PG8_LDB(B0, 0, 0); PG8_SCHED; PG8_LDA(At, 0, 0); PG8_STAGE(PG8_SA(1, 1), a1 + hstep, voffA);
            PG8_WAIT_L(8); PG8_BAR; PG8_WAIT_L(0); PG8_MMA(0, 0, At, B0); PG8_BAR; PG8_SCHED;
            PG8_LDB(B1, 0, 1); PG8_STAGE(PG8_SB(0, 0), b2, voffB);
            PG8_BAR; PG8_WAIT_L(0); PG8_MMA(0, 1, At, B1); PG8_BAR;
            PG8_LDA(At, 0, 1); PG8_STAGE(PG8_SA(0, 0), a2, voffA);
            PG8_BAR; PG8_WAIT_L(0); PG8_MMA(1, 0, At, B0); PG8_BAR; PG8_SCHED;
            PG8_STAGE(PG8_SB(0, 1), b2 + hstep, voffB);
            PG8_WAIT_V(6); PG8_BAR; PG8_MMA(1, 1, At, B1); PG8_BAR;
            PG8_LDB(B0, 1, 0); PG8_SCHED; PG8_LDA(At, 1, 0); PG8_STAGE(PG8_SA(0, 1), a2 + hstep, voffA);
            PG8_WAIT_L(8); PG8_BAR; PG8_WAIT_L(0); PG8_MMA(0, 0, At, B0); PG8_BAR; PG8_SCHED;
            PG8_LDB(B1, 1, 1); PG8_STAGE(PG8_SB(1, 0), b3, voffB);
            PG8_BAR; PG8_WAIT_L(0); PG8_MMA(0, 1, At, B1); PG8_BAR;
            PG8_LDA(At, 1, 1); PG8_STAGE(PG8_SA(1, 0), a3, voffA);
            PG8_BAR; PG8_WAIT_L(0); PG8_MMA(1, 0, At, B0); PG8_BAR; PG8_SCHED;
            PG8_STAGE(PG8_SB(1, 1), b3 + hstep, voffB);
            PG8_WAIT_V(6); PG8_BAR; PG8_MMA(1, 1, At, B1); PG8_BAR;
            }
        }
        if constexpr (ALIGN_EPI) { if (wr == 0) PG8_BAR; }
        if constexpr (!Epi::AFTER_DRAIN) { E(acc, cur, wr, wc, fr, fq); S.done(cur); }
        if (!has_next) break;
#pragma unroll
        for (int a = 0; a < 2; ++a)
#pragma unroll
            for (int b = 0; b < 2; ++b)
#pragma unroll
                for (int m = 0; m < 4; ++m)
#pragma unroll
                    for (int n = 0; n < 2; ++n) acc[a][b][m][n] = (f32x4){0.f, 0.f, 0.f, 0.f};
        cur = nxt; cA = nA; cB = nB; ++ui;
        if constexpr (ALIGN_EPI) { if (wr == 1) PG8_BAR; }
    }
    PG8_WAIT_V(0);
    if constexpr (!ALIGN_EPI) { if (wr == 0) PG8_BAR; }
    PG8_BAR;
    if constexpr (Epi::AFTER_DRAIN) { E.fused(acc, cur, wr, wc, fr, fq, lds, wid, lane); S.done(cur); }
#undef PG8_SA
#undef PG8_SB
#undef PG8_STAGE
#undef PG8_LDA
#undef PG8_LDB
#undef PG8_MMA
#undef PG8_WAIT_V
#undef PG8_WAIT_L
#undef PG8_BAR
#undef PG8_SCHED
}
}
#define GAS __attribute__((address_space(1)))
#define LAS __attribute__((address_space(3)))
typedef unsigned short bf16;
typedef unsigned v4u __attribute__((ext_vector_type(4)));
typedef float f32x4 __attribute__((ext_vector_type(4)));
typedef short bf16x8 __attribute__((ext_vector_type(8)));
typedef GAS unsigned gu32;
typedef GAS unsigned long long gu64;
#define RLX_AGENT __ATOMIC_RELAXED, __HIP_MEMORY_SCOPE_AGENT
#define LDS_WAIT() asm volatile("s_waitcnt lgkmcnt(0)" ::: "memory")
#define VM_WAIT() asm volatile("s_waitcnt vmcnt(0)" ::: "memory")
__device__ __forceinline__ unsigned long long rt() { return __builtin_amdgcn_s_memrealtime(); }
__device__ __forceinline__ unsigned f2bf(float f) { unsigned u = __builtin_bit_cast(unsigned, f); return (u + 0x7fffu + ((u >> 16) & 1u)) >> 16; }
__device__ __forceinline__ unsigned pk2(float lo, float hi) { return f2bf(lo) | (f2bf(hi) << 16); }
#define XB_TMO      128
#define XB_XCNT(j)  (256  + 64 * (j))
#define XB_XSUB(j)  (1280 + 64 * (j))
#define XB_XGEN(j)  (2304 + 64 * (j))
#define XB_TOP      3328
#define XB_TOPGEN   3392
#define XCD_BAR_WORDS 3456
#define XB_SPIN_CAP (1u << 24)

__device__ __forceinline__ unsigned xb_ld(unsigned* p)              { return __hip_atomic_load(p, __ATOMIC_RELAXED, __HIP_MEMORY_SCOPE_AGENT); }
__device__ __forceinline__ unsigned xb_add(unsigned* p, unsigned v) { return __hip_atomic_fetch_add(p, v, __ATOMIC_RELAXED, __HIP_MEMORY_SCOPE_AGENT); }
__device__ __forceinline__ unsigned xb_xcc_id() { return (unsigned)__builtin_amdgcn_s_getreg((3 << 11) | 20) & 0xFu; }
#define XB_SPIN(cond, bar) do { unsigned _sp = 0; while (cond) { __builtin_amdgcn_s_sleep(1); \
    if ((++_sp & 255u) == 0u) { if (xb_ld(&(bar)[XB_TMO])) break; if (_sp > XB_SPIN_CAP) { atomicAdd(&(bar)[XB_TMO], 1u); break; } } } } while (0)

struct XcdBarrier {
    unsigned* bar; unsigned x;
    volatile LAS unsigned* st;
};

__device__ __forceinline__ XcdBarrier xcd_barrier_post(unsigned* bar, volatile LAS unsigned* st) {
    XcdBarrier b; b.bar = bar; b.x = xb_xcc_id(); b.st = st;
    if (threadIdx.x == 0) (void)xb_add(&bar[XB_XCNT(b.x)], 1u);
    return b;
}
__device__ __forceinline__ void xcd_barrier_complete(unsigned* bar, unsigned x, unsigned& nloc, unsigned& nx) {
    const unsigned G = gridDim.x * gridDim.y * gridDim.z;
    unsigned sum, cnt, mine, sp = 0u;
    for (;;) {
        sum = 0u; cnt = 0u; mine = 0u;
#pragma unroll
        for (unsigned j = 0; j < 16; ++j) { const unsigned c = xb_ld(&bar[XB_XCNT(j)]); sum += c; cnt += (c > 0u) ? 1u : 0u; mine = (j == x) ? c : mine; }
        if (sum == G) break;
        __builtin_amdgcn_s_sleep(1);
        if ((++sp & 255u) == 0u) { if (xb_ld(&bar[XB_TMO])) break; if (sp > XB_SPIN_CAP) { atomicAdd(&bar[XB_TMO], 1u); break; } }
    }
    nloc = mine > 0u ? mine : 1u; nx = cnt > 0u ? cnt : 1u;
}

__device__ __forceinline__ void xcd_barrier(const XcdBarrier& b) {
    asm volatile("s_waitcnt vmcnt(0)" ::: "memory");
    __syncthreads();
    if (threadIdx.x == 0) {
        unsigned* bar = b.bar;
        __builtin_amdgcn_s_waitcnt(0);
        unsigned nloc = b.st[0], nx = b.st[1];
        if (nloc == 0u) { xcd_barrier_complete(bar, b.x, nloc, nx); b.st[0] = nloc; b.st[1] = nx; }
        const unsigned old = xb_add(&bar[XB_XSUB(b.x)], 1u);
        const unsigned gen = old / nloc;
        if (old + 1u == (gen + 1u) * nloc) {
            __builtin_amdgcn_fence(__ATOMIC_RELEASE, "agent");
            asm volatile("s_waitcnt vmcnt(0)" ::: "memory");
            const unsigned og = xb_add(&bar[XB_TOP], 1u);
            const unsigned tg = og / nx;
            if (og + 1u == (tg + 1u) * nx) xb_add(&bar[XB_TOPGEN], 1u);
            else XB_SPIN(xb_ld(&bar[XB_TOPGEN]) == tg, bar);
            __builtin_amdgcn_fence(__ATOMIC_ACQUIRE, "agent");
            xb_add(&bar[XB_XGEN(b.x)], 1u);
            asm volatile("s_waitcnt vmcnt(0)" ::: "memory");
        } else {
            XB_SPIN(xb_ld(&bar[XB_XGEN(b.x)]) == gen, bar);
            __builtin_amdgcn_fence(__ATOMIC_ACQUIRE, "agent");
            asm volatile("s_waitcnt vmcnt(0)" ::: "memory");
        }
    }
    __syncthreads();
}

constexpr int DM = 2048;
constexpr int NB_CTX = 16, S_CTX = 256, NB_LAT = 2, S_LAT = 4096, DEPTH = 4;
constexpr int R_CTX = NB_CTX * S_CTX;
constexpr int R_LAT = NB_LAT * S_LAT;
constexpr int MROWS = R_CTX + R_LAT;
constexpr int DIN = 5632, DFF = 5632, DGU = 2 * DFF;
constexpr float ALPHA = 1.6817928305074292f;
constexpr int C_AQ = 0, C_AK = 512, C_AV = 1024, C_BQ = 1536, C_BF = 2048, C_BB = 2560, C_BI = 3072, C_BG = 3584, C_CQ = 4096, C_CK = 5120, C_CV = 5376;
constexpr size_t O_YP = 0, O_YS = 8388608, O_DK = 25165824, O_DV = 33554432, O_SK = 41943040, O_SV = 46137344, O_ST = 50331648, O_END = 58720256;

constexpr size_t MiB = 1u << 20;
constexpr size_t WS_CTL = 0, CTL_ZERO_BYTES = 1 * MiB;
constexpr size_t WS_MODS = 1 * MiB;
constexpr size_t WS_MISC = 2 * MiB;
constexpr size_t WS_W = 4 * MiB, W_LAYER = 96 * MiB;
constexpr size_t WO_IN = 0, WO_OUT = 22 * MiB, WO_GU = 30 * MiB, WO_DN = 74 * MiB;
constexpr size_t WS_H = 388 * MiB;
constexpr size_t WS_CAT = 436 * MiB;
constexpr size_t WS_X1 = 484 * MiB;
constexpr size_t WS_OA = 580 * MiB, WS_OBF = 604 * MiB, WS_OBB = 628 * MiB;
constexpr size_t WS_P = 652 * MiB;
constexpr size_t WS_ACT = WS_P, WS_YPRE = WS_P + 132 * MiB;
constexpr size_t WS_END = 916 * MiB;

constexpr int CW_BAR = 4096;

constexpr int RING_BYTES = 131072;
constexpr int LDSCTL_OFF = RING_BYTES, MISC_OFF = LDSCTL_OFF + 320;
constexpr int LDS_BYTES = 147456;

typedef unsigned v2u __attribute__((ext_vector_type(2)));

__device__ __forceinline__ float silu_f(float a) { return a / (1.0f + __expf(-a)); }
__device__ __forceinline__ int mod_of_row(int row) { return row < R_CTX ? 0 : (row < R_CTX + S_LAT ? 1 : 2); }

struct EpiStoreF32 {
    static constexpr bool PERM = false, AFTER_DRAIN = false;
    float* C; int ldc;
    __device__ __forceinline__ void operator()(const pg8::f32x4 (&acc)[2][2][4][2], const pg8::Unit& u, int wr, int wc, int fr, int fq) const {
        const int row0 = u.pm * 256 + wr * 64 + fr, col0 = u.pn * 256 + wc * 32 + 4 * fq;
#pragma unroll
        for (int ai = 0; ai < 2; ++ai)
#pragma unroll
            for (int m = 0; m < 4; ++m) { float* rowp = C + (size_t)(row0 + ai * 128 + m * 16) * ldc + col0;
#pragma unroll
                for (int bj = 0; bj < 2; ++bj)
#pragma unroll
                    for (int n = 0; n < 2; ++n) *(pg8::f32x4*)(rowp + bj * 128 + n * 16) = acc[ai][bj][m][n]; }
    }
};
struct EpiResid {
    static constexpr bool PERM = false, AFTER_DRAIN = false;
    const float* xa; const float* xb;
    const float* gates;
    float* out;
    __device__ __forceinline__ void operator()(const pg8::f32x4 (&acc)[2][2][4][2], const pg8::Unit& u, int wr, int wc, int fr, int fq) const {
        const int mod = u.pm >> 4;
        const float* xbase = (u.pm < 16) ? xa + (size_t)u.pm * 256 * DM : xb + (size_t)(u.pm - 16) * 256 * DM;
        const int r0 = wr * 64 + fr, col0 = u.pn * 256 + wc * 32 + 4 * fq;
        pg8::f32x4 gv[2][2];
#pragma unroll
        for (int bj = 0; bj < 2; ++bj)
#pragma unroll
            for (int n = 0; n < 2; ++n) gv[bj][n] = *(const pg8::f32x4*)(gates + (size_t)mod * 6 * DM + col0 + bj * 128 + n * 16);
#pragma unroll
        for (int ai = 0; ai < 2; ++ai)
#pragma unroll
            for (int m = 0; m < 4; ++m) { const int r = r0 + ai * 128 + m * 16;
                const float* xp = xbase + (size_t)r * DM + col0; float* op = out + ((size_t)u.pm * 256 + r) * DM + col0;
#pragma unroll
                for (int bj = 0; bj < 2; ++bj)
#pragma unroll
                    for (int n = 0; n < 2; ++n) { const pg8::f32x4 xv = *(const pg8::f32x4*)(xp + bj * 128 + n * 16);
                        *(pg8::f32x4*)(op + bj * 128 + n * 16) = xv * ALPHA + gv[bj][n] * acc[ai][bj][m][n]; } }
    }
};
struct EpiSwiGLU {
    static constexpr bool PERM = true, AFTER_DRAIN = false;
    bf16* act;
    __device__ __forceinline__ void operator()(const pg8::f32x4 (&acc)[2][2][4][2], const pg8::Unit& u, int wr, int wc, int fr, int fq) const {
        const int row0 = u.pm * 256 + wr * 64 + fr, col0 = u.pn * 128 + wc * 32 + 8 * fq;
#pragma unroll
        for (int ai = 0; ai < 2; ++ai)
#pragma unroll
            for (int m = 0; m < 4; ++m) { bf16* rowp = act + (size_t)(row0 + ai * 128 + m * 16) * DFF + col0;
                float r[8];
#pragma unroll
                for (int n = 0; n < 2; ++n)
#pragma unroll
                    for (int j = 0; j < 4; ++j) { const float g = acc[ai][0][m][n][j], up = acc[ai][1][m][n][j]; r[n * 4 + j] = silu_f(g) * up; }
                pg8::u32x4 w; w.x = pg8::cvt_pk_bf16(r[0], r[1]); w.y = pg8::cvt_pk_bf16(r[2], r[3]); w.z = pg8::cvt_pk_bf16(r[4], r[5]); w.w = pg8::cvt_pk_bf16(r[6], r[7]);
                *(pg8::u32x4*)rowp = w; }
    }
};

struct Args { const float* in[24]; float* out; unsigned char* ws; int ph_lo, ph_hi, single, pad; };
enum { I_XP = 0, I_XS, I_CDK, I_CDV, I_CSK, I_CSV, I_ST, I_C, I_CCTX, I_WMOD, I_BMOD, I_WIN, I_WOUT, I_DLAM, I_DNG, I_LBL, I_HNG, I_SINK, I_LN1G, I_LN1B, I_LN2G, I_LN2B, I_WGU, I_WDN };

struct Ctx {
    LAS unsigned char* lds; int tid, lane, wave, G, bid;
    const Args* ap; float* out; unsigned char* ws;
    __device__ __forceinline__ const float* inp(int i) const { return ap->in[i]; }
    __device__ __forceinline__ float* mods() const { return (float*)(ws + WS_MODS); }
    __device__ __forceinline__ float* lball() const { return (float*)(ws + WS_MISC); }
    __device__ __forceinline__ float* lamv() const { return (float*)(ws + WS_MISC + 16384); }
    __device__ __forceinline__ float* tabD() const { return (float*)(ws + WS_MISC + 20480); }
    __device__ __forceinline__ float* tabS() const { return (float*)(ws + WS_MISC + 32768); }
    __device__ __forceinline__ bf16* wT(int l, size_t off) const { return (bf16*)(ws + WS_W + (size_t)l * W_LAYER + off); }
    __device__ __forceinline__ bf16* hbuf() const { return (bf16*)(ws + WS_H); }
    __device__ __forceinline__ bf16* cat() const { return (bf16*)(ws + WS_CAT); }
    __device__ __forceinline__ float* x1() const { return (float*)(ws + WS_X1); }
    __device__ __forceinline__ float* oa() const { return (float*)(ws + WS_OA); }
    __device__ __forceinline__ float* obf() const { return (float*)(ws + WS_OBF); }
    __device__ __forceinline__ float* obb() const { return (float*)(ws + WS_OBB); }
    __device__ __forceinline__ float* proj() const { return (float*)(ws + WS_P); }
    __device__ __forceinline__ bf16* act() const { return (bf16*)(ws + WS_ACT); }
    __device__ __forceinline__ float* ypre() const { return (float*)(ws + WS_YPRE); }
};

__device__ __forceinline__ void transpose_item(const float* W, int K, int N, bf16* WT, int k0, int n0, int drow0, LAS float* scr, int lane) {
#pragma unroll 8
    for (int i = 0; i < 32; ++i) { const int kk = 2 * i + (lane >> 5); scr[kk * 33 + (lane & 31)] = W[(size_t)(k0 + kk) * N + n0 + (lane & 31)]; }
    LDS_WAIT(); asm volatile("" ::: "memory");
    const int c = lane & 7;
#pragma unroll
    for (int j = 0; j < 4; ++j) { const int n = (lane >> 3) + 8 * j; const LAS float* s = scr + (8 * c) * 33 + n;
        v4u o; o.x = pk2(s[0 * 33], s[1 * 33]); o.y = pk2(s[2 * 33], s[3 * 33]); o.z = pk2(s[4 * 33], s[5 * 33]); o.w = pk2(s[6 * 33], s[7 * 33]);
        *(v4u*)(WT + (size_t)(drow0 + n) * K + k0 + 8 * c) = o; }
    LDS_WAIT(); asm volatile("" ::: "memory");
}

__device__ __forceinline__ void p0_prologue(const Ctx& F) {
    {
        LAS float* sc = (LAS float*)F.lds;
        LAS float* red = (LAS float*)(F.lds + 24576);
        const float* c_ctx = F.inp(I_CCTX); const float* cc = F.inp(I_C);
        for (int i = F.tid; i < 3 * DM; i += 512) { const int mid = i / DM, k = i % DM; const float c = mid == 0 ? c_ctx[k] : cc[(mid - 1) * DM + k]; sc[i] = silu_f(c); }
        __syncthreads();
        for (int task = F.bid; task < DEPTH * 48; task += F.G) {
            const int l = task / 48, cb = task % 48, w = F.wave;
            const float* wp = F.inp(I_WMOD) + ((size_t)l * DM + 256 * w) * (6 * DM) + cb * 256 + F.lane * 4;
            f32x4 a0 = {0.f, 0.f, 0.f, 0.f}, a1 = a0, a2 = a0;
#pragma unroll 8
            for (int kk = 0; kk < 256; ++kk) { const f32x4 wv = *(const f32x4*)(wp + (size_t)kk * (6 * DM));
                a0 += wv * sc[256 * w + kk]; a1 += wv * sc[DM + 256 * w + kk]; a2 += wv * sc[2 * DM + 256 * w + kk]; }
            *(LAS f32x4*)(red + (w * 3 + 0) * 256 + F.lane * 4) = a0; *(LAS f32x4*)(red + (w * 3 + 1) * 256 + F.lane * 4) = a1; *(LAS f32x4*)(red + (w * 3 + 2) * 256 + F.lane * 4) = a2;
            __syncthreads();
            for (int i = F.tid; i < 768; i += 512) { const int m = i >> 8, c = i & 255; float s = 0.f;
#pragma unroll
                for (int ww = 0; ww < 8; ++ww) s += red[(ww * 3 + m) * 256 + c];
                F.mods()[((size_t)l * 3 + m) * (6 * DM) + cb * 256 + c] = s + F.inp(I_BMOD)[(size_t)l * 6 * DM + cb * 256 + c]; }
            __syncthreads();
        }
    }
    if (F.bid == F.G - 1) {
        const float* lbl = F.inp(I_LBL);
        for (int i = F.tid; i < 1024; i += 512) { float lg[4], mx = -1e30f;
#pragma unroll
            for (int l = 0; l < 4; ++l) { lg[l] = lbl[l * 1024 + i]; mx = fmaxf(mx, lg[l]); }
            float s = 0.f;
#pragma unroll
            for (int l = 0; l < 4; ++l) { lg[l] = expf(lg[l] - mx); s += lg[l]; }
            const float w1 = lg[1] / s, w2 = lg[2] / s, w3 = lg[3] / s;
            F.lball()[0 * 1024 + i] = 0.f; F.lball()[1 * 1024 + i] = w1; F.lball()[2 * 1024 + i] = w1 + w2; F.lball()[3 * 1024 + i] = w1 + w2 + w3; }
        if (F.tid < 4) { const int l = F.tid; const float* lp = F.inp(I_DLAM) + l * 256; float s1 = 0.f, s2 = 0.f;
            for (int i = 0; i < 64; ++i) { s1 += lp[i] * lp[64 + i]; s2 += lp[128 + i] * lp[192 + i]; }
            const float li = 0.8f - 0.6f * expf(-0.3f * (float)l);
            F.lamv()[l * 2] = expf(s1) - expf(s2) + li; F.lamv()[l * 2 + 1] = li; }
        for (int i = F.tid; i < 64 * 16; i += 512) { const int pos = i / 16, j = i % 16; const float inv = powf(10000.f, -(float)j / 16.f), ang = (float)pos * inv; F.tabD()[i * 2] = cosf(ang); F.tabD()[i * 2 + 1] = sinf(ang); }
        for (int i = F.tid; i < 64 * 32; i += 512) { const int pos = i / 32, j = i % 32; const float inv = powf(10000.f, -(float)j / 32.f), ang = (float)pos * inv; F.tabS()[i * 2] = cosf(ang); F.tabS()[i * 2 + 1] = sinf(ang); }
    }
    {
        LAS float* scr = (LAS float*)(F.lds + 49152 + F.wave * 8448);
        const int gw = F.bid * 8 + F.wave, NGW = F.G * 8;
        constexpr int I_IN = 32 * 176, I_OUT = 32 * 64, I_GU = 32 * 352, I_DN = 88 * 64, I_L = I_IN + I_OUT + I_GU + I_DN;
        for (int it = gw; it < DEPTH * I_L; it += NGW) {
            const int l = it / I_L; int r = it % I_L;
            if (r < I_IN) { const int kb = r / 176, nb = r % 176; transpose_item(F.inp(I_WIN) + (size_t)l * DM * DIN, DM, DIN, F.wT(l, WO_IN), 64 * kb, 32 * nb, 32 * nb, scr, F.lane); continue; } r -= I_IN;
            if (r < I_OUT) { const int kb = r / 64, nb = r % 64; transpose_item(F.inp(I_WOUT) + (size_t)l * DM * DM, DM, DM, F.wT(l, WO_OUT), 64 * kb, 32 * nb, 32 * nb, scr, F.lane); continue; } r -= I_OUT;
            if (r < I_GU) { const int kb = r / 352, nb = r % 352, n0 = 32 * nb; const int j = n0 < DFF ? n0 : n0 - DFF; const int drow = 256 * (j >> 7) + (n0 < DFF ? 0 : 128) + (j & 127);
                transpose_item(F.inp(I_WGU) + (size_t)l * DM * DGU, DM, DGU, F.wT(l, WO_GU), 64 * kb, n0, drow, scr, F.lane); continue; } r -= I_GU;
            { const int kb = r / 64, nb = r % 64; transpose_item(F.inp(I_WDN) + (size_t)l * DFF * DM, DFF, DM, F.wT(l, WO_DN), 64 * kb, 32 * nb, 32 * nb, scr, F.lane); }
        }
    }
}

__device__ __forceinline__ void p1_h0(const Ctx& F) {
    const float* xp = F.inp(I_XP); const float* xs = F.inp(I_XS);
    for (int idx = F.bid * 512 + F.tid; idx < MROWS * 256; idx += F.G * 512) {
        const int row = idx >> 8, c8 = (idx & 255) * 8, mod = mod_of_row(row);
        const float* xr = row < R_CTX ? xp + (size_t)row * DM : xs + (size_t)(row - R_CTX) * DM;
        const float* sh = F.mods() + (size_t)(0 * 3 + mod) * 6 * DM; const float* sc = sh + DM;
        const f32x4 x0 = *(const f32x4*)(xr + c8), x1 = *(const f32x4*)(xr + c8 + 4), s0 = *(const f32x4*)(sh + c8), s1 = *(const f32x4*)(sh + c8 + 4), c0 = *(const f32x4*)(sc + c8), c1 = *(const f32x4*)(sc + c8 + 4);
        const f32x4 h0 = x0 * (c0 + 1.0f) + s0, h1 = x1 * (c1 + 1.0f) + s1;
        v4u o; o.x = pk2(h0[0], h0[1]); o.y = pk2(h0[2], h0[3]); o.z = pk2(h1[0], h1[1]); o.w = pk2(h1[2], h1[3]);
        *(v4u*)(F.hbuf() + (size_t)row * DM + c8) = o;
    }
}

__device__ __forceinline__ void e1_postproj(const Ctx& F, int l) {
    const float* lb = F.lball() + l * 1024;
    for (int row = F.bid; row < MROWS; row += F.G) {
        float* pr = F.proj() + (size_t)row * DIN;
        { const int c = F.tid; pr[C_BQ + c] = silu_f(pr[C_BQ + c]); }
        for (int c = F.tid; c < 1024; c += 512) { const float z = pr[C_BF + c], lbv = lb[c]; const float sg = 1.0f / (1.0f + expf(-z)); pr[C_BF + c] = logf(fmaxf(lbv, 1e-30f) + (1.0f - lbv) * sg); }
        if (row < R_CTX) {
            const int b = row >> 8, n = row & 255;
            for (int i = F.tid; i < 384; i += 512) {
                if (i < 128) { const int h = i >> 5, c4 = (i & 31) * 4; *(f32x4*)(F.out + O_DK + ((((size_t)b * 4 + l) * 4 + h) * 256 + n) * 128 + c4) = *(const f32x4*)(pr + C_AK + h * 128 + c4); }
                else if (i < 256) { const int ii = i - 128, h = ii >> 5, c4 = (ii & 31) * 4; *(f32x4*)(F.out + O_DV + ((((size_t)b * 4 + l) * 4 + h) * 256 + n) * 128 + c4) = *(const f32x4*)(pr + C_AV + h * 128 + c4); }
                else if (i < 320) { const int ii = i - 256, kv = ii >> 5, c4 = (ii & 31) * 4; *(f32x4*)(F.out + O_SK + ((((size_t)b * 4 + l) * 2 + kv) * 256 + n) * 128 + c4) = *(const f32x4*)(pr + C_CK + kv * 128 + c4); }
                else { const int ii = i - 320, kv = ii >> 5, c4 = (ii & 31) * 4; *(f32x4*)(F.out + O_SV + ((((size_t)b * 4 + l) * 2 + kv) * 256 + n) * 128 + c4) = *(const f32x4*)(pr + C_CV + kv * 128 + c4); }
            }
        } else {
            const int t = (row - R_CTX) & (S_LAT - 1), rpos = t >> 6, cpos = t & 63;
            { const int p = F.tid, blk = p >> 4, i = p & 15, cb = blk * 32, pos = (blk & 1) ? cpos : rpos;
              const float cs = F.tabD()[(pos * 16 + i) * 2], sn = F.tabD()[(pos * 16 + i) * 2 + 1]; const float x1 = pr[cb + i], x2 = pr[cb + 16 + i];
              pr[cb + i] = x1 * cs - x2 * sn; pr[cb + 16 + i] = x2 * cs + x1 * sn; }
            for (int p = F.tid; p < 640; p += 512) { const int blk = p >> 5, i = p & 31, cb = C_CQ + blk * 64, pos = (blk & 1) ? cpos : rpos;
              const float cs = F.tabS()[(pos * 32 + i) * 2], sn = F.tabS()[(pos * 32 + i) * 2 + 1]; const float x1 = pr[cb + i], x2 = pr[cb + 32 + i];
              pr[cb + i] = x1 * cs - x2 * sn; pr[cb + 32 + i] = x2 * cs + x1 * sn; }
        }
    }
}

struct KVSeg { const float* k; const float* v; int stride; int count; int pos0; int pad; };

template <bool DIFF>
__device__ __forceinline__ void attn_valu(const Ctx& F, const float* qbase, int qstride, const KVSeg s0, const KVSeg s1, bool band, int qpos0,
                                          float m_init, float l_init, float scale, float lam, float* out_f32, bf16* out_bf) {
    const int part = F.lane >> 5, half = DIFF ? (F.wave & 1) : part, qi = DIFF ? ((F.wave >> 1) * 32 + (F.lane & 31)) : (F.wave * 32 + (F.lane & 31));
    LAS float* sK = (LAS float*)F.lds; LAS float* sV = sK + 64 * 128;
    float q[64];
    { const float* qp = qbase + (size_t)qi * qstride + part * 64;
#pragma unroll
      for (int i = 0; i < 16; ++i) { const f32x4 t = *(const f32x4*)(qp + 4 * i); q[4 * i] = t[0] * scale; q[4 * i + 1] = t[1] * scale; q[4 * i + 2] = t[2] * scale; q[4 * i + 3] = t[3] * scale; } }
    float o[64];
#pragma unroll
    for (int i = 0; i < 64; ++i) o[i] = 0.f;
    float m = m_init, l = l_init;
    const int qpos = qpos0 + qi;
    for (int seg = 0; seg < 2; ++seg) {
        const float* kp = seg ? s1.k : s0.k; const float* vp = seg ? s1.v : s0.v; const int stride = seg ? s1.stride : s0.stride, count = seg ? s1.count : s0.count, pos0 = seg ? s1.pos0 : s0.pos0;
        const bool masked = band && seg == 0;
        for (int j0 = 0; j0 < count; j0 += 64) {
            __syncthreads();
#pragma unroll
            for (int i = 0; i < 4; ++i) { const int idx = F.tid + 512 * i, r = idx >> 5, c4 = (idx & 31) * 4; f32x4 kv = {0.f, 0.f, 0.f, 0.f}, vv = kv;
                if (j0 + r < count) { kv = *(const f32x4*)(kp + (size_t)(j0 + r) * stride + c4); vv = *(const f32x4*)(vp + (size_t)(j0 + r) * stride + c4); }
                *(LAS f32x4*)(sK + r * 128 + c4) = kv; *(LAS f32x4*)(sV + r * 128 + c4) = vv; }
            __syncthreads();
            const int jn = (count - j0) < 64 ? (count - j0) : 64;
            for (int j = 0; j < jn; ++j) {
                const LAS float* kr = sK + j * 128 + part * 64;
                float s = 0.f;
#pragma unroll
                for (int i = 0; i < 16; ++i) { const f32x4 kk = *(const LAS f32x4*)(kr + 4 * i); s += q[4 * i] * kk[0] + q[4 * i + 1] * kk[1] + q[4 * i + 2] * kk[2] + q[4 * i + 3] * kk[3]; }
                if (!DIFF) s += __shfl_xor(s, 32);
                if (masked) { const int d = qpos - (pos0 + j0 + j); if (d > 128 || d < -128) s = -1e30f; }
                if (s > m) { const float a = __expf(m - s); l *= a;
#pragma unroll
                    for (int i = 0; i < 64; ++i) o[i] *= a;
                    m = s; }
                const float p = __expf(s - m); l += p;
                const LAS float* vr = sV + j * 128 + half * 64;
#pragma unroll
                for (int i = 0; i < 16; ++i) { const f32x4 vv = *(const LAS f32x4*)(vr + 4 * i); o[4 * i] += p * vv[0]; o[4 * i + 1] += p * vv[1]; o[4 * i + 2] += p * vv[2]; o[4 * i + 3] += p * vv[3]; }
            }
        }
    }
    const float inv = 1.0f / l;
    if (DIFF) {
        float* op = out_f32 + (size_t)qi * 512 + half * 64;
#pragma unroll
        for (int i4 = 0; i4 < 16; ++i4) { f32x4 r;
#pragma unroll
            for (int j = 0; j < 4; ++j) { const float x = o[4 * i4 + j] * inv, y = __shfl_xor(x, 32); r[j] = part ? (y - lam * x) : (x - lam * y); }
            if ((i4 >> 3) == part) *(f32x4*)(op + 4 * i4) = r; }
    } else {
        bf16* op = out_bf + (size_t)qi * DM + part * 64;
#pragma unroll
        for (int i8 = 0; i8 < 8; ++i8) { v4u w; w.x = pk2(o[8 * i8] * inv, o[8 * i8 + 1] * inv); w.y = pk2(o[8 * i8 + 2] * inv, o[8 * i8 + 3] * inv); w.z = pk2(o[8 * i8 + 4] * inv, o[8 * i8 + 5] * inv); w.w = pk2(o[8 * i8 + 6] * inv, o[8 * i8 + 7] * inv);
            *(v4u*)(op + 8 * i8) = w; }
    }
}

__device__ __forceinline__ void hgrn_valu(const Ctx& F, int row0, int N, int h, int dir, int slice, const float* s_in, float* s_out, float* ob) {
    const int c = F.lane >> 5, r4 = (F.lane & 31) * 4, v = slice * 16 + F.wave * 2 + c;
    float S0 = 0.f, S1 = 0.f, S2 = 0.f, S3 = 0.f;
    if (s_in) { S0 = s_in[(r4 + 0) * 128 + v]; S1 = s_in[(r4 + 1) * 128 + v]; S2 = s_in[(r4 + 2) * 128 + v]; S3 = s_in[(r4 + 3) * 128 + v]; }
    const float* pj = F.proj();
    const float* qp = pj + C_BQ + h * 128 + r4; const float* lf = pj + C_BF + dir * 512 + h * 128 + r4; const float* vp = pj + C_BI + h * 128 + v;
#pragma unroll 4
    for (int step = 0; step < N; ++step) {
        const int t = dir ? (N - 1 - step) : step; const size_t ro = (size_t)(row0 + t) * DIN;
        const f32x4 q4 = *(const f32x4*)(qp + ro), g4 = *(const f32x4*)(lf + ro); const float vv = vp[ro];
        const float f0 = __expf(g4[0]), f1 = __expf(g4[1]), f2 = __expf(g4[2]), f3 = __expf(g4[3]);
        S0 = f0 * S0 + (1.0f - f0) * vv; S1 = f1 * S1 + (1.0f - f1) * vv; S2 = f2 * S2 + (1.0f - f2) * vv; S3 = f3 * S3 + (1.0f - f3) * vv;
        float p = q4[0] * S0 + q4[1] * S1 + q4[2] * S2 + q4[3] * S3;
        p += __shfl_xor(p, 1); p += __shfl_xor(p, 2); p += __shfl_xor(p, 4); p += __shfl_xor(p, 8); p += __shfl_xor(p, 16);
        if ((F.lane & 31) == 0) ob[(size_t)(row0 + t) * 512 + h * 128 + v] = p;
    }
    if (s_out) { s_out[(r4 + 0) * 128 + v] = S0; s_out[(r4 + 1) * 128 + v] = S1; s_out[(r4 + 2) * 128 + v] = S2; s_out[(r4 + 3) * 128 + v] = S3; }
}

__device__ __forceinline__ void mx_mixers(const Ctx& F, int l) {
    const float* pj = F.proj();
    const float lam = F.lamv()[l * 2];
    constexpr int T_LD = 256, T_LH = 128, T_LB = 256, T_CD = 128, T_CS = 128, T_CH = 1024;
    constexpr int NT = T_LD + T_LH + T_LB + T_CD + T_CS + T_CH;
    const KVSeg none = {nullptr, nullptr, 0, 0, 0, 0};
    for (int task = F.bid; task < NT; task += F.G) {
        int i = task;
        if (i < T_LD) {
            const int b = i >> 7, h = (i >> 5) & 3, qt = i & 31; const int rb = R_CTX + b * S_LAT, row0 = rb + qt * 128;
            const KVSeg s0 = {pj + (size_t)rb * DIN + C_AK + h * 128, pj + (size_t)rb * DIN + C_AV + h * 128, DIN, S_LAT, 0, 0};
            const size_t co = (((size_t)b * 4 + l) * 4 + h) * 256 * 128;
            const KVSeg s1 = {F.inp(I_CDK) + co, F.inp(I_CDV) + co, 128, 256, 0, 0};
            attn_valu<true>(F, pj + (size_t)row0 * DIN + C_AQ + h * 128, DIN, s0, s1, false, 0, -1e30f, 0.f, 0.125f, lam, F.oa() + (size_t)row0 * 512 + h * 128, nullptr);
            continue; } i -= T_LD;
        if (i < T_LH) {
            const int b = i >> 6, h = (i >> 4) & 3, dir = (i >> 3) & 1, sl = i & 7;
            const float* sin_ = F.inp(I_ST) + ((((size_t)b * 4 + l) * 2 + dir) * 4 + h) * 128 * 128;
            hgrn_valu(F, R_CTX + b * S_LAT, S_LAT, h, dir, sl, sin_, nullptr, dir ? F.obb() : F.obf());
            continue; } i -= T_LH;
        if (i < T_LB) {
            const int b = i >> 7, hh = (i >> 4) & 7, qt = i & 15, kv = hh >> 2; const int rb = R_CTX + b * S_LAT, t0 = qt * 256, row0 = rb + t0;
            const int ks = t0 - 128 < 0 ? 0 : t0 - 128, ke = t0 + 384 > S_LAT ? S_LAT : t0 + 384;
            const KVSeg s0 = {pj + (size_t)(rb + ks) * DIN + C_CK + kv * 128, pj + (size_t)(rb + ks) * DIN + C_CV + kv * 128, DIN, ke - ks, ks, 0};
            const size_t co = (((size_t)b * 4 + l) * 2 + kv) * 256 * 128;
            const KVSeg s1 = {F.inp(I_CSK) + co, F.inp(I_CSV) + co, 128, 256, 0, 0};
            attn_valu<false>(F, pj + (size_t)row0 * DIN + C_CQ + hh * 128, DIN, s0, s1, true, t0, F.inp(I_SINK)[l * 8 + hh], 1.0f, 0.08838834764831845f, 0.f, nullptr, F.cat() + (size_t)row0 * DM + 1024 + hh * 128);
            continue; } i -= T_LB;
        if (i < T_CD) {
            const int b = i >> 3, h = (i >> 1) & 3, qt = i & 1, rb = b * 256, row0 = rb + qt * 128;
            const KVSeg s0 = {pj + (size_t)rb * DIN + C_AK + h * 128, pj + (size_t)rb * DIN + C_AV + h * 128, DIN, 256, 0, 0};
            attn_valu<true>(F, pj + (size_t)row0 * DIN + C_AQ + h * 128, DIN, s0, none, false, 0, -1e30f, 0.f, 0.125f, lam, F.oa() + (size_t)row0 * 512 + h * 128, nullptr);
            continue; } i -= T_CD;
        if (i < T_CS) {
            const int b = i >> 3, hh = i & 7, kv = hh >> 2, row0 = b * 256;
            const KVSeg s0 = {pj + (size_t)row0 * DIN + C_CK + kv * 128, pj + (size_t)row0 * DIN + C_CV + kv * 128, DIN, 256, 0, 0};
            attn_valu<false>(F, pj + (size_t)row0 * DIN + C_CQ + hh * 128, DIN, s0, none, false, 0, F.inp(I_SINK)[l * 8 + hh], 1.0f, 0.08838834764831845f, 0.f, nullptr, F.cat() + (size_t)row0 * DM + 1024 + hh * 128);
            continue; } i -= T_CS;
        {
            const int b = i >> 6, h = (i >> 4) & 3, dir = (i >> 3) & 1, sl = i & 7;
            float* sout = F.out + O_ST + ((((size_t)b * 4 + l) * 2 + dir) * 4 + h) * 128 * 128;
            hgrn_valu(F, b * 256, 256, h, dir, sl, nullptr, sout, dir ? F.obb() : F.obf());
        }
    }
}

__device__ __forceinline__ void mg_merge(const Ctx& F, int l) {
    const float lam_init = F.lamv()[l * 2 + 1];
    const int vec = F.lane >> 3, sub = F.lane & 7, head = vec & 3, isB = vec >> 2, col0 = head * 128 + sub * 16;
    for (int row = F.bid * 8 + F.wave; row < MROWS; row += F.G * 8) {
        float x[16];
        if (!isB) {
#pragma unroll
            for (int i = 0; i < 4; ++i) { const f32x4 t = *(const f32x4*)(F.oa() + (size_t)row * 512 + col0 + 4 * i); x[4 * i] = t[0]; x[4 * i + 1] = t[1]; x[4 * i + 2] = t[2]; x[4 * i + 3] = t[3]; }
        } else {
#pragma unroll
            for (int i = 0; i < 4; ++i) { const f32x4 t = *(const f32x4*)(F.obf() + (size_t)row * 512 + col0 + 4 * i) + *(const f32x4*)(F.obb() + (size_t)row * 512 + col0 + 4 * i); x[4 * i] = t[0]; x[4 * i + 1] = t[1]; x[4 * i + 2] = t[2]; x[4 * i + 3] = t[3]; }
        }
        float ss = 0.f;
#pragma unroll
        for (int i = 0; i < 16; ++i) ss += x[i] * x[i];
        ss += __shfl_xor(ss, 1); ss += __shfl_xor(ss, 2); ss += __shfl_xor(ss, 4);
        const float rinv = 1.0f / sqrtf(ss * (1.0f / 128.0f) + 1e-6f);
        float y[16];
        if (!isB) { const float* g = F.inp(I_DNG) + l * 128 + sub * 16; const float sc = rinv * (1.0f - lam_init);
#pragma unroll
            for (int i = 0; i < 16; ++i) y[i] = x[i] * sc * g[i];
        } else { const float* g = F.inp(I_HNG) + l * 128 + sub * 16; const float* hg = F.proj() + (size_t)row * DIN + C_BG + col0;
#pragma unroll
            for (int i = 0; i < 16; ++i) y[i] = x[i] * rinv * g[i] * silu_f(hg[i]);
        }
        bf16* op = F.cat() + (size_t)row * DM + isB * 512 + col0;
        v4u w0, w1; w0.x = pk2(y[0], y[1]); w0.y = pk2(y[2], y[3]); w0.z = pk2(y[4], y[5]); w0.w = pk2(y[6], y[7]); w1.x = pk2(y[8], y[9]); w1.y = pk2(y[10], y[11]); w1.z = pk2(y[12], y[13]); w1.w = pk2(y[14], y[15]);
        *(v4u*)op = w0; *(v4u*)(op + 8) = w1;
    }
}

__device__ __forceinline__ void ln_phase(const Ctx& F, const float* g, const float* b, float* xo, const float* modsl  , int which_sh) {
    for (int row = F.bid * 8 + F.wave; row < MROWS; row += F.G * 8) {
        const float* yp = F.ypre() + (size_t)row * DM + F.lane * 4;
        f32x4 v[8]; float s = 0.f;
#pragma unroll
        for (int j = 0; j < 8; ++j) { v[j] = *(const f32x4*)(yp + 256 * j); s += (v[j][0] + v[j][1]) + (v[j][2] + v[j][3]); }
#pragma unroll
        for (int o = 1; o < 64; o <<= 1) s += __shfl_xor(s, o);
        const float mean = s * (1.0f / DM); float s2 = 0.f;
#pragma unroll
        for (int j = 0; j < 8; ++j) { v[j] = v[j] - mean; s2 += (v[j][0] * v[j][0] + v[j][1] * v[j][1]) + (v[j][2] * v[j][2] + v[j][3] * v[j][3]); }
#pragma unroll
        for (int o = 1; o < 64; o <<= 1) s2 += __shfl_xor(s2, o);
        const float rstd = 1.0f / sqrtf(s2 * (1.0f / DM) + 1e-5f);
        const int mod = mod_of_row(row);
        const float* sh = modsl ? modsl + ((size_t)mod * 6 + which_sh) * DM : nullptr;
#pragma unroll
        for (int j = 0; j < 8; ++j) { const int c = F.lane * 4 + 256 * j;
            const f32x4 x = v[j] * rstd * *(const f32x4*)(g + c) + *(const f32x4*)(b + c);
            *(f32x4*)(xo + (size_t)row * DM + c) = x;
            if (modsl) { const f32x4 hh = x * (*(const f32x4*)(sh + DM + c) + 1.0f) + *(const f32x4*)(sh + c);
                v2u w; w.x = pk2(hh[0], hh[1]); w.y = pk2(hh[2], hh[3]); *(v2u*)(F.hbuf() + (size_t)row * DM + c) = w; } }
    }
}

constexpr int PH_PER_LAYER = 9, N_PHASES = 2 + DEPTH * PH_PER_LAYER;
__global__ void __launch_bounds__(512, 2) fwd_kernel(Args args) {
    extern __shared__ __attribute__((aligned(16))) unsigned char lds_raw[];
    Ctx F;
    F.lds = (LAS unsigned char*)lds_raw;
    F.tid = threadIdx.x; F.lane = F.tid & 63; F.wave = __builtin_amdgcn_readfirstlane(F.tid >> 6); F.G = gridDim.x; F.bid = blockIdx.x;
    F.ap = &args; F.out = args.out; F.ws = args.ws;
    volatile LAS unsigned* MISC = (volatile LAS unsigned*)(F.lds + MISC_OFF);
    for (int u = F.tid; u < (LDS_BYTES - LDSCTL_OFF) / 4; u += 512) ((LAS unsigned*)(F.lds + LDSCTL_OFF))[u] = 0u;
    __syncthreads();
    XcdBarrier bar; bar.bar = (unsigned*)(args.ws + WS_CTL) + CW_BAR; bar.x = 0; bar.st = nullptr;
    if (args.single) bar = xcd_barrier_post((unsigned*)(args.ws + WS_CTL) + CW_BAR, MISC + 8);
    const int lo = args.ph_lo, hi = args.ph_hi;
#define IN(k) (lo <= (k) && (k) < hi)
#define FRESH() do { int ln_ = (int)__builtin_amdgcn_mbcnt_hi(~0u, __builtin_amdgcn_mbcnt_lo(~0u, 0u)); asm volatile("" : "+v"(ln_)); F.lane = ln_; asm volatile("" : "+s"(F.wave)); F.tid = F.wave * 64 + F.lane; \
    asm volatile("" : "+s"(F.bid), "+s"(F.G)); asm volatile("" : "+s"(F.ws), "+s"(F.out)); } while (0)
#define SEAM(k) do { if (IN((k) + 1)) xcd_barrier(bar); } while (0)

    if (IN(0)) { FRESH(); p0_prologue(F); SEAM(0); }
    if (IN(1)) { FRESH(); p1_h0(F); SEAM(1); }
    for (int l = 0; l < DEPTH; ++l) {
        const int k0 = 2 + l * PH_PER_LAYER;
        FRESH();
        const float* xa = l == 0 ? F.inp(I_XP) : F.out + O_YP; const float* xb = l == 0 ? F.inp(I_XS) : F.out + O_YS;
        if (IN(k0 + 0)) {
            pg8::Gemm g{F.hbuf(), F.wT(l, WO_IN), MROWS, DIN, DM}; pg8::StaticOrder S; S.init(MROWS, DIN, F.G, F.bid);
            EpiStoreF32 E{F.proj(), DIN};
            pg8::gemm_phase<EpiStoreF32, pg8::StaticOrder, true, true>(F.lds, g, S, E, F.wave);
            SEAM(k0 + 0); }
        if (IN(k0 + 1)) { FRESH(); e1_postproj(F, l); SEAM(k0 + 1); }
        if (IN(k0 + 2)) { FRESH(); mx_mixers(F, l); SEAM(k0 + 2); }
        if (IN(k0 + 3)) { FRESH(); mg_merge(F, l); SEAM(k0 + 3); }
        if (IN(k0 + 4)) {
            pg8::Gemm g{F.cat(), F.wT(l, WO_OUT), MROWS, DM, DM}; pg8::StaticOrder S; S.init(MROWS, DM, F.G, F.bid);
            EpiResid E{xa, xb, F.mods() + ((size_t)l * 3 * 6 + 2) * DM, F.ypre()};
            pg8::gemm_phase<EpiResid, pg8::StaticOrder, true, true>(F.lds, g, S, E, F.wave);
            SEAM(k0 + 4); }
        if (IN(k0 + 5)) { FRESH(); ln_phase(F, F.inp(I_LN1G) + l * DM, F.inp(I_LN1B) + l * DM, F.x1(), F.mods() + (size_t)l * 3 * 6 * DM, 3); SEAM(k0 + 5); }
        if (IN(k0 + 6)) {
            pg8::Gemm g{F.hbuf(), F.wT(l, WO_GU), MROWS, DGU, DM}; pg8::StaticOrder S; S.init(MROWS, DGU, F.G, F.bid);
            EpiSwiGLU E{F.act()};
            pg8::gemm_phase<EpiSwiGLU, pg8::StaticOrder, true, true>(F.lds, g, S, E, F.wave);
            SEAM(k0 + 6); }
        if (IN(k0 + 7)) {
            pg8::Gemm g{F.act(), F.wT(l, WO_DN), MROWS, DM, DFF}; pg8::StaticOrder S; S.init(MROWS, DM, F.G, F.bid);
            EpiResid E{F.x1(), F.x1() + (size_t)R_CTX * DM, F.mods() + ((size_t)l * 3 * 6 + 5) * DM, F.ypre()};
            pg8::gemm_phase<EpiResid, pg8::StaticOrder, true, true>(F.lds, g, S, E, F.wave);
            SEAM(k0 + 7); }
        if (IN(k0 + 8)) { FRESH(); ln_phase(F, F.inp(I_LN2G) + l * DM, F.inp(I_LN2B) + l * DM, F.out + O_YP, l + 1 < DEPTH ? F.mods() + (size_t)(l + 1) * 3 * 6 * DM : nullptr, 0); SEAM(k0 + 8); }
    }
#undef IN
#undef SEAM
#undef FRESH
}

#ifndef MK_SINGLE
#define MK_SINGLE 1
#endif
extern "C" void kernel_launch(void* const* d_in, const int* in_sizes, int n_in, void* d_out, int out_size, void* d_ws, size_t ws_size, hipStream_t stream) {
    static int grid = 0;
    if (grid == 0) {
        if (n_in != 24 || out_size != (int)O_END || ws_size < WS_END) { fprintf(stderr, "kernel_launch: unexpected sizes n_in %d out %d ws %zu\n", n_in, out_size, ws_size); grid = -1; return; }
        int dev = 0, cus = 0, per_cu = 0;
        if (hipGetDevice(&dev) != hipSuccess || hipDeviceGetAttribute(&cus, hipDeviceAttributeMultiprocessorCount, dev) != hipSuccess) { grid = -1; return; }
        if (hipFuncSetAttribute((const void*)fwd_kernel, hipFuncAttributeMaxDynamicSharedMemorySize, LDS_BYTES) != hipSuccess) { fprintf(stderr, "kernel_launch: hipFuncSetAttribute failed\n"); grid = -1; return; }
        if (hipOccupancyMaxActiveBlocksPerMultiprocessor(&per_cu, (const void*)fwd_kernel, 512, LDS_BYTES) != hipSuccess || per_cu < 1) fprintf(stderr, "kernel_launch: occupancy query says %d\n", per_cu);
        (void)hipGetLastError();
        grid = cus;
    }
    if (grid < 0) return;
    (void)hipMemsetAsync((char*)d_ws + WS_CTL, 0, CTL_ZERO_BYTES, stream);
    Args a{};
    for (int i = 0; i < 24; ++i) a.in[i] = (const float*)d_in[i];
    a.out = (float*)d_out; a.ws = (unsigned char*)d_ws; a.pad = 0;
#if MK_SINGLE
    a.ph_lo = 0; a.ph_hi = N_PHASES; a.single = 1;
    hipLaunchKernelGGL(fwd_kernel, dim3(grid), dim3(512), LDS_BYTES, stream, a);
#else
    a.single = 0;
    for (int p = 0; p < N_PHASES; ++p) { a.ph_lo = p; a.ph_hi = p + 1; hipLaunchKernelGGL(fwd_kernel, dim3(grid), dim3(512), LDS_BYTES, stream, a); }
#endif
}
```

```cpp
#include <hip/hip_runtime.h>
#include <cstdio>
#include <cstdint>
namespace pg8 {
#define PG8_LAS __attribute__((address_space(3)))
typedef unsigned short bf16_t;
typedef short bf16x8 __attribute__((ext_vector_type(8)));
typedef float f32x4 __attribute__((ext_vector_type(4)));
typedef unsigned u32x4 __attribute__((ext_vector_type(4)));
constexpr int BM = 256, BK = 64, HALF = 128, HTB = HALF * BK * 2  , STAGE_BYTES = 8 * HTB, NXCD = 8, WGM = 8;

__host__ __device__ __forceinline__ int lds_byte(int r, int c) { const int st = (r >> 4) * 2 + (c >> 5), rr = r & 15, cc = c & 31, ob = rr * 64 + cc * 2; return st * 1024 + (ob ^ (((ob >> 9) & 1) << 5)); }
__host__ __device__ __forceinline__ void stage_rc(int b, int& R, int& C) { const int st = b / 1024, sb = b % 1024, swz = sb ^ (((sb >> 9) & 1) << 5); R = (st >> 1) * 16 + swz / 64; C = (st & 1) * 32 + (swz % 64) / 2; }
__host__ __device__ __forceinline__ int perm32(int rho) { const int n = rho >> 4, i = rho & 15; return 8 * (i >> 2) + 4 * n + (i & 3); }

struct Unit { int pm, pn; };
struct Gemm { const bf16_t* A; const bf16_t* Bt; int M, N, K; };

struct StaticOrder {
    int nM, nN, nwg, G, c;
    __host__ __device__ void init(int M, int N, int G_, int c_) { nM = M / BM; nN = N / BM; nwg = nM * nN; G = G_; c = c_; }
    __host__ __device__ bool next(int i, Unit& u) const {
        const long L = (long)i * G + c; if (L >= nwg) return false;
        int wgid = (int)L; { const int q = nwg / NXCD, r = nwg % NXCD, xcd = wgid % NXCD, off = wgid / NXCD; wgid = (xcd < r ? xcd * (q + 1) : r * (q + 1) + (xcd - r) * q) + off; }
        const int nig = WGM * nN, gid = wgid / nig, fm = gid * WGM, gsz = (nM - fm) < WGM ? (nM - fm) : WGM;
        u.pm = fm + ((wgid % nig) % gsz); u.pn = (wgid % nig) / gsz; return true;
    }
    __device__ __forceinline__ void a_ready(const Unit&) const {}
    __device__ __forceinline__ void done(const Unit&) const {}
};
__device__ __forceinline__ unsigned cvt_pk_bf16(float lo, float hi) { unsigned r; asm volatile("v_cvt_pk_bf16_f32 %0, %1, %2" : "=v"(r) : "v"(lo), "v"(hi)); return r; }
typedef float f32x2 __attribute__((ext_vector_type(2)));
template <class Epi, class Sched, bool ALIGN_EPI = false, bool SP2 = false>
__device__ __forceinline__ void gemm_phase(PG8_LAS unsigned char* lds, const Gemm g, const Sched& S, const Epi& E, int wid_in) {
    int lane_ = (int)__builtin_amdgcn_mbcnt_hi(~0u, __builtin_amdgcn_mbcnt_lo(~0u, 0u)); asm volatile("" : "+v"(lane_)); asm volatile("" : "+s"(wid_in));
    const int wid = wid_in, lane = lane_, tid = wid * 64 + lane, wr = wid >> 2, wc = wid & 3, fr = lane & 15, fq = lane >> 4;
    const int K = g.K, nt = K / BK;
    unsigned voffA[2], voffB[2];
#pragma unroll
    for (int i = 0; i < 2; ++i) { int R, C; stage_rc(tid * 16 + i * 8192, R, C); const int Rb = Epi::PERM ? ((R & ~31) + perm32(R & 31)) : R;
        voffA[i] = (unsigned)(R * K + C) * 2u; voffB[i] = (unsigned)(Rb * K + C) * 2u; }
    const size_t kstep = (size_t)(BK * 2);
    const size_t hstep = (size_t)HALF * K * 2;
    const size_t tstep = 2 * hstep;
    const unsigned ldsw = (unsigned)wid * 1024u;
    const int aoff = lds_byte(wr * 64 + fr, fq * 8), boff = lds_byte(wc * 32 + fr, fq * 8);
#define PG8_SA(b, h) (((b) * 2 + (h)) * HTB)
#define PG8_SB(b, h) ((4 + (b) * 2 + (h)) * HTB)
#define PG8_STAGE(bufoff, gbase, voff) do { _Pragma("unroll") for (int _i = 0; _i < 2; ++_i) \
        __builtin_amdgcn_global_load_lds((const unsigned*)((const char*)(gbase) + (voff)[_i]), (PG8_LAS unsigned*)(lds + (bufoff) + ldsw + _i * 8192), 16, 0, 0); } while (0)
#define PG8_LDA(dst, b, h) do { _Pragma("unroll") for (int m = 0; m < 4; ++m) _Pragma("unroll") for (int k = 0; k < 2; ++k) dst[m][k] = *(const PG8_LAS bf16x8*)(lds + PG8_SA(b, h) + aoff + m * 2048 + k * 1024); } while (0)
#define PG8_LDB(dst, b, h) do { _Pragma("unroll") for (int n = 0; n < 2; ++n) _Pragma("unroll") for (int k = 0; k < 2; ++k) dst[n][k] = *(const PG8_LAS bf16x8*)(lds + PG8_SB(b, h) + boff + n * 2048 + k * 1024); } while (0)
#define PG8_MMA(ai, bj, At, Bt) do { __builtin_amdgcn_s_setprio(1); _Pragma("unroll") for (int m = 0; m < 4; ++m) _Pragma("unroll") for (int n = 0; n < 2; ++n) _Pragma("unroll") for (int k = 0; k < 2; ++k) \
        acc[ai][bj][m][n] = __builtin_amdgcn_mfma_f32_16x16x32_bf16(Bt[n][k], At[m][k], acc[ai][bj][m][n], 0, 0, 0); __builtin_amdgcn_s_setprio(0); } while (0)
#define PG8_WAIT_V(n) asm volatile("s_waitcnt vmcnt(" #n ")" ::: "memory")
#define PG8_WAIT_L(n) asm volatile("s_waitcnt lgkmcnt(" #n ")" ::: "memory")
#define PG8_BAR __builtin_amdgcn_s_barrier()
#define PG8_SCHED __builtin_amdgcn_sched_barrier(0)
    Unit cur, nxt; int ui = 0;
    if (!S.next(0, cur)) return;
    f32x4 acc[2][2][4][2];
#pragma unroll
    for (int a = 0; a < 2; ++a)
#pragma unroll
        for (int b = 0; b < 2; ++b)
#pragma unroll
            for (int m = 0; m < 4; ++m)
#pragma unroll
                for (int n = 0; n < 2; ++n) acc[a][b][m][n] = (f32x4){0.f, 0.f, 0.f, 0.f};
    bf16x8 At[4][2], B0[2][2], B1[2][2];
    const char* cA = (const char*)g.A + (size_t)cur.pm * tstep; const char* cB = (const char*)g.Bt + (size_t)cur.pn * tstep;
    S.a_ready(cur);
    if constexpr (SP2) {
        PG8_STAGE(PG8_SB(0, 0), cB, voffB); PG8_STAGE(PG8_SB(0, 1), cB + hstep, voffB); PG8_STAGE(PG8_SA(0, 0), cA, voffA); PG8_STAGE(PG8_SA(0, 1), cA + hstep, voffA);
        if (wr == 1) PG8_BAR;
        PG8_WAIT_V(2); PG8_BAR;
        PG8_STAGE(PG8_SB(1, 0), cB + kstep, voffB); PG8_STAGE(PG8_SA(1, 0), cA + kstep, voffA); PG8_STAGE(PG8_SB(1, 1), cB + hstep + kstep, voffB);
        PG8_WAIT_V(6); PG8_BAR;
    } else {
        PG8_STAGE(PG8_SB(0, 0), cB, voffB); PG8_STAGE(PG8_SA(0, 0), cA, voffA); PG8_STAGE(PG8_SB(0, 1), cB + hstep, voffB); PG8_STAGE(PG8_SA(0, 1), cA + hstep, voffA);
        if (wr == 1) PG8_BAR;
        PG8_WAIT_V(4); PG8_BAR;
        PG8_STAGE(PG8_SB(1, 0), cB + kstep, voffB); PG8_STAGE(PG8_SA(1, 0), cA + kstep, voffA); PG8_STAGE(PG8_SB(1, 1), cB + hstep + kstep, voffB);
        PG8_WAIT_V(6); PG8_BAR;
    }
    for (;;) {
        const bool has_next = S.next(ui + 1, nxt);
        const char* nA = has_next ? (const char*)g.A + (size_t)nxt.pm * tstep : cA; const char* nB = has_next ? (const char*)g.Bt + (size_t)nxt.pn * tstep : cB;
        for (int t = 0; t < nt; t += 2) {
            const bool last = (t == nt - 2);
            const char* a1 = cA + (size_t)(t + 1) * kstep;
            const char* a2 = last ? nA : cA + (size_t)(t + 2) * kstep; const char* b2 = last ? nB : cB + (size_t)(t + 2) * kstep;
            const char* a3 = a2 + kstep; const char* b3 = b2 + kstep;
            if (last && has_next) S.a_ready(nxt);
            if constexpr (SP2) {
            PG8_LDB(B0, 0, 0); PG8_LDB(B1, 0, 1); PG8_SCHED; PG8_LDA(At, 0, 0); PG8_STAGE(PG8_SA(1, 1), a1 + hstep, voffA);
            PG8_WAIT_V(8); PG8_WAIT_L(0); PG8_BAR; PG8_MMA(0, 0, At, B0); PG8_MMA(0, 1, At, B1); PG8_BAR; PG8_SCHED;
            PG8_LDA(At, 0, 1); PG8_STAGE(PG8_SB(0, 0), b2, voffB); PG8_STAGE(PG8_SB(0, 1), b2 + hstep, voffB); PG8_STAGE(PG8_SA(0, 0), a2, voffA);
            PG8_WAIT_V(8); PG8_WAIT_L(0); PG8_BAR; PG8_MMA(1, 0, At, B0); PG8_MMA(1, 1, At, B1); PG8_BAR; PG8_SCHED;
            PG8_LDB(B0, 1, 0); PG8_LDB(B1, 1, 1); PG8_SCHED; PG8_LDA(At, 1, 0); PG8_STAGE(PG8_SA(0, 1), a2 + hstep, voffA);
            PG8_WAIT_V(8); PG8_WAIT_L(0); PG8_BAR; PG8_MMA(0, 0, At, B0); PG8_MMA(0, 1, At, B1); PG8_BAR; PG8_SCHED;
            PG8_LDA(At, 1, 1); PG8_STAGE(PG8_SB(1, 0), b3, voffB); PG8_STAGE(PG8_SB(1, 1), b3 + hstep, voffB); PG8_STAGE(PG8_SA(1, 0), a3, voffA);
            PG8_WAIT_V(8); PG8_WAIT_L(0); PG8_BAR; PG8_MMA(1, 0, At, B0); PG8_MMA(1, 1, At, B1); PG8_BAR; PG8_SCHED;
            } else {
            PG8_LDB(B0, 0, 0); PG8_SCHED; PG8_LDA(At, 0, 0); PG8_STAGE(PG8_SA(1, 1), a1 + hstep, voffA);
            PG8_WAIT_L(8); PG8_BAR; PG8_WAIT_L(0); PG8_MMA(0, 0, At, B0); PG8_BAR; PG8_SCHED;
            PG8_LDB(B1, 0, 1); PG8_STAGE(PG8_SB(0, 0), b2, voffB);
            PG8_BAR; PG8_WAIT_L(0); PG8_MMA(0, 1, At, B1); PG8_BAR;
            PG8_LDA(At, 0, 1); PG8_STAGE(PG8_SA(0, 0), a2, voffA);
            PG8_BAR; PG8_WAIT_L(0); PG8_MMA(1, 0, At, B0); PG8_BAR; PG8_SCHED;
            PG8_STAGE(PG8_SB(0, 1), b2 + hstep, voffB);
            PG8_WAIT_V(6); PG8_BAR; PG8_MMA(1, 1, At, B1); PG8_BAR;
            PG8_LDB(B0, 1, 0); PG8_SCHED; PG8_LDA(At, 1, 0); PG8_STAGE(PG8_SA(0, 1), a2 + hstep, voffA);
            PG8_WAIT_L(8); PG8_BAR; PG8_WAIT_L(0); PG8_MMA(0, 0, At, B0); PG8_BAR; PG8_SCHED;
            PG8_LDB(B1, 1, 1); PG8_STAGE(PG8_SB(1, 0), b3, voffB);
            PG8_BAR; PG8_WAIT_L(0); PG8_MMA(0, 1, At, B1); PG8_BAR;
            PG8_LDA(At, 1, 1); PG8_STAGE(PG8_SA(1, 0), a3, voffA);
            PG8_BAR; PG8_WAIT_L(0); PG8_MMA(1, 0, At, B0); PG8_BAR; PG8_SCHED;
            PG8_STAGE(PG8_SB(1, 1), b3 + hstep, voffB);
            PG8_WAIT_V(6); PG8_BAR; PG8_MMA(1, 1, At, B1); PG8_BAR;
            }
        }
        if constexpr (ALIGN_EPI) { if (wr == 0) PG8_BAR; }
        if constexpr (!Epi::AFTER_DRAIN) { E(acc, cur, wr, wc, fr, fq); S.done(cur); }
        if (!has_next) break;
#pragma unroll
        for (int a = 0; a < 2; ++a)
#pragma unroll
            for (int b = 0; b < 2; ++b)
#pragma unroll
                for (int m = 0; m < 4; ++m)
#pragma unroll
                    for (int n = 0; n < 2; ++n) acc[a][b][m][n] = (f32x4){0.f, 0.f, 0.f, 0.f};
        cur = nxt; cA = nA; cB = nB; ++ui;
        if constexpr (ALIGN_EPI) { if (wr == 1) PG8_BAR; }
    }
    PG8_WAIT_V(0);
    if constexpr (!ALIGN_EPI) { if (wr == 0) PG8_BAR; }
    PG8_BAR;
    if constexpr (Epi::AFTER_DRAIN) { E.fused(acc, cur, wr, wc, fr, fq, lds, wid, lane); S.done(cur); }
#undef PG8_SA
#undef PG8_SB
#undef PG8_STAGE
#undef PG8_LDA
#undef PG8_LDB
#undef PG8_MMA
#undef PG8_WAIT_V
#undef PG8_WAIT_L
#undef PG8_BAR
#undef PG8_SCHED
}
}
#define GAS __attribute__((address_space(1)))
#define LAS __attribute__((address_space(3)))
typedef unsigned short bf16;
typedef unsigned v4u __attribute__((ext_vector_type(4)));
typedef float f32x4 __attribute__((ext_vector_type(4)));
typedef short bf16x8 __attribute__((ext_vector_type(8)));
typedef GAS unsigned gu32;
typedef GAS unsigned long long gu64;
#define RLX_AGENT __ATOMIC_RELAXED, __HIP_MEMORY_SCOPE_AGENT
#define LDS_WAIT() asm volatile("s_waitcnt lgkmcnt(0)" ::: "memory")
#define VM_WAIT() asm volatile("s_waitcnt vmcnt(0)" ::: "memory")
__device__ __forceinline__ unsigned long long rt() { return __builtin_amdgcn_s_memrealtime(); }
__device__ __forceinline__ unsigned f2bf(float f) { unsigned u = __builtin_bit_cast(unsigned, f); return (u + 0x7fffu + ((u >> 16) & 1u)) >> 16; }
__device__ __forceinline__ unsigned pk2(float lo, float hi) { return f2bf(lo) | (f2bf(hi) << 16); }
#define XB_TMO      128
#define XB_XCNT(j)  (256  + 64 * (j))
#define XB_XSUB(j)  (1280 + 64 * (j))
#define XB_XGEN(j)  (2304 + 64 * (j))
#define XB_TOP      3328
#define XB_TOPGEN   3392
#define XCD_BAR_WORDS 3456
#define XB_SPIN_CAP (1u << 24)

__device__ __forceinline__ unsigned xb_ld(unsigned* p)              { return __hip_atomic_load(p, __ATOMIC_RELAXED, __HIP_MEMORY_SCOPE_AGENT); }
__device__ __forceinline__ unsigned xb_add(unsigned* p, unsigned v) { return __hip_atomic_fetch_add(p, v, __ATOMIC_RELAXED, __HIP_MEMORY_SCOPE_AGENT); }
__device__ __forceinline__ unsigned xb_xcc_id() { return (unsigned)__builtin_amdgcn_s_getreg((3 << 11) | 20) & 0xFu; }
#define XB_SPIN(cond, bar) do { unsigned _sp = 0; while (cond) { __builtin_amdgcn_s_sleep(1); \
    if ((++_sp & 255u) == 0u) { if (xb_ld(&(bar)[XB_TMO])) break; if (_sp > XB_SPIN_CAP) { atomicAdd(&(bar)[XB_TMO], 1u); break; } } } } while (0)

struct XcdBarrier {
    unsigned* bar; unsigned x;
    volatile LAS unsigned* st;
};

__device__ __forceinline__ XcdBarrier xcd_barrier_post(unsigned* bar, volatile LAS unsigned* st) {
    XcdBarrier b; b.bar = bar; b.x = xb_xcc_id(); b.st = st;
    if (threadIdx.x == 0) (void)xb_add(&bar[XB_XCNT(b.x)], 1u);
    return b;
}
__device__ __forceinline__ void xcd_barrier_complete(unsigned* bar, unsigned x, unsigned& nloc, unsigned& nx) {
    const unsigned G = gridDim.x * gridDim.y * gridDim.z;
    unsigned sum, cnt, mine, sp = 0u;
    for (;;) {
        sum = 0u; cnt = 0u; mine = 0u;
#pragma unroll
        for (unsigned j = 0; j < 16; ++j) { const unsigned c = xb_ld(&bar[XB_XCNT(j)]); sum += c; cnt += (c > 0u) ? 1u : 0u; mine = (j == x) ? c : mine; }
        if (sum == G) break;
        __builtin_amdgcn_s_sleep(1);
        if ((++sp & 255u) == 0u) { if (xb_ld(&bar[XB_TMO])) break; if (sp > XB_SPIN_CAP) { atomicAdd(&bar[XB_TMO], 1u); break; } }
    }
    nloc = mine > 0u ? mine : 1u; nx = cnt > 0u ? cnt : 1u;
}

__device__ __forceinline__ void xcd_barrier(const XcdBarrier& b) {
    asm volatile("s_waitcnt vmcnt(0)" ::: "memory");
    __syncthreads();
    if (threadIdx.x == 0) {
        unsigned* bar = b.bar;
        __builtin_amdgcn_s_waitcnt(0);
        unsigned nloc = b.st[0], nx = b.st[1];
        if (nloc == 0u) { xcd_barrier_complete(bar, b.x, nloc, nx); b.st[0] = nloc; b.st[1] = nx; }
        const unsigned old = xb_add(&bar[XB_XSUB(b.x)], 1u);
        const unsigned gen = old / nloc;
        if (old + 1u == (gen + 1u) * nloc) {
            __builtin_amdgcn_fence(__ATOMIC_RELEASE, "agent");
            asm volatile("s_waitcnt vmcnt(0)" ::: "memory");
            const unsigned og = xb_add(&bar[XB_TOP], 1u);
            const unsigned tg = og / nx;
            if (og + 1u == (tg + 1u) * nx) xb_add(&bar[XB_TOPGEN], 1u);
            else XB_SPIN(xb_ld(&bar[XB_TOPGEN]) == tg, bar);
            __builtin_amdgcn_fence(__ATOMIC_ACQUIRE, "agent");
            xb_add(&bar[XB_XGEN(b.x)], 1u);
            asm volatile("s_waitcnt vmcnt(0)" ::: "memory");
        } else {
            XB_SPIN(xb_ld(&bar[XB_XGEN(b.x)]) == gen, bar);
            __builtin_amdgcn_fence(__ATOMIC_ACQUIRE, "agent");
            asm volatile("s_waitcnt vmcnt(0)" ::: "memory");
        }
    }
    __syncthreads();
}

constexpr int DM = 2048;
constexpr int NB_CTX = 16, S_CTX = 256, NB_LAT = 2, S_LAT = 4096, DEPTH = 4;
constexpr int R_CTX = NB_CTX * S_CTX;
constexpr int R_LAT = NB_LAT * S_LAT;
constexpr int MROWS = R_CTX + R_LAT;
constexpr int DIN = 5632, DFF = 5632, DGU = 2 * DFF;
constexpr float ALPHA = 1.6817928305074292f;
constexpr int C_AQ = 0, C_AK = 512, C_AV = 1024, C_BQ = 1536, C_BF = 2048, C_BB = 2560, C_BI = 3072, C_BG = 3584, C_CQ = 4096, C_CK = 5120, C_CV = 5376;
constexpr size_t O_YP = 0, O_YS = 8388608, O_DK = 25165824, O_DV = 33554432, O_SK = 41943040, O_SV = 46137344, O_ST = 50331648, O_END = 58720256;

constexpr size_t MiB = 1u << 20;
constexpr size_t WS_CTL = 0, CTL_ZERO_BYTES = 1 * MiB;
constexpr size_t WS_MODS = 1 * MiB;
constexpr size_t WS_MISC = 2 * MiB;
constexpr size_t WS_W = 4 * MiB, W_LAYER = 96 * MiB;
constexpr size_t WO_IN = 0, WO_OUT = 22 * MiB, WO_GU = 30 * MiB, WO_DN = 74 * MiB;
constexpr size_t WS_H = 388 * MiB;
constexpr size_t WS_CAT = 436 * MiB;
constexpr size_t WS_X1 = 484 * MiB;
constexpr size_t WS_OA = 580 * MiB, WS_OBF = 604 * MiB, WS_OBB = 628 * MiB;
constexpr size_t WS_P = 652 * MiB;
constexpr size_t WS_ACT = WS_P, WS_YPRE = WS_P + 132 * MiB;
constexpr size_t WS_C16 = 916 * MiB;
constexpr size_t WS_QKV = 922 * MiB;
constexpr int QKV_LD = 3072, Q_QD = 0, Q_KD = 512, Q_VD = 1024, Q_QS = 1536, Q_KS = 2560, Q_VS = 2816;
constexpr size_t WS_END = 994 * MiB;

constexpr int CW_BAR = 4096;

constexpr int RING_BYTES = 131072;
constexpr int LDSCTL_OFF = RING_BYTES, MISC_OFF = LDSCTL_OFF + 320;
constexpr int LDS_BYTES = 147456;

typedef unsigned v2u __attribute__((ext_vector_type(2)));

__device__ __forceinline__ float silu_f(float a) { return a / (1.0f + __expf(-a)); }
__device__ __forceinline__ int mod_of_row(int row) { return row < R_CTX ? 0 : (row < R_CTX + S_LAT ? 1 : 2); }

struct EpiStoreF32 {
    static constexpr bool PERM = false, AFTER_DRAIN = false;
    float* C; int ldc;
    __device__ __forceinline__ void operator()(const pg8::f32x4 (&acc)[2][2][4][2], const pg8::Unit& u, int wr, int wc, int fr, int fq) const {
        const int row0 = u.pm * 256 + wr * 64 + fr, col0 = u.pn * 256 + wc * 32 + 4 * fq;
#pragma unroll
        for (int ai = 0; ai < 2; ++ai)
#pragma unroll
            for (int m = 0; m < 4; ++m) { float* rowp = C + (size_t)(row0 + ai * 128 + m * 16) * ldc + col0;
#pragma unroll
                for (int bj = 0; bj < 2; ++bj)
#pragma unroll
                    for (int n = 0; n < 2; ++n) *(pg8::f32x4*)(rowp + bj * 128 + n * 16) = acc[ai][bj][m][n]; }
    }
};
struct EpiResid {
    static constexpr bool PERM = false, AFTER_DRAIN = false;
    const float* xa; const float* xb;
    const float* gates;
    float* out;
    __device__ __forceinline__ void operator()(const pg8::f32x4 (&acc)[2][2][4][2], const pg8::Unit& u, int wr, int wc, int fr, int fq) const {
        const int mod = u.pm >> 4;
        const float* xbase = (u.pm < 16) ? xa + (size_t)u.pm * 256 * DM : xb + (size_t)(u.pm - 16) * 256 * DM;
        const int r0 = wr * 64 + fr, col0 = u.pn * 256 + wc * 32 + 4 * fq;
        pg8::f32x4 gv[2][2];
#pragma unroll
        for (int bj = 0; bj < 2; ++bj)
#pragma unroll
            for (int n = 0; n < 2; ++n) gv[bj][n] = *(const pg8::f32x4*)(gates + (size_t)mod * 6 * DM + col0 + bj * 128 + n * 16);
#pragma unroll
        for (int ai = 0; ai < 2; ++ai)
#pragma unroll
            for (int m = 0; m < 4; ++m) { const int r = r0 + ai * 128 + m * 16;
                const float* xp = xbase + (size_t)r * DM + col0; float* op = out + ((size_t)u.pm * 256 + r) * DM + col0;
#pragma unroll
                for (int bj = 0; bj < 2; ++bj)
#pragma unroll
                    for (int n = 0; n < 2; ++n) { const pg8::f32x4 xv = *(const pg8::f32x4*)(xp + bj * 128 + n * 16);
                        *(pg8::f32x4*)(op + bj * 128 + n * 16) = xv * ALPHA + gv[bj][n] * acc[ai][bj][m][n]; } }
    }
};
struct EpiSwiGLU {
    static constexpr bool PERM = true, AFTER_DRAIN = false;
    bf16* act;
    __device__ __forceinline__ void operator()(const pg8::f32x4 (&acc)[2][2][4][2], const pg8::Unit& u, int wr, int wc, int fr, int fq) const {
        const int row0 = u.pm * 256 + wr * 64 + fr, col0 = u.pn * 128 + wc * 32 + 8 * fq;
#pragma unroll
        for (int ai = 0; ai < 2; ++ai)
#pragma unroll
            for (int m = 0; m < 4; ++m) { bf16* rowp = act + (size_t)(row0 + ai * 128 + m * 16) * DFF + col0;
                float r[8];
#pragma unroll
                for (int n = 0; n < 2; ++n)
#pragma unroll
                    for (int j = 0; j < 4; ++j) { const float g = acc[ai][0][m][n][j], up = acc[ai][1][m][n][j]; r[n * 4 + j] = silu_f(g) * up; }
                pg8::u32x4 w; w.x = pg8::cvt_pk_bf16(r[0], r[1]); w.y = pg8::cvt_pk_bf16(r[2], r[3]); w.z = pg8::cvt_pk_bf16(r[4], r[5]); w.w = pg8::cvt_pk_bf16(r[6], r[7]);
                *(pg8::u32x4*)rowp = w; }
    }
};

struct Args { const float* in[24]; float* out; unsigned char* ws; int ph_lo, ph_hi, single, pad; };
enum { I_XP = 0, I_XS, I_CDK, I_CDV, I_CSK, I_CSV, I_ST, I_C, I_CCTX, I_WMOD, I_BMOD, I_WIN, I_WOUT, I_DLAM, I_DNG, I_LBL, I_HNG, I_SINK, I_LN1G, I_LN1B, I_LN2G, I_LN2B, I_WGU, I_WDN };

struct Ctx {
    LAS unsigned char* lds; int tid, lane, wave, G, bid;
    const Args* ap; float* out; unsigned char* ws;
    __device__ __forceinline__ const float* inp(int i) const { return ap->in[i]; }
    __device__ __forceinline__ float* mods() const { return (float*)(ws + WS_MODS); }
    __device__ __forceinline__ float* lball() const { return (float*)(ws + WS_MISC); }
    __device__ __forceinline__ float* lamv() const { return (float*)(ws + WS_MISC + 16384); }
    __device__ __forceinline__ float* tabD() const { return (float*)(ws + WS_MISC + 20480); }
    __device__ __forceinline__ float* tabS() const { return (float*)(ws + WS_MISC + 32768); }
    __device__ __forceinline__ bf16* wT(int l, size_t off) const { return (bf16*)(ws + WS_W + (size_t)l * W_LAYER + off); }
    __device__ __forceinline__ bf16* hbuf() const { return (bf16*)(ws + WS_H); }
    __device__ __forceinline__ bf16* cat() const { return (bf16*)(ws + WS_CAT); }
    __device__ __forceinline__ float* x1() const { return (float*)(ws + WS_X1); }
    __device__ __forceinline__ float* oa() const { return (float*)(ws + WS_OA); }
    __device__ __forceinline__ float* obf() const { return (float*)(ws + WS_OBF); }
    __device__ __forceinline__ float* obb() const { return (float*)(ws + WS_OBB); }
    __device__ __forceinline__ float* proj() const { return (float*)(ws + WS_P); }
    __device__ __forceinline__ bf16* act() const { return (bf16*)(ws + WS_ACT); }
    __device__ __forceinline__ float* ypre() const { return (float*)(ws + WS_YPRE); }
    __device__ __forceinline__ bf16* qkv() const { return (bf16*)(ws + WS_QKV); }
    __device__ __forceinline__ bf16* c16(size_t off) const { return (bf16*)(ws + WS_C16 + off); }
};

__device__ __forceinline__ void transpose_item(const float* W, int K, int N, bf16* WT, int k0, int n0, int drow0, LAS float* scr, int lane) {
#pragma unroll 8
    for (int i = 0; i < 32; ++i) { const int kk = 2 * i + (lane >> 5); scr[kk * 33 + (lane & 31)] = W[(size_t)(k0 + kk) * N + n0 + (lane & 31)]; }
    LDS_WAIT(); asm volatile("" ::: "memory");
    const int c = lane & 7;
#pragma unroll
    for (int j = 0; j < 4; ++j) { const int n = (lane >> 3) + 8 * j; const LAS float* s = scr + (8 * c) * 33 + n;
        v4u o; o.x = pk2(s[0 * 33], s[1 * 33]); o.y = pk2(s[2 * 33], s[3 * 33]); o.z = pk2(s[4 * 33], s[5 * 33]); o.w = pk2(s[6 * 33], s[7 * 33]);
        *(v4u*)(WT + (size_t)(drow0 + n) * K + k0 + 8 * c) = o; }
    LDS_WAIT(); asm volatile("" ::: "memory");
}

__device__ __forceinline__ void p0_prologue(const Ctx& F) {
    {
        LAS float* sc = (LAS float*)F.lds;
        LAS float* red = (LAS float*)(F.lds + 24576);
        const float* c_ctx = F.inp(I_CCTX); const float* cc = F.inp(I_C);
        for (int i = F.tid; i < 3 * DM; i += 512) { const int mid = i / DM, k = i % DM; const float c = mid == 0 ? c_ctx[k] : cc[(mid - 1) * DM + k]; sc[i] = silu_f(c); }
        __syncthreads();
        for (int task = F.bid; task < DEPTH * 48; task += F.G) {
            const int l = task / 48, cb = task % 48, w = F.wave;
            const float* wp = F.inp(I_WMOD) + ((size_t)l * DM + 256 * w) * (6 * DM) + cb * 256 + F.lane * 4;
            f32x4 a0 = {0.f, 0.f, 0.f, 0.f}, a1 = a0, a2 = a0;
#pragma unroll 8
            for (int kk = 0; kk < 256; ++kk) { const f32x4 wv = *(const f32x4*)(wp + (size_t)kk * (6 * DM));
                a0 += wv * sc[256 * w + kk]; a1 += wv * sc[DM + 256 * w + kk]; a2 += wv * sc[2 * DM + 256 * w + kk]; }
            *(LAS f32x4*)(red + (w * 3 + 0) * 256 + F.lane * 4) = a0; *(LAS f32x4*)(red + (w * 3 + 1) * 256 + F.lane * 4) = a1; *(LAS f32x4*)(red + (w * 3 + 2) * 256 + F.lane * 4) = a2;
            __syncthreads();
            for (int i = F.tid; i < 768; i += 512) { const int m = i >> 8, c = i & 255; float s = 0.f;
#pragma unroll
                for (int ww = 0; ww < 8; ++ww) s += red[(ww * 3 + m) * 256 + c];
                F.mods()[((size_t)l * 3 + m) * (6 * DM) + cb * 256 + c] = s + F.inp(I_BMOD)[(size_t)l * 6 * DM + cb * 256 + c]; }
            __syncthreads();
        }
    }
    if (F.bid == F.G - 1) {
        const float* lbl = F.inp(I_LBL);
        for (int i = F.tid; i < 1024; i += 512) { float lg[4], mx = -1e30f;
#pragma unroll
            for (int l = 0; l < 4; ++l) { lg[l] = lbl[l * 1024 + i]; mx = fmaxf(mx, lg[l]); }
            float s = 0.f;
#pragma unroll
            for (int l = 0; l < 4; ++l) { lg[l] = expf(lg[l] - mx); s += lg[l]; }
            const float w1 = lg[1] / s, w2 = lg[2] / s, w3 = lg[3] / s;
            F.lball()[0 * 1024 + i] = 0.f; F.lball()[1 * 1024 + i] = w1; F.lball()[2 * 1024 + i] = w1 + w2; F.lball()[3 * 1024 + i] = w1 + w2 + w3; }
        if (F.tid < 4) { const int l = F.tid; const float* lp = F.inp(I_DLAM) + l * 256; float s1 = 0.f, s2 = 0.f;
            for (int i = 0; i < 64; ++i) { s1 += lp[i] * lp[64 + i]; s2 += lp[128 + i] * lp[192 + i]; }
            const float li = 0.8f - 0.6f * expf(-0.3f * (float)l);
            F.lamv()[l * 2] = expf(s1) - expf(s2) + li; F.lamv()[l * 2 + 1] = li; }
        for (int i = F.tid; i < 64 * 16; i += 512) { const int pos = i / 16, j = i % 16; const float inv = powf(10000.f, -(float)j / 16.f), ang = (float)pos * inv; F.tabD()[i * 2] = cosf(ang); F.tabD()[i * 2 + 1] = sinf(ang); }
        for (int i = F.tid; i < 64 * 32; i += 512) { const int pos = i / 32, j = i % 32; const float inv = powf(10000.f, -(float)j / 32.f), ang = (float)pos * inv; F.tabS()[i * 2] = cosf(ang); F.tabS()[i * 2 + 1] = sinf(ang); }
    }
    {
        const float* src[4] = {F.inp(I_CDK), F.inp(I_CDV), F.inp(I_CSK), F.inp(I_CSV)};
        const size_t doff[4] = {0, 2 * MiB, 4 * MiB, 5 * MiB}; const int n8[4] = {131072, 131072, 65536, 65536};
#pragma unroll
        for (int a = 0; a < 4; ++a)
            for (int i = F.bid * 512 + F.tid; i < n8[a]; i += F.G * 512) { const f32x4 x0 = *(const f32x4*)(src[a] + (size_t)i * 8), x1 = *(const f32x4*)(src[a] + (size_t)i * 8 + 4);
                v4u o; o.x = pk2(x0[0], x0[1]); o.y = pk2(x0[2], x0[3]); o.z = pk2(x1[0], x1[1]); o.w = pk2(x1[2], x1[3]); *(v4u*)(F.c16(doff[a]) + (size_t)i * 8) = o; }
    }
    {
        LAS float* scr = (LAS float*)(F.lds + 49152 + F.wave * 8448);
        const int gw = F.bid * 8 + F.wave, NGW = F.G * 8;
        constexpr int I_IN = 32 * 176, I_OUT = 32 * 64, I_GU = 32 * 352, I_DN = 88 * 64, I_L = I_IN + I_OUT + I_GU + I_DN;
        for (int it = gw; it < DEPTH * I_L; it += NGW) {
            const int l = it / I_L; int r = it % I_L;
            if (r < I_IN) { const int kb = r / 176, nb = r % 176; transpose_item(F.inp(I_WIN) + (size_t)l * DM * DIN, DM, DIN, F.wT(l, WO_IN), 64 * kb, 32 * nb, 32 * nb, scr, F.lane); continue; } r -= I_IN;
            if (r < I_OUT) { const int kb = r / 64, nb = r % 64; transpose_item(F.inp(I_WOUT) + (size_t)l * DM * DM, DM, DM, F.wT(l, WO_OUT), 64 * kb, 32 * nb, 32 * nb, scr, F.lane); continue; } r -= I_OUT;
            if (r < I_GU) { const int kb = r / 352, nb = r % 352, n0 = 32 * nb; const int j = n0 < DFF ? n0 : n0 - DFF; const int drow = 256 * (j >> 7) + (n0 < DFF ? 0 : 128) + (j & 127);
                transpose_item(F.inp(I_WGU) + (size_t)l * DM * DGU, DM, DGU, F.wT(l, WO_GU), 64 * kb, n0, drow, scr, F.lane); continue; } r -= I_GU;
            { const int kb = r / 64, nb = r % 64; transpose_item(F.inp(I_WDN) + (size_t)l * DFF * DM, DFF, DM, F.wT(l, WO_DN), 64 * kb, 32 * nb, 32 * nb, scr, F.lane); }
        }
    }
}

__device__ __forceinline__ void p1_h0(const Ctx& F) {
    const float* xp = F.inp(I_XP); const float* xs = F.inp(I_XS);
    for (int idx = F.bid * 512 + F.tid; idx < MROWS * 256; idx += F.G * 512) {
        const int row = idx >> 8, c8 = (idx & 255) * 8, mod = mod_of_row(row);
        const float* xr = row < R_CTX ? xp + (size_t)row * DM : xs + (size_t)(row - R_CTX) * DM;
        const float* sh = F.mods() + (size_t)(0 * 3 + mod) * 6 * DM; const float* sc = sh + DM;
        const f32x4 x0 = *(const f32x4*)(xr + c8), x1 = *(const f32x4*)(xr + c8 + 4), s0 = *(const f32x4*)(sh + c8), s1 = *(const f32x4*)(sh + c8 + 4), c0 = *(const f32x4*)(sc + c8), c1 = *(const f32x4*)(sc + c8 + 4);
        const f32x4 h0 = x0 * (c0 + 1.0f) + s0, h1 = x1 * (c1 + 1.0f) + s1;
        v4u o; o.x = pk2(h0[0], h0[1]); o.y = pk2(h0[2], h0[3]); o.z = pk2(h1[0], h1[1]); o.w = pk2(h1[2], h1[3]);
        *(v4u*)(F.hbuf() + (size_t)row * DM + c8) = o;
    }
}

constexpr float LOG2E = 1.4426950408889634f;
constexpr float QSC_D = 0.125f * LOG2E, QSC_S = 0.08838834764831845f * LOG2E;
__device__ __forceinline__ void e1_postproj(const Ctx& F, int l) {
    const float* lb = F.lball() + l * 1024;
    for (int row = F.bid; row < MROWS; row += F.G) {
        float* pr = F.proj() + (size_t)row * DIN; bf16* qk = F.qkv() + (size_t)row * QKV_LD;
        const bool lat = row >= R_CTX; const int t = (row - R_CTX) & (S_LAT - 1), rpos = t >> 6, cpos = t & 63;
        { const int c = F.tid; pr[C_BQ + c] = silu_f(pr[C_BQ + c]); }
        for (int c = F.tid; c < 1024; c += 512) { const float z = pr[C_BF + c], lbv = lb[c]; const float sg = 1.0f / (1.0f + expf(-z)); pr[C_BF + c] = logf(fmaxf(lbv, 1e-30f) + (1.0f - lbv) * sg); }
        { const int p = F.tid, blk = p >> 4, i = p & 15, cb = blk * 32, pos = (blk & 1) ? cpos : rpos;
          float cs = 1.f, sn = 0.f; if (lat) { cs = F.tabD()[(pos * 16 + i) * 2]; sn = F.tabD()[(pos * 16 + i) * 2 + 1]; }
          const float x1 = pr[cb + i], x2 = pr[cb + 16 + i], sc = cb < 512 ? QSC_D : 1.0f;
          qk[cb + i] = (bf16)f2bf((x1 * cs - x2 * sn) * sc); qk[cb + 16 + i] = (bf16)f2bf((x2 * cs + x1 * sn) * sc); }
        for (int p = F.tid; p < 640; p += 512) { const int blk = p >> 5, i = p & 31, cb = C_CQ + blk * 64, db = Q_QS + blk * 64, pos = (blk & 1) ? cpos : rpos;
          float cs = 1.f, sn = 0.f; if (lat) { cs = F.tabS()[(pos * 32 + i) * 2]; sn = F.tabS()[(pos * 32 + i) * 2 + 1]; }
          const float x1 = pr[cb + i], x2 = pr[cb + 32 + i], sc = blk < 16 ? QSC_S : 1.0f;
          qk[db + i] = (bf16)f2bf((x1 * cs - x2 * sn) * sc); qk[db + 32 + i] = (bf16)f2bf((x2 * cs + x1 * sn) * sc); }
        { const int c = F.tid; qk[Q_VD + c] = (bf16)f2bf(pr[C_AV + c]); if (c < 256) qk[Q_VS + c] = (bf16)f2bf(pr[C_CV + c]); }
        if (!lat) {
            const int b = row >> 8, n = row & 255;
            for (int i = F.tid; i < 384; i += 512) {
                if (i < 128) { const int h = i >> 5, c4 = (i & 31) * 4; *(f32x4*)(F.out + O_DK + ((((size_t)b * 4 + l) * 4 + h) * 256 + n) * 128 + c4) = *(const f32x4*)(pr + C_AK + h * 128 + c4); }
                else if (i < 256) { const int ii = i - 128, h = ii >> 5, c4 = (ii & 31) * 4; *(f32x4*)(F.out + O_DV + ((((size_t)b * 4 + l) * 4 + h) * 256 + n) * 128 + c4) = *(const f32x4*)(pr + C_AV + h * 128 + c4); }
                else if (i < 320) { const int ii = i - 256, kv = ii >> 5, c4 = (ii & 31) * 4; *(f32x4*)(F.out + O_SK + ((((size_t)b * 4 + l) * 2 + kv) * 256 + n) * 128 + c4) = *(const f32x4*)(pr + C_CK + kv * 128 + c4); }
                else { const int ii = i - 320, kv = ii >> 5, c4 = (ii & 31) * 4; *(f32x4*)(F.out + O_SV + ((((size_t)b * 4 + l) * 2 + kv) * 256 + n) * 128 + c4) = *(const f32x4*)(pr + C_CV + kv * 128 + c4); }
            }
        }
    }
}

typedef float f32x16 __attribute__((ext_vector_type(16)));
typedef short s16x4 __attribute__((ext_vector_type(4)));
typedef __bf16 bf16x2_t __attribute__((ext_vector_type(2)));
typedef float f32x2_t __attribute__((ext_vector_type(2)));
__device__ __forceinline__ unsigned cvt2(float a, float b) { const f32x2_t f = {a, b}; return __builtin_bit_cast(unsigned, __builtin_convertvector(f, bf16x2_t)); }
#define MFMA32(a, b, c) __builtin_amdgcn_mfma_f32_32x32x16_bf16((a), (b), (c), 0, 0, 0)

struct AttnSeg { const bf16* k; const bf16* v; int stride; int ntiles; };
constexpr int KPB = 272, VPB = 320;
constexpr int KT_BYTES = 64 * KPB, VT_BYTES = 64 * VPB, ABUF_BYTES = KT_BYTES + VT_BYTES;
constexpr float ATT_THR = 8.0f;

template <int DQK, bool DIFF>
__device__ __forceinline__ void attn_mfma(const Ctx& F, const bf16* qptr, int kcol, const AttnSeg s0, const AttnSeg s1, bool band, int qpos, int kpos0,
                                          float m_init, float l_init, float lam, float post_scale, const float* gvec, bf16* outp  ) {
    int lane_ = (int)__builtin_amdgcn_mbcnt_hi(~0u, __builtin_amdgcn_mbcnt_lo(~0u, 0u)); asm volatile("" : "+v"(lane_));
    const int lane = lane_, tid = F.wave * 64 + lane, r32 = lane & 31, h = lane >> 5;
    __syncthreads();
    bf16x8 qf[DQK / 16];
#pragma unroll
    for (int ks = 0; ks < DQK / 16; ++ks) qf[ks] = *(const bf16x8*)(qptr + (size_t)r32 * QKV_LD + 16 * ks + 8 * h);
    f32x16 o[4];
#pragma unroll
    for (int t = 0; t < 4; ++t)
#pragma unroll
        for (int r = 0; r < 16; ++r) o[t][r] = 0.f;
    float m = m_init, l = l_init;
    const int nt = s0.ntiles + s1.ntiles;
    const int srow = tid >> 4, spc = tid & 15;
    v4u kreg[2], vreg[2];
#define ATT_ISSUE(ti) do { const bool s1_ = (ti) >= s0.ntiles; const int tt_ = s1_ ? (ti) - s0.ntiles : (ti); const bf16* kb_ = s1_ ? s1.k : s0.k; const bf16* vb_ = s1_ ? s1.v : s0.v; const int st_ = s1_ ? s1.stride : s0.stride; \
        _Pragma("unroll") for (int i_ = 0; i_ < 2; ++i_) { const size_t go_ = (size_t)(tt_ * 64 + srow + 32 * i_) * st_ + spc * 8; kreg[i_] = *(const v4u*)(kb_ + go_); vreg[i_] = *(const v4u*)(vb_ + go_); } } while (0)
#define ATT_WRITE(b) do { _Pragma("unroll") for (int i_ = 0; i_ < 2; ++i_) { *(LAS v4u*)(F.lds + (b) * ABUF_BYTES + (srow + 32 * i_) * KPB + spc * 16) = kreg[i_]; \
        *(LAS v4u*)(F.lds + (b) * ABUF_BYTES + KT_BYTES + (srow + 32 * i_) * VPB + spc * 16) = vreg[i_]; } } while (0)
    ATT_ISSUE(0); ATT_WRITE(0);
    __syncthreads();
    const int koff = r32 * KPB + (kcol + 8 * h) * 2;
    const int voff = KT_BYTES + (4 * h + ((lane & 15) >> 2)) * VPB + (16 * ((lane >> 4) & 1) + 4 * (lane & 3)) * 2;
    for (int ti = 0; ti < nt; ++ti) {
        const int buf = ti & 1;
        if (ti + 1 < nt) ATT_ISSUE(ti + 1);
        const LAS unsigned char* kb = F.lds + buf * ABUF_BYTES;
        f32x16 st[2];
#pragma unroll
        for (int kt = 0; kt < 2; ++kt) {
#pragma unroll
            for (int r = 0; r < 16; ++r) st[kt][r] = 0.f;
#pragma unroll
            for (int ks = 0; ks < DQK / 16; ++ks) { const bf16x8 kf = *(const LAS bf16x8*)(kb + koff + kt * 32 * KPB + ks * 32); st[kt] = MFMA32(kf, qf[ks], st[kt]); }
        }
        if (band && ti < s0.ntiles) {
            const int kp = kpos0 + ti * 64 + 4 * h - (qpos + r32);
#pragma unroll
            for (int kt = 0; kt < 2; ++kt)
#pragma unroll
                for (int r = 0; r < 16; ++r) { const int d = kp + 32 * kt + (r & 3) + 8 * (r >> 2); if (d > 128 || d < -128) st[kt][r] = -1e30f; }
        }
        float mx = st[0][0];
#pragma unroll
        for (int kt = 0; kt < 2; ++kt)
#pragma unroll
            for (int r = 0; r < 16; ++r) mx = fmaxf(mx, st[kt][r]);
        mx = fmaxf(mx, __shfl_xor(mx, 32));
        if (__builtin_amdgcn_ballot_w64(mx > m + ATT_THR) != 0ull) {
            const float mn = fmaxf(m, mx), a = __builtin_amdgcn_exp2f(m - mn); l *= a; m = mn;
#pragma unroll
            for (int t = 0; t < 4; ++t)
#pragma unroll
                for (int r = 0; r < 16; ++r) o[t][r] *= a;
        }
        float rs = 0.f;
#pragma unroll
        for (int kt = 0; kt < 2; ++kt)
#pragma unroll
            for (int r = 0; r < 16; ++r) { const float p = __builtin_amdgcn_exp2f(st[kt][r] - m); st[kt][r] = p; rs += p; }
        rs += __shfl_xor(rs, 32); l += rs;
#pragma unroll
        for (int kt = 0; kt < 2; ++kt)
#pragma unroll
            for (int s = 0; s < 2; ++s) {
                v4u pw; pw.x = cvt2(st[kt][8 * s], st[kt][8 * s + 1]); pw.y = cvt2(st[kt][8 * s + 2], st[kt][8 * s + 3]); pw.z = cvt2(st[kt][8 * s + 4], st[kt][8 * s + 5]); pw.w = cvt2(st[kt][8 * s + 6], st[kt][8 * s + 7]);
                const bf16x8 pf = __builtin_bit_cast(bf16x8, pw);
#pragma unroll
                for (int t = 0; t < 4; ++t) {
                    const s16x4 lo = __builtin_amdgcn_ds_read_tr16_b64_v4i16((LAS s16x4*)(kb + voff + (32 * kt + 16 * s) * VPB + t * 64));
                    const s16x4 hi = __builtin_amdgcn_ds_read_tr16_b64_v4i16((LAS s16x4*)(kb + voff + (32 * kt + 16 * s + 8) * VPB + t * 64));
                    const bf16x8 vf = __builtin_shufflevector(lo, hi, 0, 1, 2, 3, 4, 5, 6, 7);
                    o[t] = MFMA32(vf, pf, o[t]);
                }
            }
        if (ti + 1 < nt) ATT_WRITE(buf ^ 1);
        __syncthreads();
    }
#undef ATT_ISSUE
#undef ATT_WRITE
    const float inv = 1.0f / l;
    if (DIFF) {
        LAS float* ex = (LAS float*)F.lds;
        if (F.wave >= 4) {
#pragma unroll
            for (int t = 0; t < 4; ++t)
#pragma unroll
                for (int r = 0; r < 16; ++r) ex[((F.wave - 4) * 64 + t * 16 + r) * 64 + lane] = o[t][r] * inv;
        }
        __syncthreads();
        if (F.wave < 4) {
            float ss = 0.f;
#pragma unroll
            for (int t = 0; t < 4; ++t)
#pragma unroll
                for (int r = 0; r < 16; ++r) { const float x = o[t][r] * inv - lam * ex[(F.wave * 64 + t * 16 + r) * 64 + lane]; o[t][r] = x; ss += x * x; }
            ss += __shfl_xor(ss, 32);
            const float sc = post_scale / sqrtf(ss * (1.0f / 128.0f) + 1e-6f);
            bf16* op = outp + (size_t)r32 * DM;
#pragma unroll
            for (int t = 0; t < 4; ++t)
#pragma unroll
                for (int g4 = 0; g4 < 4; ++g4) { const int dv = 32 * t + 8 * g4 + 4 * h; const f32x4 gv = *(const f32x4*)(gvec + dv);
                    v2u w; w.x = cvt2(o[t][4 * g4] * sc * gv[0], o[t][4 * g4 + 1] * sc * gv[1]); w.y = cvt2(o[t][4 * g4 + 2] * sc * gv[2], o[t][4 * g4 + 3] * sc * gv[3]); *(v2u*)(op + dv) = w; }
        }
    } else {
        bf16* op = outp + (size_t)r32 * DM;
#pragma unroll
        for (int t = 0; t < 4; ++t)
#pragma unroll
            for (int g4 = 0; g4 < 4; ++g4) { const int dv = 32 * t + 8 * g4 + 4 * h;
                v2u w; w.x = cvt2(o[t][4 * g4] * inv, o[t][4 * g4 + 1] * inv); w.y = cvt2(o[t][4 * g4 + 2] * inv, o[t][4 * g4 + 3] * inv); *(v2u*)(op + dv) = w; }
    }
}

__device__ __forceinline__ void hgrn_valu(const Ctx& F, int row0, int N, int h, int dir, int slice, const float* s_in, float* s_out, float* ob) {
    int lane_ = (int)__builtin_amdgcn_mbcnt_hi(~0u, __builtin_amdgcn_mbcnt_lo(~0u, 0u)); asm volatile("" : "+v"(lane_));
    const int lane = lane_, c = lane >> 5, r4 = (lane & 31) * 4, v = slice * 16 + F.wave * 2 + c;
    float S0 = 0.f, S1 = 0.f, S2 = 0.f, S3 = 0.f;
    if (s_in) { S0 = s_in[(r4 + 0) * 128 + v]; S1 = s_in[(r4 + 1) * 128 + v]; S2 = s_in[(r4 + 2) * 128 + v]; S3 = s_in[(r4 + 3) * 128 + v]; }
    const float* pj = F.proj();
    const float* qp = pj + C_BQ + h * 128 + r4; const float* lf = pj + C_BF + dir * 512 + h * 128 + r4; const float* vp = pj + C_BI + h * 128 + v;
#pragma unroll 4
    for (int step = 0; step < N; ++step) {
        const int t = dir ? (N - 1 - step) : step; const size_t ro = (size_t)(row0 + t) * DIN;
        const f32x4 q4 = *(const f32x4*)(qp + ro), g4 = *(const f32x4*)(lf + ro); const float vv = vp[ro];
        const float f0 = __expf(g4[0]), f1 = __expf(g4[1]), f2 = __expf(g4[2]), f3 = __expf(g4[3]);
        S0 = f0 * S0 + (1.0f - f0) * vv; S1 = f1 * S1 + (1.0f - f1) * vv; S2 = f2 * S2 + (1.0f - f2) * vv; S3 = f3 * S3 + (1.0f - f3) * vv;
        float p = q4[0] * S0 + q4[1] * S1 + q4[2] * S2 + q4[3] * S3;
        p += __shfl_xor(p, 1); p += __shfl_xor(p, 2); p += __shfl_xor(p, 4); p += __shfl_xor(p, 8); p += __shfl_xor(p, 16);
        if ((lane & 31) == 0) ob[(size_t)(row0 + t) * 512 + h * 128 + v] = p;
    }
    if (s_out) { s_out[(r4 + 0) * 128 + v] = S0; s_out[(r4 + 1) * 128 + v] = S1; s_out[(r4 + 2) * 128 + v] = S2; s_out[(r4 + 3) * 128 + v] = S3; }
}

__device__ __forceinline__ void mx_mixers(const Ctx& F, int l) {
    const float lam = F.lamv()[l * 2], lam_init = F.lamv()[l * 2 + 1];
    const bf16* qkv = F.qkv();
    constexpr int T_LH = 128, T_LD = 256, T_LB = 256, T_CD = 128, T_CS = 128, T_CH = 1024;
    constexpr int NT = T_LH + T_LD + T_LB + T_CD + T_CS + T_CH;
    const AttnSeg none = {nullptr, nullptr, 0, 0};
    const int w = F.wave;
    for (int task = F.bid; task < NT; task += F.G) {
        int i = task;
        if (i < T_LH) {
            const int b = i >> 6, h = (i >> 4) & 3, dir = (i >> 3) & 1, sl = i & 7;
            const float* sin_ = F.inp(I_ST) + ((((size_t)b * 4 + l) * 2 + dir) * 4 + h) * 128 * 128;
            hgrn_valu(F, R_CTX + b * S_LAT, S_LAT, h, dir, sl, sin_, nullptr, dir ? F.obb() : F.obf());
            continue; } i -= T_LH;
        if (i < T_LD) {
            const int b = i >> 7, h = (i >> 5) & 3, qt = i & 31, map = w >> 2; const int rb = R_CTX + b * S_LAT, wrow = rb + qt * 128 + 32 * (w & 3);
            const AttnSeg s0 = {qkv + (size_t)rb * QKV_LD + Q_KD + h * 128, qkv + (size_t)rb * QKV_LD + Q_VD + h * 128, QKV_LD, S_LAT / 64};
            const size_t co = (((size_t)b * 4 + l) * 4 + h) * 256 * 128;
            const AttnSeg s1 = {F.c16(0) + co, F.c16(2 * MiB) + co, 128, 4};
            attn_mfma<64, true>(F, qkv + (size_t)wrow * QKV_LD + Q_QD + h * 128 + map * 64, map * 64, s0, s1, false, 0, 0, -1e30f, 0.f, lam, 1.0f - lam_init, F.inp(I_DNG) + l * 128, F.cat() + (size_t)wrow * DM + h * 128);
            continue; } i -= T_LD;
        if (i < T_LB) {
            const int b = i >> 7, kv = (i >> 6) & 1, qt = i & 63, hh = kv * 4 + (w >> 1); const int rb = R_CTX + b * S_LAT, t0 = qt * 64, wrow = rb + t0 + 32 * (w & 1);
            const int ks = t0 - 128 < 0 ? 0 : t0 - 128, ke = t0 + 192 > S_LAT ? S_LAT : t0 + 192;
            const AttnSeg s0 = {qkv + (size_t)(rb + ks) * QKV_LD + Q_KS + kv * 128, qkv + (size_t)(rb + ks) * QKV_LD + Q_VS + kv * 128, QKV_LD, (ke - ks) / 64};
            const size_t co = (((size_t)b * 4 + l) * 2 + kv) * 256 * 128;
            const AttnSeg s1 = {F.c16(4 * MiB) + co, F.c16(5 * MiB) + co, 128, 4};
            attn_mfma<128, false>(F, qkv + (size_t)wrow * QKV_LD + Q_QS + hh * 128, 0, s0, s1, true, t0 + 32 * (w & 1), ks, F.inp(I_SINK)[l * 8 + hh] * LOG2E, 1.0f, 0.f, 1.0f, nullptr, F.cat() + (size_t)wrow * DM + 1024 + hh * 128);
            continue; } i -= T_LB;
        if (i < T_CD) {
            const int b = i >> 3, h = (i >> 1) & 3, qt = i & 1, map = w >> 2, rb = b * 256, wrow = rb + qt * 128 + 32 * (w & 3);
            const AttnSeg s0 = {qkv + (size_t)rb * QKV_LD + Q_KD + h * 128, qkv + (size_t)rb * QKV_LD + Q_VD + h * 128, QKV_LD, 4};
            attn_mfma<64, true>(F, qkv + (size_t)wrow * QKV_LD + Q_QD + h * 128 + map * 64, map * 64, s0, none, false, 0, 0, -1e30f, 0.f, lam, 1.0f - lam_init, F.inp(I_DNG) + l * 128, F.cat() + (size_t)wrow * DM + h * 128);
            continue; } i -= T_CD;
        if (i < T_CS) {
            const int b = i >> 3, kv = (i >> 2) & 1, qt = i & 3, hh = kv * 4 + (w >> 1), rb = b * 256, wrow = rb + qt * 64 + 32 * (w & 1);
            const AttnSeg s0 = {qkv + (size_t)rb * QKV_LD + Q_KS + kv * 128, qkv + (size_t)rb * QKV_LD + Q_VS + kv * 128, QKV_LD, 4};
            attn_mfma<128, false>(F, qkv + (size_t)wrow * QKV_LD + Q_QS + hh * 128, 0, s0, none, false, 0, 0, F.inp(I_SINK)[l * 8 + hh] * LOG2E, 1.0f, 0.f, 1.0f, nullptr, F.cat() + (size_t)wrow * DM + 1024 + hh * 128);
            continue; } i -= T_CS;
        {
            const int b = i >> 6, h = (i >> 4) & 3, dir = (i >> 3) & 1, sl = i & 7;
            float* sout = F.out + O_ST + ((((size_t)b * 4 + l) * 2 + dir) * 4 + h) * 128 * 128;
            hgrn_valu(F, b * 256, 256, h, dir, sl, nullptr, sout, dir ? F.obb() : F.obf());
        }
    }
}

__device__ __forceinline__ void mg_merge(const Ctx& F, int l) {
    const int head = F.lane >> 4, sub = F.lane & 15, col0 = head * 128 + sub * 8;
    for (int row = F.bid * 8 + F.wave; row < MROWS; row += F.G * 8) {
        const f32x4 a0 = *(const f32x4*)(F.obf() + (size_t)row * 512 + col0) + *(const f32x4*)(F.obb() + (size_t)row * 512 + col0);
        const f32x4 a1 = *(const f32x4*)(F.obf() + (size_t)row * 512 + col0 + 4) + *(const f32x4*)(F.obb() + (size_t)row * 512 + col0 + 4);
        float ss = (a0[0] * a0[0] + a0[1] * a0[1]) + (a0[2] * a0[2] + a0[3] * a0[3]) + (a1[0] * a1[0] + a1[1] * a1[1]) + (a1[2] * a1[2] + a1[3] * a1[3]);
        ss += __shfl_xor(ss, 1); ss += __shfl_xor(ss, 2); ss += __shfl_xor(ss, 4); ss += __shfl_xor(ss, 8);
        const float rinv = 1.0f / sqrtf(ss * (1.0f / 128.0f) + 1e-6f);
        const float* g = F.inp(I_HNG) + l * 128 + sub * 8; const float* hg = F.proj() + (size_t)row * DIN + C_BG + col0;
        const f32x4 g0 = *(const f32x4*)g, g1 = *(const f32x4*)(g + 4), h0 = *(const f32x4*)hg, h1 = *(const f32x4*)(hg + 4);
        float y[8];
#pragma unroll
        for (int i = 0; i < 4; ++i) { y[i] = a0[i] * rinv * g0[i] * silu_f(h0[i]); y[4 + i] = a1[i] * rinv * g1[i] * silu_f(h1[i]); }
        v4u w; w.x = pk2(y[0], y[1]); w.y = pk2(y[2], y[3]); w.z = pk2(y[4], y[5]); w.w = pk2(y[6], y[7]);
        *(v4u*)(F.cat() + (size_t)row * DM + 512 + col0) = w;
    }
}

__device__ __forceinline__ void ln_phase(const Ctx& F, const float* g, const float* b, float* xo, const float* modsl  , int which_sh) {
    for (int row = F.bid * 8 + F.wave; row < MROWS; row += F.G * 8) {
        const float* yp = F.ypre() + (size_t)row * DM + F.lane * 4;
        f32x4 v[8]; float s = 0.f;
#pragma unroll
        for (int j = 0; j < 8; ++j) { v[j] = *(const f32x4*)(yp + 256 * j); s += (v[j][0] + v[j][1]) + (v[j][2] + v[j][3]); }
#pragma unroll
        for (int o = 1; o < 64; o <<= 1) s += __shfl_xor(s, o);
        const float mean = s * (1.0f / DM); float s2 = 0.f;
#pragma unroll
        for (int j = 0; j < 8; ++j) { v[j] = v[j] - mean; s2 += (v[j][0] * v[j][0] + v[j][1] * v[j][1]) + (v[j][2] * v[j][2] + v[j][3] * v[j][3]); }
#pragma unroll
        for (int o = 1; o < 64; o <<= 1) s2 += __shfl_xor(s2, o);
        const float rstd = 1.0f / sqrtf(s2 * (1.0f / DM) + 1e-5f);
        const int mod = mod_of_row(row);
        const float* sh = modsl ? modsl + ((size_t)mod * 6 + which_sh) * DM : nullptr;
#pragma unroll
        for (int j = 0; j < 8; ++j) { const int c = F.lane * 4 + 256 * j;
            const f32x4 x = v[j] * rstd * *(const f32x4*)(g + c) + *(const f32x4*)(b + c);
            *(f32x4*)(xo + (size_t)row * DM + c) = x;
            if (modsl) { const f32x4 hh = x * (*(const f32x4*)(sh + DM + c) + 1.0f) + *(const f32x4*)(sh + c);
                v2u w; w.x = pk2(hh[0], hh[1]); w.y = pk2(hh[2], hh[3]); *(v2u*)(F.hbuf() + (size_t)row * DM + c) = w; } }
    }
}

constexpr int PH_PER_LAYER = 9, N_PHASES = 2 + DEPTH * PH_PER_LAYER;
__global__ void __launch_bounds__(512, 2) fwd_kernel(Args args) {
    extern __shared__ __attribute__((aligned(16))) unsigned char lds_raw[];
    Ctx F;
    F.lds = (LAS unsigned char*)lds_raw;
    F.tid = threadIdx.x; F.lane = F.tid & 63; F.wave = __builtin_amdgcn_readfirstlane(F.tid >> 6); F.G = gridDim.x; F.bid = blockIdx.x;
    F.ap = &args; F.out = args.out; F.ws = args.ws;
    volatile LAS unsigned* MISC = (volatile LAS unsigned*)(F.lds + MISC_OFF);
    for (int u = F.tid; u < (LDS_BYTES - LDSCTL_OFF) / 4; u += 512) ((LAS unsigned*)(F.lds + LDSCTL_OFF))[u] = 0u;
    __syncthreads();
    XcdBarrier bar; bar.bar = (unsigned*)(args.ws + WS_CTL) + CW_BAR; bar.x = 0; bar.st = nullptr;
    if (args.single) bar = xcd_barrier_post((unsigned*)(args.ws + WS_CTL) + CW_BAR, MISC + 8);
    const int lo = args.ph_lo, hi = args.ph_hi;
#define IN(k) (lo <= (k) && (k) < hi)
#define FRESH() do { int ln_ = (int)__builtin_amdgcn_mbcnt_hi(~0u, __builtin_amdgcn_mbcnt_lo(~0u, 0u)); asm volatile("" : "+v"(ln_)); F.lane = ln_; asm volatile("" : "+s"(F.wave)); F.tid = F.wave * 64 + F.lane; \
    asm volatile("" : "+s"(F.bid), "+s"(F.G)); asm volatile("" : "+s"(F.ws), "+s"(F.out)); } while (0)
#define SEAM(k) do { if (IN((k) + 1)) xcd_barrier(bar); } while (0)

    if (IN(0)) { FRESH(); p0_prologue(F); SEAM(0); }
    if (IN(1)) { FRESH(); p1_h0(F); SEAM(1); }
    for (int l = 0; l < DEPTH; ++l) {
        const int k0 = 2 + l * PH_PER_LAYER;
        FRESH();
        const float* xa = l == 0 ? F.inp(I_XP) : F.out + O_YP; const float* xb = l == 0 ? F.inp(I_XS) : F.out + O_YS;
        if (IN(k0 + 0)) {
            pg8::Gemm g{F.hbuf(), F.wT(l, WO_IN), MROWS, DIN, DM}; pg8::StaticOrder S; S.init(MROWS, DIN, F.G, F.bid);
            EpiStoreF32 E{F.proj(), DIN};
            pg8::gemm_phase<EpiStoreF32, pg8::StaticOrder, true, true>(F.lds, g, S, E, F.wave);
            SEAM(k0 + 0); }
        if (IN(k0 + 1)) { FRESH(); e1_postproj(F, l); SEAM(k0 + 1); }
        if (IN(k0 + 2)) { FRESH(); mx_mixers(F, l); SEAM(k0 + 2); }
        if (IN(k0 + 3)) { FRESH(); mg_merge(F, l); SEAM(k0 + 3); }
        if (IN(k0 + 4)) {
            pg8::Gemm g{F.cat(), F.wT(l, WO_OUT), MROWS, DM, DM}; pg8::StaticOrder S; S.init(MROWS, DM, F.G, F.bid);
            EpiResid E{xa, xb, F.mods() + ((size_t)l * 3 * 6 + 2) * DM, F.ypre()};
            pg8::gemm_phase<EpiResid, pg8::StaticOrder, true, true>(F.lds, g, S, E, F.wave);
            SEAM(k0 + 4); }
        if (IN(k0 + 5)) { FRESH(); ln_phase(F, F.inp(I_LN1G) + l * DM, F.inp(I_LN1B) + l * DM, F.x1(), F.mods() + (size_t)l * 3 * 6 * DM, 3); SEAM(k0 + 5); }
        if (IN(k0 + 6)) {
            pg8::Gemm g{F.hbuf(), F.wT(l, WO_GU), MROWS, DGU, DM}; pg8::StaticOrder S; S.init(MROWS, DGU, F.G, F.bid);
            EpiSwiGLU E{F.act()};
            pg8::gemm_phase<EpiSwiGLU, pg8::StaticOrder, true, true>(F.lds, g, S, E, F.wave);
            SEAM(k0 + 6); }
        if (IN(k0 + 7)) {
            pg8::Gemm g{F.act(), F.wT(l, WO_DN), MROWS, DM, DFF}; pg8::StaticOrder S; S.init(MROWS, DM, F.G, F.bid);
            EpiResid E{F.x1(), F.x1() + (size_t)R_CTX * DM, F.mods() + ((size_t)l * 3 * 6 + 5) * DM, F.ypre()};
            pg8::gemm_phase<EpiResid, pg8::StaticOrder, true, true>(F.lds, g, S, E, F.wave);
            SEAM(k0 + 7); }
        if (IN(k0 + 8)) { FRESH(); ln_phase(F, F.inp(I_LN2G) + l * DM, F.inp(I_LN2B) + l * DM, F.out + O_YP, l + 1 < DEPTH ? F.mods() + (size_t)(l + 1) * 3 * 6 * DM : nullptr, 0); SEAM(k0 + 8); }
    }
#undef IN
#undef SEAM
#undef FRESH
}

#ifndef MK_SINGLE
#define MK_SINGLE 1
#endif
extern "C" void kernel_launch(void* const* d_in, const int* in_sizes, int n_in, void* d_out, int out_size, void* d_ws, size_t ws_size, hipStream_t stream) {
    static int grid = 0;
    if (grid == 0) {
        if (n_in != 24 || out_size != (int)O_END || ws_size < WS_END) { fprintf(stderr, "kernel_launch: unexpected sizes n_in %d out %d ws %zu\n", n_in, out_size, ws_size); grid = -1; return; }
        int dev = 0, cus = 0, per_cu = 0;
        if (hipGetDevice(&dev) != hipSuccess || hipDeviceGetAttribute(&cus, hipDeviceAttributeMultiprocessorCount, dev) != hipSuccess) { grid = -1; return; }
        if (hipFuncSetAttribute((const void*)fwd_kernel, hipFuncAttributeMaxDynamicSharedMemorySize, LDS_BYTES) != hipSuccess) { fprintf(stderr, "kernel_launch: hipFuncSetAttribute failed\n"); grid = -1; return; }
        if (hipOccupancyMaxActiveBlocksPerMultiprocessor(&per_cu, (const void*)fwd_kernel, 512, LDS_BYTES) != hipSuccess || per_cu < 1) fprintf(stderr, "kernel_launch: occupancy query says %d\n", per_cu);
        (void)hipGetLastError();
        grid = cus;
    }
    if (grid < 0) return;
    (void)hipMemsetAsync((char*)d_ws + WS_CTL, 0, CTL_ZERO_BYTES, stream);
    Args a{};
    for (int i = 0; i < 24; ++i) a.in[i] = (const float*)d_in[i];
    a.out = (float*)d_out; a.ws = (unsigned char*)d_ws; a.pad = 0;
#if MK_SINGLE
    a.ph_lo = 0; a.ph_hi = N_PHASES; a.single = 1;
    hipLaunchKernelGGL(fwd_kernel, dim3(grid), dim3(512), LDS_BYTES, stream, a);
#else
    a.single = 0;
    for (int p = 0; p < N_PHASES; ++p) { a.ph_lo = p; a.ph_hi = p + 1; hipLaunchKernelGGL(fwd_kernel, dim3(grid), dim3(512), LDS_BYTES, stream, a); }
#endif
}
```

```cpp
#include <hip/hip_runtime.h>
#include <cstdio>
#include <cstdint>
namespace pg8 {
#define PG8_LAS __attribute__((address_space(3)))
typedef unsigned short bf16_t;
typedef short bf16x8 __attribute__((ext_vector_type(8)));
typedef float f32x4 __attribute__((ext_vector_type(4)));
typedef unsigned u32x4 __attribute__((ext_vector_type(4)));
constexpr int BM = 256, BK = 64, HALF = 128, HTB = HALF * BK * 2  , STAGE_BYTES = 8 * HTB, NXCD = 8, WGM = 8;

__host__ __device__ __forceinline__ int lds_byte(int r, int c) { const int st = (r >> 4) * 2 + (c >> 5), rr = r & 15, cc = c & 31, ob = rr * 64 + cc * 2; return st * 1024 + (ob ^ (((ob >> 9) & 1) << 5)); }
__host__ __device__ __forceinline__ void stage_rc(int b, int& R, int& C) { const int st = b / 1024, sb = b % 1024, swz = sb ^ (((sb >> 9) & 1) << 5); R = (st >> 1) * 16 + swz / 64; C = (st & 1) * 32 + (swz % 64) / 2; }
__host__ __device__ __forceinline__ int perm32(int rho) { const int n = rho >> 4, i = rho & 15; return 8 * (i >> 2) + 4 * n + (i & 3); }

struct Unit { int pm, pn; };
struct Gemm { const bf16_t* A; const bf16_t* Bt; int M, N, K; };

struct StaticOrder {
    int nM, nN, nwg, G, c;
    __host__ __device__ void init(int M, int N, int G_, int c_) { nM = M / BM; nN = N / BM; nwg = nM * nN; G = G_; c = c_; }
    __host__ __device__ bool next(int i, Unit& u) const {
        const long L = (long)i * G + c; if (L >= nwg) return false;
        int wgid = (int)L; { const int q = nwg / NXCD, r = nwg % NXCD, xcd = wgid % NXCD, off = wgid / NXCD; wgid = (xcd < r ? xcd * (q + 1) : r * (q + 1) + (xcd - r) * q) + off; }
        const int nig = WGM * nN, gid = wgid / nig, fm = gid * WGM, gsz = (nM - fm) < WGM ? (nM - fm) : WGM;
        u.pm = fm + ((wgid % nig) % gsz); u.pn = (wgid % nig) / gsz; return true;
    }
    __device__ __forceinline__ void a_ready(const Unit&) const {}
    __device__ __forceinline__ void done(const Unit&) const {}
};
__device__ __forceinline__ unsigned cvt_pk_bf16(float lo, float hi) { unsigned r; asm volatile("v_cvt_pk_bf16_f32 %0, %1, %2" : "=v"(r) : "v"(lo), "v"(hi)); return r; }
typedef float f32x2 __attribute__((ext_vector_type(2)));
template <class Epi, class Sched, bool ALIGN_EPI = false, bool SP2 = false>
__device__ __forceinline__ void gemm_phase(PG8_LAS unsigned char* lds, const Gemm g, const Sched& S, const Epi& E, int wid_in) {
    int lane_ = (int)__builtin_amdgcn_mbcnt_hi(~0u, __builtin_amdgcn_mbcnt_lo(~0u, 0u)); asm volatile("" : "+v"(lane_)); asm volatile("" : "+s"(wid_in));
    const int wid = wid_in, lane = lane_, tid = wid * 64 + lane, wr = wid >> 2, wc = wid & 3, fr = lane & 15, fq = lane >> 4;
    const int K = g.K, nt = K / BK;
    unsigned voffA[2], voffB[2];
#pragma unroll
    for (int i = 0; i < 2; ++i) { int R, C; stage_rc(tid * 16 + i * 8192, R, C); const int Rb = Epi::PERM ? ((R & ~31) + perm32(R & 31)) : R;
        voffA[i] = (unsigned)(R * K + C) * 2u; voffB[i] = (unsigned)(Rb * K + C) * 2u; }
    const size_t kstep = (size_t)(BK * 2);
    const size_t hstep = (size_t)HALF * K * 2;
    const size_t tstep = 2 * hstep;
    const unsigned ldsw = (unsigned)wid * 1024u;
    const int aoff = lds_byte(wr * 64 + fr, fq * 8), boff = lds_byte(wc * 32 + fr, fq * 8);
#define PG8_SA(b, h) (((b) * 2 + (h)) * HTB)
#define PG8_SB(b, h) ((4 + (b) * 2 + (h)) * HTB)
#define PG8_STAGE(bufoff, gbase, voff) do { _Pragma("unroll") for (int _i = 0; _i < 2; ++_i) \
        __builtin_amdgcn_global_load_lds((const unsigned*)((const char*)(gbase) + (voff)[_i]), (PG8_LAS unsigned*)(lds + (bufoff) + ldsw + _i * 8192), 16, 0, 0); } while (0)
#define PG8_LDA(dst, b, h) do { _Pragma("unroll") for (int m = 0; m < 4; ++m) _Pragma("unroll") for (int k = 0; k < 2; ++k) dst[m][k] = *(const PG8_LAS bf16x8*)(lds + PG8_SA(b, h) + aoff + m * 2048 + k * 1024); } while (0)
#define PG8_LDB(dst, b, h) do { _Pragma("unroll") for (int n = 0; n < 2; ++n) _Pragma("unroll") for (int k = 0; k < 2; ++k) dst[n][k] = *(const PG8_LAS bf16x8*)(lds + PG8_SB(b, h) + boff + n * 2048 + k * 1024); } while (0)
#define PG8_MMA(ai, bj, At, Bt) do { __builtin_amdgcn_s_setprio(1); _Pragma("unroll") for (int m = 0; m < 4; ++m) _Pragma("unroll") for (int n = 0; n < 2; ++n) _Pragma("unroll") for (int k = 0; k < 2; ++k) \
        acc[ai][bj][m][n] = __builtin_amdgcn_mfma_f32_16x16x32_bf16(Bt[n][k], At[m][k], acc[ai][bj][m][n], 0, 0, 0); __builtin_amdgcn_s_setprio(0); } while (0)
#define PG8_WAIT_V(n) asm volatile("s_waitcnt vmcnt(" #n ")" ::: "memory")
#define PG8_WAIT_L(n) asm volatile("s_waitcnt lgkmcnt(" #n ")" ::: "memory")
#define PG8_BAR __builtin_amdgcn_s_barrier()
#define PG8_SCHED __builtin_amdgcn_sched_barrier(0)
    Unit cur, nxt; int ui = 0;
    if (!S.next(0, cur)) return;
    f32x4 acc[2][2][4][2];
#pragma unroll
    for (int a = 0; a < 2; ++a)
#pragma unroll
        for (int b = 0; b < 2; ++b)
#pragma unroll
            for (int m = 0; m < 4; ++m)
#pragma unroll
                for (int n = 0; n < 2; ++n) acc[a][b][m][n] = (f32x4){0.f, 0.f, 0.f, 0.f};
    bf16x8 At[4][2], B0[2][2], B1[2][2];
    const char* cA = (const char*)g.A + (size_t)cur.pm * tstep; const char* cB = (const char*)g.Bt + (size_t)cur.pn * tstep;
    S.a_ready(cur);
    if constexpr (SP2) {
        PG8_STAGE(PG8_SB(0, 0), cB, voffB); PG8_STAGE(PG8_SB(0, 1), cB + hstep, voffB); PG8_STAGE(PG8_SA(0, 0), cA, voffA); PG8_STAGE(PG8_SA(0, 1), cA + hstep, voffA);
        if (wr == 1) PG8_BAR;
        PG8_WAIT_V(2); PG8_BAR;
        PG8_STAGE(PG8_SB(1, 0), cB + kstep, voffB); PG8_STAGE(PG8_SA(1, 0), cA + kstep, voffA); PG8_STAGE(PG8_SB(1, 1), cB + hstep + kstep, voffB);
        PG8_WAIT_V(6); PG8_BAR;
    } else {
        PG8_STAGE(PG8_SB(0, 0), cB, voffB); PG8_STAGE(PG8_SA(0, 0), cA, voffA); PG8_STAGE(PG8_SB(0, 1), cB + hstep, voffB); PG8_STAGE(PG8_SA(0, 1), cA + hstep, voffA);
        if (wr == 1) PG8_BAR;
        PG8_WAIT_V(4); PG8_BAR;
        PG8_STAGE(PG8_SB(1, 0), cB + kstep, voffB); PG8_STAGE(PG8_SA(1, 0), cA + kstep, voffA); PG8_STAGE(PG8_SB(1, 1), cB + hstep + kstep, voffB);
        PG8_WAIT_V(6); PG8_BAR;
    }
    for (;;) {
        const bool has_next = S.next(ui + 1, nxt);
        const char* nA = has_next ? (const char*)g.A + (size_t)nxt.pm * tstep : cA; const char* nB = has_next ? (const char*)g.Bt + (size_t)nxt.pn * tstep : cB;
        for (int t = 0; t < nt; t += 2) {
            const bool last = (t == nt - 2);
            const char* a1 = cA + (size_t)(t + 1) * kstep;
            const char* a2 = last ? nA : cA + (size_t)(t + 2) * kstep; const char* b2 = last ? nB : cB + (size_t)(t + 2) * kstep;
            const char* a3 = a2 + kstep; const char* b3 = b2 + kstep;
            if (last && has_next) S.a_ready(nxt);
            if constexpr (SP2) {
            PG8_LDB(B0, 0, 0); PG8_LDB(B1, 0, 1); PG8_SCHED; PG8_LDA(At, 0, 0); PG8_STAGE(PG8_SA(1, 1), a1 + hstep, voffA);
            PG8_WAIT_V(8); PG8_WAIT_L(0); PG8_BAR; PG8_MMA(0, 0, At, B0); PG8_MMA(0, 1, At, B1); PG8_BAR; PG8_SCHED;
            PG8_LDA(At, 0, 1); PG8_STAGE(PG8_SB(0, 0), b2, voffB); PG8_STAGE(PG8_SB(0, 1), b2 + hstep, voffB); PG8_STAGE(PG8_SA(0, 0), a2, voffA);
            PG8_WAIT_V(8); PG8_WAIT_L(0); PG8_BAR; PG8_MMA(1, 0, At, B0); PG8_MMA(1, 1, At, B1); PG8_BAR; PG8_SCHED;
            PG8_LDB(B0, 1, 0); PG8_LDB(B1, 1, 1); PG8_SCHED; PG8_LDA(At, 1, 0); PG8_STAGE(PG8_SA(0, 1), a2 + hstep, voffA);
            PG8_WAIT_V(8); PG8_WAIT_L(0); PG8_BAR; PG8_MMA(0, 0, At, B0); PG8_MMA(0, 1, At, B1); PG8_BAR; PG8_SCHED;
            PG8_LDA(At, 1, 1); PG8_STAGE(PG8_SB(1, 0), b3, voffB); PG8_STAGE(PG8_SB(1, 1), b3 + hstep, voffB); PG8_STAGE(PG8_SA(1, 0), a3, voffA);
            PG8_WAIT_V(8); PG8_WAIT_L(0); PG8_BAR; PG8_MMA(1, 0, At, B0); PG8_MMA(1, 1, At, B1); PG8_BAR; PG8_SCHED;
            } else {
            PG8_LDB(B0, 0, 0); PG8_SCHED; PG8_LDA(At, 0, 0); PG8_STAGE(PG8_SA(1, 1), a1 + hstep, voffA);
            PG8_WAIT_L(8); PG8_BAR; PG8_WAIT_L(0); PG8_MMA(0, 0, At, B0); PG8_BAR; PG8_SCHED;
            PG8_LDB(B1, 0, 1); PG8_STAGE(PG8_SB(0, 0), b2, voffB);
            PG8_BAR; PG8_WAIT_L(0); PG8_MMA(0, 1, At, B1); PG8_BAR;
            PG8_LDA(At, 0, 1); PG8_STAGE(PG8_SA(0, 0), a2, voffA);
            PG8_BAR; PG8_WAIT_L(0); PG8_MMA(1, 0, At, B0); PG8_BAR; PG8_SCHED;
            PG8_STAGE(PG8_SB(0, 1), b2 + hstep, voffB);
            PG8_WAIT_V(6); PG8_BAR; PG8_MMA(1, 1, At, B1); PG8_BAR;
            PG8_LDB(B0, 1, 0); PG8_SCHED; PG8_LDA(At, 1, 0); PG8_STAGE(PG8_SA(0, 1), a2 + hstep, voffA);
            PG8_WAIT_L(8); PG8_BAR; PG8_WAIT_L(0); PG8_MMA(0, 0, At, B0); PG8_BAR; PG8_SCHED;
            PG8_LDB(B1, 1, 1); PG8_STAGE(PG8_SB(1, 0), b3, voffB);
            PG8_BAR; PG8_WAIT_L(0); PG8_MMA(0, 1, At, B1); PG8_BAR;
            PG8_LDA(At, 1, 1); PG8_STAGE(PG8_SA(1, 0), a3, voffA);
            PG8_BAR; PG8_WAIT_L(0); PG8_MMA(1, 0, At, B0); PG8_BAR; PG8_SCHED;
            PG8_STAGE(PG8_SB(1, 1), b3 + hstep, voffB);
            PG8_WAIT_V(6); PG8_BAR; PG8_MMA(1, 1, At, B1); PG8_BAR;
            }
        }
        if constexpr (ALIGN_EPI) { if (wr == 0) PG8_BAR; }
        if constexpr (!Epi::AFTER_DRAIN) { E(acc, cur, wr, wc, fr, fq); S.done(cur); }
        if (!has_next) break;
#pragma unroll
        for (int a = 0; a < 2; ++a)
#pragma unroll
            for (int b = 0; b < 2; ++b)
#pragma unroll
                for (int m = 0; m < 4; ++m)
#pragma unroll
                    for (int n = 0; n < 2; ++n) acc[a][b][m][n] = (f32x4){0.f, 0.f, 0.f, 0.f};
        cur = nxt; cA = nA; cB = nB; ++ui;
        if constexpr (ALIGN_EPI) { if (wr == 1) PG8_BAR; }
    }
    PG8_WAIT_V(0);
    if constexpr (!ALIGN_EPI) { if (wr == 0) PG8_BAR; }
    PG8_BAR;
    if constexpr (Epi::AFTER_DRAIN) { E.fused(acc, cur, wr, wc, fr, fq, lds, wid, lane); S.done(cur); }
#undef PG8_SA
#undef PG8_SB
#undef PG8_STAGE
#undef PG8_LDA
#undef PG8_LDB
#undef PG8_MMA
#undef PG8_WAIT_V
#undef PG8_WAIT_L
#undef PG8_BAR
#undef PG8_SCHED
}
}
#define GAS __attribute__((address_space(1)))
#define LAS __attribute__((address_space(3)))
typedef unsigned short bf16;
typedef unsigned v4u __attribute__((ext_vector_type(4)));
typedef float f32x4 __attribute__((ext_vector_type(4)));
typedef short bf16x8 __attribute__((ext_vector_type(8)));
typedef GAS unsigned gu32;
typedef GAS unsigned long long gu64;
#define RLX_AGENT __ATOMIC_RELAXED, __HIP_MEMORY_SCOPE_AGENT
#define LDS_WAIT() asm volatile("s_waitcnt lgkmcnt(0)" ::: "memory")
#define VM_WAIT() asm volatile("s_waitcnt vmcnt(0)" ::: "memory")
__device__ __forceinline__ unsigned long long rt() { return __builtin_amdgcn_s_memrealtime(); }
__device__ __forceinline__ unsigned f2bf(float f) { unsigned u = __builtin_bit_cast(unsigned, f); return (u + 0x7fffu + ((u >> 16) & 1u)) >> 16; }
__device__ __forceinline__ unsigned pk2(float lo, float hi) { return f2bf(lo) | (f2bf(hi) << 16); }
#define XB_TMO      128
#define XB_XCNT(j)  (256  + 64 * (j))
#define XB_XSUB(j)  (1280 + 64 * (j))
#define XB_XGEN(j)  (2304 + 64 * (j))
#define XB_TOP      3328
#define XB_TOPGEN   3392
#define XCD_BAR_WORDS 3456
#define XB_SPIN_CAP (1u << 24)

__device__ __forceinline__ unsigned xb_ld(unsigned* p)              { return __hip_atomic_load(p, __ATOMIC_RELAXED, __HIP_MEMORY_SCOPE_AGENT); }
__device__ __forceinline__ unsigned xb_add(unsigned* p, unsigned v) { return __hip_atomic_fetch_add(p, v, __ATOMIC_RELAXED, __HIP_MEMORY_SCOPE_AGENT); }
__device__ __forceinline__ unsigned xb_xcc_id() { return (unsigned)__builtin_amdgcn_s_getreg((3 << 11) | 20) & 0xFu; }
#define XB_SPIN(cond, bar) do { unsigned _sp = 0; while (cond) { __builtin_amdgcn_s_sleep(1); \
    if ((++_sp & 255u) == 0u) { if (xb_ld(&(bar)[XB_TMO])) break; if (_sp > XB_SPIN_CAP) { atomicAdd(&(bar)[XB_TMO], 1u); break; } } } } while (0)

struct XcdBarrier {
    unsigned* bar; unsigned x;
    volatile LAS unsigned* st;
};

__device__ __forceinline__ XcdBarrier xcd_barrier_post(unsigned* bar, volatile LAS unsigned* st) {
    XcdBarrier b; b.bar = bar; b.x = xb_xcc_id(); b.st = st;
    if (threadIdx.x == 0) (void)xb_add(&bar[XB_XCNT(b.x)], 1u);
    return b;
}
__device__ __forceinline__ void xcd_barrier_complete(unsigned* bar, unsigned x, unsigned& nloc, unsigned& nx) {
    const unsigned G = gridDim.x * gridDim.y * gridDim.z;
    unsigned sum, cnt, mine, sp = 0u;
    for (;;) {
        sum = 0u; cnt = 0u; mine = 0u;
#pragma unroll
        for (unsigned j = 0; j < 16; ++j) { const unsigned c = xb_ld(&bar[XB_XCNT(j)]); sum += c; cnt += (c > 0u) ? 1u : 0u; mine = (j == x) ? c : mine; }
        if (sum == G) break;
        __builtin_amdgcn_s_sleep(1);
        if ((++sp & 255u) == 0u) { if (xb_ld(&bar[XB_TMO])) break; if (sp > XB_SPIN_CAP) { atomicAdd(&bar[XB_TMO], 1u); break; } }
    }
    nloc = mine > 0u ? mine : 1u; nx = cnt > 0u ? cnt : 1u;
}

__device__ __forceinline__ void xcd_barrier(const XcdBarrier& b) {
    asm volatile("s_waitcnt vmcnt(0)" ::: "memory");
    __syncthreads();
    if (threadIdx.x == 0) {
        unsigned* bar = b.bar;
        __builtin_amdgcn_s_waitcnt(0);
        unsigned nloc = b.st[0], nx = b.st[1];
        if (nloc == 0u) { xcd_barrier_complete(bar, b.x, nloc, nx); b.st[0] = nloc; b.st[1] = nx; }
        const unsigned old = xb_add(&bar[XB_XSUB(b.x)], 1u);
        const unsigned gen = old / nloc;
        if (old + 1u == (gen + 1u) * nloc) {
            __builtin_amdgcn_fence(__ATOMIC_RELEASE, "agent");
            asm volatile("s_waitcnt vmcnt(0)" ::: "memory");
            const unsigned og = xb_add(&bar[XB_TOP], 1u);
            const unsigned tg = og / nx;
            if (og + 1u == (tg + 1u) * nx) xb_add(&bar[XB_TOPGEN], 1u);
            else XB_SPIN(xb_ld(&bar[XB_TOPGEN]) == tg, bar);
            __builtin_amdgcn_fence(__ATOMIC_ACQUIRE, "agent");
            xb_add(&bar[XB_XGEN(b.x)], 1u);
            asm volatile("s_waitcnt vmcnt(0)" ::: "memory");
        } else {
            XB_SPIN(xb_ld(&bar[XB_XGEN(b.x)]) == gen, bar);
            __builtin_amdgcn_fence(__ATOMIC_ACQUIRE, "agent");
            asm volatile("s_waitcnt vmcnt(0)" ::: "memory");
        }
    }
    __syncthreads();
}

constexpr int DM = 2048;
constexpr int NB_CTX = 16, S_CTX = 256, NB_LAT = 2, S_LAT = 4096, DEPTH = 4;
constexpr int R_CTX = NB_CTX * S_CTX;
constexpr int R_LAT = NB_LAT * S_LAT;
constexpr int MROWS = R_CTX + R_LAT;
constexpr int DIN = 5632, DFF = 5632, DGU = 2 * DFF;
constexpr float ALPHA = 1.6817928305074292f;
constexpr int C_AQ = 0, C_AK = 512, C_AV = 1024, C_BQ = 1536, C_BF = 2048, C_BB = 2560, C_BI = 3072, C_BG = 3584, C_CQ = 4096, C_CK = 5120, C_CV = 5376;
constexpr size_t O_YP = 0, O_YS = 8388608, O_DK = 25165824, O_DV = 33554432, O_SK = 41943040, O_SV = 46137344, O_ST = 50331648, O_END = 58720256;

constexpr size_t MiB = 1u << 20;
constexpr size_t WS_CTL = 0, CTL_ZERO_BYTES = 1 * MiB;
constexpr size_t WS_MODS = 1 * MiB;
constexpr size_t WS_MISC = 2 * MiB;
constexpr size_t WS_W = 4 * MiB, W_LAYER = 96 * MiB;
constexpr size_t WO_IN = 0, WO_OUT = 22 * MiB, WO_GU = 30 * MiB, WO_DN = 74 * MiB;
constexpr size_t WS_H = 388 * MiB;
constexpr size_t WS_CAT = 436 * MiB;
constexpr size_t WS_X1 = 484 * MiB;
constexpr size_t WS_OA = 580 * MiB, WS_OBF = 604 * MiB, WS_OBB = 628 * MiB;
constexpr size_t WS_P = 652 * MiB;
constexpr size_t WS_ACT = WS_P, WS_YPRE = WS_P + 132 * MiB;
constexpr size_t WS_C16 = 916 * MiB;
constexpr size_t WS_QKV = 922 * MiB;
constexpr int QKV_LD = 3072, Q_QD = 0, Q_KD = 512, Q_VD = 1024, Q_QS = 1536, Q_KS = 2560, Q_VS = 2816;
constexpr size_t WS_HQ = 994 * MiB;
constexpr size_t WS_HKM = 1018 * MiB;
constexpr size_t WS_HKP = 1042 * MiB;
constexpr size_t WS_HVT = 1066 * MiB;
constexpr size_t WS_HDEC = 1090 * MiB;
constexpr size_t WS_END = 1093 * MiB;

constexpr int CW_BAR = 4096;

constexpr int RING_BYTES = 131072;
constexpr int LDSCTL_OFF = RING_BYTES, MISC_OFF = LDSCTL_OFF + 320;
constexpr int LDS_BYTES = 147456;

typedef unsigned v2u __attribute__((ext_vector_type(2)));

__device__ __forceinline__ float silu_f(float a) { return a / (1.0f + __expf(-a)); }
__device__ __forceinline__ int mod_of_row(int row) { return row < R_CTX ? 0 : (row < R_CTX + S_LAT ? 1 : 2); }

struct EpiStoreF32 {
    static constexpr bool PERM = false, AFTER_DRAIN = false;
    float* C; int ldc;
    __device__ __forceinline__ void operator()(const pg8::f32x4 (&acc)[2][2][4][2], const pg8::Unit& u, int wr, int wc, int fr, int fq) const {
        const int row0 = u.pm * 256 + wr * 64 + fr, col0 = u.pn * 256 + wc * 32 + 4 * fq;
#pragma unroll
        for (int ai = 0; ai < 2; ++ai)
#pragma unroll
            for (int m = 0; m < 4; ++m) { float* rowp = C + (size_t)(row0 + ai * 128 + m * 16) * ldc + col0;
#pragma unroll
                for (int bj = 0; bj < 2; ++bj)
#pragma unroll
                    for (int n = 0; n < 2; ++n) *(pg8::f32x4*)(rowp + bj * 128 + n * 16) = acc[ai][bj][m][n]; }
    }
};
struct EpiResid {
    static constexpr bool PERM = false, AFTER_DRAIN = false;
    const float* xa; const float* xb;
    const float* gates;
    float* out;
    __device__ __forceinline__ void operator()(const pg8::f32x4 (&acc)[2][2][4][2], const pg8::Unit& u, int wr, int wc, int fr, int fq) const {
        const int mod = u.pm >> 4;
        const float* xbase = (u.pm < 16) ? xa + (size_t)u.pm * 256 * DM : xb + (size_t)(u.pm - 16) * 256 * DM;
        const int r0 = wr * 64 + fr, col0 = u.pn * 256 + wc * 32 + 4 * fq;
        pg8::f32x4 gv[2][2];
#pragma unroll
        for (int bj = 0; bj < 2; ++bj)
#pragma unroll
            for (int n = 0; n < 2; ++n) gv[bj][n] = *(const pg8::f32x4*)(gates + (size_t)mod * 6 * DM + col0 + bj * 128 + n * 16);
#pragma unroll
        for (int ai = 0; ai < 2; ++ai)
#pragma unroll
            for (int m = 0; m < 4; ++m) { const int r = r0 + ai * 128 + m * 16;
                const float* xp = xbase + (size_t)r * DM + col0; float* op = out + ((size_t)u.pm * 256 + r) * DM + col0;
#pragma unroll
                for (int bj = 0; bj < 2; ++bj)
#pragma unroll
                    for (int n = 0; n < 2; ++n) { const pg8::f32x4 xv = *(const pg8::f32x4*)(xp + bj * 128 + n * 16);
                        *(pg8::f32x4*)(op + bj * 128 + n * 16) = xv * ALPHA + gv[bj][n] * acc[ai][bj][m][n]; } }
    }
};
struct EpiSwiGLU {
    static constexpr bool PERM = true, AFTER_DRAIN = false;
    bf16* act;
    __device__ __forceinline__ void operator()(const pg8::f32x4 (&acc)[2][2][4][2], const pg8::Unit& u, int wr, int wc, int fr, int fq) const {
        const int row0 = u.pm * 256 + wr * 64 + fr, col0 = u.pn * 128 + wc * 32 + 8 * fq;
#pragma unroll
        for (int ai = 0; ai < 2; ++ai)
#pragma unroll
            for (int m = 0; m < 4; ++m) { bf16* rowp = act + (size_t)(row0 + ai * 128 + m * 16) * DFF + col0;
                float r[8];
#pragma unroll
                for (int n = 0; n < 2; ++n)
#pragma unroll
                    for (int j = 0; j < 4; ++j) { const float g = acc[ai][0][m][n][j], up = acc[ai][1][m][n][j]; r[n * 4 + j] = silu_f(g) * up; }
                pg8::u32x4 w; w.x = pg8::cvt_pk_bf16(r[0], r[1]); w.y = pg8::cvt_pk_bf16(r[2], r[3]); w.z = pg8::cvt_pk_bf16(r[4], r[5]); w.w = pg8::cvt_pk_bf16(r[6], r[7]);
                *(pg8::u32x4*)rowp = w; }
    }
};

struct Args { const float* in[24]; float* out; unsigned char* ws; int ph_lo, ph_hi, single, pad; };
enum { I_XP = 0, I_XS, I_CDK, I_CDV, I_CSK, I_CSV, I_ST, I_C, I_CCTX, I_WMOD, I_BMOD, I_WIN, I_WOUT, I_DLAM, I_DNG, I_LBL, I_HNG, I_SINK, I_LN1G, I_LN1B, I_LN2G, I_LN2B, I_WGU, I_WDN };

struct Ctx {
    LAS unsigned char* lds; int tid, lane, wave, G, bid;
    const Args* ap; float* out; unsigned char* ws;
    __device__ __forceinline__ const float* inp(int i) const { return ap->in[i]; }
    __device__ __forceinline__ float* mods() const { return (float*)(ws + WS_MODS); }
    __device__ __forceinline__ float* lball() const { return (float*)(ws + WS_MISC); }
    __device__ __forceinline__ float* lamv() const { return (float*)(ws + WS_MISC + 16384); }
    __device__ __forceinline__ float* tabD() const { return (float*)(ws + WS_MISC + 20480); }
    __device__ __forceinline__ float* tabS() const { return (float*)(ws + WS_MISC + 32768); }
    __device__ __forceinline__ bf16* wT(int l, size_t off) const { return (bf16*)(ws + WS_W + (size_t)l * W_LAYER + off); }
    __device__ __forceinline__ bf16* hbuf() const { return (bf16*)(ws + WS_H); }
    __device__ __forceinline__ bf16* cat() const { return (bf16*)(ws + WS_CAT); }
    __device__ __forceinline__ float* x1() const { return (float*)(ws + WS_X1); }
    __device__ __forceinline__ float* oa() const { return (float*)(ws + WS_OA); }
    __device__ __forceinline__ float* obf() const { return (float*)(ws + WS_OBF); }
    __device__ __forceinline__ float* obb() const { return (float*)(ws + WS_OBB); }
    __device__ __forceinline__ float* proj() const { return (float*)(ws + WS_P); }
    __device__ __forceinline__ bf16* act() const { return (bf16*)(ws + WS_ACT); }
    __device__ __forceinline__ float* ypre() const { return (float*)(ws + WS_YPRE); }
    __device__ __forceinline__ bf16* qkv() const { return (bf16*)(ws + WS_QKV); }
    __device__ __forceinline__ bf16* hq(int dir) const { return (bf16*)(ws + WS_HQ) + (size_t)dir * MROWS * 512; }
    __device__ __forceinline__ bf16* hkm(int dir) const { return (bf16*)(ws + WS_HKM) + (size_t)dir * MROWS * 512; }
    __device__ __forceinline__ bf16* hkp(int dir) const { return (bf16*)(ws + WS_HKP) + (size_t)dir * 768 * 512 * 16; }
    __device__ __forceinline__ bf16* hvt(int dir) const { return (bf16*)(ws + WS_HVT) + (size_t)dir * 768 * 512 * 16; }
    __device__ __forceinline__ float* hdec(int dir) const { return (float*)(ws + WS_HDEC) + (size_t)dir * 768 * 512; }
    __device__ __forceinline__ bf16* c16(size_t off) const { return (bf16*)(ws + WS_C16 + off); }
};

__device__ __forceinline__ void transpose_item(const float* W, int K, int N, bf16* WT, int k0, int n0, int drow0, LAS float* scr, int lane) {
#pragma unroll 8
    for (int i = 0; i < 32; ++i) { const int kk = 2 * i + (lane >> 5); scr[kk * 33 + (lane & 31)] = W[(size_t)(k0 + kk) * N + n0 + (lane & 31)]; }
    LDS_WAIT(); asm volatile("" ::: "memory");
    const int c = lane & 7;
#pragma unroll
    for (int j = 0; j < 4; ++j) { const int n = (lane >> 3) + 8 * j; const LAS float* s = scr + (8 * c) * 33 + n;
        v4u o; o.x = pk2(s[0 * 33], s[1 * 33]); o.y = pk2(s[2 * 33], s[3 * 33]); o.z = pk2(s[4 * 33], s[5 * 33]); o.w = pk2(s[6 * 33], s[7 * 33]);
        *(v4u*)(WT + (size_t)(drow0 + n) * K + k0 + 8 * c) = o; }
    LDS_WAIT(); asm volatile("" ::: "memory");
}

__device__ __forceinline__ void p0_prologue(const Ctx& F) {
    {
        LAS float* sc = (LAS float*)F.lds;
        LAS float* red = (LAS float*)(F.lds + 24576);
        const float* c_ctx = F.inp(I_CCTX); const float* cc = F.inp(I_C);
        for (int i = F.tid; i < 3 * DM; i += 512) { const int mid = i / DM, k = i % DM; const float c = mid == 0 ? c_ctx[k] : cc[(mid - 1) * DM + k]; sc[i] = silu_f(c); }
        __syncthreads();
        for (int task = F.bid; task < DEPTH * 48; task += F.G) {
            const int l = task / 48, cb = task % 48, w = F.wave;
            const float* wp = F.inp(I_WMOD) + ((size_t)l * DM + 256 * w) * (6 * DM) + cb * 256 + F.lane * 4;
            f32x4 a0 = {0.f, 0.f, 0.f, 0.f}, a1 = a0, a2 = a0;
#pragma unroll 8
            for (int kk = 0; kk < 256; ++kk) { const f32x4 wv = *(const f32x4*)(wp + (size_t)kk * (6 * DM));
                a0 += wv * sc[256 * w + kk]; a1 += wv * sc[DM + 256 * w + kk]; a2 += wv * sc[2 * DM + 256 * w + kk]; }
            *(LAS f32x4*)(red + (w * 3 + 0) * 256 + F.lane * 4) = a0; *(LAS f32x4*)(red + (w * 3 + 1) * 256 + F.lane * 4) = a1; *(LAS f32x4*)(red + (w * 3 + 2) * 256 + F.lane * 4) = a2;
            __syncthreads();
            for (int i = F.tid; i < 768; i += 512) { const int m = i >> 8, c = i & 255; float s = 0.f;
#pragma unroll
                for (int ww = 0; ww < 8; ++ww) s += red[(ww * 3 + m) * 256 + c];
                F.mods()[((size_t)l * 3 + m) * (6 * DM) + cb * 256 + c] = s + F.inp(I_BMOD)[(size_t)l * 6 * DM + cb * 256 + c]; }
            __syncthreads();
        }
    }
    if (F.bid == F.G - 1) {
        const float* lbl = F.inp(I_LBL);
        for (int i = F.tid; i < 1024; i += 512) { float lg[4], mx = -1e30f;
#pragma unroll
            for (int l = 0; l < 4; ++l) { lg[l] = lbl[l * 1024 + i]; mx = fmaxf(mx, lg[l]); }
            float s = 0.f;
#pragma unroll
            for (int l = 0; l < 4; ++l) { lg[l] = expf(lg[l] - mx); s += lg[l]; }
            const float w1 = lg[1] / s, w2 = lg[2] / s, w3 = lg[3] / s;
            F.lball()[0 * 1024 + i] = 0.f; F.lball()[1 * 1024 + i] = w1; F.lball()[2 * 1024 + i] = w1 + w2; F.lball()[3 * 1024 + i] = w1 + w2 + w3; }
        if (F.tid < 4) { const int l = F.tid; const float* lp = F.inp(I_DLAM) + l * 256; float s1 = 0.f, s2 = 0.f;
            for (int i = 0; i < 64; ++i) { s1 += lp[i] * lp[64 + i]; s2 += lp[128 + i] * lp[192 + i]; }
            const float li = 0.8f - 0.6f * expf(-0.3f * (float)l);
            F.lamv()[l * 2] = expf(s1) - expf(s2) + li; F.lamv()[l * 2 + 1] = li; }
        for (int i = F.tid; i < 64 * 16; i += 512) { const int pos = i / 16, j = i % 16; const float inv = powf(10000.f, -(float)j / 16.f), ang = (float)pos * inv; F.tabD()[i * 2] = cosf(ang); F.tabD()[i * 2 + 1] = sinf(ang); }
        for (int i = F.tid; i < 64 * 32; i += 512) { const int pos = i / 32, j = i % 32; const float inv = powf(10000.f, -(float)j / 32.f), ang = (float)pos * inv; F.tabS()[i * 2] = cosf(ang); F.tabS()[i * 2 + 1] = sinf(ang); }
    }
    {
        const float* src[4] = {F.inp(I_CDK), F.inp(I_CDV), F.inp(I_CSK), F.inp(I_CSV)};
        const size_t doff[4] = {0, 2 * MiB, 4 * MiB, 5 * MiB}; const int n8[4] = {131072, 131072, 65536, 65536};
#pragma unroll
        for (int a = 0; a < 4; ++a)
            for (int i = F.bid * 512 + F.tid; i < n8[a]; i += F.G * 512) { const f32x4 x0 = *(const f32x4*)(src[a] + (size_t)i * 8), x1 = *(const f32x4*)(src[a] + (size_t)i * 8 + 4);
                v4u o; o.x = pk2(x0[0], x0[1]); o.y = pk2(x0[2], x0[3]); o.z = pk2(x1[0], x1[1]); o.w = pk2(x1[2], x1[3]); *(v4u*)(F.c16(doff[a]) + (size_t)i * 8) = o; }
    }
    {
        LAS float* scr = (LAS float*)(F.lds + 49152 + F.wave * 8448);
        const int gw = F.bid * 8 + F.wave, NGW = F.G * 8;
        constexpr int I_IN = 32 * 176, I_OUT = 32 * 64, I_GU = 32 * 352, I_DN = 88 * 64, I_L = I_IN + I_OUT + I_GU + I_DN;
        for (int it = gw; it < DEPTH * I_L; it += NGW) {
            const int l = it / I_L; int r = it % I_L;
            if (r < I_IN) { const int kb = r / 176, nb = r % 176; transpose_item(F.inp(I_WIN) + (size_t)l * DM * DIN, DM, DIN, F.wT(l, WO_IN), 64 * kb, 32 * nb, 32 * nb, scr, F.lane); continue; } r -= I_IN;
            if (r < I_OUT) { const int kb = r / 64, nb = r % 64; transpose_item(F.inp(I_WOUT) + (size_t)l * DM * DM, DM, DM, F.wT(l, WO_OUT), 64 * kb, 32 * nb, 32 * nb, scr, F.lane); continue; } r -= I_OUT;
            if (r < I_GU) { const int kb = r / 352, nb = r % 352, n0 = 32 * nb; const int j = n0 < DFF ? n0 : n0 - DFF; const int drow = 256 * (j >> 7) + (n0 < DFF ? 0 : 128) + (j & 127);
                transpose_item(F.inp(I_WGU) + (size_t)l * DM * DGU, DM, DGU, F.wT(l, WO_GU), 64 * kb, n0, drow, scr, F.lane); continue; } r -= I_GU;
            { const int kb = r / 64, nb = r % 64; transpose_item(F.inp(I_WDN) + (size_t)l * DFF * DM, DFF, DM, F.wT(l, WO_DN), 64 * kb, 32 * nb, 32 * nb, scr, F.lane); }
        }
    }
}

__device__ __forceinline__ void p1_h0(const Ctx& F) {
    const float* xp = F.inp(I_XP); const float* xs = F.inp(I_XS);
    for (int idx = F.bid * 512 + F.tid; idx < MROWS * 256; idx += F.G * 512) {
        const int row = idx >> 8, c8 = (idx & 255) * 8, mod = mod_of_row(row);
        const float* xr = row < R_CTX ? xp + (size_t)row * DM : xs + (size_t)(row - R_CTX) * DM;
        const float* sh = F.mods() + (size_t)(0 * 3 + mod) * 6 * DM; const float* sc = sh + DM;
        const f32x4 x0 = *(const f32x4*)(xr + c8), x1 = *(const f32x4*)(xr + c8 + 4), s0 = *(const f32x4*)(sh + c8), s1 = *(const f32x4*)(sh + c8 + 4), c0 = *(const f32x4*)(sc + c8), c1 = *(const f32x4*)(sc + c8 + 4);
        const f32x4 h0 = x0 * (c0 + 1.0f) + s0, h1 = x1 * (c1 + 1.0f) + s1;
        v4u o; o.x = pk2(h0[0], h0[1]); o.y = pk2(h0[2], h0[3]); o.z = pk2(h1[0], h1[1]); o.w = pk2(h1[2], h1[3]);
        *(v4u*)(F.hbuf() + (size_t)row * DM + c8) = o;
    }
}

constexpr float LOG2E = 1.4426950408889634f;
constexpr float QSC_D = 0.125f * LOG2E, QSC_S = 0.08838834764831845f * LOG2E;
__device__ __forceinline__ void e1_postproj(const Ctx& F, int l) {
    const float* lb = F.lball() + l * 1024;
    for (int grp = F.bid; grp < MROWS / 16; grp += F.G) {
        const int row0 = grp * 16;
        for (int rr = 0; rr < 16; ++rr) {
            const int row = row0 + rr;
            const float* pr = F.proj() + (size_t)row * DIN; bf16* qk = F.qkv() + (size_t)row * QKV_LD;
            const bool lat = row >= R_CTX; const int t = (row - R_CTX) & (S_LAT - 1), rpos = t >> 6, cpos = t & 63;
            { const int p = F.tid, blk = p >> 4, i = p & 15, cb = blk * 32, pos = (blk & 1) ? cpos : rpos;
              float cs = 1.f, sn = 0.f; if (lat) { cs = F.tabD()[(pos * 16 + i) * 2]; sn = F.tabD()[(pos * 16 + i) * 2 + 1]; }
              const float x1 = pr[cb + i], x2 = pr[cb + 16 + i], sc = cb < 512 ? QSC_D : 1.0f;
              qk[cb + i] = (bf16)f2bf((x1 * cs - x2 * sn) * sc); qk[cb + 16 + i] = (bf16)f2bf((x2 * cs + x1 * sn) * sc); }
            for (int p = F.tid; p < 640; p += 512) { const int blk = p >> 5, i = p & 31, cb = C_CQ + blk * 64, db = Q_QS + blk * 64, pos = (blk & 1) ? cpos : rpos;
              float cs = 1.f, sn = 0.f; if (lat) { cs = F.tabS()[(pos * 32 + i) * 2]; sn = F.tabS()[(pos * 32 + i) * 2 + 1]; }
              const float x1 = pr[cb + i], x2 = pr[cb + 32 + i], sc = blk < 16 ? QSC_S : 1.0f;
              qk[db + i] = (bf16)f2bf((x1 * cs - x2 * sn) * sc); qk[db + 32 + i] = (bf16)f2bf((x2 * cs + x1 * sn) * sc); }
            { const int c = F.tid; qk[Q_VD + c] = (bf16)f2bf(pr[C_AV + c]); if (c < 256) qk[Q_VS + c] = (bf16)f2bf(pr[C_CV + c]); }
            if (!lat) {
                const int b = row >> 8, n = row & 255;
                for (int i = F.tid; i < 384; i += 512) {
                    if (i < 128) { const int h = i >> 5, c4 = (i & 31) * 4; *(f32x4*)(F.out + O_DK + ((((size_t)b * 4 + l) * 4 + h) * 256 + n) * 128 + c4) = *(const f32x4*)(pr + C_AK + h * 128 + c4); }
                    else if (i < 256) { const int ii = i - 128, h = ii >> 5, c4 = (ii & 31) * 4; *(f32x4*)(F.out + O_DV + ((((size_t)b * 4 + l) * 4 + h) * 256 + n) * 128 + c4) = *(const f32x4*)(pr + C_AV + h * 128 + c4); }
                    else if (i < 320) { const int ii = i - 256, kv = ii >> 5, c4 = (ii & 31) * 4; *(f32x4*)(F.out + O_SK + ((((size_t)b * 4 + l) * 2 + kv) * 256 + n) * 128 + c4) = *(const f32x4*)(pr + C_CK + kv * 128 + c4); }
                    else { const int ii = i - 320, kv = ii >> 5, c4 = (ii & 31) * 4; *(f32x4*)(F.out + O_SV + ((((size_t)b * 4 + l) * 2 + kv) * 256 + n) * 128 + c4) = *(const f32x4*)(pr + C_CV + kv * 128 + c4); }
                }
            }
        }
        {
            const int c = F.tid; const float* pc = F.proj() + (size_t)row0 * DIN;
            float qv[16], vv[16];
#pragma unroll
            for (int r = 0; r < 16; ++r) { qv[r] = silu_f(pc[(size_t)r * DIN + C_BQ + c]); vv[r] = pc[(size_t)r * DIN + C_BI + c]; }
#pragma unroll
            for (int dir = 0; dir < 2; ++dir) {
                const float lbv = lb[dir * 512 + c], lbm = fmaxf(lbv, 1e-30f), oml = 1.0f - lbv;
                float g[16], cum[16]; float run = 0.f;
#pragma unroll
                for (int p = 0; p < 16; ++p) { const int r = dir ? 15 - p : p; const float z = pc[(size_t)r * DIN + C_BF + dir * 512 + c];
                    g[p] = logf(lbm + oml / (1.0f + expf(-z))); run += g[p]; cum[p] = run; }
                const float last = run;
                unsigned kpw[8], vtw[8];
#pragma unroll
                for (int p = 0; p < 16; p += 2) {
                    float kp2[2];
#pragma unroll
                    for (int e = 0; e < 2; ++e) { const int pp = p + e, r = dir ? 15 - pp : pp; const float k = 1.0f - expf(g[pp]); const float cc = fmaxf(cum[pp], -80.0f);
                        F.hq(dir)[(size_t)(row0 + r) * 512 + c] = (bf16)f2bf(qv[r] * expf(cc)); F.hkm(dir)[(size_t)(row0 + r) * 512 + c] = (bf16)f2bf(k * expf(-cc));
                        kp2[e] = k * expf(last - cum[pp]); }
                    kpw[p >> 1] = pk2(kp2[0], kp2[1]); vtw[p >> 1] = pk2(vv[dir ? 15 - p : p], vv[dir ? 14 - p : p + 1]);
                }
                v4u* kd = (v4u*)(F.hkp(dir) + ((size_t)grp * 512 + c) * 16); v4u* vd = (v4u*)(F.hvt(dir) + ((size_t)grp * 512 + c) * 16);
                kd[0] = (v4u){kpw[0], kpw[1], kpw[2], kpw[3]}; kd[1] = (v4u){kpw[4], kpw[5], kpw[6], kpw[7]};
                vd[0] = (v4u){vtw[0], vtw[1], vtw[2], vtw[3]}; vd[1] = (v4u){vtw[4], vtw[5], vtw[6], vtw[7]};
                F.hdec(dir)[(size_t)grp * 512 + c] = expf(last);
            }
        }
    }
}

typedef float f32x16 __attribute__((ext_vector_type(16)));
typedef short s16x4 __attribute__((ext_vector_type(4)));
typedef __bf16 bf16x2_t __attribute__((ext_vector_type(2)));
typedef float f32x2_t __attribute__((ext_vector_type(2)));
__device__ __forceinline__ unsigned cvt2(float a, float b) { const f32x2_t f = {a, b}; return __builtin_bit_cast(unsigned, __builtin_convertvector(f, bf16x2_t)); }
#define MFMA32(a, b, c) __builtin_amdgcn_mfma_f32_32x32x16_bf16((a), (b), (c), 0, 0, 0)

struct AttnSeg { const bf16* k; const bf16* v; int stride; int ntiles; };
constexpr int KPB = 272, VPB = 320;
constexpr int KT_BYTES = 64 * KPB, VT_BYTES = 64 * VPB, ABUF_BYTES = KT_BYTES + VT_BYTES;
constexpr float ATT_THR = 8.0f;

template <int DQK, bool DIFF>
__device__ __forceinline__ void attn_mfma(const Ctx& F, const bf16* qptr, int kcol, const AttnSeg s0, const AttnSeg s1, bool band, int qpos, int kpos0,
                                          float m_init, float l_init, float lam, float post_scale, const float* gvec, bf16* outp  ) {
    int lane_ = (int)__builtin_amdgcn_mbcnt_hi(~0u, __builtin_amdgcn_mbcnt_lo(~0u, 0u)); asm volatile("" : "+v"(lane_));
    const int lane = lane_, tid = F.wave * 64 + lane, r32 = lane & 31, h = lane >> 5;
    __syncthreads();
    bf16x8 qf[DQK / 16];
#pragma unroll
    for (int ks = 0; ks < DQK / 16; ++ks) qf[ks] = *(const bf16x8*)(qptr + (size_t)r32 * QKV_LD + 16 * ks + 8 * h);
    f32x16 o[4];
#pragma unroll
    for (int t = 0; t < 4; ++t)
#pragma unroll
        for (int r = 0; r < 16; ++r) o[t][r] = 0.f;
    float m = m_init, l = l_init;
    const int nt = s0.ntiles + s1.ntiles;
    const int srow = tid >> 4, spc = tid & 15;
    v4u kreg[2], vreg[2];
#define ATT_ISSUE(ti) do { const bool s1_ = (ti) >= s0.ntiles; const int tt_ = s1_ ? (ti) - s0.ntiles : (ti); const bf16* kb_ = s1_ ? s1.k : s0.k; const bf16* vb_ = s1_ ? s1.v : s0.v; const int st_ = s1_ ? s1.stride : s0.stride; \
        _Pragma("unroll") for (int i_ = 0; i_ < 2; ++i_) { const size_t go_ = (size_t)(tt_ * 64 + srow + 32 * i_) * st_ + spc * 8; kreg[i_] = *(const v4u*)(kb_ + go_); vreg[i_] = *(const v4u*)(vb_ + go_); } } while (0)
#define ATT_WRITE(b) do { _Pragma("unroll") for (int i_ = 0; i_ < 2; ++i_) { *(LAS v4u*)(F.lds + (b) * ABUF_BYTES + (srow + 32 * i_) * KPB + spc * 16) = kreg[i_]; \
        *(LAS v4u*)(F.lds + (b) * ABUF_BYTES + KT_BYTES + (srow + 32 * i_) * VPB + spc * 16) = vreg[i_]; } } while (0)
    ATT_ISSUE(0); ATT_WRITE(0);
    __syncthreads();
    const int koff = r32 * KPB + (kcol + 8 * h) * 2;
    const int voff = KT_BYTES + (4 * h + ((lane & 15) >> 2)) * VPB + (16 * ((lane >> 4) & 1) + 4 * (lane & 3)) * 2;
    for (int ti = 0; ti < nt; ++ti) {
        const int buf = ti & 1;
        if (ti + 1 < nt) ATT_ISSUE(ti + 1);
        const LAS unsigned char* kb = F.lds + buf * ABUF_BYTES;
        f32x16 st[2];
#pragma unroll
        for (int kt = 0; kt < 2; ++kt) {
#pragma unroll
            for (int r = 0; r < 16; ++r) st[kt][r] = 0.f;
#pragma unroll
            for (int ks = 0; ks < DQK / 16; ++ks) { const bf16x8 kf = *(const LAS bf16x8*)(kb + koff + kt * 32 * KPB + ks * 32); st[kt] = MFMA32(kf, qf[ks], st[kt]); }
        }
        if (band && ti < s0.ntiles) {
            const int kp = kpos0 + ti * 64 + 4 * h - (qpos + r32);
#pragma unroll
            for (int kt = 0; kt < 2; ++kt)
#pragma unroll
                for (int r = 0; r < 16; ++r) { const int d = kp + 32 * kt + (r & 3) + 8 * (r >> 2); if (d > 128 || d < -128) st[kt][r] = -1e30f; }
        }
        float mx = st[0][0];
#pragma unroll
        for (int kt = 0; kt < 2; ++kt)
#pragma unroll
            for (int r = 0; r < 16; ++r) mx = fmaxf(mx, st[kt][r]);
        mx = fmaxf(mx, __shfl_xor(mx, 32));
        if (__builtin_amdgcn_ballot_w64(mx > m + ATT_THR) != 0ull) {
            const float mn = fmaxf(m, mx), a = __builtin_amdgcn_exp2f(m - mn); l *= a; m = mn;
#pragma unroll
            for (int t = 0; t < 4; ++t)
#pragma unroll
                for (int r = 0; r < 16; ++r) o[t][r] *= a;
        }
        float rs = 0.f;
#pragma unroll
        for (int kt = 0; kt < 2; ++kt)
#pragma unroll
            for (int r = 0; r < 16; ++r) { const float p = __builtin_amdgcn_exp2f(st[kt][r] - m); st[kt][r] = p; rs += p; }
        rs += __shfl_xor(rs, 32); l += rs;
#pragma unroll
        for (int kt = 0; kt < 2; ++kt)
#pragma unroll
            for (int s = 0; s < 2; ++s) {
                v4u pw; pw.x = cvt2(st[kt][8 * s], st[kt][8 * s + 1]); pw.y = cvt2(st[kt][8 * s + 2], st[kt][8 * s + 3]); pw.z = cvt2(st[kt][8 * s + 4], st[kt][8 * s + 5]); pw.w = cvt2(st[kt][8 * s + 6], st[kt][8 * s + 7]);
                const bf16x8 pf = __builtin_bit_cast(bf16x8, pw);
#pragma unroll
                for (int t = 0; t < 4; ++t) {
                    const s16x4 lo = __builtin_amdgcn_ds_read_tr16_b64_v4i16((LAS s16x4*)(kb + voff + (32 * kt + 16 * s) * VPB + t * 64));
                    const s16x4 hi = __builtin_amdgcn_ds_read_tr16_b64_v4i16((LAS s16x4*)(kb + voff + (32 * kt + 16 * s + 8) * VPB + t * 64));
                    const bf16x8 vf = __builtin_shufflevector(lo, hi, 0, 1, 2, 3, 4, 5, 6, 7);
                    o[t] = MFMA32(vf, pf, o[t]);
                }
            }
        if (ti + 1 < nt) ATT_WRITE(buf ^ 1);
        __syncthreads();
    }
#undef ATT_ISSUE
#undef ATT_WRITE
    const float inv = 1.0f / l;
    if (DIFF) {
        LAS float* ex = (LAS float*)F.lds;
        if (F.wave >= 4) {
#pragma unroll
            for (int t = 0; t < 4; ++t)
#pragma unroll
                for (int r = 0; r < 16; ++r) ex[((F.wave - 4) * 64 + t * 16 + r) * 64 + lane] = o[t][r] * inv;
        }
        __syncthreads();
        if (F.wave < 4) {
            float ss = 0.f;
#pragma unroll
            for (int t = 0; t < 4; ++t)
#pragma unroll
                for (int r = 0; r < 16; ++r) { const float x = o[t][r] * inv - lam * ex[(F.wave * 64 + t * 16 + r) * 64 + lane]; o[t][r] = x; ss += x * x; }
            ss += __shfl_xor(ss, 32);
            const float sc = post_scale / sqrtf(ss * (1.0f / 128.0f) + 1e-6f);
            bf16* op = outp + (size_t)r32 * DM;
#pragma unroll
            for (int t = 0; t < 4; ++t)
#pragma unroll
                for (int g4 = 0; g4 < 4; ++g4) { const int dv = 32 * t + 8 * g4 + 4 * h; const f32x4 gv = *(const f32x4*)(gvec + dv);
                    v2u w; w.x = cvt2(o[t][4 * g4] * sc * gv[0], o[t][4 * g4 + 1] * sc * gv[1]); w.y = cvt2(o[t][4 * g4 + 2] * sc * gv[2], o[t][4 * g4 + 3] * sc * gv[3]); *(v2u*)(op + dv) = w; }
        }
    } else {
        bf16* op = outp + (size_t)r32 * DM;
#pragma unroll
        for (int t = 0; t < 4; ++t)
#pragma unroll
            for (int g4 = 0; g4 < 4; ++g4) { const int dv = 32 * t + 8 * g4 + 4 * h;
                v2u w; w.x = cvt2(o[t][4 * g4] * inv, o[t][4 * g4 + 1] * inv); w.y = cvt2(o[t][4 * g4 + 2] * inv, o[t][4 * g4 + 3] * inv); *(v2u*)(op + dv) = w; }
    }
}

#define MFMA16(a, b, c) __builtin_amdgcn_mfma_f32_16x16x32_bf16((a), (b), (c), 0, 0, 0)
__device__ __forceinline__ bf16x8 frag2(v2u lo, v2u hi) { const v4u w = {lo.x, lo.y, hi.x, hi.y}; return __builtin_bit_cast(bf16x8, w); }
__device__ __forceinline__ void hgrn_mfma(const Ctx& F, int rb, int nchunks, int h, int dir, const float* s_in, float* s_out, float* ob) {
    int lane_ = (int)__builtin_amdgcn_mbcnt_hi(~0u, __builtin_amdgcn_mbcnt_lo(~0u, 0u)); asm volatile("" : "+v"(lane_));
    const int lane = lane_, t16 = lane & 15, G = lane >> 4, vcol = h * 128 + F.wave * 16 + t16;
    f32x4 S[8];
#pragma unroll
    for (int i = 0; i < 8; ++i)
#pragma unroll
        for (int r = 0; r < 4; ++r) S[i][r] = s_in ? s_in[(size_t)(16 * i + 4 * G + r) * 128 + F.wave * 16 + t16] : 0.f;
    const bf16* HQ = F.hq(dir) + h * 128 + 4 * G; const bf16* HKM = F.hkm(dir) + h * 128 + 4 * G;
    const bf16* HKP = F.hkp(dir) + (size_t)(h * 128 + t16) * 16 + 4 * G; const bf16* HVT = F.hvt(dir) + (size_t)vcol * 16 + 4 * G; const float* HDEC = F.hdec(dir) + h * 128 + 4 * G;
    const v2u z2 = {0u, 0u};
    v2u qn[8], kn[8], vtn;
#define HG_LOAD_QK(cc) do { const int ch_ = dir ? nchunks - 1 - (cc) : (cc); const size_t ar_ = (size_t)(rb + ch_ * 16 + (dir ? 15 - t16 : t16)) * 512; const size_t gc_ = (size_t)(rb / 16 + ch_); \
        _Pragma("unroll") for (int i_ = 0; i_ < 8; ++i_) { qn[i_] = *(const v2u*)(HQ + ar_ + 16 * i_); kn[i_] = *(const v2u*)(HKM + ar_ + 16 * i_); } vtn = *(const v2u*)(HVT + gc_ * 512 * 16); } while (0)
    HG_LOAD_QK(0);
    for (int cc = 0; cc < nchunks; ++cc) {
        const int ch = dir ? nchunks - 1 - cc : cc; const size_t gc = (size_t)(rb / 16 + ch);
        v2u q[8], k[8]; const v2u vt = vtn;
#pragma unroll
        for (int i = 0; i < 8; ++i) { q[i] = qn[i]; k[i] = kn[i]; }
        v2u kp[8]; f32x4 dec[8];
#pragma unroll
        for (int i = 0; i < 8; ++i) { kp[i] = *(const v2u*)(HKP + (gc * 512 + 16 * i) * 16); dec[i] = *(const f32x4*)(HDEC + gc * 512 + 16 * i); }
        { const int cn = cc + 1 < nchunks ? cc + 1 : cc; HG_LOAD_QK(cn); }
        f32x4 pt = {0.f, 0.f, 0.f, 0.f};
#pragma unroll
        for (int kk = 0; kk < 4; ++kk) pt = MFMA16(frag2(k[2 * kk], k[2 * kk + 1]), frag2(q[2 * kk], q[2 * kk + 1]), pt);
#pragma unroll
        for (int r = 0; r < 4; ++r) if (4 * G + r > t16) pt[r] = 0.f;
        const v2u pb = {cvt2(pt[0], pt[1]), cvt2(pt[2], pt[3])};
        const bf16x8 vb = frag2(vt, z2);
        f32x4 o = {0.f, 0.f, 0.f, 0.f};
        o = MFMA16(frag2(pb, z2), vb, o);
#pragma unroll
        for (int kk = 0; kk < 4; ++kk) { const v2u s0 = {cvt2(S[2 * kk][0], S[2 * kk][1]), cvt2(S[2 * kk][2], S[2 * kk][3])}, s1 = {cvt2(S[2 * kk + 1][0], S[2 * kk + 1][1]), cvt2(S[2 * kk + 1][2], S[2 * kk + 1][3])};
            o = MFMA16(frag2(q[2 * kk], q[2 * kk + 1]), frag2(s0, s1), o); }
#pragma unroll
        for (int i = 0; i < 8; ++i) { S[i] = S[i] * dec[i]; S[i] = MFMA16(frag2(kp[i], z2), vb, S[i]); }
        const int crow = rb + ch * 16;
#pragma unroll
        for (int r = 0; r < 4; ++r) { const int pr_ = 4 * G + r; ob[(size_t)(crow + (dir ? 15 - pr_ : pr_)) * 512 + vcol] = o[r]; }
    }
#undef HG_LOAD_QK
    if (s_out) {
#pragma unroll
        for (int i = 0; i < 8; ++i)
#pragma unroll
            for (int r = 0; r < 4; ++r) s_out[(size_t)(16 * i + 4 * G + r) * 128 + F.wave * 16 + t16] = S[i][r];
    }
}

__device__ __forceinline__ void mx_mixers(const Ctx& F, int l) {
    const float lam = F.lamv()[l * 2], lam_init = F.lamv()[l * 2 + 1];
    const bf16* qkv = F.qkv();
    constexpr int T_LH = 16, T_LD = 256, T_LB = 256, T_CD = 128, T_CS = 128, T_CH = 128;
    constexpr int NT = T_LH + T_LD + T_LB + T_CD + T_CS + T_CH;
    const AttnSeg none = {nullptr, nullptr, 0, 0};
    const int w = F.wave;
    for (int task = F.bid; task < NT; task += F.G) {
        int i = task;
        if (i < T_LH) {
            const int b = i >> 3, h = (i >> 1) & 3, dir = i & 1;
            const float* sin_ = F.inp(I_ST) + ((((size_t)b * 4 + l) * 2 + dir) * 4 + h) * 128 * 128;
            hgrn_mfma(F, R_CTX + b * S_LAT, S_LAT / 16, h, dir, sin_, nullptr, dir ? F.obb() : F.obf());
            continue; } i -= T_LH;
        if (i < T_LD) {
            const int b = i >> 7, h = (i >> 5) & 3, qt = i & 31, map = w >> 2; const int rb = R_CTX + b * S_LAT, wrow = rb + qt * 128 + 32 * (w & 3);
            const AttnSeg s0 = {qkv + (size_t)rb * QKV_LD + Q_KD + h * 128, qkv + (size_t)rb * QKV_LD + Q_VD + h * 128, QKV_LD, S_LAT / 64};
            const size_t co = (((size_t)b * 4 + l) * 4 + h) * 256 * 128;
            const AttnSeg s1 = {F.c16(0) + co, F.c16(2 * MiB) + co, 128, 4};
            attn_mfma<64, true>(F, qkv + (size_t)wrow * QKV_LD + Q_QD + h * 128 + map * 64, map * 64, s0, s1, false, 0, 0, -1e30f, 0.f, lam, 1.0f - lam_init, F.inp(I_DNG) + l * 128, F.cat() + (size_t)wrow * DM + h * 128);
            continue; } i -= T_LD;
        if (i < T_LB) {
            const int b = i >> 7, kv = (i >> 6) & 1, qt = i & 63, hh = kv * 4 + (w >> 1); const int rb = R_CTX + b * S_LAT, t0 = qt * 64, wrow = rb + t0 + 32 * (w & 1);
            const int ks = t0 - 128 < 0 ? 0 : t0 - 128, ke = t0 + 192 > S_LAT ? S_LAT : t0 + 192;
            const AttnSeg s0 = {qkv + (size_t)(rb + ks) * QKV_LD + Q_KS + kv * 128, qkv + (size_t)(rb + ks) * QKV_LD + Q_VS + kv * 128, QKV_LD, (ke - ks) / 64};
            const size_t co = (((size_t)b * 4 + l) * 2 + kv) * 256 * 128;
            const AttnSeg s1 = {F.c16(4 * MiB) + co, F.c16(5 * MiB) + co, 128, 4};
            attn_mfma<128, false>(F, qkv + (size_t)wrow * QKV_LD + Q_QS + hh * 128, 0, s0, s1, true, t0 + 32 * (w & 1), ks, F.inp(I_SINK)[l * 8 + hh] * LOG2E, 1.0f, 0.f, 1.0f, nullptr, F.cat() + (size_t)wrow * DM + 1024 + hh * 128);
            continue; } i -= T_LB;
        if (i < T_CD) {
            const int b = i >> 3, h = (i >> 1) & 3, qt = i & 1, map = w >> 2, rb = b * 256, wrow = rb + qt * 128 + 32 * (w & 3);
            const AttnSeg s0 = {qkv + (size_t)rb * QKV_LD + Q_KD + h * 128, qkv + (size_t)rb * QKV_LD + Q_VD + h * 128, QKV_LD, 4};
            attn_mfma<64, true>(F, qkv + (size_t)wrow * QKV_LD + Q_QD + h * 128 + map * 64, map * 64, s0, none, false, 0, 0, -1e30f, 0.f, lam, 1.0f - lam_init, F.inp(I_DNG) + l * 128, F.cat() + (size_t)wrow * DM + h * 128);
            continue; } i -= T_CD;
        if (i < T_CS) {
            const int b = i >> 3, kv = (i >> 2) & 1, qt = i & 3, hh = kv * 4 + (w >> 1), rb = b * 256, wrow = rb + qt * 64 + 32 * (w & 1);
            const AttnSeg s0 = {qkv + (size_t)rb * QKV_LD + Q_KS + kv * 128, qkv + (size_t)rb * QKV_LD + Q_VS + kv * 128, QKV_LD, 4};
            attn_mfma<128, false>(F, qkv + (size_t)wrow * QKV_LD + Q_QS + hh * 128, 0, s0, none, false, 0, 0, F.inp(I_SINK)[l * 8 + hh] * LOG2E, 1.0f, 0.f, 1.0f, nullptr, F.cat() + (size_t)wrow * DM + 1024 + hh * 128);
            continue; } i -= T_CS;
        {
            const int b = i >> 3, h = (i >> 1) & 3, dir = i & 1;
            float* sout = F.out + O_ST + ((((size_t)b * 4 + l) * 2 + dir) * 4 + h) * 128 * 128;
            hgrn_mfma(F, b * 256, 16, h, dir, nullptr, sout, dir ? F.obb() : F.obf());
        }
    }
}

__device__ __forceinline__ void mg_merge(const Ctx& F, int l) {
    const int head = F.lane >> 4, sub = F.lane & 15, col0 = head * 128 + sub * 8;
    for (int row = F.bid * 8 + F.wave; row < MROWS; row += F.G * 8) {
        const f32x4 a0 = *(const f32x4*)(F.obf() + (size_t)row * 512 + col0) + *(const f32x4*)(F.obb() + (size_t)row * 512 + col0);
        const f32x4 a1 = *(const f32x4*)(F.obf() + (size_t)row * 512 + col0 + 4) + *(const f32x4*)(F.obb() + (size_t)row * 512 + col0 + 4);
        float ss = (a0[0] * a0[0] + a0[1] * a0[1]) + (a0[2] * a0[2] + a0[3] * a0[3]) + (a1[0] * a1[0] + a1[1] * a1[1]) + (a1[2] * a1[2] + a1[3] * a1[3]);
        ss += __shfl_xor(ss, 1); ss += __shfl_xor(ss, 2); ss += __shfl_xor(ss, 4); ss += __shfl_xor(ss, 8);
        const float rinv = 1.0f / sqrtf(ss * (1.0f / 128.0f) + 1e-6f);
        const float* g = F.inp(I_HNG) + l * 128 + sub * 8; const float* hg = F.proj() + (size_t)row * DIN + C_BG + col0;
        const f32x4 g0 = *(const f32x4*)g, g1 = *(const f32x4*)(g + 4), h0 = *(const f32x4*)hg, h1 = *(const f32x4*)(hg + 4);
        float y[8];
#pragma unroll
        for (int i = 0; i < 4; ++i) { y[i] = a0[i] * rinv * g0[i] * silu_f(h0[i]); y[4 + i] = a1[i] * rinv * g1[i] * silu_f(h1[i]); }
        v4u w; w.x = pk2(y[0], y[1]); w.y = pk2(y[2], y[3]); w.z = pk2(y[4], y[5]); w.w = pk2(y[6], y[7]);
        *(v4u*)(F.cat() + (size_t)row * DM + 512 + col0) = w;
    }
}

__device__ __forceinline__ void ln_phase(const Ctx& F, const float* g, const float* b, float* xo, const float* modsl  , int which_sh) {
    for (int row = F.bid * 8 + F.wave; row < MROWS; row += F.G * 8) {
        const float* yp = F.ypre() + (size_t)row * DM + F.lane * 4;
        f32x4 v[8]; float s = 0.f;
#pragma unroll
        for (int j = 0; j < 8; ++j) { v[j] = *(const f32x4*)(yp + 256 * j); s += (v[j][0] + v[j][1]) + (v[j][2] + v[j][3]); }
#pragma unroll
        for (int o = 1; o < 64; o <<= 1) s += __shfl_xor(s, o);
        const float mean = s * (1.0f / DM); float s2 = 0.f;
#pragma unroll
        for (int j = 0; j < 8; ++j) { v[j] = v[j] - mean; s2 += (v[j][0] * v[j][0] + v[j][1] * v[j][1]) + (v[j][2] * v[j][2] + v[j][3] * v[j][3]); }
#pragma unroll
        for (int o = 1; o < 64; o <<= 1) s2 += __shfl_xor(s2, o);
        const float rstd = 1.0f / sqrtf(s2 * (1.0f / DM) + 1e-5f);
        const int mod = mod_of_row(row);
        const float* sh = modsl ? modsl + ((size_t)mod * 6 + which_sh) * DM : nullptr;
#pragma unroll
        for (int j = 0; j < 8; ++j) { const int c = F.lane * 4 + 256 * j;
            const f32x4 x = v[j] * rstd * *(const f32x4*)(g + c) + *(const f32x4*)(b + c);
            *(f32x4*)(xo + (size_t)row * DM + c) = x;
            if (modsl) { const f32x4 hh = x * (*(const f32x4*)(sh + DM + c) + 1.0f) + *(const f32x4*)(sh + c);
                v2u w; w.x = pk2(hh[0], hh[1]); w.y = pk2(hh[2], hh[3]); *(v2u*)(F.hbuf() + (size_t)row * DM + c) = w; } }
    }
}

constexpr int PH_PER_LAYER = 9, N_PHASES = 2 + DEPTH * PH_PER_LAYER;
__global__ void __launch_bounds__(512, 2) fwd_kernel(Args args) {
    extern __shared__ __attribute__((aligned(16))) unsigned char lds_raw[];
    Ctx F;
    F.lds = (LAS unsigned char*)lds_raw;
    F.tid = threadIdx.x; F.lane = F.tid & 63; F.wave = __builtin_amdgcn_readfirstlane(F.tid >> 6); F.G = gridDim.x; F.bid = blockIdx.x;
    F.ap = &args; F.out = args.out; F.ws = args.ws;
    volatile LAS unsigned* MISC = (volatile LAS unsigned*)(F.lds + MISC_OFF);
    for (int u = F.tid; u < (LDS_BYTES - LDSCTL_OFF) / 4; u += 512) ((LAS unsigned*)(F.lds + LDSCTL_OFF))[u] = 0u;
    __syncthreads();
    XcdBarrier bar; bar.bar = (unsigned*)(args.ws + WS_CTL) + CW_BAR; bar.x = 0; bar.st = nullptr;
    if (args.single) bar = xcd_barrier_post((unsigned*)(args.ws + WS_CTL) + CW_BAR, MISC + 8);
    const int lo = args.ph_lo, hi = args.ph_hi;
#define IN(k) (lo <= (k) && (k) < hi)
#define FRESH() do { int ln_ = (int)__builtin_amdgcn_mbcnt_hi(~0u, __builtin_amdgcn_mbcnt_lo(~0u, 0u)); asm volatile("" : "+v"(ln_)); F.lane = ln_; asm volatile("" : "+s"(F.wave)); F.tid = F.wave * 64 + F.lane; \
    asm volatile("" : "+s"(F.bid), "+s"(F.G)); asm volatile("" : "+s"(F.ws), "+s"(F.out)); } while (0)
#define SEAM(k) do { if (IN((k) + 1)) xcd_barrier(bar); } while (0)

    if (IN(0)) { FRESH(); p0_prologue(F); SEAM(0); }
    if (IN(1)) { FRESH(); p1_h0(F); SEAM(1); }
    for (int l = 0; l < DEPTH; ++l) {
        const int k0 = 2 + l * PH_PER_LAYER;
        FRESH();
        const float* xa = l == 0 ? F.inp(I_XP) : F.out + O_YP; const float* xb = l == 0 ? F.inp(I_XS) : F.out + O_YS;
        if (IN(k0 + 0)) {
            pg8::Gemm g{F.hbuf(), F.wT(l, WO_IN), MROWS, DIN, DM}; pg8::StaticOrder S; S.init(MROWS, DIN, F.G, F.bid);
            EpiStoreF32 E{F.proj(), DIN};
            pg8::gemm_phase<EpiStoreF32, pg8::StaticOrder, true, true>(F.lds, g, S, E, F.wave);
            SEAM(k0 + 0); }
        if (IN(k0 + 1)) { FRESH(); e1_postproj(F, l); SEAM(k0 + 1); }
        if (IN(k0 + 2)) { FRESH(); mx_mixers(F, l); SEAM(k0 + 2); }
        if (IN(k0 + 3)) { FRESH(); mg_merge(F, l); SEAM(k0 + 3); }
        if (IN(k0 + 4)) {
            pg8::Gemm g{F.cat(), F.wT(l, WO_OUT), MROWS, DM, DM}; pg8::StaticOrder S; S.init(MROWS, DM, F.G, F.bid);
            EpiResid E{xa, xb, F.mods() + ((size_t)l * 3 * 6 + 2) * DM, F.ypre()};
            pg8::gemm_phase<EpiResid, pg8::StaticOrder, true, true>(F.lds, g, S, E, F.wave);
            SEAM(k0 + 4); }
        if (IN(k0 + 5)) { FRESH(); ln_phase(F, F.inp(I_LN1G) + l * DM, F.inp(I_LN1B) + l * DM, F.x1(), F.mods() + (size_t)l * 3 * 6 * DM, 3); SEAM(k0 + 5); }
        if (IN(k0 + 6)) {
            pg8::Gemm g{F.hbuf(), F.wT(l, WO_GU), MROWS, DGU, DM}; pg8::StaticOrder S; S.init(MROWS, DGU, F.G, F.bid);
            EpiSwiGLU E{F.act()};
            pg8::gemm_phase<EpiSwiGLU, pg8::StaticOrder, true, true>(F.lds, g, S, E, F.wave);
            SEAM(k0 + 6); }
        if (IN(k0 + 7)) {
            pg8::Gemm g{F.act(), F.wT(l, WO_DN), MROWS, DM, DFF}; pg8::StaticOrder S; S.init(MROWS, DM, F.G, F.bid);
            EpiResid E{F.x1(), F.x1() + (size_t)R_CTX * DM, F.mods() + ((size_t)l * 3 * 6 + 5) * DM, F.ypre()};
            pg8::gemm_phase<EpiResid, pg8::StaticOrder, true, true>(F.lds, g, S, E, F.wave);
            SEAM(k0 + 7); }
        if (IN(k0 + 8)) { FRESH(); ln_phase(F, F.inp(I_LN2G) + l * DM, F.inp(I_LN2B) + l * DM, F.out + O_YP, l + 1 < DEPTH ? F.mods() + (size_t)(l + 1) * 3 * 6 * DM : nullptr, 0); SEAM(k0 + 8); }
    }
#undef IN
#undef SEAM
#undef FRESH
}

#ifndef MK_SINGLE
#define MK_SINGLE 1
#endif
extern "C" void kernel_launch(void* const* d_in, const int* in_sizes, int n_in, void* d_out, int out_size, void* d_ws, size_t ws_size, hipStream_t stream) {
    static int grid = 0;
    if (grid == 0) {
        if (n_in != 24 || out_size != (int)O_END || ws_size < WS_END) { fprintf(stderr, "kernel_launch: unexpected sizes n_in %d out %d ws %zu\n", n_in, out_size, ws_size); grid = -1; return; }
        int dev = 0, cus = 0, per_cu = 0;
        if (hipGetDevice(&dev) != hipSuccess || hipDeviceGetAttribute(&cus, hipDeviceAttributeMultiprocessorCount, dev) != hipSuccess) { grid = -1; return; }
        if (hipFuncSetAttribute((const void*)fwd_kernel, hipFuncAttributeMaxDynamicSharedMemorySize, LDS_BYTES) != hipSuccess) { fprintf(stderr, "kernel_launch: hipFuncSetAttribute failed\n"); grid = -1; return; }
        if (hipOccupancyMaxActiveBlocksPerMultiprocessor(&per_cu, (const void*)fwd_kernel, 512, LDS_BYTES) != hipSuccess || per_cu < 1) fprintf(stderr, "kernel_launch: occupancy query says %d\n", per_cu);
        (void)hipGetLastError();
        grid = cus;
    }
    if (grid < 0) return;
    (void)hipMemsetAsync((char*)d_ws + WS_CTL, 0, CTL_ZERO_BYTES, stream);
    Args a{};
    for (int i = 0; i < 24; ++i) a.in[i] = (const float*)d_in[i];
    a.out = (float*)d_out; a.ws = (unsigned char*)d_ws; a.pad = 0;
#if MK_SINGLE
    a.ph_lo = 0; a.ph_hi = N_PHASES; a.single = 1;
    hipLaunchKernelGGL(fwd_kernel, dim3(grid), dim3(512), LDS_BYTES, stream, a);
#else
    a.single = 0;
    for (int p = 0; p < N_PHASES; ++p) { a.ph_lo = p; a.ph_hi = p + 1; hipLaunchKernelGGL(fwd_kernel, dim3(grid), dim3(512), LDS_BYTES, stream, a); }
#endif
}
```

```cpp
#include <hip/hip_runtime.h>
#include <cstdio>
#include <cstdint>
namespace pg8 {
#define PG8_LAS __attribute__((address_space(3)))
typedef unsigned short bf16_t;
typedef short bf16x8 __attribute__((ext_vector_type(8)));
typedef float f32x4 __attribute__((ext_vector_type(4)));
typedef unsigned u32x4 __attribute__((ext_vector_type(4)));
constexpr int BM = 256, BK = 64, HALF = 128, HTB = HALF * BK * 2  , STAGE_BYTES = 8 * HTB, NXCD = 8, WGM = 8;

__host__ __device__ __forceinline__ int lds_byte(int r, int c) { const int st = (r >> 4) * 2 + (c >> 5), rr = r & 15, cc = c & 31, ob = rr * 64 + cc * 2; return st * 1024 + (ob ^ (((ob >> 9) & 1) << 5)); }
__host__ __device__ __forceinline__ void stage_rc(int b, int& R, int& C) { const int st = b / 1024, sb = b % 1024, swz = sb ^ (((sb >> 9) & 1) << 5); R = (st >> 1) * 16 + swz / 64; C = (st & 1) * 32 + (swz % 64) / 2; }
__host__ __device__ __forceinline__ int perm32(int rho) { const int n = rho >> 4, i = rho & 15; return 8 * (i >> 2) + 4 * n + (i & 3); }

struct Unit { int pm, pn; };
struct Gemm { const bf16_t* A; const bf16_t* Bt; int M, N, K; };

struct StaticOrder {
    int nM, nN, nwg, G, c;
    __host__ __device__ void init(int M, int N, int G_, int c_) { nM = M / BM; nN = N / BM; nwg = nM * nN; G = G_; c = c_; }
    __host__ __device__ bool next(int i, Unit& u) const {
        const long L = (long)i * G + c; if (L >= nwg) return false;
        int wgid = (int)L; { const int q = nwg / NXCD, r = nwg % NXCD, xcd = wgid % NXCD, off = wgid / NXCD; wgid = (xcd < r ? xcd * (q + 1) : r * (q + 1) + (xcd - r) * q) + off; }
        const int nig = WGM * nN, gid = wgid / nig, fm = gid * WGM, gsz = (nM - fm) < WGM ? (nM - fm) : WGM;
        u.pm = fm + ((wgid % nig) % gsz); u.pn = (wgid % nig) / gsz; return true;
    }
    __device__ __forceinline__ void a_ready(const Unit&) const {}
    __device__ __forceinline__ void done(const Unit&) const {}
};
__device__ __forceinline__ unsigned cvt_pk_bf16(float lo, float hi) { unsigned r; asm volatile("v_cvt_pk_bf16_f32 %0, %1, %2" : "=v"(r) : "v"(lo), "v"(hi)); return r; }
typedef float f32x2 __attribute__((ext_vector_type(2)));
template <class Epi, class Sched, bool ALIGN_EPI = false, bool SP2 = false>
__device__ __forceinline__ void gemm_phase(PG8_LAS unsigned char* lds, const Gemm g, const Sched& S, const Epi& E, int wid_in) {
    int lane_ = (int)__builtin_amdgcn_mbcnt_hi(~0u, __builtin_amdgcn_mbcnt_lo(~0u, 0u)); asm volatile("" : "+v"(lane_)); asm volatile("" : "+s"(wid_in));
    const int wid = wid_in, lane = lane_, tid = wid * 64 + lane, wr = wid >> 2, wc = wid & 3, fr = lane & 15, fq = lane >> 4;
    const int K = g.K, nt = K / BK;
    unsigned voffA[2], voffB[2];
#pragma unroll
    for (int i = 0; i < 2; ++i) { int R, C; stage_rc(tid * 16 + i * 8192, R, C); const int Rb = Epi::PERM ? ((R & ~31) + perm32(R & 31)) : R;
        voffA[i] = (unsigned)(R * K + C) * 2u; voffB[i] = (unsigned)(Rb * K + C) * 2u; }
    const size_t kstep = (size_t)(BK * 2);
    const size_t hstep = (size_t)HALF * K * 2;
    const size_t tstep = 2 * hstep;
    const unsigned ldsw = (unsigned)wid * 1024u;
    const int aoff = lds_byte(wr * 64 + fr, fq * 8), boff = lds_byte(wc * 32 + fr, fq * 8);
#define PG8_SA(b, h) (((b) * 2 + (h)) * HTB)
#define PG8_SB(b, h) ((4 + (b) * 2 + (h)) * HTB)
#define PG8_STAGE(bufoff, gbase, voff) do { _Pragma("unroll") for (int _i = 0; _i < 2; ++_i) \
        __builtin_amdgcn_global_load_lds((const unsigned*)((const char*)(gbase) + (voff)[_i]), (PG8_LAS unsigned*)(lds + (bufoff) + ldsw + _i * 8192), 16, 0, 0); } while (0)
#define PG8_LDA(dst, b, h) do { _Pragma("unroll") for (int m = 0; m < 4; ++m) _Pragma("unroll") for (int k = 0; k < 2; ++k) dst[m][k] = *(const PG8_LAS bf16x8*)(lds + PG8_SA(b, h) + aoff + m * 2048 + k * 1024); } while (0)
#define PG8_LDB(dst, b, h) do { _Pragma("unroll") for (int n = 0; n < 2; ++n) _Pragma("unroll") for (int k = 0; k < 2; ++k) dst[n][k] = *(const PG8_LAS bf16x8*)(lds + PG8_SB(b, h) + boff + n * 2048 + k * 1024); } while (0)
#define PG8_MMA(ai, bj, At, Bt) do { __builtin_amdgcn_s_setprio(1); _Pragma("unroll") for (int m = 0; m < 4; ++m) _Pragma("unroll") for (int n = 0; n < 2; ++n) _Pragma("unroll") for (int k = 0; k < 2; ++k) \
        acc[ai][bj][m][n] = __builtin_amdgcn_mfma_f32_16x16x32_bf16(Bt[n][k], At[m][k], acc[ai][bj][m][n], 0, 0, 0); __builtin_amdgcn_s_setprio(0); } while (0)
#define PG8_WAIT_V(n) asm volatile("s_waitcnt vmcnt(" #n ")" ::: "memory")
#define PG8_WAIT_L(n) asm volatile("s_waitcnt lgkmcnt(" #n ")" ::: "memory")
#define PG8_BAR __builtin_amdgcn_s_barrier()
#define PG8_SCHED __builtin_amdgcn_sched_barrier(0)
    Unit cur, nxt; int ui = 0;
    if (!S.next(0, cur)) return;
    f32x4 acc[2][2][4][2];
#pragma unroll
    for (int a = 0; a < 2; ++a)
#pragma unroll
        for (int b = 0; b < 2; ++b)
#pragma unroll
            for (int m = 0; m < 4; ++m)
#pragma unroll
                for (int n = 0; n < 2; ++n) acc[a][b][m][n] = (f32x4){0.f, 0.f, 0.f, 0.f};
    bf16x8 At[4][2], B0[2][2], B1[2][2];
    const char* cA = (const char*)g.A + (size_t)cur.pm * tstep; const char* cB = (const char*)g.Bt + (size_t)cur.pn * tstep;
    S.a_ready(cur);
    if constexpr (SP2) {
        PG8_STAGE(PG8_SB(0, 0), cB, voffB); PG8_STAGE(PG8_SB(0, 1), cB + hstep, voffB); PG8_STAGE(PG8_SA(0, 0), cA, voffA); PG8_STAGE(PG8_SA(0, 1), cA + hstep, voffA);
        if (wr == 1) PG8_BAR;
        PG8_WAIT_V(2); PG8_BAR;
        PG8_STAGE(PG8_SB(1, 0), cB + kstep, voffB); PG8_STAGE(PG8_SA(1, 0), cA + kstep, voffA); PG8_STAGE(PG8_SB(1, 1), cB + hstep + kstep, voffB);
        PG8_WAIT_V(6); PG8_BAR;
    } else {
        PG8_STAGE(PG8_SB(0, 0), cB, voffB); PG8_STAGE(PG8_SA(0, 0), cA, voffA); PG8_STAGE(PG8_SB(0, 1), cB + hstep, voffB); PG8_STAGE(PG8_SA(0, 1), cA + hstep, voffA);
        if (wr == 1) PG8_BAR;
        PG8_WAIT_V(4); PG8_BAR;
        PG8_STAGE(PG8_SB(1, 0), cB + kstep, voffB); PG8_STAGE(PG8_SA(1, 0), cA + kstep, voffA); PG8_STAGE(PG8_SB(1, 1), cB + hstep + kstep, voffB);
        PG8_WAIT_V(6); PG8_BAR;
    }
    for (;;) {
        const bool has_next = S.next(ui + 1, nxt);
        const char* nA = has_next ? (const char*)g.A + (size_t)nxt.pm * tstep : cA; const char* nB = has_next ? (const char*)g.Bt + (size_t)nxt.pn * tstep : cB;
        for (int t = 0; t < nt; t += 2) {
            const bool last = (t == nt - 2);
            const char* a1 = cA + (size_t)(t + 1) * kstep;
            const char* a2 = last ? nA : cA + (size_t)(t + 2) * kstep; const char* b2 = last ? nB : cB + (size_t)(t + 2) * kstep;
            const char* a3 = a2 + kstep; const char* b3 = b2 + kstep;
            if (last && has_next) S.a_ready(nxt);
            if constexpr (SP2) {
            PG8_LDB(B0, 0, 0); PG8_LDB(B1, 0, 1); PG8_SCHED; PG8_LDA(At, 0, 0); PG8_STAGE(PG8_SA(1, 1), a1 + hstep, voffA);
            PG8_WAIT_V(8); PG8_WAIT_L(0); PG8_BAR; PG8_MMA(0, 0, At, B0); PG8_MMA(0, 1, At, B1); PG8_BAR; PG8_SCHED;
            PG8_LDA(At, 0, 1); PG8_STAGE(PG8_SB(0, 0), b2, voffB); PG8_STAGE(PG8_SB(0, 1), b2 + hstep, voffB); PG8_STAGE(PG8_SA(0, 0), a2, voffA);
            PG8_WAIT_V(8); PG8_WAIT_L(0); PG8_BAR; PG8_MMA(1, 0, At, B0); PG8_MMA(1, 1, At, B1); PG8_BAR; PG8_SCHED;
            PG8_LDB(B0, 1, 0); PG8_LDB(B1, 1, 1); PG8_SCHED; PG8_LDA(At, 1, 0); PG8_STAGE(PG8_SA(0, 1), a2 + hstep, voffA);
            PG8_WAIT_V(8); PG8_WAIT_L(0); PG8_BAR; PG8_MMA(0, 0, At, B0); PG8_MMA(0, 1, At, B1); PG8_BAR; PG8_SCHED;
            PG8_LDA(At, 1, 1); PG8_STAGE(PG8_SB(1, 0), b3, voffB); PG8_STAGE(PG8_SB(1, 1), b3 + hstep, voffB); PG8_STAGE(PG8_SA(1, 0), a3, voffA);
            PG8_WAIT_V(8); PG8_WAIT_L(0); PG8_BAR; PG8_MMA(1, 0, At, B0); PG8_MMA(1, 1, At, B1); PG8_BAR; PG8_SCHED;
            } else {
            PG8_LDB(B0, 0, 0); PG8_SCHED; PG8_LDA(At, 0, 0); PG8_STAGE(PG8_SA(1, 1), a1 + hstep, voffA);
            PG8_WAIT_L(8); PG8_BAR; PG8_WAIT_L(0); PG8_MMA(0, 0, At, B0); PG8_BAR; PG8_SCHED;
            PG8_LDB(B1, 0, 1); PG8_STAGE(PG8_SB(0, 0), b2, voffB);
            PG8_BAR; PG8_WAIT_L(0); PG8_MMA(0, 1, At, B1); PG8_BAR;
            PG8_LDA(At, 0, 1); PG8_STAGE(PG8_SA(0, 0), a2, voffA);
            PG8_BAR; PG8_WAIT_L(0); PG8_MMA(1, 0, At, B0); PG8_BAR; PG8_SCHED;
            PG8_STAGE(PG8_SB(0, 1), b2 + hstep, voffB);
            PG8_WAIT_V(6); PG8_BAR; PG8_MMA(1, 1, At, B1); PG8_BAR;
            PG8_LDB(B0, 1, 0); PG8_SCHED; PG8_LDA(At, 1, 0); PG8_STAGE(PG8_SA(0, 1), a2 + hstep, voffA);
            PG8_WAIT_L(8); PG8_BAR; PG8_WAIT_L(0); PG8_MMA(0, 0, At, B0); PG8_BAR; PG8_SCHED;
            PG8_LDB(B1, 1, 1); PG8_STAGE(PG8_SB(1, 0), b3, voffB);
            PG8_BAR; PG8_WAIT_L(0); PG8_MMA(0, 1, At, B1); PG8_BAR;
            PG8_LDA(At, 1, 1); PG8_STAGE(PG8_SA(1, 0), a3, voffA);
            PG8_BAR; PG8_WAIT_L(0); PG8_MMA(1, 0, At, B0); PG8_BAR; PG8_SCHED;
            PG8_STAGE(PG8_SB(1, 1), b3 + hstep, voffB);
            PG8_WAIT_V(6); PG8_BAR; PG8_MMA(1, 1, At, B1); PG8_BAR;
            }
        }
        if constexpr (ALIGN_EPI) { if (wr == 0) PG8_BAR; }
        if constexpr (!Epi::AFTER_DRAIN) { E(acc, cur, wr, wc, fr, fq); S.done(cur); }
        if (!has_next) break;
#pragma unroll
        for (int a = 0; a < 2; ++a)
#pragma unroll
            for (int b = 0; b < 2; ++b)
#pragma unroll
                for (int m = 0; m < 4; ++m)
#pragma unroll
                    for (int n = 0; n < 2; ++n) acc[a][b][m][n] = (f32x4){0.f, 0.f, 0.f, 0.f};
        cur = nxt; cA = nA; cB = nB; ++ui;
        if constexpr (ALIGN_EPI) { if (wr == 1) PG8_BAR; }
    }
    PG8_WAIT_V(0);
    if constexpr (!ALIGN_EPI) { if (wr == 0) PG8_BAR; }
    PG8_BAR;
    if constexpr (Epi::AFTER_DRAIN) { E.fused(acc, cur, wr, wc, fr, fq, lds, wid, lane); S.done(cur); }
#undef PG8_SA
#undef PG8_SB
#undef PG8_STAGE
#undef PG8_LDA
#undef PG8_LDB
#undef PG8_MMA
#undef PG8_WAIT_V
#undef PG8_WAIT_L
#undef PG8_BAR
#undef PG8_SCHED
}
}
#define GAS __attribute__((address_space(1)))
#define LAS __attribute__((address_space(3)))
typedef unsigned short bf16;
typedef unsigned v4u __attribute__((ext_vector_type(4)));
typedef float f32x4 __attribute__((ext_vector_type(4)));
typedef short bf16x8 __attribute__((ext_vector_type(8)));
typedef GAS unsigned gu32;
typedef GAS unsigned long long gu64;
#define RLX_AGENT __ATOMIC_RELAXED, __HIP_MEMORY_SCOPE_AGENT
#define LDS_WAIT() asm volatile("s_waitcnt lgkmcnt(0)" ::: "memory")
#define VM_WAIT() asm volatile("s_waitcnt vmcnt(0)" ::: "memory")
__device__ __forceinline__ unsigned long long rt() { return __builtin_amdgcn_s_memrealtime(); }
__device__ __forceinline__ unsigned f2bf(float f) { unsigned u = __builtin_bit_cast(unsigned, f); return (u + 0x7fffu + ((u >> 16) & 1u)) >> 16; }
__device__ __forceinline__ unsigned pk2(float lo, float hi) { return f2bf(lo) | (f2bf(hi) << 16); }
#define XB_TMO      128
#define XB_XCNT(j)  (256  + 64 * (j))
#define XB_XSUB(j)  (1280 + 64 * (j))
#define XB_XGEN(j)  (2304 + 64 * (j))
#define XB_TOP      3328
#define XB_TOPGEN   3392
#define XCD_BAR_WORDS 3456
#define XB_SPIN_CAP (1u << 24)

__device__ __forceinline__ unsigned xb_ld(unsigned* p)              { return __hip_atomic_load(p, __ATOMIC_RELAXED, __HIP_MEMORY_SCOPE_AGENT); }
__device__ __forceinline__ unsigned xb_add(unsigned* p, unsigned v) { return __hip_atomic_fetch_add(p, v, __ATOMIC_RELAXED, __HIP_MEMORY_SCOPE_AGENT); }
__device__ __forceinline__ unsigned xb_xcc_id() { return (unsigned)__builtin_amdgcn_s_getreg((3 << 11) | 20) & 0xFu; }
#define XB_SPIN(cond, bar) do { unsigned _sp = 0; while (cond) { __builtin_amdgcn_s_sleep(1); \
    if ((++_sp & 255u) == 0u) { if (xb_ld(&(bar)[XB_TMO])) break; if (_sp > XB_SPIN_CAP) { atomicAdd(&(bar)[XB_TMO], 1u); break; } } } } while (0)

struct XcdBarrier {
    unsigned* bar; unsigned x;
    volatile LAS unsigned* st;
};

__device__ __forceinline__ XcdBarrier xcd_barrier_post(unsigned* bar, volatile LAS unsigned* st) {
    XcdBarrier b; b.bar = bar; b.x = xb_xcc_id(); b.st = st;
    if (threadIdx.x == 0) (void)xb_add(&bar[XB_XCNT(b.x)], 1u);
    return b;
}
__device__ __forceinline__ void xcd_barrier_complete(unsigned* bar, unsigned x, unsigned& nloc, unsigned& nx) {
    const unsigned G = gridDim.x * gridDim.y * gridDim.z;
    unsigned sum, cnt, mine, sp = 0u;
    for (;;) {
        sum = 0u; cnt = 0u; mine = 0u;
#pragma unroll
        for (unsigned j = 0; j < 16; ++j) { const unsigned c = xb_ld(&bar[XB_XCNT(j)]); sum += c; cnt += (c > 0u) ? 1u : 0u; mine = (j == x) ? c : mine; }
        if (sum == G) break;
        __builtin_amdgcn_s_sleep(1);
        if ((++sp & 255u) == 0u) { if (xb_ld(&bar[XB_TMO])) break; if (sp > XB_SPIN_CAP) { atomicAdd(&bar[XB_TMO], 1u); break; } }
    }
    nloc = mine > 0u ? mine : 1u; nx = cnt > 0u ? cnt : 1u;
}

__device__ __forceinline__ void xcd_barrier(const XcdBarrier& b) {
    asm volatile("s_waitcnt vmcnt(0)" ::: "memory");
    __syncthreads();
    if (threadIdx.x == 0) {
        unsigned* bar = b.bar;
        __builtin_amdgcn_s_waitcnt(0);
        unsigned nloc = b.st[0], nx = b.st[1];
        if (nloc == 0u) { xcd_barrier_complete(bar, b.x, nloc, nx); b.st[0] = nloc; b.st[1] = nx; }
        const unsigned old = xb_add(&bar[XB_XSUB(b.x)], 1u);
        const unsigned gen = old / nloc;
        if (old + 1u == (gen + 1u) * nloc) {
            __builtin_amdgcn_fence(__ATOMIC_RELEASE, "agent");
            asm volatile("s_waitcnt vmcnt(0)" ::: "memory");
            const unsigned og = xb_add(&bar[XB_TOP], 1u);
            const unsigned tg = og / nx;
            if (og + 1u == (tg + 1u) * nx) xb_add(&bar[XB_TOPGEN], 1u);
            else XB_SPIN(xb_ld(&bar[XB_TOPGEN]) == tg, bar);
            __builtin_amdgcn_fence(__ATOMIC_ACQUIRE, "agent");
            xb_add(&bar[XB_XGEN(b.x)], 1u);
            asm volatile("s_waitcnt vmcnt(0)" ::: "memory");
        } else {
            XB_SPIN(xb_ld(&bar[XB_XGEN(b.x)]) == gen, bar);
            __builtin_amdgcn_fence(__ATOMIC_ACQUIRE, "agent");
            asm volatile("s_waitcnt vmcnt(0)" ::: "memory");
        }
    }
    __syncthreads();
}

constexpr int DM = 2048;
constexpr int NB_CTX = 16, S_CTX = 256, NB_LAT = 2, S_LAT = 4096, DEPTH = 4;
constexpr int R_CTX = NB_CTX * S_CTX;
constexpr int R_LAT = NB_LAT * S_LAT;
constexpr int MROWS = R_CTX + R_LAT;
constexpr int DIN = 5632, DFF = 5632, DGU = 2 * DFF;
constexpr float ALPHA = 1.6817928305074292f;
constexpr int C_AQ = 0, C_AK = 512, C_AV = 1024, C_BQ = 1536, C_BF = 2048, C_BB = 2560, C_BI = 3072, C_BG = 3584, C_CQ = 4096, C_CK = 5120, C_CV = 5376;
constexpr size_t O_YP = 0, O_YS = 8388608, O_DK = 25165824, O_DV = 33554432, O_SK = 41943040, O_SV = 46137344, O_ST = 50331648, O_END = 58720256;

constexpr size_t MiB = 1u << 20;
constexpr size_t WS_CTL = 0, CTL_ZERO_BYTES = 1 * MiB;
constexpr size_t WS_MODS = 1 * MiB;
constexpr size_t WS_MISC = 2 * MiB;
constexpr size_t WS_W = 4 * MiB, W_LAYER = 96 * MiB;
constexpr size_t WO_IN = 0, WO_OUT = 22 * MiB, WO_GU = 30 * MiB, WO_DN = 74 * MiB;
constexpr size_t WS_H = 388 * MiB;
constexpr size_t WS_CAT = 436 * MiB;
constexpr size_t WS_X1 = 484 * MiB;
constexpr size_t WS_OA = 580 * MiB, WS_OBF = 604 * MiB, WS_OBB = 628 * MiB;
constexpr size_t WS_P = 652 * MiB;
constexpr size_t WS_ACT = WS_P, WS_YPRE = WS_P + 132 * MiB;
constexpr size_t WS_C16 = 916 * MiB;
constexpr size_t WS_QKV = 922 * MiB;
constexpr int QKV_LD = 3072, Q_QD = 0, Q_KD = 512, Q_VD = 1024, Q_QS = 1536, Q_KS = 2560, Q_VS = 2816;
constexpr size_t WS_HQ = 994 * MiB;
constexpr size_t WS_HKM = 1018 * MiB;
constexpr size_t WS_HKP = 1042 * MiB;
constexpr size_t WS_HVT = 1066 * MiB;
constexpr size_t WS_HDEC = 1090 * MiB;
constexpr size_t WS_END = 1093 * MiB;

constexpr int CW_BAR = 4096;

constexpr int RING_BYTES = 131072;
constexpr int LDSCTL_OFF = RING_BYTES, MISC_OFF = LDSCTL_OFF + 320;
constexpr int LDS_BYTES = 147456;

typedef unsigned v2u __attribute__((ext_vector_type(2)));
typedef GAS float gf32;
typedef GAS unsigned short gbf16;

__device__ __forceinline__ float silu_f(float a) { return a / (1.0f + __expf(-a)); }
__device__ __forceinline__ int mod_of_row(int row) { return row < R_CTX ? 0 : (row < R_CTX + S_LAT ? 1 : 2); }

struct EpiStoreF32 {
    static constexpr bool PERM = false, AFTER_DRAIN = false;
    gf32* C; int ldc;
    __device__ __forceinline__ void operator()(const pg8::f32x4 (&acc)[2][2][4][2], const pg8::Unit& u, int wr, int wc, int fr, int fq) const {
        const int row0 = u.pm * 256 + wr * 64 + fr, col0 = u.pn * 256 + wc * 32 + 4 * fq;
#pragma unroll
        for (int ai = 0; ai < 2; ++ai)
#pragma unroll
            for (int m = 0; m < 4; ++m) { gf32* rowp = C + (size_t)(row0 + ai * 128 + m * 16) * ldc + col0;
#pragma unroll
                for (int bj = 0; bj < 2; ++bj)
#pragma unroll
                    for (int n = 0; n < 2; ++n) *(GAS pg8::f32x4*)(rowp + bj * 128 + n * 16) = acc[ai][bj][m][n]; }
    }
};
struct EpiResid {
    static constexpr bool PERM = false, AFTER_DRAIN = false;
    const gf32* xa; const gf32* xb;
    const gf32* gates;
    gf32* out;
    __device__ __forceinline__ void operator()(const pg8::f32x4 (&acc)[2][2][4][2], const pg8::Unit& u, int wr, int wc, int fr, int fq) const {
        const int mod = u.pm >> 4;
        const gf32* xbase = (u.pm < 16) ? xa + (size_t)u.pm * 256 * DM : xb + (size_t)(u.pm - 16) * 256 * DM;
        const int r0 = wr * 64 + fr, col0 = u.pn * 256 + wc * 32 + 4 * fq;
        pg8::f32x4 gv[2][2];
#pragma unroll
        for (int bj = 0; bj < 2; ++bj)
#pragma unroll
            for (int n = 0; n < 2; ++n) gv[bj][n] = *(const GAS pg8::f32x4*)(gates + (size_t)mod * 6 * DM + col0 + bj * 128 + n * 16);
#pragma unroll
        for (int ai = 0; ai < 2; ++ai)
#pragma unroll
            for (int m = 0; m < 4; ++m) { const int r = r0 + ai * 128 + m * 16;
                const gf32* xp = xbase + (size_t)r * DM + col0; gf32* op = out + ((size_t)u.pm * 256 + r) * DM + col0;
#pragma unroll
                for (int bj = 0; bj < 2; ++bj)
#pragma unroll
                    for (int n = 0; n < 2; ++n) { const pg8::f32x4 xv = *(const GAS pg8::f32x4*)(xp + bj * 128 + n * 16);
                        *(GAS pg8::f32x4*)(op + bj * 128 + n * 16) = xv * ALPHA + gv[bj][n] * acc[ai][bj][m][n]; } }
    }
};
struct EpiSwiGLU {
    static constexpr bool PERM = true, AFTER_DRAIN = false;
    gbf16* act;
    __device__ __forceinline__ void operator()(const pg8::f32x4 (&acc)[2][2][4][2], const pg8::Unit& u, int wr, int wc, int fr, int fq) const {
        const int row0 = u.pm * 256 + wr * 64 + fr, col0 = u.pn * 128 + wc * 32 + 8 * fq;
#pragma unroll
        for (int ai = 0; ai < 2; ++ai)
#pragma unroll
            for (int m = 0; m < 4; ++m) { gbf16* rowp = act + (size_t)(row0 + ai * 128 + m * 16) * DFF + col0;
                float r[8];
#pragma unroll
                for (int n = 0; n < 2; ++n)
#pragma unroll
                    for (int j = 0; j < 4; ++j) { const float g = acc[ai][0][m][n][j], up = acc[ai][1][m][n][j]; r[n * 4 + j] = silu_f(g) * up; }
                pg8::u32x4 w; w.x = pg8::cvt_pk_bf16(r[0], r[1]); w.y = pg8::cvt_pk_bf16(r[2], r[3]); w.z = pg8::cvt_pk_bf16(r[4], r[5]); w.w = pg8::cvt_pk_bf16(r[6], r[7]);
                *(GAS pg8::u32x4*)rowp = w; }
    }
};

struct Args { const float* in[24]; float* out; unsigned char* ws; int ph_lo, ph_hi, single, pad; };
enum { I_XP = 0, I_XS, I_CDK, I_CDV, I_CSK, I_CSV, I_ST, I_C, I_CCTX, I_WMOD, I_BMOD, I_WIN, I_WOUT, I_DLAM, I_DNG, I_LBL, I_HNG, I_SINK, I_LN1G, I_LN1B, I_LN2G, I_LN2B, I_WGU, I_WDN };

struct Ctx {
    LAS unsigned char* lds; int tid, lane, wave, G, bid;
    const Args* ap; gf32* out; GAS unsigned char* ws;
    __device__ __forceinline__ const gf32* inp(int i) const { return (const gf32*)ap->in[i]; }
    __device__ __forceinline__ gf32* mods() const { return (gf32*)(ws + WS_MODS); }
    __device__ __forceinline__ gf32* lball() const { return (gf32*)(ws + WS_MISC); }
    __device__ __forceinline__ gf32* lamv() const { return (gf32*)(ws + WS_MISC + 16384); }
    __device__ __forceinline__ gf32* tabD() const { return (gf32*)(ws + WS_MISC + 20480); }
    __device__ __forceinline__ gf32* tabS() const { return (gf32*)(ws + WS_MISC + 32768); }
    __device__ __forceinline__ gbf16* wT(int l, size_t off) const { return (gbf16*)(ws + WS_W + (size_t)l * W_LAYER + off); }
    __device__ __forceinline__ gbf16* hbuf() const { return (gbf16*)(ws + WS_H); }
    __device__ __forceinline__ gbf16* cat() const { return (gbf16*)(ws + WS_CAT); }
    __device__ __forceinline__ gf32* x1() const { return (gf32*)(ws + WS_X1); }
    __device__ __forceinline__ gf32* oa() const { return (gf32*)(ws + WS_OA); }
    __device__ __forceinline__ gf32* obf() const { return (gf32*)(ws + WS_OBF); }
    __device__ __forceinline__ gf32* obb() const { return (gf32*)(ws + WS_OBB); }
    __device__ __forceinline__ gf32* proj() const { return (gf32*)(ws + WS_P); }
    __device__ __forceinline__ gbf16* act() const { return (gbf16*)(ws + WS_ACT); }
    __device__ __forceinline__ gf32* ypre() const { return (gf32*)(ws + WS_YPRE); }
    __device__ __forceinline__ gbf16* qkv() const { return (gbf16*)(ws + WS_QKV); }
    __device__ __forceinline__ gbf16* hq(int dir) const { return (gbf16*)(ws + WS_HQ) + (size_t)dir * MROWS * 512; }
    __device__ __forceinline__ gbf16* hkm(int dir) const { return (gbf16*)(ws + WS_HKM) + (size_t)dir * MROWS * 512; }
    __device__ __forceinline__ gbf16* hkp(int dir) const { return (gbf16*)(ws + WS_HKP) + (size_t)dir * 768 * 512 * 16; }
    __device__ __forceinline__ gbf16* hvt(int dir) const { return (gbf16*)(ws + WS_HVT) + (size_t)dir * 768 * 512 * 16; }
    __device__ __forceinline__ gf32* hdec(int dir) const { return (gf32*)(ws + WS_HDEC) + (size_t)dir * 768 * 512; }
    __device__ __forceinline__ gbf16* c16(size_t off) const { return (gbf16*)(ws + WS_C16 + off); }
};

__device__ __forceinline__ void transpose_item(const gf32* W, int K, int N, gbf16* WT, int k0, int n0, int drow0, LAS float* scr, int lane) {
#pragma unroll 8
    for (int i = 0; i < 32; ++i) { const int kk = 2 * i + (lane >> 5); scr[kk * 33 + (lane & 31)] = W[(size_t)(k0 + kk) * N + n0 + (lane & 31)]; }
    LDS_WAIT(); asm volatile("" ::: "memory");
    const int c = lane & 7;
#pragma unroll
    for (int j = 0; j < 4; ++j) { const int n = (lane >> 3) + 8 * j; const LAS float* s = scr + (8 * c) * 33 + n;
        v4u o; o.x = pk2(s[0 * 33], s[1 * 33]); o.y = pk2(s[2 * 33], s[3 * 33]); o.z = pk2(s[4 * 33], s[5 * 33]); o.w = pk2(s[6 * 33], s[7 * 33]);
        *(GAS v4u*)(WT + (size_t)(drow0 + n) * K + k0 + 8 * c) = o; }
    LDS_WAIT(); asm volatile("" ::: "memory");
}

__device__ __forceinline__ void p0_prologue(const Ctx& F) {
    {
        LAS float* sc = (LAS float*)F.lds;
        LAS float* red = (LAS float*)(F.lds + 24576);
        const gf32* c_ctx = F.inp(I_CCTX); const gf32* cc = F.inp(I_C);
        for (int i = F.tid; i < 3 * DM; i += 512) { const int mid = i / DM, k = i % DM; const float c = mid == 0 ? c_ctx[k] : cc[(mid - 1) * DM + k]; sc[i] = silu_f(c); }
        __syncthreads();
        for (int task = F.bid; task < DEPTH * 48; task += F.G) {
            const int l = task / 48, cb = task % 48, w = F.wave;
            const gf32* wp = F.inp(I_WMOD) + ((size_t)l * DM + 256 * w) * (6 * DM) + cb * 256 + F.lane * 4;
            f32x4 a0 = {0.f, 0.f, 0.f, 0.f}, a1 = a0, a2 = a0;
#pragma unroll 8
            for (int kk = 0; kk < 256; ++kk) { const f32x4 wv = *(const GAS f32x4*)(wp + (size_t)kk * (6 * DM));
                a0 += wv * sc[256 * w + kk]; a1 += wv * sc[DM + 256 * w + kk]; a2 += wv * sc[2 * DM + 256 * w + kk]; }
            *(LAS f32x4*)(red + (w * 3 + 0) * 256 + F.lane * 4) = a0; *(LAS f32x4*)(red + (w * 3 + 1) * 256 + F.lane * 4) = a1; *(LAS f32x4*)(red + (w * 3 + 2) * 256 + F.lane * 4) = a2;
            __syncthreads();
            for (int i = F.tid; i < 768; i += 512) { const int m = i >> 8, c = i & 255; float s = 0.f;
#pragma unroll
                for (int ww = 0; ww < 8; ++ww) s += red[(ww * 3 + m) * 256 + c];
                F.mods()[((size_t)l * 3 + m) * (6 * DM) + cb * 256 + c] = s + F.inp(I_BMOD)[(size_t)l * 6 * DM + cb * 256 + c]; }
            __syncthreads();
        }
    }
    if (F.bid == F.G - 1) {
        const gf32* lbl = F.inp(I_LBL);
        for (int i = F.tid; i < 1024; i += 512) { float lg[4], mx = -1e30f;
#pragma unroll
            for (int l = 0; l < 4; ++l) { lg[l] = lbl[l * 1024 + i]; mx = fmaxf(mx, lg[l]); }
            float s = 0.f;
#pragma unroll
            for (int l = 0; l < 4; ++l) { lg[l] = expf(lg[l] - mx); s += lg[l]; }
            const float w1 = lg[1] / s, w2 = lg[2] / s, w3 = lg[3] / s;
            F.lball()[0 * 1024 + i] = 0.f; F.lball()[1 * 1024 + i] = w1; F.lball()[2 * 1024 + i] = w1 + w2; F.lball()[3 * 1024 + i] = w1 + w2 + w3; }
        if (F.tid < 4) { const int l = F.tid; const gf32* lp = F.inp(I_DLAM) + l * 256; float s1 = 0.f, s2 = 0.f;
            for (int i = 0; i < 64; ++i) { s1 += lp[i] * lp[64 + i]; s2 += lp[128 + i] * lp[192 + i]; }
            const float li = 0.8f - 0.6f * expf(-0.3f * (float)l);
            F.lamv()[l * 2] = expf(s1) - expf(s2) + li; F.lamv()[l * 2 + 1] = li; }
        for (int i = F.tid; i < 64 * 16; i += 512) { const int pos = i / 16, j = i % 16; const float inv = powf(10000.f, -(float)j / 16.f), ang = (float)pos * inv; F.tabD()[i * 2] = cosf(ang); F.tabD()[i * 2 + 1] = sinf(ang); }
        for (int i = F.tid; i < 64 * 32; i += 512) { const int pos = i / 32, j = i % 32; const float inv = powf(10000.f, -(float)j / 32.f), ang = (float)pos * inv; F.tabS()[i * 2] = cosf(ang); F.tabS()[i * 2 + 1] = sinf(ang); }
    }
    {
        const gf32* src[4] = {F.inp(I_CDK), F.inp(I_CDV), F.inp(I_CSK), F.inp(I_CSV)};
        const size_t doff[4] = {0, 2 * MiB, 4 * MiB, 5 * MiB}; const int n8[4] = {131072, 131072, 65536, 65536};
#pragma unroll
        for (int a = 0; a < 4; ++a)
            for (int i = F.bid * 512 + F.tid; i < n8[a]; i += F.G * 512) { const f32x4 x0 = *(const GAS f32x4*)(src[a] + (size_t)i * 8), x1 = *(const GAS f32x4*)(src[a] + (size_t)i * 8 + 4);
                v4u o; o.x = pk2(x0[0], x0[1]); o.y = pk2(x0[2], x0[3]); o.z = pk2(x1[0], x1[1]); o.w = pk2(x1[2], x1[3]); *(GAS v4u*)(F.c16(doff[a]) + (size_t)i * 8) = o; }
    }
    {
        LAS float* scr = (LAS float*)(F.lds + 49152 + F.wave * 8448);
        const int gw = F.bid * 8 + F.wave, NGW = F.G * 8;
        constexpr int I_IN = 32 * 176, I_OUT = 32 * 64, I_GU = 32 * 352, I_DN = 88 * 64, I_L = I_IN + I_OUT + I_GU + I_DN;
        for (int it = gw; it < DEPTH * I_L; it += NGW) {
            const int l = it / I_L; int r = it % I_L;
            if (r < I_IN) { const int kb = r / 176, nb = r % 176; transpose_item(F.inp(I_WIN) + (size_t)l * DM * DIN, DM, DIN, F.wT(l, WO_IN), 64 * kb, 32 * nb, 32 * nb, scr, F.lane); continue; } r -= I_IN;
            if (r < I_OUT) { const int kb = r / 64, nb = r % 64; transpose_item(F.inp(I_WOUT) + (size_t)l * DM * DM, DM, DM, F.wT(l, WO_OUT), 64 * kb, 32 * nb, 32 * nb, scr, F.lane); continue; } r -= I_OUT;
            if (r < I_GU) { const int kb = r / 352, nb = r % 352, n0 = 32 * nb; const int j = n0 < DFF ? n0 : n0 - DFF; const int drow = 256 * (j >> 7) + (n0 < DFF ? 0 : 128) + (j & 127);
                transpose_item(F.inp(I_WGU) + (size_t)l * DM * DGU, DM, DGU, F.wT(l, WO_GU), 64 * kb, n0, drow, scr, F.lane); continue; } r -= I_GU;
            { const int kb = r / 64, nb = r % 64; transpose_item(F.inp(I_WDN) + (size_t)l * DFF * DM, DFF, DM, F.wT(l, WO_DN), 64 * kb, 32 * nb, 32 * nb, scr, F.lane); }
        }
    }
}

__device__ __forceinline__ void p1_h0(const Ctx& F) {
    const gf32* xp = F.inp(I_XP); const gf32* xs = F.inp(I_XS);
    for (int idx = F.bid * 512 + F.tid; idx < MROWS * 256; idx += F.G * 512) {
        const int row = idx >> 8, c8 = (idx & 255) * 8, mod = mod_of_row(row);
        const gf32* xr = row < R_CTX ? xp + (size_t)row * DM : xs + (size_t)(row - R_CTX) * DM;
        const gf32* sh = F.mods() + (size_t)(0 * 3 + mod) * 6 * DM; const gf32* sc = sh + DM;
        const f32x4 x0 = *(const GAS f32x4*)(xr + c8), x1 = *(const GAS f32x4*)(xr + c8 + 4), s0 = *(const GAS f32x4*)(sh + c8), s1 = *(const GAS f32x4*)(sh + c8 + 4), c0 = *(const GAS f32x4*)(sc + c8), c1 = *(const GAS f32x4*)(sc + c8 + 4);
        const f32x4 h0 = x0 * (c0 + 1.0f) + s0, h1 = x1 * (c1 + 1.0f) + s1;
        v4u o; o.x = pk2(h0[0], h0[1]); o.y = pk2(h0[2], h0[3]); o.z = pk2(h1[0], h1[1]); o.w = pk2(h1[2], h1[3]);
        *(GAS v4u*)(F.hbuf() + (size_t)row * DM + c8) = o;
    }
}

constexpr float LOG2E = 1.4426950408889634f;
constexpr float QSC_D = 0.125f * LOG2E, QSC_S = 0.08838834764831845f * LOG2E;
__device__ __forceinline__ void e1_postproj(const Ctx& F, int l) {
    const gf32* lb = F.lball() + l * 1024;
    for (int grp = F.bid; grp < MROWS / 16; grp += F.G) {
        const int row0 = grp * 16;
        for (int rr = 0; rr < 16; ++rr) {
            const int row = row0 + rr;
            const gf32* pr = F.proj() + (size_t)row * DIN; gbf16* qk = F.qkv() + (size_t)row * QKV_LD;
            const bool lat = row >= R_CTX; const int t = (row - R_CTX) & (S_LAT - 1), rpos = t >> 6, cpos = t & 63;
            { const int p = F.tid, blk = p >> 4, i = p & 15, cb = blk * 32, pos = (blk & 1) ? cpos : rpos;
              float cs = 1.f, sn = 0.f; if (lat) { cs = F.tabD()[(pos * 16 + i) * 2]; sn = F.tabD()[(pos * 16 + i) * 2 + 1]; }
              const float x1 = pr[cb + i], x2 = pr[cb + 16 + i], sc = cb < 512 ? QSC_D : 1.0f;
              qk[cb + i] = (bf16)f2bf((x1 * cs - x2 * sn) * sc); qk[cb + 16 + i] = (bf16)f2bf((x2 * cs + x1 * sn) * sc); }
            for (int p = F.tid; p < 640; p += 512) { const int blk = p >> 5, i = p & 31, cb = C_CQ + blk * 64, db = Q_QS + blk * 64, pos = (blk & 1) ? cpos : rpos;
              float cs = 1.f, sn = 0.f; if (lat) { cs = F.tabS()[(pos * 32 + i) * 2]; sn = F.tabS()[(pos * 32 + i) * 2 + 1]; }
              const float x1 = pr[cb + i], x2 = pr[cb + 32 + i], sc = blk < 16 ? QSC_S : 1.0f;
              qk[db + i] = (bf16)f2bf((x1 * cs - x2 * sn) * sc); qk[db + 32 + i] = (bf16)f2bf((x2 * cs + x1 * sn) * sc); }
            { const int c = F.tid; qk[Q_VD + c] = (bf16)f2bf(pr[C_AV + c]); if (c < 256) qk[Q_VS + c] = (bf16)f2bf(pr[C_CV + c]); }
            if (!lat) {
                const int b = row >> 8, n = row & 255;
                for (int i = F.tid; i < 384; i += 512) {
                    if (i < 128) { const int h = i >> 5, c4 = (i & 31) * 4; *(GAS f32x4*)(F.out + O_DK + ((((size_t)b * 4 + l) * 4 + h) * 256 + n) * 128 + c4) = *(const GAS f32x4*)(pr + C_AK + h * 128 + c4); }
                    else if (i < 256) { const int ii = i - 128, h = ii >> 5, c4 = (ii & 31) * 4; *(GAS f32x4*)(F.out + O_DV + ((((size_t)b * 4 + l) * 4 + h) * 256 + n) * 128 + c4) = *(const GAS f32x4*)(pr + C_AV + h * 128 + c4); }
                    else if (i < 320) { const int ii = i - 256, kv = ii >> 5, c4 = (ii & 31) * 4; *(GAS f32x4*)(F.out + O_SK + ((((size_t)b * 4 + l) * 2 + kv) * 256 + n) * 128 + c4) = *(const GAS f32x4*)(pr + C_CK + kv * 128 + c4); }
                    else { const int ii = i - 320, kv = ii >> 5, c4 = (ii & 31) * 4; *(GAS f32x4*)(F.out + O_SV + ((((size_t)b * 4 + l) * 2 + kv) * 256 + n) * 128 + c4) = *(const GAS f32x4*)(pr + C_CV + kv * 128 + c4); }
                }
            }
        }
        {
            const int c = F.tid; const gf32* pc = F.proj() + (size_t)row0 * DIN;
            float qv[16], vv[16];
#pragma unroll
            for (int r = 0; r < 16; ++r) { qv[r] = silu_f(pc[(size_t)r * DIN + C_BQ + c]); vv[r] = pc[(size_t)r * DIN + C_BI + c]; }
#pragma unroll
            for (int dir = 0; dir < 2; ++dir) {
                const float lbv = lb[dir * 512 + c], lbm = fmaxf(lbv, 1e-30f), oml = 1.0f - lbv;
                float g[16], cum[16]; float run = 0.f;
#pragma unroll
                for (int p = 0; p < 16; ++p) { const int r = dir ? 15 - p : p; const float z = pc[(size_t)r * DIN + C_BF + dir * 512 + c];
                    g[p] = logf(lbm + oml / (1.0f + expf(-z))); run += g[p]; cum[p] = run; }
                const float last = run;
                unsigned kpw[8], vtw[8];
#pragma unroll
                for (int p = 0; p < 16; p += 2) {
                    float kp2[2];
#pragma unroll
                    for (int e = 0; e < 2; ++e) { const int pp = p + e, r = dir ? 15 - pp : pp; const float k = 1.0f - expf(g[pp]); const float cc = fmaxf(cum[pp], -80.0f);
                        F.hq(dir)[(size_t)(row0 + r) * 512 + c] = (bf16)f2bf(qv[r] * expf(cc)); F.hkm(dir)[(size_t)(row0 + r) * 512 + c] = (bf16)f2bf(k * expf(-cc));
                        kp2[e] = k * expf(last - cum[pp]); }
                    kpw[p >> 1] = pk2(kp2[0], kp2[1]); vtw[p >> 1] = pk2(vv[dir ? 15 - p : p], vv[dir ? 14 - p : p + 1]);
                }
                GAS v4u* kd = (GAS v4u*)(F.hkp(dir) + ((size_t)grp * 512 + c) * 16); GAS v4u* vd = (GAS v4u*)(F.hvt(dir) + ((size_t)grp * 512 + c) * 16);
                kd[0] = (v4u){kpw[0], kpw[1], kpw[2], kpw[3]}; kd[1] = (v4u){kpw[4], kpw[5], kpw[6], kpw[7]};
                vd[0] = (v4u){vtw[0], vtw[1], vtw[2], vtw[3]}; vd[1] = (v4u){vtw[4], vtw[5], vtw[6], vtw[7]};
                F.hdec(dir)[(size_t)grp * 512 + c] = expf(last);
            }
        }
    }
}

typedef float f32x16 __attribute__((ext_vector_type(16)));
typedef short s16x4 __attribute__((ext_vector_type(4)));
typedef __bf16 bf16x2_t __attribute__((ext_vector_type(2)));
typedef float f32x2_t __attribute__((ext_vector_type(2)));
__device__ __forceinline__ unsigned cvt2(float a, float b) { const f32x2_t f = {a, b}; return __builtin_bit_cast(unsigned, __builtin_convertvector(f, bf16x2_t)); }
#define MFMA32(a, b, c) __builtin_amdgcn_mfma_f32_32x32x16_bf16((a), (b), (c), 0, 0, 0)

struct AttnSeg { const gbf16* k; const gbf16* v; int stride; int ntiles; };
constexpr int KPB = 272, VPB = 320;
constexpr int KT_BYTES = 64 * KPB, VT_BYTES = 64 * VPB, ABUF_BYTES = KT_BYTES + VT_BYTES;
constexpr float ATT_THR = 8.0f;

template <int DQK, bool DIFF>
__device__ __forceinline__ void attn_mfma(const Ctx& F, const gbf16* qptr, int kcol, const AttnSeg s0, const AttnSeg s1, bool band, int qpos, int kpos0,
                                          float m_init, float l_init, float lam, float post_scale, const gf32* gvec, gbf16* outp  ) {
    int lane_ = (int)__builtin_amdgcn_mbcnt_hi(~0u, __builtin_amdgcn_mbcnt_lo(~0u, 0u)); asm volatile("" : "+v"(lane_));
    const int lane = lane_, tid = F.wave * 64 + lane, r32 = lane & 31, h = lane >> 5;
    __syncthreads();
    bf16x8 qf[DQK / 16];
#pragma unroll
    for (int ks = 0; ks < DQK / 16; ++ks) qf[ks] = *(const GAS bf16x8*)(qptr + (size_t)r32 * QKV_LD + 16 * ks + 8 * h);
    f32x16 o[4];
#pragma unroll
    for (int t = 0; t < 4; ++t)
#pragma unroll
        for (int r = 0; r < 16; ++r) o[t][r] = 0.f;
    float m = m_init, l = l_init;
    const int nt = s0.ntiles + s1.ntiles;
    const int srow = tid >> 4, spc = tid & 15;
    v4u kreg[2], vreg[2];
#define ATT_ISSUE(ti) do { const bool s1_ = (ti) >= s0.ntiles; const int tt_ = s1_ ? (ti) - s0.ntiles : (ti); const gbf16* kb_ = s1_ ? s1.k : s0.k; const gbf16* vb_ = s1_ ? s1.v : s0.v; const int st_ = s1_ ? s1.stride : s0.stride; \
        _Pragma("unroll") for (int i_ = 0; i_ < 2; ++i_) { const size_t go_ = (size_t)(tt_ * 64 + srow + 32 * i_) * st_ + spc * 8; kreg[i_] = *(const GAS v4u*)(kb_ + go_); vreg[i_] = *(const GAS v4u*)(vb_ + go_); } } while (0)
#define ATT_WRITE(b) do { _Pragma("unroll") for (int i_ = 0; i_ < 2; ++i_) { *(LAS v4u*)(F.lds + (b) * ABUF_BYTES + (srow + 32 * i_) * KPB + spc * 16) = kreg[i_]; \
        *(LAS v4u*)(F.lds + (b) * ABUF_BYTES + KT_BYTES + (srow + 32 * i_) * VPB + spc * 16) = vreg[i_]; } } while (0)
    ATT_ISSUE(0); ATT_WRITE(0);
    __syncthreads();
    const int koff = r32 * KPB + (kcol + 8 * h) * 2;
    const int voff = KT_BYTES + (4 * h + ((lane & 15) >> 2)) * VPB + (16 * ((lane >> 4) & 1) + 4 * (lane & 3)) * 2;
    for (int ti = 0; ti < nt; ++ti) {
        const int buf = ti & 1;
        if (ti + 1 < nt) ATT_ISSUE(ti + 1);
        const LAS unsigned char* kb = F.lds + buf * ABUF_BYTES;
        f32x16 st[2];
#pragma unroll
        for (int kt = 0; kt < 2; ++kt) {
#pragma unroll
            for (int r = 0; r < 16; ++r) st[kt][r] = 0.f;
#pragma unroll
            for (int ks = 0; ks < DQK / 16; ++ks) { const bf16x8 kf = *(const LAS bf16x8*)(kb + koff + kt * 32 * KPB + ks * 32); st[kt] = MFMA32(kf, qf[ks], st[kt]); }
        }
        if (band && ti < s0.ntiles) {
            const int kp = kpos0 + ti * 64 + 4 * h - (qpos + r32);
#pragma unroll
            for (int kt = 0; kt < 2; ++kt)
#pragma unroll
                for (int r = 0; r < 16; ++r) { const int d = kp + 32 * kt + (r & 3) + 8 * (r >> 2); if (d > 128 || d < -128) st[kt][r] = -1e30f; }
        }
        float mx = st[0][0];
#pragma unroll
        for (int kt = 0; kt < 2; ++kt)
#pragma unroll
            for (int r = 0; r < 16; ++r) mx = fmaxf(mx, st[kt][r]);
        mx = fmaxf(mx, __shfl_xor(mx, 32));
        if (__builtin_amdgcn_ballot_w64(mx > m + ATT_THR) != 0ull) {
            const float mn = fmaxf(m, mx), a = __builtin_amdgcn_exp2f(m - mn); l *= a; m = mn;
#pragma unroll
            for (int t = 0; t < 4; ++t)
#pragma unroll
                for (int r = 0; r < 16; ++r) o[t][r] *= a;
        }
        float rs = 0.f;
#pragma unroll
        for (int kt = 0; kt < 2; ++kt)
#pragma unroll
            for (int r = 0; r < 16; ++r) { const float p = __builtin_amdgcn_exp2f(st[kt][r] - m); st[kt][r] = p; rs += p; }
        rs += __shfl_xor(rs, 32); l += rs;
#pragma unroll
        for (int kt = 0; kt < 2; ++kt)
#pragma unroll
            for (int s = 0; s < 2; ++s) {
                v4u pw; pw.x = cvt2(st[kt][8 * s], st[kt][8 * s + 1]); pw.y = cvt2(st[kt][8 * s + 2], st[kt][8 * s + 3]); pw.z = cvt2(st[kt][8 * s + 4], st[kt][8 * s + 5]); pw.w = cvt2(st[kt][8 * s + 6], st[kt][8 * s + 7]);
                const bf16x8 pf = __builtin_bit_cast(bf16x8, pw);
#pragma unroll
                for (int t = 0; t < 4; ++t) {
                    const s16x4 lo = __builtin_amdgcn_ds_read_tr16_b64_v4i16((LAS s16x4*)(kb + voff + (32 * kt + 16 * s) * VPB + t * 64));
                    const s16x4 hi = __builtin_amdgcn_ds_read_tr16_b64_v4i16((LAS s16x4*)(kb + voff + (32 * kt + 16 * s + 8) * VPB + t * 64));
                    const bf16x8 vf = __builtin_shufflevector(lo, hi, 0, 1, 2, 3, 4, 5, 6, 7);
                    o[t] = MFMA32(vf, pf, o[t]);
                }
            }
        if (ti + 1 < nt) ATT_WRITE(buf ^ 1);
        __syncthreads();
    }
#undef ATT_ISSUE
#undef ATT_WRITE
    const float inv = 1.0f / l;
    if (DIFF) {
        LAS float* ex = (LAS float*)F.lds;
        if (F.wave >= 4) {
#pragma unroll
            for (int t = 0; t < 4; ++t)
#pragma unroll
                for (int r = 0; r < 16; ++r) ex[((F.wave - 4) * 64 + t * 16 + r) * 64 + lane] = o[t][r] * inv;
        }
        __syncthreads();
        if (F.wave < 4) {
            float ss = 0.f;
#pragma unroll
            for (int t = 0; t < 4; ++t)
#pragma unroll
                for (int r = 0; r < 16; ++r) { const float x = o[t][r] * inv - lam * ex[(F.wave * 64 + t * 16 + r) * 64 + lane]; o[t][r] = x; ss += x * x; }
            ss += __shfl_xor(ss, 32);
            const float sc = post_scale / sqrtf(ss * (1.0f / 128.0f) + 1e-6f);
            gbf16* op = outp + (size_t)r32 * DM;
#pragma unroll
            for (int t = 0; t < 4; ++t)
#pragma unroll
                for (int g4 = 0; g4 < 4; ++g4) { const int dv = 32 * t + 8 * g4 + 4 * h; const f32x4 gv = *(const GAS f32x4*)(gvec + dv);
                    v2u w; w.x = cvt2(o[t][4 * g4] * sc * gv[0], o[t][4 * g4 + 1] * sc * gv[1]); w.y = cvt2(o[t][4 * g4 + 2] * sc * gv[2], o[t][4 * g4 + 3] * sc * gv[3]); *(GAS v2u*)(op + dv) = w; }
        }
    } else {
        gbf16* op = outp + (size_t)r32 * DM;
#pragma unroll
        for (int t = 0; t < 4; ++t)
#pragma unroll
            for (int g4 = 0; g4 < 4; ++g4) { const int dv = 32 * t + 8 * g4 + 4 * h;
                v2u w; w.x = cvt2(o[t][4 * g4] * inv, o[t][4 * g4 + 1] * inv); w.y = cvt2(o[t][4 * g4 + 2] * inv, o[t][4 * g4 + 3] * inv); *(GAS v2u*)(op + dv) = w; }
    }
}

#define MFMA16(a, b, c) __builtin_amdgcn_mfma_f32_16x16x32_bf16((a), (b), (c), 0, 0, 0)
__device__ __forceinline__ bf16x8 frag2(v2u lo, v2u hi) { const v4u w = {lo.x, lo.y, hi.x, hi.y}; return __builtin_bit_cast(bf16x8, w); }
constexpr int HG_NS = 7, HG_SLOT = 17408;
#define HG_VMWAIT(n) asm volatile("s_waitcnt vmcnt(" #n ")" ::: "memory")
__device__ __forceinline__ void hgrn_mfma(const Ctx& F, int rb, int nchunks, int h, int dir, const gf32* s_in, gf32* s_out, gf32* ob) {
    int lane_ = (int)__builtin_amdgcn_mbcnt_hi(~0u, __builtin_amdgcn_mbcnt_lo(~0u, 0u)); asm volatile("" : "+v"(lane_));
    const int lane = lane_, t16 = lane & 15, G = lane >> 4, w = F.wave, vcol = h * 128 + w * 16 + t16;
    __syncthreads();
    f32x4 S[8];
#pragma unroll
    for (int i = 0; i < 8; ++i)
#pragma unroll
        for (int r = 0; r < 4; ++r) S[i][r] = s_in ? s_in[(size_t)(16 * i + 4 * G + r) * 128 + w * 16 + t16] : 0.f;
    const GAS unsigned char* srcA = (const GAS unsigned char*)((w < 4 ? F.hq(dir) : F.hkm(dir)) + h * 128);
    const GAS unsigned char* srcB = (const GAS unsigned char*)((w < 4 ? F.hkp(dir) : F.hvt(dir)) + (size_t)h * 128 * 16);
    const GAS unsigned char* srcC = (const GAS unsigned char*)(F.hdec(dir) + h * 128) + (lane & 31) * 16;
    const int rA = 4 * (w & 3) + (lane >> 4);
    const unsigned offA = (unsigned)((dir ? 15 - rA : rA) * 1024 + (((lane & 15) ^ rA) * 16));
    const int dB = 32 * (w & 3) + (lane >> 1);
    const unsigned offB = (unsigned)(dB * 32 + (((lane & 1) ^ ((dB >> 3) & 1)) * 16));
    const int dstA = (w < 4 ? 0 : 4096) + (w & 3) * 1024, dstB = (w < 4 ? 8192 : 12288) + (w & 3) * 1024;
#define HG_ISSUE(cj) do { const int ce_ = (cj) < nchunks ? (cj) : nchunks - 1; const int ch_ = dir ? nchunks - 1 - ce_ : ce_; const size_t gc_ = (size_t)(rb / 16 + ch_); \
        LAS unsigned char* sl_ = F.lds + ((cj) % HG_NS) * HG_SLOT; \
        __builtin_amdgcn_global_load_lds((const GAS unsigned*)(srcA + (size_t)(rb + ch_ * 16) * 1024 + offA), (LAS unsigned*)(sl_ + dstA), 16, 0, 0); \
        __builtin_amdgcn_global_load_lds((const GAS unsigned*)(srcB + gc_ * 16384 + offB), (LAS unsigned*)(sl_ + dstB), 16, 0, 0); \
        if (w == 0) __builtin_amdgcn_global_load_lds((const GAS unsigned*)(srcC + gc_ * 2048), (LAS unsigned*)(sl_ + 16384), 16, 0, 0); } while (0)
    const int qoff = t16 * 256 + 8 * (G & 1);
    const int g1 = G >> 1;
    const int kpoff = 8192 + t16 * 32 + ((g1 ^ ((t16 >> 3) & 1)) * 16) + 8 * (G & 1);
    const int vtoff = 12288 + (w * 16 + t16) * 32 + ((g1 ^ ((t16 >> 3) & 1)) * 16) + 8 * (G & 1);
    const int dcoff = 16384 + 16 * G;
    const v2u z2 = {0u, 0u};
#pragma unroll
    for (int j = 0; j < HG_NS - 1; ++j) HG_ISSUE(j);
    for (int cc = 0; cc < nchunks; ++cc) {
        if (cc < HG_NS - 1) { if (w == 0) HG_VMWAIT(15); else HG_VMWAIT(10); }
        else                { if (w == 0) HG_VMWAIT(39); else HG_VMWAIT(34); }
        asm volatile("s_waitcnt lgkmcnt(0)" ::: "memory"); __builtin_amdgcn_s_barrier(); asm volatile("" ::: "memory");
        HG_ISSUE(cc + HG_NS - 1);
        const LAS unsigned char* sl = F.lds + (cc % HG_NS) * HG_SLOT;
        v2u q[8], k[8];
#pragma unroll
        for (int i = 0; i < 8; ++i) { const int po = (((2 * i + g1) ^ t16) * 16); q[i] = *(const LAS v2u*)(sl + qoff + po); k[i] = *(const LAS v2u*)(sl + 4096 + qoff + po); }
        const v2u vt = *(const LAS v2u*)(sl + vtoff);
        f32x4 pt = {0.f, 0.f, 0.f, 0.f};
#pragma unroll
        for (int kk = 0; kk < 4; ++kk) pt = MFMA16(frag2(k[2 * kk], k[2 * kk + 1]), frag2(q[2 * kk], q[2 * kk + 1]), pt);
#pragma unroll
        for (int r = 0; r < 4; ++r) if (4 * G + r > t16) pt[r] = 0.f;
        const v2u pb = {cvt2(pt[0], pt[1]), cvt2(pt[2], pt[3])};
        const bf16x8 vb = frag2(vt, z2);
        f32x4 o = {0.f, 0.f, 0.f, 0.f};
        o = MFMA16(frag2(pb, z2), vb, o);
#pragma unroll
        for (int kk = 0; kk < 4; ++kk) { const v2u s0 = {cvt2(S[2 * kk][0], S[2 * kk][1]), cvt2(S[2 * kk][2], S[2 * kk][3])}, s1 = {cvt2(S[2 * kk + 1][0], S[2 * kk + 1][1]), cvt2(S[2 * kk + 1][2], S[2 * kk + 1][3])};
            o = MFMA16(frag2(q[2 * kk], q[2 * kk + 1]), frag2(s0, s1), o); }
#pragma unroll
        for (int i = 0; i < 8; ++i) { const v2u kp = *(const LAS v2u*)(sl + kpoff + i * 512); const f32x4 dec = *(const LAS f32x4*)(sl + dcoff + i * 64);
            S[i] = S[i] * dec; S[i] = MFMA16(frag2(kp, z2), vb, S[i]); }
        const int ch = dir ? nchunks - 1 - cc : cc, crow = rb + ch * 16;
#pragma unroll
        for (int r = 0; r < 4; ++r) { const int pr_ = 4 * G + r; ob[(size_t)(crow + (dir ? 15 - pr_ : pr_)) * 512 + vcol] = o[r]; }
    }
#undef HG_ISSUE
    HG_VMWAIT(0);
    __syncthreads();
    if (s_out) {
#pragma unroll
        for (int i = 0; i < 8; ++i)
#pragma unroll
            for (int r = 0; r < 4; ++r) s_out[(size_t)(16 * i + 4 * G + r) * 128 + w * 16 + t16] = S[i][r];
    }
}

__device__ __forceinline__ void mx_mixers(const Ctx& F, int l) {
    const float lam = F.lamv()[l * 2], lam_init = F.lamv()[l * 2 + 1];
    const gbf16* qkv = F.qkv();
    constexpr int T_LH = 16, T_LD = 256, T_LB = 256, T_CD = 128, T_CS = 128, T_CH = 128;
    constexpr int NT = T_LH + T_LD + T_LB + T_CD + T_CS + T_CH;
    const AttnSeg none = {nullptr, nullptr, 0, 0};
    const int w = F.wave;
    for (int task = F.bid; task < NT; task += F.G) {
        int i = task;
        if (i < T_LH) {
            const int b = i >> 3, h = (i >> 1) & 3, dir = i & 1;
            const gf32* sin_ = F.inp(I_ST) + ((((size_t)b * 4 + l) * 2 + dir) * 4 + h) * 128 * 128;
            hgrn_mfma(F, R_CTX + b * S_LAT, S_LAT / 16, h, dir, sin_, nullptr, dir ? F.obb() : F.obf());
            continue; } i -= T_LH;
        if (i < T_LD) {
            const int b = i >> 7, h = (i >> 5) & 3, qt = i & 31, map = w >> 2; const int rb = R_CTX + b * S_LAT, wrow = rb + qt * 128 + 32 * (w & 3);
            const AttnSeg s0 = {qkv + (size_t)rb * QKV_LD + Q_KD + h * 128, qkv + (size_t)rb * QKV_LD + Q_VD + h * 128, QKV_LD, S_LAT / 64};
            const size_t co = (((size_t)b * 4 + l) * 4 + h) * 256 * 128;
            const AttnSeg s1 = {F.c16(0) + co, F.c16(2 * MiB) + co, 128, 4};
            attn_mfma<64, true>(F, qkv + (size_t)wrow * QKV_LD + Q_QD + h * 128 + map * 64, map * 64, s0, s1, false, 0, 0, -1e30f, 0.f, lam, 1.0f - lam_init, F.inp(I_DNG) + l * 128, F.cat() + (size_t)wrow * DM + h * 128);
            continue; } i -= T_LD;
        if (i < T_LB) {
            const int b = i >> 7, kv = (i >> 6) & 1, qt = i & 63, hh = kv * 4 + (w >> 1); const int rb = R_CTX + b * S_LAT, t0 = qt * 64, wrow = rb + t0 + 32 * (w & 1);
            const int ks = t0 - 128 < 0 ? 0 : t0 - 128, ke = t0 + 192 > S_LAT ? S_LAT : t0 + 192;
            const AttnSeg s0 = {qkv + (size_t)(rb + ks) * QKV_LD + Q_KS + kv * 128, qkv + (size_t)(rb + ks) * QKV_LD + Q_VS + kv * 128, QKV_LD, (ke - ks) / 64};
            const size_t co = (((size_t)b * 4 + l) * 2 + kv) * 256 * 128;
            const AttnSeg s1 = {F.c16(4 * MiB) + co, F.c16(5 * MiB) + co, 128, 4};
            attn_mfma<128, false>(F, qkv + (size_t)wrow * QKV_LD + Q_QS + hh * 128, 0, s0, s1, true, t0 + 32 * (w & 1), ks, F.inp(I_SINK)[l * 8 + hh] * LOG2E, 1.0f, 0.f, 1.0f, nullptr, F.cat() + (size_t)wrow * DM + 1024 + hh * 128);
            continue; } i -= T_LB;
        if (i < T_CD) {
            const int b = i >> 3, h = (i >> 1) & 3, qt = i & 1, map = w >> 2, rb = b * 256, wrow = rb + qt * 128 + 32 * (w & 3);
            const AttnSeg s0 = {qkv + (size_t)rb * QKV_LD + Q_KD + h * 128, qkv + (size_t)rb * QKV_LD + Q_VD + h * 128, QKV_LD, 4};
            attn_mfma<64, true>(F, qkv + (size_t)wrow * QKV_LD + Q_QD + h * 128 + map * 64, map * 64, s0, none, false, 0, 0, -1e30f, 0.f, lam, 1.0f - lam_init, F.inp(I_DNG) + l * 128, F.cat() + (size_t)wrow * DM + h * 128);
            continue; } i -= T_CD;
        if (i < T_CS) {
            const int b = i >> 3, kv = (i >> 2) & 1, qt = i & 3, hh = kv * 4 + (w >> 1), rb = b * 256, wrow = rb + qt * 64 + 32 * (w & 1);
            const AttnSeg s0 = {qkv + (size_t)rb * QKV_LD + Q_KS + kv * 128, qkv + (size_t)rb * QKV_LD + Q_VS + kv * 128, QKV_LD, 4};
            attn_mfma<128, false>(F, qkv + (size_t)wrow * QKV_LD + Q_QS + hh * 128, 0, s0, none, false, 0, 0, F.inp(I_SINK)[l * 8 + hh] * LOG2E, 1.0f, 0.f, 1.0f, nullptr, F.cat() + (size_t)wrow * DM + 1024 + hh * 128);
            continue; } i -= T_CS;
        {
            const int b = i >> 3, h = (i >> 1) & 3, dir = i & 1;
            gf32* sout = F.out + O_ST + ((((size_t)b * 4 + l) * 2 + dir) * 4 + h) * 128 * 128;
            hgrn_mfma(F, b * 256, 16, h, dir, nullptr, sout, dir ? F.obb() : F.obf());
        }
    }
}

__device__ __forceinline__ void mg_merge(const Ctx& F, int l) {
    const int head = F.lane >> 4, sub = F.lane & 15, col0 = head * 128 + sub * 8;
    for (int row = F.bid * 8 + F.wave; row < MROWS; row += F.G * 8) {
        const f32x4 a0 = *(const GAS f32x4*)(F.obf() + (size_t)row * 512 + col0) + *(const GAS f32x4*)(F.obb() + (size_t)row * 512 + col0);
        const f32x4 a1 = *(const GAS f32x4*)(F.obf() + (size_t)row * 512 + col0 + 4) + *(const GAS f32x4*)(F.obb() + (size_t)row * 512 + col0 + 4);
        float ss = (a0[0] * a0[0] + a0[1] * a0[1]) + (a0[2] * a0[2] + a0[3] * a0[3]) + (a1[0] * a1[0] + a1[1] * a1[1]) + (a1[2] * a1[2] + a1[3] * a1[3]);
        ss += __shfl_xor(ss, 1); ss += __shfl_xor(ss, 2); ss += __shfl_xor(ss, 4); ss += __shfl_xor(ss, 8);
        const float rinv = 1.0f / sqrtf(ss * (1.0f / 128.0f) + 1e-6f);
        const gf32* g = F.inp(I_HNG) + l * 128 + sub * 8; const gf32* hg = F.proj() + (size_t)row * DIN + C_BG + col0;
        const f32x4 g0 = *(const GAS f32x4*)g, g1 = *(const GAS f32x4*)(g + 4), h0 = *(const GAS f32x4*)hg, h1 = *(const GAS f32x4*)(hg + 4);
        float y[8];
#pragma unroll
        for (int i = 0; i < 4; ++i) { y[i] = a0[i] * rinv * g0[i] * silu_f(h0[i]); y[4 + i] = a1[i] * rinv * g1[i] * silu_f(h1[i]); }
        v4u w; w.x = pk2(y[0], y[1]); w.y = pk2(y[2], y[3]); w.z = pk2(y[4], y[5]); w.w = pk2(y[6], y[7]);
        *(GAS v4u*)(F.cat() + (size_t)row * DM + 512 + col0) = w;
    }
}

__device__ __forceinline__ void ln_phase(const Ctx& F, const gf32* g, const gf32* b, gf32* xo, const gf32* modsl  , int which_sh) {
    for (int row = F.bid * 8 + F.wave; row < MROWS; row += F.G * 8) {
        const gf32* yp = F.ypre() + (size_t)row * DM + F.lane * 4;
        f32x4 v[8]; float s = 0.f;
#pragma unroll
        for (int j = 0; j < 8; ++j) { v[j] = *(const GAS f32x4*)(yp + 256 * j); s += (v[j][0] + v[j][1]) + (v[j][2] + v[j][3]); }
#pragma unroll
        for (int o = 1; o < 64; o <<= 1) s += __shfl_xor(s, o);
        const float mean = s * (1.0f / DM); float s2 = 0.f;
#pragma unroll
        for (int j = 0; j < 8; ++j) { v[j] = v[j] - mean; s2 += (v[j][0] * v[j][0] + v[j][1] * v[j][1]) + (v[j][2] * v[j][2] + v[j][3] * v[j][3]); }
#pragma unroll
        for (int o = 1; o < 64; o <<= 1) s2 += __shfl_xor(s2, o);
        const float rstd = 1.0f / sqrtf(s2 * (1.0f / DM) + 1e-5f);
        const int mod = mod_of_row(row);
        const gf32* sh = modsl ? modsl + ((size_t)mod * 6 + which_sh) * DM : nullptr;
#pragma unroll
        for (int j = 0; j < 8; ++j) { const int c = F.lane * 4 + 256 * j;
            const f32x4 x = v[j] * rstd * *(const GAS f32x4*)(g + c) + *(const GAS f32x4*)(b + c);
            *(GAS f32x4*)(xo + (size_t)row * DM + c) = x;
            if (modsl) { const f32x4 hh = x * (*(const GAS f32x4*)(sh + DM + c) + 1.0f) + *(const GAS f32x4*)(sh + c);
                v2u w; w.x = pk2(hh[0], hh[1]); w.y = pk2(hh[2], hh[3]); *(GAS v2u*)(F.hbuf() + (size_t)row * DM + c) = w; } }
    }
}

constexpr int PH_PER_LAYER = 9, N_PHASES = 2 + DEPTH * PH_PER_LAYER;
__global__ void __launch_bounds__(512, 2) fwd_kernel(Args args) {
    extern __shared__ __attribute__((aligned(16))) unsigned char lds_raw[];
    Ctx F;
    F.lds = (LAS unsigned char*)lds_raw;
    F.tid = threadIdx.x; F.lane = F.tid & 63; F.wave = __builtin_amdgcn_readfirstlane(F.tid >> 6); F.G = gridDim.x; F.bid = blockIdx.x;
    F.ap = &args; F.out = (gf32*)args.out; F.ws = (GAS unsigned char*)args.ws;
    volatile LAS unsigned* MISC = (volatile LAS unsigned*)(F.lds + MISC_OFF);
    for (int u = F.tid; u < (LDS_BYTES - LDSCTL_OFF) / 4; u += 512) ((LAS unsigned*)(F.lds + LDSCTL_OFF))[u] = 0u;
    __syncthreads();
    XcdBarrier bar; bar.bar = (unsigned*)(args.ws + WS_CTL) + CW_BAR; bar.x = 0; bar.st = nullptr;
    if (args.single) bar = xcd_barrier_post((unsigned*)(args.ws + WS_CTL) + CW_BAR, MISC + 8);
    const int lo = args.ph_lo, hi = args.ph_hi;
#define IN(k) (lo <= (k) && (k) < hi)
#define FRESH() do { int ln_ = (int)__builtin_amdgcn_mbcnt_hi(~0u, __builtin_amdgcn_mbcnt_lo(~0u, 0u)); asm volatile("" : "+v"(ln_)); F.lane = ln_; asm volatile("" : "+s"(F.wave)); F.tid = F.wave * 64 + F.lane; \
    asm volatile("" : "+s"(F.bid), "+s"(F.G)); asm volatile("" : "+s"(F.ws), "+s"(F.out)); } while (0)
#define SEAM(k) do { if (IN((k) + 1)) xcd_barrier(bar); } while (0)

    if (IN(0)) { FRESH(); p0_prologue(F); SEAM(0); }
    if (IN(1)) { FRESH(); p1_h0(F); SEAM(1); }
    for (int l = 0; l < DEPTH; ++l) {
        const int k0 = 2 + l * PH_PER_LAYER;
        FRESH();
        const gf32* xa = l == 0 ? F.inp(I_XP) : F.out + O_YP; const gf32* xb = l == 0 ? F.inp(I_XS) : F.out + O_YS;
        if (IN(k0 + 0)) {
            pg8::Gemm g{(const pg8::bf16_t*)F.hbuf(), (const pg8::bf16_t*)F.wT(l, WO_IN), MROWS, DIN, DM}; pg8::StaticOrder S; S.init(MROWS, DIN, F.G, F.bid);
            EpiStoreF32 E{F.proj(), DIN};
            pg8::gemm_phase<EpiStoreF32, pg8::StaticOrder, true, true>(F.lds, g, S, E, F.wave);
            SEAM(k0 + 0); }
        if (IN(k0 + 1)) { FRESH(); e1_postproj(F, l); SEAM(k0 + 1); }
        if (IN(k0 + 2)) { FRESH(); mx_mixers(F, l); SEAM(k0 + 2); }
        if (IN(k0 + 3)) { FRESH(); mg_merge(F, l); SEAM(k0 + 3); }
        if (IN(k0 + 4)) {
            pg8::Gemm g{(const pg8::bf16_t*)F.cat(), (const pg8::bf16_t*)F.wT(l, WO_OUT), MROWS, DM, DM}; pg8::StaticOrder S; S.init(MROWS, DM, F.G, F.bid);
            EpiResid E{xa, xb, F.mods() + ((size_t)l * 3 * 6 + 2) * DM, F.ypre()};
            pg8::gemm_phase<EpiResid, pg8::StaticOrder, true, true>(F.lds, g, S, E, F.wave);
            SEAM(k0 + 4); }
        if (IN(k0 + 5)) { FRESH(); ln_phase(F, F.inp(I_LN1G) + l * DM, F.inp(I_LN1B) + l * DM, F.x1(), F.mods() + (size_t)l * 3 * 6 * DM, 3); SEAM(k0 + 5); }
        if (IN(k0 + 6)) {
            pg8::Gemm g{(const pg8::bf16_t*)F.hbuf(), (const pg8::bf16_t*)F.wT(l, WO_GU), MROWS, DGU, DM}; pg8::StaticOrder S; S.init(MROWS, DGU, F.G, F.bid);
            EpiSwiGLU E{F.act()};
            pg8::gemm_phase<EpiSwiGLU, pg8::StaticOrder, true, true>(F.lds, g, S, E, F.wave);
            SEAM(k0 + 6); }
        if (IN(k0 + 7)) {
            pg8::Gemm g{(const pg8::bf16_t*)F.act(), (const pg8::bf16_t*)F.wT(l, WO_DN), MROWS, DM, DFF}; pg8::StaticOrder S; S.init(MROWS, DM, F.G, F.bid);
            EpiResid E{F.x1(), F.x1() + (size_t)R_CTX * DM, F.mods() + ((size_t)l * 3 * 6 + 5) * DM, F.ypre()};
            pg8::gemm_phase<EpiResid, pg8::StaticOrder, true, true>(F.lds, g, S, E, F.wave);
            SEAM(k0 + 7); }
        if (IN(k0 + 8)) { FRESH(); ln_phase(F, F.inp(I_LN2G) + l * DM, F.inp(I_LN2B) + l * DM, F.out + O_YP, l + 1 < DEPTH ? F.mods() + (size_t)(l + 1) * 3 * 6 * DM : nullptr, 0); SEAM(k0 + 8); }
    }
#undef IN
#undef SEAM
#undef FRESH
}

#ifndef MK_SINGLE
#define MK_SINGLE 1
#endif
extern "C" void kernel_launch(void* const* d_in, const int* in_sizes, int n_in, void* d_out, int out_size, void* d_ws, size_t ws_size, hipStream_t stream) {
    static int grid = 0;
    if (grid == 0) {
        if (n_in != 24 || out_size != (int)O_END || ws_size < WS_END) { fprintf(stderr, "kernel_launch: unexpected sizes n_in %d out %d ws %zu\n", n_in, out_size, ws_size); grid = -1; return; }
        int dev = 0, cus = 0, per_cu = 0;
        if (hipGetDevice(&dev) != hipSuccess || hipDeviceGetAttribute(&cus, hipDeviceAttributeMultiprocessorCount, dev) != hipSuccess) { grid = -1; return; }
        if (hipFuncSetAttribute((const void*)fwd_kernel, hipFuncAttributeMaxDynamicSharedMemorySize, LDS_BYTES) != hipSuccess) { fprintf(stderr, "kernel_launch: hipFuncSetAttribute failed\n"); grid = -1; return; }
        if (hipOccupancyMaxActiveBlocksPerMultiprocessor(&per_cu, (const void*)fwd_kernel, 512, LDS_BYTES) != hipSuccess || per_cu < 1) fprintf(stderr, "kernel_launch: occupancy query says %d\n", per_cu);
        (void)hipGetLastError();
        grid = cus;
    }
    if (grid < 0) return;
    (void)hipMemsetAsync((char*)d_ws + WS_CTL, 0, CTL_ZERO_BYTES, stream);
    Args a{};
    for (int i = 0; i < 24; ++i) a.in[i] = (const float*)d_in[i];
    a.out = (float*)d_out; a.ws = (unsigned char*)d_ws; a.pad = 0;
#if MK_SINGLE
    a.ph_lo = 0; a.ph_hi = N_PHASES; a.single = 1;
    hipLaunchKernelGGL(fwd_kernel, dim3(grid), dim3(512), LDS_BYTES, stream, a);
#else
    a.single = 0;
    for (int p = 0; p < N_PHASES; ++p) { a.ph_lo = p; a.ph_hi = p + 1; hipLaunchKernelGGL(fwd_kernel, dim3(grid), dim3(512), LDS_BYTES, stream, a);
#ifdef PROBE_REP_MASK
        const int ty = p == 0 ? 9 : (p == 1 ? 10 : (p - 2) % PH_PER_LAYER);
        if ((PROBE_REP_MASK >> ty) & 1) for (int r = 0; r < PROBE_REP_N; ++r) hipLaunchKernelGGL(fwd_kernel, dim3(grid), dim3(512), LDS_BYTES, stream, a);
#endif
    }
#endif
}
```

```cpp
#include <hip/hip_runtime.h>
#include <cstdio>
#include <cstdint>
namespace pg8 {
#define PG8_LAS __attribute__((address_space(3)))
typedef unsigned short bf16_t;
typedef short bf16x8 __attribute__((ext_vector_type(8)));
typedef float f32x4 __attribute__((ext_vector_type(4)));
typedef unsigned u32x4 __attribute__((ext_vector_type(4)));
constexpr int BM = 256, BK = 64, HALF = 128, HTB = HALF * BK * 2  , STAGE_BYTES = 8 * HTB, NXCD = 8, WGM = 8;

__host__ __device__ __forceinline__ int lds_byte(int r, int c) { const int st = (r >> 4) * 2 + (c >> 5), rr = r & 15, cc = c & 31, ob = rr * 64 + cc * 2; return st * 1024 + (ob ^ (((ob >> 9) & 1) << 5)); }
__host__ __device__ __forceinline__ void stage_rc(int b, int& R, int& C) { const int st = b / 1024, sb = b % 1024, swz = sb ^ (((sb >> 9) & 1) << 5); R = (st >> 1) * 16 + swz / 64; C = (st & 1) * 32 + (swz % 64) / 2; }
__host__ __device__ __forceinline__ int perm32(int rho) { const int n = rho >> 4, i = rho & 15; return 8 * (i >> 2) + 4 * n + (i & 3); }

struct Unit { int pm, pn; };
struct Gemm { const bf16_t* A; const bf16_t* Bt; int M, N, K; };

struct StaticOrder {
    int nM, nN, nwg, G, c;
    __host__ __device__ void init(int M, int N, int G_, int c_) { nM = M / BM; nN = N / BM; nwg = nM * nN; G = G_; c = c_; }
    __host__ __device__ bool next(int i, Unit& u) const {
        const long L = (long)i * G + c; if (L >= nwg) return false;
        int wgid = (int)L; { const int q = nwg / NXCD, r = nwg % NXCD, xcd = wgid % NXCD, off = wgid / NXCD; wgid = (xcd < r ? xcd * (q + 1) : r * (q + 1) + (xcd - r) * q) + off; }
        const int nig = WGM * nN, gid = wgid / nig, fm = gid * WGM, gsz = (nM - fm) < WGM ? (nM - fm) : WGM;
        u.pm = fm + ((wgid % nig) % gsz); u.pn = (wgid % nig) / gsz; return true;
    }
    __device__ __forceinline__ void a_ready(const Unit&) const {}
    __device__ __forceinline__ void done(const Unit&) const {}
};
__device__ __forceinline__ unsigned cvt_pk_bf16(float lo, float hi) { unsigned r; asm volatile("v_cvt_pk_bf16_f32 %0, %1, %2" : "=v"(r) : "v"(lo), "v"(hi)); return r; }
typedef float f32x2 __attribute__((ext_vector_type(2)));
template <class Epi, class Sched, bool ALIGN_EPI = false, bool SP2 = false>
__device__ __forceinline__ void gemm_phase(PG8_LAS unsigned char* lds, const Gemm g, const Sched& S, const Epi& E, int wid_in) {
    int lane_ = (int)__builtin_amdgcn_mbcnt_hi(~0u, __builtin_amdgcn_mbcnt_lo(~0u, 0u)); asm volatile("" : "+v"(lane_)); asm volatile("" : "+s"(wid_in));
    const int wid = wid_in, lane = lane_, tid = wid * 64 + lane, wr = wid >> 2, wc = wid & 3, fr = lane & 15, fq = lane >> 4;
    const int K = g.K, nt = K / BK;
    unsigned voffA[2], voffB[2];
#pragma unroll
    for (int i = 0; i < 2; ++i) { int R, C; stage_rc(tid * 16 + i * 8192, R, C); const int Rb = Epi::PERM ? ((R & ~31) + perm32(R & 31)) : R;
        voffA[i] = (unsigned)(R * K + C) * 2u; voffB[i] = (unsigned)(Rb * K + C) * 2u; }
    const size_t kstep = (size_t)(BK * 2);
    const size_t hstep = (size_t)HALF * K * 2;
    const size_t tstep = 2 * hstep;
    const unsigned ldsw = (unsigned)wid * 1024u;
    const int aoff = lds_byte(wr * 64 + fr, fq * 8), boff = lds_byte(wc * 32 + fr, fq * 8);
#define PG8_SA(b, h) (((b) * 2 + (h)) * HTB)
#define PG8_SB(b, h) ((4 + (b) * 2 + (h)) * HTB)
#define PG8_STAGE(bufoff, gbase, voff) do { _Pragma("unroll") for (int _i = 0; _i < 2; ++_i) \
        __builtin_amdgcn_global_load_lds((const unsigned*)((const char*)(gbase) + (voff)[_i]), (PG8_LAS unsigned*)(lds + (bufoff) + ldsw + _i * 8192), 16, 0, 0); } while (0)
#define PG8_LDA(dst, b, h) do { _Pragma("unroll") for (int m = 0; m < 4; ++m) _Pragma("unroll") for (int k = 0; k < 2; ++k) dst[m][k] = *(const PG8_LAS bf16x8*)(lds + PG8_SA(b, h) + aoff + m * 2048 + k * 1024); } while (0)
#define PG8_LDB(dst, b, h) do { _Pragma("unroll") for (int n = 0; n < 2; ++n) _Pragma("unroll") for (int k = 0; k < 2; ++k) dst[n][k] = *(const PG8_LAS bf16x8*)(lds + PG8_SB(b, h) + boff + n * 2048 + k * 1024); } while (0)
#define PG8_MMA(ai, bj, At, Bt) do { __builtin_amdgcn_s_setprio(1); _Pragma("unroll") for (int m = 0; m < 4; ++m) _Pragma("unroll") for (int n = 0; n < 2; ++n) _Pragma("unroll") for (int k = 0; k < 2; ++k) \
        acc[ai][bj][m][n] = __builtin_amdgcn_mfma_f32_16x16x32_bf16(Bt[n][k], At[m][k], acc[ai][bj][m][n], 0, 0, 0); __builtin_amdgcn_s_setprio(0); } while (0)
#define PG8_WAIT_V(n) asm volatile("s_waitcnt vmcnt(" #n ")" ::: "memory")
#define PG8_WAIT_L(n) asm volatile("s_waitcnt lgkmcnt(" #n ")" ::: "memory")
#define PG8_BAR __builtin_amdgcn_s_barrier()
#define PG8_SCHED __builtin_amdgcn_sched_barrier(0)
    Unit cur, nxt; int ui = 0;
    if (!S.next(0, cur)) return;
    f32x4 acc[2][2][4][2];
#pragma unroll
    for (int a = 0; a < 2; ++a)
#pragma unroll
        for (int b = 0; b < 2; ++b)
#pragma unroll
            for (int m = 0; m < 4; ++m)
#pragma unroll
                for (int n = 0; n < 2; ++n) acc[a][b][m][n] = (f32x4){0.f, 0.f, 0.f, 0.f};
    bf16x8 At[4][2], B0[2][2], B1[2][2];
    const char* cA = (const char*)g.A + (size_t)cur.pm * tstep; const char* cB = (const char*)g.Bt + (size_t)cur.pn * tstep;
    S.a_ready(cur);
    if constexpr (SP2) {
        PG8_STAGE(PG8_SB(0, 0), cB, voffB); PG8_STAGE(PG8_SB(0, 1), cB + hstep, voffB); PG8_STAGE(PG8_SA(0, 0), cA, voffA); PG8_STAGE(PG8_SA(0, 1), cA + hstep, voffA);
        if (wr == 1) PG8_BAR;
        PG8_WAIT_V(2); PG8_BAR;
        PG8_STAGE(PG8_SB(1, 0), cB + kstep, voffB); PG8_STAGE(PG8_SA(1, 0), cA + kstep, voffA); PG8_STAGE(PG8_SB(1, 1), cB + hstep + kstep, voffB);
        PG8_WAIT_V(6); PG8_BAR;
    } else {
        PG8_STAGE(PG8_SB(0, 0), cB, voffB); PG8_STAGE(PG8_SA(0, 0), cA, voffA); PG8_STAGE(PG8_SB(0, 1), cB + hstep, voffB); PG8_STAGE(PG8_SA(0, 1), cA + hstep, voffA);
        if (wr == 1) PG8_BAR;
        PG8_WAIT_V(4); PG8_BAR;
        PG8_STAGE(PG8_SB(1, 0), cB + kstep, voffB); PG8_STAGE(PG8_SA(1, 0), cA + kstep, voffA); PG8_STAGE(PG8_SB(1, 1), cB + hstep + kstep, voffB);
        PG8_WAIT_V(6); PG8_BAR;
    }
    for (;;) {
        const bool has_next = S.next(ui + 1, nxt);
        const char* nA = has_next ? (const char*)g.A + (size_t)nxt.pm * tstep : cA; const char* nB = has_next ? (const char*)g.Bt + (size_t)nxt.pn * tstep : cB;
        for (int t = 0; t < nt; t += 2) {
            const bool last = (t == nt - 2);
            const char* a1 = cA + (size_t)(t + 1) * kstep;
            const char* a2 = last ? nA : cA + (size_t)(t + 2) * kstep; const char* b2 = last ? nB : cB + (size_t)(t + 2) * kstep;
            const char* a3 = a2 + kstep; const char* b3 = b2 + kstep;
            if (last && has_next) S.a_ready(nxt);
            if constexpr (SP2) {
            PG8_LDB(B0, 0, 0); PG8_LDB(B1, 0, 1); PG8_SCHED; PG8_LDA(At, 0, 0); PG8_STAGE(PG8_SA(1, 1), a1 + hstep, voffA);
            PG8_WAIT_V(8); PG8_WAIT_L(0); PG8_BAR; PG8_MMA(0, 0, At, B0); PG8_MMA(0, 1, At, B1); PG8_BAR; PG8_SCHED;
            PG8_LDA(At, 0, 1); PG8_STAGE(PG8_SB(0, 0), b2, voffB); PG8_STAGE(PG8_SB(0, 1), b2 + hstep, voffB); PG8_STAGE(PG8_SA(0, 0), a2, voffA);
            PG8_WAIT_V(8); PG8_WAIT_L(0); PG8_BAR; PG8_MMA(1, 0, At, B0); PG8_MMA(1, 1, At, B1); PG8_BAR; PG8_SCHED;
            PG8_LDB(B0, 1, 0); PG8_LDB(B1, 1, 1); PG8_SCHED; PG8_LDA(At, 1, 0); PG8_STAGE(PG8_SA(0, 1), a2 + hstep, voffA);
            PG8_WAIT_V(8); PG8_WAIT_L(0); PG8_BAR; PG8_MMA(0, 0, At, B0); PG8_MMA(0, 1, At, B1); PG8_BAR; PG8_SCHED;
            PG8_LDA(At, 1, 1); PG8_STAGE(PG8_SB(1, 0), b3, voffB); PG8_STAGE(PG8_SB(1, 1), b3 + hstep, voffB); PG8_STAGE(PG8_SA(1, 0), a3, voffA);
            PG8_WAIT_V(8); PG8_WAIT_L(0); PG8_BAR; PG8_MMA(1, 0, At, B0); PG8_MMA(1, 1, At, B1); PG8_BAR; PG8_SCHED;
            } else {
            PG8_LDB(B0, 0, 0); PG8_SCHED; PG8_LDA(At, 0, 0); PG8_STAGE(PG8_SA(1, 1), a1 + hstep, voffA);
            PG8_WAIT_L(8); PG8_BAR; PG8_WAIT_L(0); PG8_MMA(0, 0, At, B0); PG8_BAR; PG8_SCHED;
            PG8_LDB(B1, 0, 1); PG8_STAGE(PG8_SB(0, 0), b2, voffB);
            PG8_BAR; PG8_WAIT_L(0); PG8_MMA(0, 1, At, B1); PG8_BAR;
            PG8_LDA(At, 0, 1); PG8_STAGE(PG8_SA(0, 0), a2, voffA);
            PG8_BAR; PG8_WAIT_L(0); PG8_MMA(1, 0, At, B0); PG8_BAR; PG8_SCHED;
            PG8_STAGE(PG8_SB(0, 1), b2 + hstep, voffB);
            PG8_WAIT_V(6); PG8_BAR; PG8_MMA(1, 1, At, B1); PG8_BAR;
            PG8_LDB(B0, 1, 0); PG8_SCHED; PG8_LDA(At, 1, 0); PG8_STAGE(PG8_SA(0, 1), a2 + hstep, voffA);
            PG8_WAIT_L(8); PG8_BAR; PG8_WAIT_L(0); PG8_MMA(0, 0, At, B0); PG8_BAR; PG8_SCHED;
            PG8_LDB(B1, 1, 1); PG8_STAGE(PG8_SB(1, 0), b3, voffB);
            PG8_BAR; PG8_WAIT_L(0); PG8_MMA(0, 1, At, B1); PG8_BAR;
            PG8_LDA(At, 1, 1); PG8_STAGE(PG8_SA(1, 0), a3, voffA);
            PG8_BAR; PG8_WAIT_L(0); PG8_MMA(1, 0, At, B0); PG8_BAR; PG8_SCHED;
            PG8_STAGE(PG8_SB(1, 1), b3 + hstep, voffB);
            PG8_WAIT_V(6); PG8_BAR; PG8_MMA(1, 1, At, B1); PG8_BAR;
            }
        }
        if constexpr (ALIGN_EPI) { if (wr == 0) PG8_BAR; }
        if constexpr (!Epi::AFTER_DRAIN) { E(acc, cur, wr, wc, fr, fq); S.done(cur); }
        if (!has_next) break;
#pragma unroll
        for (int a = 0; a < 2; ++a)
#pragma unroll
            for (int b = 0; b < 2; ++b)
#pragma unroll
                for (int m = 0; m < 4; ++m)
#pragma unroll
                    for (int n = 0; n < 2; ++n) acc[a][b][m][n] = (f32x4){0.f, 0.f, 0.f, 0.f};
        cur = nxt; cA = nA; cB = nB; ++ui;
        if constexpr (ALIGN_EPI) { if (wr == 1) PG8_BAR; }
    }
    PG8_WAIT_V(0);
    if constexpr (!ALIGN_EPI) { if (wr == 0) PG8_BAR; }
    PG8_BAR;
    if constexpr (Epi::AFTER_DRAIN) { E.fused(acc, cur, wr, wc, fr, fq, lds, wid, lane); S.done(cur); }
#undef PG8_SA
#undef PG8_SB
#undef PG8_STAGE
#undef PG8_LDA
#undef PG8_LDB
#undef PG8_MMA
#undef PG8_WAIT_V
#undef PG8_WAIT_L
#undef PG8_BAR
#undef PG8_SCHED
}
}
#define GAS __attribute__((address_space(1)))
#define LAS __attribute__((address_space(3)))
typedef unsigned short bf16;
typedef unsigned v4u __attribute__((ext_vector_type(4)));
typedef float f32x4 __attribute__((ext_vector_type(4)));
typedef short bf16x8 __attribute__((ext_vector_type(8)));
typedef GAS unsigned gu32;
typedef GAS unsigned long long gu64;
#define RLX_AGENT __ATOMIC_RELAXED, __HIP_MEMORY_SCOPE_AGENT
#define LDS_WAIT() asm volatile("s_waitcnt lgkmcnt(0)" ::: "memory")
#define VM_WAIT() asm volatile("s_waitcnt vmcnt(0)" ::: "memory")
__device__ __forceinline__ unsigned long long rt() { return __builtin_amdgcn_s_memrealtime(); }
__device__ __forceinline__ unsigned f2bf(float f) { unsigned u = __builtin_bit_cast(unsigned, f); return (u + 0x7fffu + ((u >> 16) & 1u)) >> 16; }
__device__ __forceinline__ unsigned pk2(float lo, float hi) { return f2bf(lo) | (f2bf(hi) << 16); }
#define XB_TMO      128
#define XB_XCNT(j)  (256  + 64 * (j))
#define XB_XSUB(j)  (1280 + 64 * (j))
#define XB_XGEN(j)  (2304 + 64 * (j))
#define XB_TOP      3328
#define XB_TOPGEN   3392
#define XCD_BAR_WORDS 3456
#define XB_SPIN_CAP (1u << 24)

__device__ __forceinline__ unsigned xb_ld(unsigned* p)              { return __hip_atomic_load(p, __ATOMIC_RELAXED, __HIP_MEMORY_SCOPE_AGENT); }
__device__ __forceinline__ unsigned xb_add(unsigned* p, unsigned v) { return __hip_atomic_fetch_add(p, v, __ATOMIC_RELAXED, __HIP_MEMORY_SCOPE_AGENT); }
__device__ __forceinline__ unsigned xb_xcc_id() { return (unsigned)__builtin_amdgcn_s_getreg((3 << 11) | 20) & 0xFu; }
#define XB_SPIN(cond, bar) do { unsigned _sp = 0; while (cond) { __builtin_amdgcn_s_sleep(1); \
    if ((++_sp & 255u) == 0u) { if (xb_ld(&(bar)[XB_TMO])) break; if (_sp > XB_SPIN_CAP) { atomicAdd(&(bar)[XB_TMO], 1u); break; } } } } while (0)

struct XcdBarrier {
    unsigned* bar; unsigned x;
    volatile LAS unsigned* st;
};

__device__ __forceinline__ XcdBarrier xcd_barrier_post(unsigned* bar, volatile LAS unsigned* st) {
    XcdBarrier b; b.bar = bar; b.x = xb_xcc_id(); b.st = st;
    if (threadIdx.x == 0) (void)xb_add(&bar[XB_XCNT(b.x)], 1u);
    return b;
}
__device__ __forceinline__ void xcd_barrier_complete(unsigned* bar, unsigned x, unsigned& nloc, unsigned& nx) {
    const unsigned G = gridDim.x * gridDim.y * gridDim.z;
    unsigned sum, cnt, mine, sp = 0u;
    for (;;) {
        sum = 0u; cnt = 0u; mine = 0u;
#pragma unroll
        for (unsigned j = 0; j < 16; ++j) { const unsigned c = xb_ld(&bar[XB_XCNT(j)]); sum += c; cnt += (c > 0u) ? 1u : 0u; mine = (j == x) ? c : mine; }
        if (sum == G) break;
        __builtin_amdgcn_s_sleep(1);
        if ((++sp & 255u) == 0u) { if (xb_ld(&bar[XB_TMO])) break; if (sp > XB_SPIN_CAP) { atomicAdd(&bar[XB_TMO], 1u); break; } }
    }
    nloc = mine > 0u ? mine : 1u; nx = cnt > 0u ? cnt : 1u;
}

__device__ __forceinline__ void xcd_barrier(const XcdBarrier& b) {
    asm volatile("s_waitcnt vmcnt(0)" ::: "memory");
    __syncthreads();
    if (threadIdx.x == 0) {
        unsigned* bar = b.bar;
        __builtin_amdgcn_s_waitcnt(0);
        unsigned nloc = b.st[0], nx = b.st[1];
        if (nloc == 0u) { xcd_barrier_complete(bar, b.x, nloc, nx); b.st[0] = nloc; b.st[1] = nx; }
        const unsigned old = xb_add(&bar[XB_XSUB(b.x)], 1u);
        const unsigned gen = old / nloc;
        if (old + 1u == (gen + 1u) * nloc) {
            __builtin_amdgcn_fence(__ATOMIC_RELEASE, "agent");
            asm volatile("s_waitcnt vmcnt(0)" ::: "memory");
            const unsigned og = xb_add(&bar[XB_TOP], 1u);
            const unsigned tg = og / nx;
            if (og + 1u == (tg + 1u) * nx) xb_add(&bar[XB_TOPGEN], 1u);
            else XB_SPIN(xb_ld(&bar[XB_TOPGEN]) == tg, bar);
            __builtin_amdgcn_fence(__ATOMIC_ACQUIRE, "agent");
            xb_add(&bar[XB_XGEN(b.x)], 1u);
            asm volatile("s_waitcnt vmcnt(0)" ::: "memory");
        } else {
            XB_SPIN(xb_ld(&bar[XB_XGEN(b.x)]) == gen, bar);
            __builtin_amdgcn_fence(__ATOMIC_ACQUIRE, "agent");
            asm volatile("s_waitcnt vmcnt(0)" ::: "memory");
        }
    }
    __syncthreads();
}

constexpr int DM = 2048;
constexpr int NB_CTX = 16, S_CTX = 256, NB_LAT = 2, S_LAT = 4096, DEPTH = 4;
constexpr int R_CTX = NB_CTX * S_CTX;
constexpr int R_LAT = NB_LAT * S_LAT;
constexpr int MROWS = R_CTX + R_LAT;
constexpr int DIN = 5632, DFF = 5632, DGU = 2 * DFF;
constexpr float ALPHA = 1.6817928305074292f;
constexpr int C_AQ = 0, C_AK = 512, C_AV = 1024, C_BQ = 1536, C_BF = 2048, C_BB = 2560, C_BI = 3072, C_BG = 3584, C_CQ = 4096, C_CK = 5120, C_CV = 5376;
constexpr size_t O_YP = 0, O_YS = 8388608, O_DK = 25165824, O_DV = 33554432, O_SK = 41943040, O_SV = 46137344, O_ST = 50331648, O_END = 58720256;

constexpr size_t MiB = 1u << 20;
constexpr size_t WS_CTL = 0, CTL_ZERO_BYTES = 1 * MiB;
constexpr size_t WS_MODS = 1 * MiB;
constexpr size_t WS_MISC = 2 * MiB;
constexpr size_t WS_W = 4 * MiB, W_LAYER = 96 * MiB;
constexpr size_t WO_IN = 0, WO_OUT = 22 * MiB, WO_GU = 30 * MiB, WO_DN = 74 * MiB;
constexpr size_t WS_H = 388 * MiB;
constexpr size_t WS_CAT = 436 * MiB;
constexpr size_t WS_X1 = 484 * MiB;
constexpr size_t WS_OA = 580 * MiB, WS_OBF = 604 * MiB, WS_OBB = 628 * MiB;
constexpr size_t WS_P = 652 * MiB;
constexpr size_t WS_ACT = WS_P, WS_YPRE = WS_P + 132 * MiB;
constexpr size_t WS_C16 = 916 * MiB;
constexpr size_t WS_QKV = 922 * MiB;
constexpr int QKV_LD = 3072, Q_QD = 0, Q_KD = 512, Q_VD = 1024, Q_QS = 1536, Q_KS = 2560, Q_VS = 2816;
constexpr size_t WS_HQ = 994 * MiB;
constexpr size_t WS_HKM = 1018 * MiB;
constexpr size_t WS_HKP = 1042 * MiB;
constexpr size_t WS_HVT = 1066 * MiB;
constexpr size_t WS_HDEC = 1090 * MiB;
constexpr size_t WS_SLOC = 1094 * MiB;
constexpr size_t WS_DSEG = 1110 * MiB;
constexpr size_t WS_END = 1111 * MiB;

constexpr int CW_BAR = 4096;

constexpr int RING_BYTES = 131072;
constexpr int LDSCTL_OFF = RING_BYTES, MISC_OFF = LDSCTL_OFF + 320;
constexpr int LDS_BYTES = 147456;

typedef unsigned v2u __attribute__((ext_vector_type(2)));
typedef GAS float gf32;
typedef GAS unsigned short gbf16;

__device__ __forceinline__ float silu_f(float a) { return a / (1.0f + __expf(-a)); }
__device__ __forceinline__ int mod_of_row(int row) { return row < R_CTX ? 0 : (row < R_CTX + S_LAT ? 1 : 2); }

struct EpiStoreF32 {
    static constexpr bool PERM = false, AFTER_DRAIN = false;
    gf32* C; int ldc;
    __device__ __forceinline__ void operator()(const pg8::f32x4 (&acc)[2][2][4][2], const pg8::Unit& u, int wr, int wc, int fr, int fq) const {
        const int row0 = u.pm * 256 + wr * 64 + fr, col0 = u.pn * 256 + wc * 32 + 4 * fq;
#pragma unroll
        for (int ai = 0; ai < 2; ++ai)
#pragma unroll
            for (int m = 0; m < 4; ++m) { gf32* rowp = C + (size_t)(row0 + ai * 128 + m * 16) * ldc + col0;
#pragma unroll
                for (int bj = 0; bj < 2; ++bj)
#pragma unroll
                    for (int n = 0; n < 2; ++n) *(GAS pg8::f32x4*)(rowp + bj * 128 + n * 16) = acc[ai][bj][m][n]; }
    }
};
struct EpiResid {
    static constexpr bool PERM = false, AFTER_DRAIN = false;
    const gf32* xa; const gf32* xb;
    const gf32* gates;
    gf32* out;
    __device__ __forceinline__ void operator()(const pg8::f32x4 (&acc)[2][2][4][2], const pg8::Unit& u, int wr, int wc, int fr, int fq) const {
        const int mod = u.pm >> 4;
        const gf32* xbase = (u.pm < 16) ? xa + (size_t)u.pm * 256 * DM : xb + (size_t)(u.pm - 16) * 256 * DM;
        const int r0 = wr * 64 + fr, col0 = u.pn * 256 + wc * 32 + 4 * fq;
        pg8::f32x4 gv[2][2];
#pragma unroll
        for (int bj = 0; bj < 2; ++bj)
#pragma unroll
            for (int n = 0; n < 2; ++n) gv[bj][n] = *(const GAS pg8::f32x4*)(gates + (size_t)mod * 6 * DM + col0 + bj * 128 + n * 16);
#pragma unroll
        for (int ai = 0; ai < 2; ++ai)
#pragma unroll
            for (int m = 0; m < 4; ++m) { const int r = r0 + ai * 128 + m * 16;
                const gf32* xp = xbase + (size_t)r * DM + col0; gf32* op = out + ((size_t)u.pm * 256 + r) * DM + col0;
#pragma unroll
                for (int bj = 0; bj < 2; ++bj)
#pragma unroll
                    for (int n = 0; n < 2; ++n) { const pg8::f32x4 xv = *(const GAS pg8::f32x4*)(xp + bj * 128 + n * 16);
                        *(GAS pg8::f32x4*)(op + bj * 128 + n * 16) = xv * ALPHA + gv[bj][n] * acc[ai][bj][m][n]; } }
    }
};
struct EpiSwiGLU {
    static constexpr bool PERM = true, AFTER_DRAIN = false;
    gbf16* act;
    __device__ __forceinline__ void operator()(const pg8::f32x4 (&acc)[2][2][4][2], const pg8::Unit& u, int wr, int wc, int fr, int fq) const {
        const int row0 = u.pm * 256 + wr * 64 + fr, col0 = u.pn * 128 + wc * 32 + 8 * fq;
#pragma unroll
        for (int ai = 0; ai < 2; ++ai)
#pragma unroll
            for (int m = 0; m < 4; ++m) { gbf16* rowp = act + (size_t)(row0 + ai * 128 + m * 16) * DFF + col0;
                float r[8];
#pragma unroll
                for (int n = 0; n < 2; ++n)
#pragma unroll
                    for (int j = 0; j < 4; ++j) { const float g = acc[ai][0][m][n][j], up = acc[ai][1][m][n][j]; r[n * 4 + j] = silu_f(g) * up; }
                pg8::u32x4 w; w.x = pg8::cvt_pk_bf16(r[0], r[1]); w.y = pg8::cvt_pk_bf16(r[2], r[3]); w.z = pg8::cvt_pk_bf16(r[4], r[5]); w.w = pg8::cvt_pk_bf16(r[6], r[7]);
                *(GAS pg8::u32x4*)rowp = w; }
    }
};

struct Args { const float* in[24]; float* out; unsigned char* ws; int ph_lo, ph_hi, single, pad; };
enum { I_XP = 0, I_XS, I_CDK, I_CDV, I_CSK, I_CSV, I_ST, I_C, I_CCTX, I_WMOD, I_BMOD, I_WIN, I_WOUT, I_DLAM, I_DNG, I_LBL, I_HNG, I_SINK, I_LN1G, I_LN1B, I_LN2G, I_LN2B, I_WGU, I_WDN };

struct Ctx {
    LAS unsigned char* lds; int tid, lane, wave, G, bid;
    const Args* ap; gf32* out; GAS unsigned char* ws;
    __device__ __forceinline__ const gf32* inp(int i) const { return (const gf32*)ap->in[i]; }
    __device__ __forceinline__ gf32* mods() const { return (gf32*)(ws + WS_MODS); }
    __device__ __forceinline__ gf32* lball() const { return (gf32*)(ws + WS_MISC); }
    __device__ __forceinline__ gf32* lamv() const { return (gf32*)(ws + WS_MISC + 16384); }
    __device__ __forceinline__ gf32* tabD() const { return (gf32*)(ws + WS_MISC + 20480); }
    __device__ __forceinline__ gf32* tabS() const { return (gf32*)(ws + WS_MISC + 32768); }
    __device__ __forceinline__ gbf16* wT(int l, size_t off) const { return (gbf16*)(ws + WS_W + (size_t)l * W_LAYER + off); }
    __device__ __forceinline__ gbf16* hbuf() const { return (gbf16*)(ws + WS_H); }
    __device__ __forceinline__ gbf16* cat() const { return (gbf16*)(ws + WS_CAT); }
    __device__ __forceinline__ gf32* x1() const { return (gf32*)(ws + WS_X1); }
    __device__ __forceinline__ gf32* oa() const { return (gf32*)(ws + WS_OA); }
    __device__ __forceinline__ gf32* obf() const { return (gf32*)(ws + WS_OBF); }
    __device__ __forceinline__ gf32* obb() const { return (gf32*)(ws + WS_OBB); }
    __device__ __forceinline__ gf32* proj() const { return (gf32*)(ws + WS_P); }
    __device__ __forceinline__ gbf16* act() const { return (gbf16*)(ws + WS_ACT); }
    __device__ __forceinline__ gf32* ypre() const { return (gf32*)(ws + WS_YPRE); }
    __device__ __forceinline__ gbf16* qkv() const { return (gbf16*)(ws + WS_QKV); }
    __device__ __forceinline__ gbf16* hq(int dir) const { return (gbf16*)(ws + WS_HQ) + (size_t)dir * MROWS * 512; }
    __device__ __forceinline__ gbf16* hkm(int dir) const { return (gbf16*)(ws + WS_HKM) + (size_t)dir * MROWS * 512; }
    __device__ __forceinline__ gbf16* hkp(int dir) const { return (gbf16*)(ws + WS_HKP) + (size_t)dir * 768 * 512 * 16; }
    __device__ __forceinline__ gbf16* hvt(int dir) const { return (gbf16*)(ws + WS_HVT) + (size_t)dir * 768 * 512 * 16; }
    __device__ __forceinline__ gf32* sloc() const { return (gf32*)(ws + WS_SLOC); }
    __device__ __forceinline__ gf32* dseg() const { return (gf32*)(ws + WS_DSEG); }
    __device__ __forceinline__ gf32* hdec(int dir) const { return (gf32*)(ws + WS_HDEC) + (size_t)dir * 768 * 512; }
    __device__ __forceinline__ gbf16* c16(size_t off) const { return (gbf16*)(ws + WS_C16 + off); }
};

__device__ __forceinline__ void transpose_item(const gf32* W, int K, int N, gbf16* WT, int k0, int n0, int drow0, LAS float* scr, int lane) {
#pragma unroll 8
    for (int i = 0; i < 32; ++i) { const int kk = 2 * i + (lane >> 5); scr[kk * 33 + (lane & 31)] = W[(size_t)(k0 + kk) * N + n0 + (lane & 31)]; }
    LDS_WAIT(); asm volatile("" ::: "memory");
    const int c = lane & 7;
#pragma unroll
    for (int j = 0; j < 4; ++j) { const int n = (lane >> 3) + 8 * j; const LAS float* s = scr + (8 * c) * 33 + n;
        v4u o; o.x = pk2(s[0 * 33], s[1 * 33]); o.y = pk2(s[2 * 33], s[3 * 33]); o.z = pk2(s[4 * 33], s[5 * 33]); o.w = pk2(s[6 * 33], s[7 * 33]);
        *(GAS v4u*)(WT + (size_t)(drow0 + n) * K + k0 + 8 * c) = o; }
    LDS_WAIT(); asm volatile("" ::: "memory");
}

__device__ __forceinline__ void p0_prologue(const Ctx& F) {
    {
        LAS float* sc = (LAS float*)F.lds;
        LAS float* red = (LAS float*)(F.lds + 24576);
        const gf32* c_ctx = F.inp(I_CCTX); const gf32* cc = F.inp(I_C);
        for (int i = F.tid; i < 3 * DM; i += 512) { const int mid = i / DM, k = i % DM; const float c = mid == 0 ? c_ctx[k] : cc[(mid - 1) * DM + k]; sc[i] = silu_f(c); }
        __syncthreads();
        for (int task = F.bid; task < DEPTH * 48; task += F.G) {
            const int l = task / 48, cb = task % 48, w = F.wave;
            const gf32* wp = F.inp(I_WMOD) + ((size_t)l * DM + 256 * w) * (6 * DM) + cb * 256 + F.lane * 4;
            f32x4 a0 = {0.f, 0.f, 0.f, 0.f}, a1 = a0, a2 = a0;
#pragma unroll 8
            for (int kk = 0; kk < 256; ++kk) { const f32x4 wv = *(const GAS f32x4*)(wp + (size_t)kk * (6 * DM));
                a0 += wv * sc[256 * w + kk]; a1 += wv * sc[DM + 256 * w + kk]; a2 += wv * sc[2 * DM + 256 * w + kk]; }
            *(LAS f32x4*)(red + (w * 3 + 0) * 256 + F.lane * 4) = a0; *(LAS f32x4*)(red + (w * 3 + 1) * 256 + F.lane * 4) = a1; *(LAS f32x4*)(red + (w * 3 + 2) * 256 + F.lane * 4) = a2;
            __syncthreads();
            for (int i = F.tid; i < 768; i += 512) { const int m = i >> 8, c = i & 255; float s = 0.f;
#pragma unroll
                for (int ww = 0; ww < 8; ++ww) s += red[(ww * 3 + m) * 256 + c];
                F.mods()[((size_t)l * 3 + m) * (6 * DM) + cb * 256 + c] = s + F.inp(I_BMOD)[(size_t)l * 6 * DM + cb * 256 + c]; }
            __syncthreads();
        }
    }
    if (F.bid == F.G - 1) {
        const gf32* lbl = F.inp(I_LBL);
        for (int i = F.tid; i < 1024; i += 512) { float lg[4], mx = -1e30f;
#pragma unroll
            for (int l = 0; l < 4; ++l) { lg[l] = lbl[l * 1024 + i]; mx = fmaxf(mx, lg[l]); }
            float s = 0.f;
#pragma unroll
            for (int l = 0; l < 4; ++l) { lg[l] = expf(lg[l] - mx); s += lg[l]; }
            const float w1 = lg[1] / s, w2 = lg[2] / s, w3 = lg[3] / s;
            F.lball()[0 * 1024 + i] = 0.f; F.lball()[1 * 1024 + i] = w1; F.lball()[2 * 1024 + i] = w1 + w2; F.lball()[3 * 1024 + i] = w1 + w2 + w3; }
        if (F.tid < 4) { const int l = F.tid; const gf32* lp = F.inp(I_DLAM) + l * 256; float s1 = 0.f, s2 = 0.f;
            for (int i = 0; i < 64; ++i) { s1 += lp[i] * lp[64 + i]; s2 += lp[128 + i] * lp[192 + i]; }
            const float li = 0.8f - 0.6f * expf(-0.3f * (float)l);
            F.lamv()[l * 2] = expf(s1) - expf(s2) + li; F.lamv()[l * 2 + 1] = li; }
        for (int i = F.tid; i < 64 * 16; i += 512) { const int pos = i / 16, j = i % 16; const float inv = powf(10000.f, -(float)j / 16.f), ang = (float)pos * inv; F.tabD()[i * 2] = cosf(ang); F.tabD()[i * 2 + 1] = sinf(ang); }
        for (int i = F.tid; i < 64 * 32; i += 512) { const int pos = i / 32, j = i % 32; const float inv = powf(10000.f, -(float)j / 32.f), ang = (float)pos * inv; F.tabS()[i * 2] = cosf(ang); F.tabS()[i * 2 + 1] = sinf(ang); }
    }
    {
        const gf32* src[4] = {F.inp(I_CDK), F.inp(I_CDV), F.inp(I_CSK), F.inp(I_CSV)};
        const size_t doff[4] = {0, 2 * MiB, 4 * MiB, 5 * MiB}; const int n8[4] = {131072, 131072, 65536, 65536};
#pragma unroll
        for (int a = 0; a < 4; ++a)
            for (int i = F.bid * 512 + F.tid; i < n8[a]; i += F.G * 512) { const f32x4 x0 = *(const GAS f32x4*)(src[a] + (size_t)i * 8), x1 = *(const GAS f32x4*)(src[a] + (size_t)i * 8 + 4);
                v4u o; o.x = pk2(x0[0], x0[1]); o.y = pk2(x0[2], x0[3]); o.z = pk2(x1[0], x1[1]); o.w = pk2(x1[2], x1[3]); *(GAS v4u*)(F.c16(doff[a]) + (size_t)i * 8) = o; }
    }
    {
        LAS float* scr = (LAS float*)(F.lds + 49152 + F.wave * 8448);
        const int gw = F.bid * 8 + F.wave, NGW = F.G * 8;
        constexpr int I_IN = 32 * 176, I_OUT = 32 * 64, I_GU = 32 * 352, I_DN = 88 * 64, I_L = I_IN + I_OUT + I_GU + I_DN;
        for (int it = gw; it < DEPTH * I_L; it += NGW) {
            const int l = it / I_L; int r = it % I_L;
            if (r < I_IN) { const int kb = r / 176, nb = r % 176; transpose_item(F.inp(I_WIN) + (size_t)l * DM * DIN, DM, DIN, F.wT(l, WO_IN), 64 * kb, 32 * nb, 32 * nb, scr, F.lane); continue; } r -= I_IN;
            if (r < I_OUT) { const int kb = r / 64, nb = r % 64; transpose_item(F.inp(I_WOUT) + (size_t)l * DM * DM, DM, DM, F.wT(l, WO_OUT), 64 * kb, 32 * nb, 32 * nb, scr, F.lane); continue; } r -= I_OUT;
            if (r < I_GU) { const int kb = r / 352, nb = r % 352, n0 = 32 * nb; const int j = n0 < DFF ? n0 : n0 - DFF; const int drow = 256 * (j >> 7) + (n0 < DFF ? 0 : 128) + (j & 127);
                transpose_item(F.inp(I_WGU) + (size_t)l * DM * DGU, DM, DGU, F.wT(l, WO_GU), 64 * kb, n0, drow, scr, F.lane); continue; } r -= I_GU;
            { const int kb = r / 64, nb = r % 64; transpose_item(F.inp(I_WDN) + (size_t)l * DFF * DM, DFF, DM, F.wT(l, WO_DN), 64 * kb, 32 * nb, 32 * nb, scr, F.lane); }
        }
    }
}

__device__ __forceinline__ void p1_h0(const Ctx& F) {
    const gf32* xp = F.inp(I_XP); const gf32* xs = F.inp(I_XS);
    for (int idx = F.bid * 512 + F.tid; idx < MROWS * 256; idx += F.G * 512) {
        const int row = idx >> 8, c8 = (idx & 255) * 8, mod = mod_of_row(row);
        const gf32* xr = row < R_CTX ? xp + (size_t)row * DM : xs + (size_t)(row - R_CTX) * DM;
        const gf32* sh = F.mods() + (size_t)(0 * 3 + mod) * 6 * DM; const gf32* sc = sh + DM;
        const f32x4 x0 = *(const GAS f32x4*)(xr + c8), x1 = *(const GAS f32x4*)(xr + c8 + 4), s0 = *(const GAS f32x4*)(sh + c8), s1 = *(const GAS f32x4*)(sh + c8 + 4), c0 = *(const GAS f32x4*)(sc + c8), c1 = *(const GAS f32x4*)(sc + c8 + 4);
        const f32x4 h0 = x0 * (c0 + 1.0f) + s0, h1 = x1 * (c1 + 1.0f) + s1;
        v4u o; o.x = pk2(h0[0], h0[1]); o.y = pk2(h0[2], h0[3]); o.z = pk2(h1[0], h1[1]); o.w = pk2(h1[2], h1[3]);
        *(GAS v4u*)(F.hbuf() + (size_t)row * DM + c8) = o;
    }
}

constexpr float LOG2E = 1.4426950408889634f;
constexpr float QSC_D = 0.125f * LOG2E, QSC_S = 0.08838834764831845f * LOG2E;
__device__ __forceinline__ void e1_postproj(const Ctx& F, int l) {
    const gf32* lb = F.lball() + l * 1024;
    for (int grp = F.bid; grp < MROWS / 16; grp += F.G) {
        const int row0 = grp * 16;
        for (int rr = 0; rr < 16; ++rr) {
            const int row = row0 + rr;
            const gf32* pr = F.proj() + (size_t)row * DIN; gbf16* qk = F.qkv() + (size_t)row * QKV_LD;
            const bool lat = row >= R_CTX; const int t = (row - R_CTX) & (S_LAT - 1), rpos = t >> 6, cpos = t & 63;
            { const int p = F.tid, blk = p >> 4, i = p & 15, cb = blk * 32, pos = (blk & 1) ? cpos : rpos;
              float cs = 1.f, sn = 0.f; if (lat) { cs = F.tabD()[(pos * 16 + i) * 2]; sn = F.tabD()[(pos * 16 + i) * 2 + 1]; }
              const float x1 = pr[cb + i], x2 = pr[cb + 16 + i], sc = cb < 512 ? QSC_D : 1.0f;
              qk[cb + i] = (bf16)f2bf((x1 * cs - x2 * sn) * sc); qk[cb + 16 + i] = (bf16)f2bf((x2 * cs + x1 * sn) * sc); }
            for (int p = F.tid; p < 640; p += 512) { const int blk = p >> 5, i = p & 31, cb = C_CQ + blk * 64, db = Q_QS + blk * 64, pos = (blk & 1) ? cpos : rpos;
              float cs = 1.f, sn = 0.f; if (lat) { cs = F.tabS()[(pos * 32 + i) * 2]; sn = F.tabS()[(pos * 32 + i) * 2 + 1]; }
              const float x1 = pr[cb + i], x2 = pr[cb + 32 + i], sc = blk < 16 ? QSC_S : 1.0f;
              qk[db + i] = (bf16)f2bf((x1 * cs - x2 * sn) * sc); qk[db + 32 + i] = (bf16)f2bf((x2 * cs + x1 * sn) * sc); }
            { const int c = F.tid; qk[Q_VD + c] = (bf16)f2bf(pr[C_AV + c]); if (c < 256) qk[Q_VS + c] = (bf16)f2bf(pr[C_CV + c]); }
            if (!lat) {
                const int b = row >> 8, n = row & 255;
                for (int i = F.tid; i < 384; i += 512) {
                    if (i < 128) { const int h = i >> 5, c4 = (i & 31) * 4; *(GAS f32x4*)(F.out + O_DK + ((((size_t)b * 4 + l) * 4 + h) * 256 + n) * 128 + c4) = *(const GAS f32x4*)(pr + C_AK + h * 128 + c4); }
                    else if (i < 256) { const int ii = i - 128, h = ii >> 5, c4 = (ii & 31) * 4; *(GAS f32x4*)(F.out + O_DV + ((((size_t)b * 4 + l) * 4 + h) * 256 + n) * 128 + c4) = *(const GAS f32x4*)(pr + C_AV + h * 128 + c4); }
                    else if (i < 320) { const int ii = i - 256, kv = ii >> 5, c4 = (ii & 31) * 4; *(GAS f32x4*)(F.out + O_SK + ((((size_t)b * 4 + l) * 2 + kv) * 256 + n) * 128 + c4) = *(const GAS f32x4*)(pr + C_CK + kv * 128 + c4); }
                    else { const int ii = i - 320, kv = ii >> 5, c4 = (ii & 31) * 4; *(GAS f32x4*)(F.out + O_SV + ((((size_t)b * 4 + l) * 2 + kv) * 256 + n) * 128 + c4) = *(const GAS f32x4*)(pr + C_CV + kv * 128 + c4); }
                }
            }
        }
        {
            const int c = F.tid; const gf32* pc = F.proj() + (size_t)row0 * DIN;
            float qv[16], vv[16];
#pragma unroll
            for (int r = 0; r < 16; ++r) { qv[r] = silu_f(pc[(size_t)r * DIN + C_BQ + c]); vv[r] = pc[(size_t)r * DIN + C_BI + c]; }
#pragma unroll
            for (int dir = 0; dir < 2; ++dir) {
                const float lbv = lb[dir * 512 + c], lbm = fmaxf(lbv, 1e-30f), oml = 1.0f - lbv;
                float g[16], cum[16]; float run = 0.f;
#pragma unroll
                for (int p = 0; p < 16; ++p) { const int r = dir ? 15 - p : p; const float z = pc[(size_t)r * DIN + C_BF + dir * 512 + c];
                    g[p] = logf(lbm + oml / (1.0f + expf(-z))); run += g[p]; cum[p] = run; }
                const float last = run;
                unsigned kpw[8], vtw[8];
#pragma unroll
                for (int p = 0; p < 16; p += 2) {
                    float kp2[2];
#pragma unroll
                    for (int e = 0; e < 2; ++e) { const int pp = p + e, r = dir ? 15 - pp : pp; const float k = 1.0f - expf(g[pp]); const float cc = fmaxf(cum[pp], -80.0f);
                        F.hq(dir)[(size_t)(row0 + r) * 512 + c] = (bf16)f2bf(qv[r] * expf(cc)); F.hkm(dir)[(size_t)(row0 + r) * 512 + c] = (bf16)f2bf(k * expf(-cc));
                        kp2[e] = k * expf(last - cum[pp]); }
                    kpw[p >> 1] = pk2(kp2[0], kp2[1]); vtw[p >> 1] = pk2(vv[dir ? 15 - p : p], vv[dir ? 14 - p : p + 1]);
                }
                GAS v4u* kd = (GAS v4u*)(F.hkp(dir) + ((size_t)grp * 512 + c) * 16); GAS v4u* vd = (GAS v4u*)(F.hvt(dir) + ((size_t)grp * 512 + c) * 16);
                kd[0] = (v4u){kpw[0], kpw[1], kpw[2], kpw[3]}; kd[1] = (v4u){kpw[4], kpw[5], kpw[6], kpw[7]};
                vd[0] = (v4u){vtw[0], vtw[1], vtw[2], vtw[3]}; vd[1] = (v4u){vtw[4], vtw[5], vtw[6], vtw[7]};
                F.hdec(dir)[(size_t)grp * 512 + c] = expf(last);
            }
        }
    }
}

typedef float f32x16 __attribute__((ext_vector_type(16)));
typedef short s16x4 __attribute__((ext_vector_type(4)));
typedef __bf16 bf16x2_t __attribute__((ext_vector_type(2)));
typedef float f32x2_t __attribute__((ext_vector_type(2)));
__device__ __forceinline__ unsigned cvt2(float a, float b) { const f32x2_t f = {a, b}; return __builtin_bit_cast(unsigned, __builtin_convertvector(f, bf16x2_t)); }
#define MFMA32(a, b, c) __builtin_amdgcn_mfma_f32_32x32x16_bf16((a), (b), (c), 0, 0, 0)

struct AttnSeg { const gbf16* k; const gbf16* v; int stride; int ntiles; };
constexpr int KPB = 272, VPB = 320;
constexpr int KT_BYTES = 64 * KPB, VT_BYTES = 64 * VPB, ABUF_BYTES = KT_BYTES + VT_BYTES;
constexpr float ATT_THR = 8.0f;

template <int DQK, bool DIFF>
__device__ __forceinline__ void attn_mfma(const Ctx& F, const gbf16* qptr, int kcol, const AttnSeg s0, const AttnSeg s1, bool band, int qpos, int kpos0,
                                          float m_init, float l_init, float lam, float post_scale, const gf32* gvec, gbf16* outp  ) {
    int lane_ = (int)__builtin_amdgcn_mbcnt_hi(~0u, __builtin_amdgcn_mbcnt_lo(~0u, 0u)); asm volatile("" : "+v"(lane_));
    const int lane = lane_, tid = F.wave * 64 + lane, r32 = lane & 31, h = lane >> 5;
    __syncthreads();
    bf16x8 qf[DQK / 16];
#pragma unroll
    for (int ks = 0; ks < DQK / 16; ++ks) qf[ks] = *(const GAS bf16x8*)(qptr + (size_t)r32 * QKV_LD + 16 * ks + 8 * h);
#pragma unroll
    for (int ks = 0; ks < DQK / 16; ++ks) asm volatile("" : "+v"(qf[ks]));
    __builtin_amdgcn_s_waitcnt(0);
    f32x16 o[4];
#pragma unroll
    for (int t = 0; t < 4; ++t)
#pragma unroll
        for (int r = 0; r < 16; ++r) o[t][r] = 0.f;
    float m = m_init, l = l_init;
    const int nt = s0.ntiles + s1.ntiles;
    const int srow = tid >> 4, spc = tid & 15;
    v4u kreg[2], vreg[2];
#define ATT_ISSUE(ti) do { const bool s1_ = (ti) >= s0.ntiles; const int tt_ = s1_ ? (ti) - s0.ntiles : (ti); const gbf16* kb_ = s1_ ? s1.k : s0.k; const gbf16* vb_ = s1_ ? s1.v : s0.v; const int st_ = s1_ ? s1.stride : s0.stride; \
        _Pragma("unroll") for (int i_ = 0; i_ < 2; ++i_) { const size_t go_ = (size_t)(tt_ * 64 + srow + 32 * i_) * st_ + spc * 8; kreg[i_] = *(const GAS v4u*)(kb_ + go_); vreg[i_] = *(const GAS v4u*)(vb_ + go_); } } while (0)
#define ATT_WRITE(b) do { _Pragma("unroll") for (int i_ = 0; i_ < 2; ++i_) { *(LAS v4u*)(F.lds + (b) * ABUF_BYTES + (srow + 32 * i_) * KPB + spc * 16) = kreg[i_]; \
        *(LAS v4u*)(F.lds + (b) * ABUF_BYTES + KT_BYTES + (srow + 32 * i_) * VPB + spc * 16) = vreg[i_]; } } while (0)
    ATT_ISSUE(0); ATT_WRITE(0);
    __syncthreads();
    const int koff = r32 * KPB + (kcol + 8 * h) * 2;
    const int voff = KT_BYTES + (4 * h + ((lane & 15) >> 2)) * VPB + (16 * ((lane >> 4) & 1) + 4 * (lane & 3)) * 2;
    for (int ti = 0; ti < nt; ++ti) {
        const int buf = ti & 1;
        if (ti + 1 < nt) ATT_ISSUE(ti + 1);
        const LAS unsigned char* kb = F.lds + buf * ABUF_BYTES;
        f32x16 st[2];
#pragma unroll
        for (int kt = 0; kt < 2; ++kt)
#pragma unroll
            for (int r = 0; r < 16; ++r) st[kt][r] = 0.f;
        {
            constexpr int NG = 2 * (DQK / 64);
            bf16x8 kfa[4], kfb[4];
#define ATT_LDK(dst, g) do { const int kt_ = (g) / (DQK / 64), k0_ = ((g) % (DQK / 64)) * 4; _Pragma("unroll") for (int j_ = 0; j_ < 4; ++j_) dst[j_] = *(const LAS bf16x8*)(kb + koff + kt_ * 32 * KPB + (k0_ + j_) * 32); } while (0)
#define ATT_MMK(src, g) do { const int kt_ = (g) / (DQK / 64), k0_ = ((g) % (DQK / 64)) * 4; _Pragma("unroll") for (int j_ = 0; j_ < 4; ++j_) st[kt_] = MFMA32(src[j_], qf[k0_ + j_], st[kt_]); } while (0)
            ATT_LDK(kfa, 0); __builtin_amdgcn_sched_barrier(0);
#pragma unroll
            for (int g = 0; g < NG; g += 2) {
                ATT_LDK(kfb, g + 1); __builtin_amdgcn_sched_barrier(0);
                ATT_MMK(kfa, g);
                if (g + 2 < NG) { ATT_LDK(kfa, g + 2); __builtin_amdgcn_sched_barrier(0); }
                ATT_MMK(kfb, g + 1);
            }
#undef ATT_LDK
#undef ATT_MMK
        }
        if (band && ti < s0.ntiles) {
            const int kp = kpos0 + ti * 64 + 4 * h - (qpos + r32);
#pragma unroll
            for (int kt = 0; kt < 2; ++kt)
#pragma unroll
                for (int r = 0; r < 16; ++r) { const int d = kp + 32 * kt + (r & 3) + 8 * (r >> 2); if (d > 128 || d < -128) st[kt][r] = -1e30f; }
        }
        float mx = st[0][0];
#pragma unroll
        for (int kt = 0; kt < 2; ++kt)
#pragma unroll
            for (int r = 0; r < 16; ++r) mx = fmaxf(mx, st[kt][r]);
        mx = fmaxf(mx, __shfl_xor(mx, 32));
        if (__builtin_amdgcn_ballot_w64(mx > m + ATT_THR) != 0ull) {
            const float mn = fmaxf(m, mx), a = __builtin_amdgcn_exp2f(m - mn); l *= a; m = mn;
#pragma unroll
            for (int t = 0; t < 4; ++t)
#pragma unroll
                for (int r = 0; r < 16; ++r) o[t][r] *= a;
        }
        float rs = 0.f;
#pragma unroll
        for (int kt = 0; kt < 2; ++kt)
#pragma unroll
            for (int r = 0; r < 16; ++r) { const float p = __builtin_amdgcn_exp2f(st[kt][r] - m); st[kt][r] = p; rs += p; }
        rs += __shfl_xor(rs, 32); l += rs;
        {
            s16x4 va[8], vb[8];
#define ATT_LDV(dst, g) do { _Pragma("unroll") for (int t_ = 0; t_ < 4; ++t_) { dst[2 * t_] = __builtin_amdgcn_ds_read_tr16_b64_v4i16((LAS s16x4*)(kb + voff + (16 * (g)) * VPB + t_ * 64)); \
                dst[2 * t_ + 1] = __builtin_amdgcn_ds_read_tr16_b64_v4i16((LAS s16x4*)(kb + voff + (16 * (g) + 8) * VPB + t_ * 64)); } } while (0)
#define ATT_MMV(src, g) do { const int kt_ = (g) >> 1, s_ = (g) & 1; v4u pw_; pw_.x = cvt2(st[kt_][8 * s_], st[kt_][8 * s_ + 1]); pw_.y = cvt2(st[kt_][8 * s_ + 2], st[kt_][8 * s_ + 3]); pw_.z = cvt2(st[kt_][8 * s_ + 4], st[kt_][8 * s_ + 5]); pw_.w = cvt2(st[kt_][8 * s_ + 6], st[kt_][8 * s_ + 7]); \
            const bf16x8 pf_ = __builtin_bit_cast(bf16x8, pw_); _Pragma("unroll") for (int t_ = 0; t_ < 4; ++t_) o[t_] = MFMA32(__builtin_shufflevector(src[2 * t_], src[2 * t_ + 1], 0, 1, 2, 3, 4, 5, 6, 7), pf_, o[t_]); } while (0)
            ATT_LDV(va, 0); __builtin_amdgcn_sched_barrier(0);
            ATT_LDV(vb, 1); __builtin_amdgcn_sched_barrier(0);
            ATT_MMV(va, 0);
            ATT_LDV(va, 2); __builtin_amdgcn_sched_barrier(0);
            ATT_MMV(vb, 1);
            ATT_LDV(vb, 3); __builtin_amdgcn_sched_barrier(0);
            ATT_MMV(va, 2);
            ATT_MMV(vb, 3);
#undef ATT_LDV
#undef ATT_MMV
        }
        if (ti + 1 < nt) ATT_WRITE(buf ^ 1);
        __syncthreads();
    }
#undef ATT_ISSUE
#undef ATT_WRITE
    const float inv = 1.0f / l;
    if (DIFF) {
        LAS float* ex = (LAS float*)F.lds;
        if (F.wave >= 4) {
#pragma unroll
            for (int t = 0; t < 4; ++t)
#pragma unroll
                for (int r = 0; r < 16; ++r) ex[((F.wave - 4) * 64 + t * 16 + r) * 64 + lane] = o[t][r] * inv;
        }
        __syncthreads();
        if (F.wave < 4) {
            float ss = 0.f;
#pragma unroll
            for (int t = 0; t < 4; ++t)
#pragma unroll
                for (int r = 0; r < 16; ++r) { const float x = o[t][r] * inv - lam * ex[(F.wave * 64 + t * 16 + r) * 64 + lane]; o[t][r] = x; ss += x * x; }
            ss += __shfl_xor(ss, 32);
            const float sc = post_scale / sqrtf(ss * (1.0f / 128.0f) + 1e-6f);
            gbf16* op = outp + (size_t)r32 * DM;
#pragma unroll
            for (int t = 0; t < 4; ++t)
#pragma unroll
                for (int g4 = 0; g4 < 4; ++g4) { const int dv = 32 * t + 8 * g4 + 4 * h; const f32x4 gv = *(const GAS f32x4*)(gvec + dv);
                    v2u w; w.x = cvt2(o[t][4 * g4] * sc * gv[0], o[t][4 * g4 + 1] * sc * gv[1]); w.y = cvt2(o[t][4 * g4 + 2] * sc * gv[2], o[t][4 * g4 + 3] * sc * gv[3]); *(GAS v2u*)(op + dv) = w; }
        }
    } else {
        gbf16* op = outp + (size_t)r32 * DM;
#pragma unroll
        for (int t = 0; t < 4; ++t)
#pragma unroll
            for (int g4 = 0; g4 < 4; ++g4) { const int dv = 32 * t + 8 * g4 + 4 * h;
                v2u w; w.x = cvt2(o[t][4 * g4] * inv, o[t][4 * g4 + 1] * inv); w.y = cvt2(o[t][4 * g4 + 2] * inv, o[t][4 * g4 + 3] * inv); *(GAS v2u*)(op + dv) = w; }
    }
}

#define MFMA16(a, b, c) __builtin_amdgcn_mfma_f32_16x16x32_bf16((a), (b), (c), 0, 0, 0)
__device__ __forceinline__ bf16x8 frag2(v2u lo, v2u hi) { const v4u w = {lo.x, lo.y, hi.x, hi.y}; return __builtin_bit_cast(bf16x8, w); }
constexpr int HG_NS = 7, HG_SLOT = 17408;
#define HG_VMWAIT(n) asm volatile("s_waitcnt vmcnt(" #n ")" ::: "memory")
template <int MODE>
__device__ __forceinline__ void hgrn_mfma(const Ctx& F, int rb, int nchunks, int cc0, int ncc, int h, int dir, const gf32* s_in, gf32* s_out, gf32* ob, const gf32* fold_s, const gf32* fold_d, int nfold, gf32* d_out) {
    int lane_ = (int)__builtin_amdgcn_mbcnt_hi(~0u, __builtin_amdgcn_mbcnt_lo(~0u, 0u)); asm volatile("" : "+v"(lane_));
    const int lane = lane_, t16 = lane & 15, G = lane >> 4, w = F.wave, vcol = h * 128 + w * 16 + t16;
    __syncthreads();
    f32x4 S[8];
#pragma unroll
    for (int i = 0; i < 8; ++i)
#pragma unroll
        for (int r = 0; r < 4; ++r) S[i][r] = (MODE == 2) ? s_in[(size_t)(16 * i + 4 * G + r) * 128 + w * 16 + t16] : 0.f;
    if (MODE == 2) {
        for (int j = 0; j < nfold; ++j) {
#pragma unroll
            for (int i = 0; i < 8; ++i) { const f32x4 dj = *(const GAS f32x4*)(fold_d + (size_t)j * 128 + 16 * i + 4 * G);
#pragma unroll
                for (int r = 0; r < 4; ++r) S[i][r] = S[i][r] * dj[r] + fold_s[((size_t)j * 128 + 16 * i + 4 * G + r) * 128 + w * 16 + t16]; }
        }
    }
    f32x4 Dacc[8];
#pragma unroll
    for (int i = 0; i < 8; ++i) Dacc[i] = (f32x4){1.f, 1.f, 1.f, 1.f};
#pragma unroll
    for (int i = 0; i < 8; ++i) asm volatile("" : "+v"(S[i]));
    __builtin_amdgcn_s_waitcnt(0);
    const GAS unsigned char* srcA = (const GAS unsigned char*)((w < 4 ? F.hq(dir) : F.hkm(dir)) + h * 128);
    const GAS unsigned char* srcB = (const GAS unsigned char*)((w < 4 ? F.hkp(dir) : F.hvt(dir)) + (size_t)h * 128 * 16);
    const GAS unsigned char* srcC = (const GAS unsigned char*)(F.hdec(dir) + h * 128) + (lane & 31) * 16;
    const int rA = 4 * (w & 3) + (lane >> 4);
    const unsigned offA = (unsigned)((dir ? 15 - rA : rA) * 1024 + (((lane & 15) ^ rA) * 16));
    const int dB = 32 * (w & 3) + (lane >> 1);
    const unsigned offB = (unsigned)(dB * 32 + (((lane & 1) ^ ((dB >> 3) & 1)) * 16));
    const int dstA = (w < 4 ? 0 : 4096) + (w & 3) * 1024, dstB = (w < 4 ? 8192 : 12288) + (w & 3) * 1024;
#define HG_ISSUE(cj) do { const int ce_ = cc0 + ((cj) < ncc ? (cj) : ncc - 1); const int ch_ = dir ? nchunks - 1 - ce_ : ce_; const size_t gc_ = (size_t)(rb / 16 + ch_); \
        LAS unsigned char* sl_ = F.lds + ((cj) % HG_NS) * HG_SLOT; \
        if (MODE != 1) __builtin_amdgcn_global_load_lds((const GAS unsigned*)(srcA + (size_t)(rb + ch_ * 16) * 1024 + offA), (LAS unsigned*)(sl_ + dstA), 16, 0, 0); \
        __builtin_amdgcn_global_load_lds((const GAS unsigned*)(srcB + gc_ * 16384 + offB), (LAS unsigned*)(sl_ + dstB), 16, 0, 0); \
        if (w == 0) __builtin_amdgcn_global_load_lds((const GAS unsigned*)(srcC + gc_ * 2048), (LAS unsigned*)(sl_ + 16384), 16, 0, 0); } while (0)
    const int qoff = t16 * 256 + 8 * (G & 1);
    const int g1 = G >> 1;
    const int kpoff = 8192 + t16 * 32 + ((g1 ^ ((t16 >> 3) & 1)) * 16) + 8 * (G & 1);
    const int vtoff = 12288 + (w * 16 + t16) * 32 + ((g1 ^ ((t16 >> 3) & 1)) * 16) + 8 * (G & 1);
    const int dcoff = 16384 + 16 * G;
    const v2u z2 = {0u, 0u};
#pragma unroll
    for (int j = 0; j < HG_NS - 1; ++j) HG_ISSUE(j);
    for (int cc = 0; cc < ncc; ++cc) {
        if (MODE == 1) { if (w == 0) HG_VMWAIT(10); else HG_VMWAIT(5); }
        else if (cc < HG_NS - 1) { if (w == 0) HG_VMWAIT(15); else HG_VMWAIT(10); }
        else                     { if (w == 0) HG_VMWAIT(39); else HG_VMWAIT(34); }
        asm volatile("s_waitcnt lgkmcnt(0)" ::: "memory"); __builtin_amdgcn_s_barrier(); asm volatile("" ::: "memory");
        HG_ISSUE(cc + HG_NS - 1);
        const LAS unsigned char* sl = F.lds + (cc % HG_NS) * HG_SLOT;
        v2u q[8], k[8], kp[8]; f32x4 dec[8];
        if (MODE != 1) {
#pragma unroll
            for (int i = 0; i < 8; ++i) { const int po = (((2 * i + g1) ^ t16) * 16); q[i] = *(const LAS v2u*)(sl + qoff + po); k[i] = *(const LAS v2u*)(sl + 4096 + qoff + po); }
        }
        const v2u vt = *(const LAS v2u*)(sl + vtoff);
#pragma unroll
        for (int i = 0; i < 8; ++i) { kp[i] = *(const LAS v2u*)(sl + kpoff + i * 512); dec[i] = *(const LAS f32x4*)(sl + dcoff + i * 64); }
        __builtin_amdgcn_sched_barrier(0);
        const bf16x8 vb = frag2(vt, z2);
        if (MODE != 1) {
            f32x4 pt = {0.f, 0.f, 0.f, 0.f};
#pragma unroll
            for (int kk = 0; kk < 4; ++kk) pt = MFMA16(frag2(k[2 * kk], k[2 * kk + 1]), frag2(q[2 * kk], q[2 * kk + 1]), pt);
#pragma unroll
            for (int r = 0; r < 4; ++r) if (4 * G + r > t16) pt[r] = 0.f;
            const v2u pb = {cvt2(pt[0], pt[1]), cvt2(pt[2], pt[3])};
            f32x4 o = {0.f, 0.f, 0.f, 0.f};
            o = MFMA16(frag2(pb, z2), vb, o);
#pragma unroll
            for (int kk = 0; kk < 4; ++kk) { const v2u s0 = {cvt2(S[2 * kk][0], S[2 * kk][1]), cvt2(S[2 * kk][2], S[2 * kk][3])}, s1 = {cvt2(S[2 * kk + 1][0], S[2 * kk + 1][1]), cvt2(S[2 * kk + 1][2], S[2 * kk + 1][3])};
                o = MFMA16(frag2(q[2 * kk], q[2 * kk + 1]), frag2(s0, s1), o); }
            const int ce = cc0 + cc, ch = dir ? nchunks - 1 - ce : ce, crow = rb + ch * 16;
#pragma unroll
            for (int r = 0; r < 4; ++r) { const int pr_ = 4 * G + r; ob[(size_t)(crow + (dir ? 15 - pr_ : pr_)) * 512 + vcol] = o[r]; }
        }
#pragma unroll
        for (int i = 0; i < 8; ++i) { S[i] = S[i] * dec[i]; S[i] = MFMA16(frag2(kp[i], z2), vb, S[i]); if (MODE == 1) Dacc[i] = Dacc[i] * dec[i]; }
    }
#undef HG_ISSUE
    HG_VMWAIT(0);
    __syncthreads();
    if (MODE != 2) {
#pragma unroll
        for (int i = 0; i < 8; ++i)
#pragma unroll
            for (int r = 0; r < 4; ++r) s_out[(size_t)(16 * i + 4 * G + r) * 128 + w * 16 + t16] = S[i][r];
    }
    if (MODE == 1 && w == 0 && t16 == 0) {
#pragma unroll
        for (int i = 0; i < 8; ++i) *(GAS f32x4*)(d_out + 16 * i + 4 * G) = Dacc[i];
    }
}

__device__ __forceinline__ void hp_states(const Ctx& F, int l) {
    for (int i = F.bid; i < 256; i += F.G) {
        const int sq = i >> 4, seg = i & 15, b = sq >> 3, h = (sq >> 1) & 3, dir = sq & 1;
        if (seg == 15) continue;
        hgrn_mfma<1>(F, R_CTX + b * S_LAT, S_LAT / 16, seg * 16, 16, h, dir, nullptr, F.sloc() + ((size_t)sq * 16 + seg) * 16384, nullptr, nullptr, nullptr, 0, F.dseg() + ((size_t)sq * 16 + seg) * 128);
    }
}

#ifndef PROBE_MX_DUP
#define PROBE_MX_DUP 0
#endif
#define MXREP(cls) for (int rep_ = 0; rep_ < 1 + ((PROBE_MX_DUP >> (cls)) & 1); ++rep_)
__device__ __forceinline__ void mx_mixers(const Ctx& F, int l) {
    float lam = F.lamv()[l * 2], lam_init = F.lamv()[l * 2 + 1];
    asm volatile("" : "+v"(lam), "+v"(lam_init));
    const gbf16* qkv = F.qkv();
    constexpr int T_LH = 256, T_LD = 256, T_LB = 256, T_CD = 128, T_CS = 128, T_CH = 128;
    constexpr int NT = T_LH + T_LD + T_LB + T_CD + T_CS + T_CH;
    const AttnSeg none = {nullptr, nullptr, 0, 0};
    const int w = F.wave;
    for (int task = F.bid; task < NT; task += F.G) {
        int i = task;
        if (i < T_LH) {
            const int sq = i >> 4, seg = i & 15, b = sq >> 3, h = (sq >> 1) & 3, dir = sq & 1;
            const gf32* sin_ = F.inp(I_ST) + ((((size_t)b * 4 + l) * 2 + dir) * 4 + h) * 128 * 128;
            MXREP(0) hgrn_mfma<2>(F, R_CTX + b * S_LAT, S_LAT / 16, seg * 16, 16, h, dir, sin_, nullptr, dir ? F.obb() : F.obf(), F.sloc() + (size_t)sq * 16 * 16384, F.dseg() + (size_t)sq * 16 * 128, seg, nullptr);
            continue; } i -= T_LH;
        if (i < T_LD) {
            const int b = i >> 7, h = (i >> 5) & 3, qt = i & 31, map = w >> 2; const int rb = R_CTX + b * S_LAT, wrow = rb + qt * 128 + 32 * (w & 3);
            const AttnSeg s0 = {qkv + (size_t)rb * QKV_LD + Q_KD + h * 128, qkv + (size_t)rb * QKV_LD + Q_VD + h * 128, QKV_LD, S_LAT / 64};
            const size_t co = (((size_t)b * 4 + l) * 4 + h) * 256 * 128;
            const AttnSeg s1 = {F.c16(0) + co, F.c16(2 * MiB) + co, 128, 4};
            MXREP(1) attn_mfma<64, true>(F, qkv + (size_t)wrow * QKV_LD + Q_QD + h * 128 + map * 64, map * 64, s0, s1, false, 0, 0, -1e30f, 0.f, lam, 1.0f - lam_init, F.inp(I_DNG) + l * 128, F.cat() + (size_t)wrow * DM + h * 128);
            continue; } i -= T_LD;
        if (i < T_LB) {
            const int b = i >> 7, kv = (i >> 6) & 1, qt = i & 63, hh = kv * 4 + (w >> 1); const int rb = R_CTX + b * S_LAT, t0 = qt * 64, wrow = rb + t0 + 32 * (w & 1);
            const int ks = t0 - 128 < 0 ? 0 : t0 - 128, ke = t0 + 192 > S_LAT ? S_LAT : t0 + 192;
            const AttnSeg s0 = {qkv + (size_t)(rb + ks) * QKV_LD + Q_KS + kv * 128, qkv + (size_t)(rb + ks) * QKV_LD + Q_VS + kv * 128, QKV_LD, (ke - ks) / 64};
            const size_t co = (((size_t)b * 4 + l) * 2 + kv) * 256 * 128;
            const AttnSeg s1 = {F.c16(4 * MiB) + co, F.c16(5 * MiB) + co, 128, 4};
            MXREP(2) attn_mfma<128, false>(F, qkv + (size_t)wrow * QKV_LD + Q_QS + hh * 128, 0, s0, s1, true, t0 + 32 * (w & 1), ks, F.inp(I_SINK)[l * 8 + hh] * LOG2E, 1.0f, 0.f, 1.0f, nullptr, F.cat() + (size_t)wrow * DM + 1024 + hh * 128);
            continue; } i -= T_LB;
        if (i < T_CD) {
            const int b = i >> 3, h = (i >> 1) & 3, qt = i & 1, map = w >> 2, rb = b * 256, wrow = rb + qt * 128 + 32 * (w & 3);
            const AttnSeg s0 = {qkv + (size_t)rb * QKV_LD + Q_KD + h * 128, qkv + (size_t)rb * QKV_LD + Q_VD + h * 128, QKV_LD, 4};
            MXREP(3) attn_mfma<64, true>(F, qkv + (size_t)wrow * QKV_LD + Q_QD + h * 128 + map * 64, map * 64, s0, none, false, 0, 0, -1e30f, 0.f, lam, 1.0f - lam_init, F.inp(I_DNG) + l * 128, F.cat() + (size_t)wrow * DM + h * 128);
            continue; } i -= T_CD;
        if (i < T_CS) {
            const int b = i >> 3, kv = (i >> 2) & 1, qt = i & 3, hh = kv * 4 + (w >> 1), rb = b * 256, wrow = rb + qt * 64 + 32 * (w & 1);
            const AttnSeg s0 = {qkv + (size_t)rb * QKV_LD + Q_KS + kv * 128, qkv + (size_t)rb * QKV_LD + Q_VS + kv * 128, QKV_LD, 4};
            MXREP(4) attn_mfma<128, false>(F, qkv + (size_t)wrow * QKV_LD + Q_QS + hh * 128, 0, s0, none, false, 0, 0, F.inp(I_SINK)[l * 8 + hh] * LOG2E, 1.0f, 0.f, 1.0f, nullptr, F.cat() + (size_t)wrow * DM + 1024 + hh * 128);
            continue; } i -= T_CS;
        {
            const int b = i >> 3, h = (i >> 1) & 3, dir = i & 1;
            gf32* sout = F.out + O_ST + ((((size_t)b * 4 + l) * 2 + dir) * 4 + h) * 128 * 128;
            MXREP(5) hgrn_mfma<0>(F, b * 256, 16, 0, 16, h, dir, nullptr, sout, dir ? F.obb() : F.obf(), nullptr, nullptr, 0, nullptr);
        }
    }
}

__device__ __forceinline__ void mg_merge(const Ctx& F, int l) {
    const int head = F.lane >> 4, sub = F.lane & 15, col0 = head * 128 + sub * 8;
    for (int row = F.bid * 8 + F.wave; row < MROWS; row += F.G * 8) {
        const f32x4 a0 = *(const GAS f32x4*)(F.obf() + (size_t)row * 512 + col0) + *(const GAS f32x4*)(F.obb() + (size_t)row * 512 + col0);
        const f32x4 a1 = *(const GAS f32x4*)(F.obf() + (size_t)row * 512 + col0 + 4) + *(const GAS f32x4*)(F.obb() + (size_t)row * 512 + col0 + 4);
        float ss = (a0[0] * a0[0] + a0[1] * a0[1]) + (a0[2] * a0[2] + a0[3] * a0[3]) + (a1[0] * a1[0] + a1[1] * a1[1]) + (a1[2] * a1[2] + a1[3] * a1[3]);
        ss += __shfl_xor(ss, 1); ss += __shfl_xor(ss, 2); ss += __shfl_xor(ss, 4); ss += __shfl_xor(ss, 8);
        const float rinv = 1.0f / sqrtf(ss * (1.0f / 128.0f) + 1e-6f);
        const gf32* g = F.inp(I_HNG) + l * 128 + sub * 8; const gf32* hg = F.proj() + (size_t)row * DIN + C_BG + col0;
        const f32x4 g0 = *(const GAS f32x4*)g, g1 = *(const GAS f32x4*)(g + 4), h0 = *(const GAS f32x4*)hg, h1 = *(const GAS f32x4*)(hg + 4);
        float y[8];
#pragma unroll
        for (int i = 0; i < 4; ++i) { y[i] = a0[i] * rinv * g0[i] * silu_f(h0[i]); y[4 + i] = a1[i] * rinv * g1[i] * silu_f(h1[i]); }
        v4u w; w.x = pk2(y[0], y[1]); w.y = pk2(y[2], y[3]); w.z = pk2(y[4], y[5]); w.w = pk2(y[6], y[7]);
        *(GAS v4u*)(F.cat() + (size_t)row * DM + 512 + col0) = w;
    }
}

__device__ __forceinline__ void ln_phase(const Ctx& F, const gf32* g, const gf32* b, gf32* xo, const gf32* modsl  , int which_sh) {
    for (int row = F.bid * 8 + F.wave; row < MROWS; row += F.G * 8) {
        const gf32* yp = F.ypre() + (size_t)row * DM + F.lane * 4;
        f32x4 v[8]; float s = 0.f;
#pragma unroll
        for (int j = 0; j < 8; ++j) { v[j] = *(const GAS f32x4*)(yp + 256 * j); s += (v[j][0] + v[j][1]) + (v[j][2] + v[j][3]); }
#pragma unroll
        for (int o = 1; o < 64; o <<= 1) s += __shfl_xor(s, o);
        const float mean = s * (1.0f / DM); float s2 = 0.f;
#pragma unroll
        for (int j = 0; j < 8; ++j) { v[j] = v[j] - mean; s2 += (v[j][0] * v[j][0] + v[j][1] * v[j][1]) + (v[j][2] * v[j][2] + v[j][3] * v[j][3]); }
#pragma unroll
        for (int o = 1; o < 64; o <<= 1) s2 += __shfl_xor(s2, o);
        const float rstd = 1.0f / sqrtf(s2 * (1.0f / DM) + 1e-5f);
        const int mod = mod_of_row(row);
        const gf32* sh = modsl ? modsl + ((size_t)mod * 6 + which_sh) * DM : nullptr;
#pragma unroll
        for (int j = 0; j < 8; ++j) { const int c = F.lane * 4 + 256 * j;
            const f32x4 x = v[j] * rstd * *(const GAS f32x4*)(g + c) + *(const GAS f32x4*)(b + c);
            *(GAS f32x4*)(xo + (size_t)row * DM + c) = x;
            if (modsl) { const f32x4 hh = x * (*(const GAS f32x4*)(sh + DM + c) + 1.0f) + *(const GAS f32x4*)(sh + c);
                v2u w; w.x = pk2(hh[0], hh[1]); w.y = pk2(hh[2], hh[3]); *(GAS v2u*)(F.hbuf() + (size_t)row * DM + c) = w; } }
    }
}

constexpr int PH_PER_LAYER = 10, N_PHASES = 2 + DEPTH * PH_PER_LAYER;
__global__ void __launch_bounds__(512, 2) fwd_kernel(Args args) {
    extern __shared__ __attribute__((aligned(16))) unsigned char lds_raw[];
    Ctx F;
    F.lds = (LAS unsigned char*)lds_raw;
    F.tid = threadIdx.x; F.lane = F.tid & 63; F.wave = __builtin_amdgcn_readfirstlane(F.tid >> 6); F.G = gridDim.x; F.bid = blockIdx.x;
    F.ap = &args; F.out = (gf32*)args.out; F.ws = (GAS unsigned char*)args.ws;
    volatile LAS unsigned* MISC = (volatile LAS unsigned*)(F.lds + MISC_OFF);
    for (int u = F.tid; u < (LDS_BYTES - LDSCTL_OFF) / 4; u += 512) ((LAS unsigned*)(F.lds + LDSCTL_OFF))[u] = 0u;
    __syncthreads();
    XcdBarrier bar; bar.bar = (unsigned*)(args.ws + WS_CTL) + CW_BAR; bar.x = 0; bar.st = nullptr;
    if (args.single) bar = xcd_barrier_post((unsigned*)(args.ws + WS_CTL) + CW_BAR, MISC + 8);
    const int lo = args.ph_lo, hi = args.ph_hi;
#define IN(k) (lo <= (k) && (k) < hi)
#define FRESH() do { int ln_ = (int)__builtin_amdgcn_mbcnt_hi(~0u, __builtin_amdgcn_mbcnt_lo(~0u, 0u)); asm volatile("" : "+v"(ln_)); F.lane = ln_; asm volatile("" : "+s"(F.wave)); F.tid = F.wave * 64 + F.lane; \
    asm volatile("" : "+s"(F.bid), "+s"(F.G)); asm volatile("" : "+s"(F.ws), "+s"(F.out)); } while (0)
#define SEAM(k) do { if (IN((k) + 1)) xcd_barrier(bar); } while (0)

    if (IN(0)) { FRESH(); p0_prologue(F); SEAM(0); }
    if (IN(1)) { FRESH(); p1_h0(F); SEAM(1); }
    for (int l = 0; l < DEPTH; ++l) {
        const int k0 = 2 + l * PH_PER_LAYER;
        FRESH();
        const gf32* xa = l == 0 ? F.inp(I_XP) : F.out + O_YP; const gf32* xb = l == 0 ? F.inp(I_XS) : F.out + O_YS;
        if (IN(k0 + 0)) {
            pg8::Gemm g{(const pg8::bf16_t*)F.hbuf(), (const pg8::bf16_t*)F.wT(l, WO_IN), MROWS, DIN, DM}; pg8::StaticOrder S; S.init(MROWS, DIN, F.G, F.bid);
            EpiStoreF32 E{F.proj(), DIN};
            pg8::gemm_phase<EpiStoreF32, pg8::StaticOrder, true, true>(F.lds, g, S, E, F.wave);
            SEAM(k0 + 0); }
        if (IN(k0 + 1)) { FRESH(); e1_postproj(F, l); SEAM(k0 + 1); }
        if (IN(k0 + 2)) { FRESH(); hp_states(F, l); SEAM(k0 + 2); }
        if (IN(k0 + 3)) { FRESH(); mx_mixers(F, l); SEAM(k0 + 3); }
        if (IN(k0 + 4)) { FRESH(); mg_merge(F, l); SEAM(k0 + 4); }
        if (IN(k0 + 5)) {
            pg8::Gemm g{(const pg8::bf16_t*)F.cat(), (const pg8::bf16_t*)F.wT(l, WO_OUT), MROWS, DM, DM}; pg8::StaticOrder S; S.init(MROWS, DM, F.G, F.bid);
            EpiResid E{xa, xb, F.mods() + ((size_t)l * 3 * 6 + 2) * DM, F.ypre()};
            pg8::gemm_phase<EpiResid, pg8::StaticOrder, true, true>(F.lds, g, S, E, F.wave);
            SEAM(k0 + 5); }
        if (IN(k0 + 6)) { FRESH(); ln_phase(F, F.inp(I_LN1G) + l * DM, F.inp(I_LN1B) + l * DM, F.x1(), F.mods() + (size_t)l * 3 * 6 * DM, 3); SEAM(k0 + 6); }
        if (IN(k0 + 7)) {
            pg8::Gemm g{(const pg8::bf16_t*)F.hbuf(), (const pg8::bf16_t*)F.wT(l, WO_GU), MROWS, DGU, DM}; pg8::StaticOrder S; S.init(MROWS, DGU, F.G, F.bid);
            EpiSwiGLU E{F.act()};
            pg8::gemm_phase<EpiSwiGLU, pg8::StaticOrder, true, true>(F.lds, g, S, E, F.wave);
            SEAM(k0 + 7); }
        if (IN(k0 + 8)) {
            pg8::Gemm g{(const pg8::bf16_t*)F.act(), (const pg8::bf16_t*)F.wT(l, WO_DN), MROWS, DM, DFF}; pg8::StaticOrder S; S.init(MROWS, DM, F.G, F.bid);
            EpiResid E{F.x1(), F.x1() + (size_t)R_CTX * DM, F.mods() + ((size_t)l * 3 * 6 + 5) * DM, F.ypre()};
            pg8::gemm_phase<EpiResid, pg8::StaticOrder, true, true>(F.lds, g, S, E, F.wave);
            SEAM(k0 + 8); }
        if (IN(k0 + 9)) { FRESH(); ln_phase(F, F.inp(I_LN2G) + l * DM, F.inp(I_LN2B) + l * DM, F.out + O_YP, l + 1 < DEPTH ? F.mods() + (size_t)(l + 1) * 3 * 6 * DM : nullptr, 0); SEAM(k0 + 9); }
    }
#undef IN
#undef SEAM
#undef FRESH
}

#ifndef MK_SINGLE
#define MK_SINGLE 1
#endif
extern "C" void kernel_launch(void* const* d_in, const int* in_sizes, int n_in, void* d_out, int out_size, void* d_ws, size_t ws_size, hipStream_t stream) {
    static int grid = 0;
    if (grid == 0) {
        if (n_in != 24 || out_size != (int)O_END || ws_size < WS_END) { fprintf(stderr, "kernel_launch: unexpected sizes n_in %d out %d ws %zu\n", n_in, out_size, ws_size); grid = -1; return; }
        int dev = 0, cus = 0, per_cu = 0;
        if (hipGetDevice(&dev) != hipSuccess || hipDeviceGetAttribute(&cus, hipDeviceAttributeMultiprocessorCount, dev) != hipSuccess) { grid = -1; return; }
        if (hipFuncSetAttribute((const void*)fwd_kernel, hipFuncAttributeMaxDynamicSharedMemorySize, LDS_BYTES) != hipSuccess) { fprintf(stderr, "kernel_launch: hipFuncSetAttribute failed\n"); grid = -1; return; }
        if (hipOccupancyMaxActiveBlocksPerMultiprocessor(&per_cu, (const void*)fwd_kernel, 512, LDS_BYTES) != hipSuccess || per_cu < 1) fprintf(stderr, "kernel_launch: occupancy query says %d\n", per_cu);
        (void)hipGetLastError();
        grid = cus;
    }
    if (grid < 0) return;
    (void)hipMemsetAsync((char*)d_ws + WS_CTL, 0, CTL_ZERO_BYTES, stream);
    Args a{};
    for (int i = 0; i < 24; ++i) a.in[i] = (const float*)d_in[i];
    a.out = (float*)d_out; a.ws = (unsigned char*)d_ws; a.pad = 0;
#if MK_SINGLE
    a.ph_lo = 0; a.ph_hi = N_PHASES; a.single = 1;
    hipLaunchKernelGGL(fwd_kernel, dim3(grid), dim3(512), LDS_BYTES, stream, a);
#else
    a.single = 0;
    for (int p = 0; p < N_PHASES; ++p) { a.ph_lo = p; a.ph_hi = p + 1; hipLaunchKernelGGL(fwd_kernel, dim3(grid), dim3(512), LDS_BYTES, stream, a);
#ifdef PROBE_REP_MASK
        const int ty = p == 0 ? 10 : (p == 1 ? 11 : (p - 2) % PH_PER_LAYER);
        if ((PROBE_REP_MASK >> ty) & 1) for (int r = 0; r < PROBE_REP_N; ++r) hipLaunchKernelGGL(fwd_kernel, dim3(grid), dim3(512), LDS_BYTES, stream, a);
#endif
    }
#endif
}
```

```cpp
#include <hip/hip_runtime.h>
#include <cstdio>
#include <cstdint>
namespace pg8 {
#define PG8_LAS __attribute__((address_space(3)))
typedef unsigned short bf16_t;
typedef short bf16x8 __attribute__((ext_vector_type(8)));
typedef float f32x4 __attribute__((ext_vector_type(4)));
typedef unsigned u32x4 __attribute__((ext_vector_type(4)));
constexpr int BM = 256, BK = 64, HALF = 128, HTB = HALF * BK * 2  , STAGE_BYTES = 8 * HTB, NXCD = 8, WGM = 8;

__host__ __device__ __forceinline__ int lds_byte(int r, int c) { const int st = (r >> 4) * 2 + (c >> 5), rr = r & 15, cc = c & 31, ob = rr * 64 + cc * 2; return st * 1024 + (ob ^ (((ob >> 9) & 1) << 5)); }
__host__ __device__ __forceinline__ void stage_rc(int b, int& R, int& C) { const int st = b / 1024, sb = b % 1024, swz = sb ^ (((sb >> 9) & 1) << 5); R = (st >> 1) * 16 + swz / 64; C = (st & 1) * 32 + (swz % 64) / 2; }
__host__ __device__ __forceinline__ int perm32(int rho) { const int n = rho >> 4, i = rho & 15; return 8 * (i >> 2) + 4 * n + (i & 3); }

struct Unit { int pm, pn; };
struct Gemm { const bf16_t* A; const bf16_t* Bt; int M, N, K; };

struct StaticOrder {
    int nM, nN, nwg, G, c;
    __host__ __device__ void init(int M, int N, int G_, int c_) { nM = M / BM; nN = N / BM; nwg = nM * nN; G = G_; c = c_; }
    __host__ __device__ bool next(int i, Unit& u) const {
        const long L = (long)i * G + c; if (L >= nwg) return false;
        int wgid = (int)L; { const int q = nwg / NXCD, r = nwg % NXCD, xcd = wgid % NXCD, off = wgid / NXCD; wgid = (xcd < r ? xcd * (q + 1) : r * (q + 1) + (xcd - r) * q) + off; }
        const int nig = WGM * nN, gid = wgid / nig, fm = gid * WGM, gsz = (nM - fm) < WGM ? (nM - fm) : WGM;
        u.pm = fm + ((wgid % nig) % gsz); u.pn = (wgid % nig) / gsz; return true;
    }
    __device__ __forceinline__ void a_ready(const Unit&) const {}
    __device__ __forceinline__ void done(const Unit&) const {}
};
__device__ __forceinline__ unsigned cvt_pk_bf16(float lo, float hi) { unsigned r; asm volatile("v_cvt_pk_bf16_f32 %0, %1, %2" : "=v"(r) : "v"(lo), "v"(hi)); return r; }
typedef float f32x2 __attribute__((ext_vector_type(2)));
template <class Epi, class Sched, bool ALIGN_EPI = false, bool SP2 = false>
__device__ __forceinline__ void gemm_phase(PG8_LAS unsigned char* lds, const Gemm g, const Sched& S, const Epi& E, int wid_in) {
    int lane_ = (int)__builtin_amdgcn_mbcnt_hi(~0u, __builtin_amdgcn_mbcnt_lo(~0u, 0u)); asm volatile("" : "+v"(lane_)); asm volatile("" : "+s"(wid_in));
    const int wid = wid_in, lane = lane_, tid = wid * 64 + lane, wr = wid >> 2, wc = wid & 3, fr = lane & 15, fq = lane >> 4;
    const int K = g.K, nt = K / BK;
    unsigned voffA[2], voffB[2];
#pragma unroll
    for (int i = 0; i < 2; ++i) { int R, C; stage_rc(tid * 16 + i * 8192, R, C); const int Rb = Epi::PERM ? ((R & ~31) + perm32(R & 31)) : R;
        voffA[i] = (unsigned)(R * K + C) * 2u; voffB[i] = (unsigned)(Rb * K + C) * 2u; }
    const size_t kstep = (size_t)(BK * 2);
    const size_t hstep = (size_t)HALF * K * 2;
    const size_t tstep = 2 * hstep;
    const unsigned ldsw = (unsigned)wid * 1024u;
    const int aoff = lds_byte(wr * 64 + fr, fq * 8), boff = lds_byte(wc * 32 + fr, fq * 8);
#define PG8_SA(b, h) (((b) * 2 + (h)) * HTB)
#define PG8_SB(b, h) ((4 + (b) * 2 + (h)) * HTB)
#define PG8_STAGE(bufoff, gbase, voff) do { _Pragma("unroll") for (int _i = 0; _i < 2; ++_i) \
        __builtin_amdgcn_global_load_lds((const unsigned*)((const char*)(gbase) + (voff)[_i]), (PG8_LAS unsigned*)(lds + (bufoff) + ldsw + _i * 8192), 16, 0, 0); } while (0)
#define PG8_LDA(dst, b, h) do { _Pragma("unroll") for (int m = 0; m < 4; ++m) _Pragma("unroll") for (int k = 0; k < 2; ++k) dst[m][k] = *(const PG8_LAS bf16x8*)(lds + PG8_SA(b, h) + aoff + m * 2048 + k * 1024); } while (0)
#define PG8_LDB(dst, b, h) do { _Pragma("unroll") for (int n = 0; n < 2; ++n) _Pragma("unroll") for (int k = 0; k < 2; ++k) dst[n][k] = *(const PG8_LAS bf16x8*)(lds + PG8_SB(b, h) + boff + n * 2048 + k * 1024); } while (0)
#define PG8_MMA(ai, bj, At, Bt) do { __builtin_amdgcn_s_setprio(1); _Pragma("unroll") for (int m = 0; m < 4; ++m) _Pragma("unroll") for (int n = 0; n < 2; ++n) _Pragma("unroll") for (int k = 0; k < 2; ++k) \
        acc[ai][bj][m][n] = __builtin_amdgcn_mfma_f32_16x16x32_bf16(Bt[n][k], At[m][k], acc[ai][bj][m][n], 0, 0, 0); __builtin_amdgcn_s_setprio(0); } while (0)
#define PG8_WAIT_V(n) asm volatile("s_waitcnt vmcnt(" #n ")" ::: "memory")
#define PG8_WAIT_L(n) asm volatile("s_waitcnt lgkmcnt(" #n ")" ::: "memory")
#define PG8_BAR __builtin_amdgcn_s_barrier()
#define PG8_SCHED __builtin_amdgcn_sched_barrier(0)
    Unit cur, nxt; int ui = 0;
    if (!S.next(0, cur)) return;
    f32x4 acc[2][2][4][2];
#pragma unroll
    for (int a = 0; a < 2; ++a)
#pragma unroll
        for (int b = 0; b < 2; ++b)
#pragma unroll
            for (int m = 0; m < 4; ++m)
#pragma unroll
                for (int n = 0; n < 2; ++n) acc[a][b][m][n] = (f32x4){0.f, 0.f, 0.f, 0.f};
    bf16x8 At[4][2], B0[2][2], B1[2][2];
    const char* cA = (const char*)g.A + (size_t)cur.pm * tstep; const char* cB = (const char*)g.Bt + (size_t)cur.pn * tstep;
    S.a_ready(cur);
    if constexpr (SP2) {
        PG8_STAGE(PG8_SB(0, 0), cB, voffB); PG8_STAGE(PG8_SB(0, 1), cB + hstep, voffB); PG8_STAGE(PG8_SA(0, 0), cA, voffA); PG8_STAGE(PG8_SA(0, 1), cA + hstep, voffA);
        if (wr == 1) PG8_BAR;
        PG8_WAIT_V(2); PG8_BAR;
        PG8_STAGE(PG8_SB(1, 0), cB + kstep, voffB); PG8_STAGE(PG8_SA(1, 0), cA + kstep, voffA); PG8_STAGE(PG8_SB(1, 1), cB + hstep + kstep, voffB);
        PG8_WAIT_V(6); PG8_BAR;
    } else {
        PG8_STAGE(PG8_SB(0, 0), cB, voffB); PG8_STAGE(PG8_SA(0, 0), cA, voffA); PG8_STAGE(PG8_SB(0, 1), cB + hstep, voffB); PG8_STAGE(PG8_SA(0, 1), cA + hstep, voffA);
        if (wr == 1) PG8_BAR;
        PG8_WAIT_V(4); PG8_BAR;
        PG8_STAGE(PG8_SB(1, 0), cB + kstep, voffB); PG8_STAGE(PG8_SA(1, 0), cA + kstep, voffA); PG8_STAGE(PG8_SB(1, 1), cB + hstep + kstep, voffB);
        PG8_WAIT_V(6); PG8_BAR;
    }
    for (;;) {
        const bool has_next = S.next(ui + 1, nxt);
        const char* nA = has_next ? (const char*)g.A + (size_t)nxt.pm * tstep : cA; const char* nB = has_next ? (const char*)g.Bt + (size_t)nxt.pn * tstep : cB;
        for (int t = 0; t < nt; t += 2) {
            const bool last = (t == nt - 2);
            const char* a1 = cA + (size_t)(t + 1) * kstep;
            const char* a2 = last ? nA : cA + (size_t)(t + 2) * kstep; const char* b2 = last ? nB : cB + (size_t)(t + 2) * kstep;
            const char* a3 = a2 + kstep; const char* b3 = b2 + kstep;
            if (last && has_next) S.a_ready(nxt);
            if constexpr (SP2) {
            PG8_LDB(B0, 0, 0); PG8_LDB(B1, 0, 1); PG8_SCHED; PG8_LDA(At, 0, 0); PG8_STAGE(PG8_SA(1, 1), a1 + hstep, voffA);
            PG8_WAIT_V(8); PG8_WAIT_L(0); PG8_BAR; PG8_MMA(0, 0, At, B0); PG8_MMA(0, 1, At, B1); PG8_BAR; PG8_SCHED;
            PG8_LDA(At, 0, 1); PG8_STAGE(PG8_SB(0, 0), b2, voffB); PG8_STAGE(PG8_SB(0, 1), b2 + hstep, voffB); PG8_STAGE(PG8_SA(0, 0), a2, voffA);
            PG8_WAIT_V(8); PG8_WAIT_L(0); PG8_BAR; PG8_MMA(1, 0, At, B0); PG8_MMA(1, 1, At, B1); PG8_BAR; PG8_SCHED;
            PG8_LDB(B0, 1, 0); PG8_LDB(B1, 1, 1); PG8_SCHED; PG8_LDA(At, 1, 0); PG8_STAGE(PG8_SA(0, 1), a2 + hstep, voffA);
            PG8_WAIT_V(8); PG8_WAIT_L(0); PG8_BAR; PG8_MMA(0, 0, At, B0); PG8_MMA(0, 1, At, B1); PG8_BAR; PG8_SCHED;
            PG8_LDA(At, 1, 1); PG8_STAGE(PG8_SB(1, 0), b3, voffB); PG8_STAGE(PG8_SB(1, 1), b3 + hstep, voffB); PG8_STAGE(PG8_SA(1, 0), a3, voffA);
            PG8_WAIT_V(8); PG8_WAIT_L(0); PG8_BAR; PG8_MMA(1, 0, At, B0); PG8_MMA(1, 1, At, B1); PG8_BAR; PG8_SCHED;
            } else {
            PG8_LDB(B0, 0, 0); PG8_SCHED; PG8_LDA(At, 0, 0); PG8_STAGE(PG8_SA(1, 1), a1 + hstep, voffA);
            PG8_WAIT_L(8); PG8_BAR; PG8_WAIT_L(0); PG8_MMA(0, 0, At, B0); PG8_BAR; PG8_SCHED;
            PG8_LDB(B1, 0, 1); PG8_STAGE(PG8_SB(0, 0), b2, voffB);
            PG8_BAR; PG8_WAIT_L(0); PG8_MMA(0, 1, At, B1); PG8_BAR;
            PG8_LDA(At, 0, 1); PG8_STAGE(PG8_SA(0, 0), a2, voffA);
            PG8_BAR; PG8_WAIT_L(0); PG8_MMA(1, 0, At, B0); PG8_BAR; PG8_SCHED;
            PG8_STAGE(PG8_SB(0, 1), b2 + hstep, voffB);
            PG8_WAIT_V(6); PG8_BAR; PG8_MMA(1, 1, At, B1); PG8_BAR;
            PG8_LDB(B0, 1, 0); PG8_SCHED; PG8_LDA(At, 1, 0); PG8_STAGE(PG8_SA(0, 1), a2 + hstep, voffA);
            PG8_WAIT_L(8); PG8_BAR; PG8_WAIT_L(0); PG8_MMA(0, 0, At, B0); PG8_BAR; PG8_SCHED;
            PG8_LDB(B1, 1, 1); PG8_STAGE(PG8_SB(1, 0), b3, voffB);
            PG8_BAR; PG8_WAIT_L(0); PG8_MMA(0, 1, At, B1); PG8_BAR;
            PG8_LDA(At, 1, 1); PG8_STAGE(PG8_SA(1, 0), a3, voffA);
            PG8_BAR; PG8_WAIT_L(0); PG8_MMA(1, 0, At, B0); PG8_BAR; PG8_SCHED;
            PG8_STAGE(PG8_SB(1, 1), b3 + hstep, voffB);
            PG8_WAIT_V(6); PG8_BAR; PG8_MMA(1, 1, At, B1); PG8_BAR;
            }
        }
        if constexpr (ALIGN_EPI) { if (wr == 0) PG8_BAR; }
        if constexpr (!Epi::AFTER_DRAIN) { E(acc, cur, wr, wc, fr, fq); S.done(cur); }
        if (!has_next) break;
#pragma unroll
        for (int a = 0; a < 2; ++a)
#pragma unroll
            for (int b = 0; b < 2; ++b)
#pragma unroll
                for (int m = 0; m < 4; ++m)
#pragma unroll
                    for (int n = 0; n < 2; ++n) acc[a][b][m][n] = (f32x4){0.f, 0.f, 0.f, 0.f};
        cur = nxt; cA = nA; cB = nB; ++ui;
        if constexpr (ALIGN_EPI) { if (wr == 1) PG8_BAR; }
    }
    PG8_WAIT_V(0);
    if constexpr (!ALIGN_EPI) { if (wr == 0) PG8_BAR; }
    PG8_BAR;
    if constexpr (Epi::AFTER_DRAIN) { E.fused(acc, cur, wr, wc, fr, fq, lds, wid, lane); S.done(cur); }
#undef PG8_SA
#undef PG8_SB
#undef PG8_STAGE
#undef PG8_LDA
#undef PG8_LDB
#undef PG8_MMA
#undef PG8_WAIT_V
#undef PG8_WAIT_L
#undef PG8_BAR
#undef PG8_SCHED
}
}
#define GAS __attribute__((address_space(1)))
#define LAS __attribute__((address_space(3)))
typedef unsigned short bf16;
typedef unsigned v4u __attribute__((ext_vector_type(4)));
typedef float f32x4 __attribute__((ext_vector_type(4)));
typedef short bf16x8 __attribute__((ext_vector_type(8)));
typedef GAS unsigned gu32;
typedef GAS unsigned long long gu64;
#define RLX_AGENT __ATOMIC_RELAXED, __HIP_MEMORY_SCOPE_AGENT
#define LDS_WAIT() asm volatile("s_waitcnt lgkmcnt(0)" ::: "memory")
#define VM_WAIT() asm volatile("s_waitcnt vmcnt(0)" ::: "memory")
__device__ __forceinline__ unsigned long long rt() { return __builtin_amdgcn_s_memrealtime(); }
__device__ __forceinline__ unsigned f2bf(float f) { unsigned u = __builtin_bit_cast(unsigned, f); return (u + 0x7fffu + ((u >> 16) & 1u)) >> 16; }
__device__ __forceinline__ unsigned pk2(float lo, float hi) { return f2bf(lo) | (f2bf(hi) << 16); }
#define XB_TMO      128
#define XB_XCNT(j)  (256  + 64 * (j))
#define XB_XSUB(j)  (1280 + 64 * (j))
#define XB_XGEN(j)  (2304 + 64 * (j))
#define XB_TOP      3328
#define XB_TOPGEN   3392
#define XCD_BAR_WORDS 3456
#define XB_SPIN_CAP (1u << 24)

__device__ __forceinline__ unsigned xb_ld(unsigned* p)              { return __hip_atomic_load(p, __ATOMIC_RELAXED, __HIP_MEMORY_SCOPE_AGENT); }
__device__ __forceinline__ unsigned xb_add(unsigned* p, unsigned v) { return __hip_atomic_fetch_add(p, v, __ATOMIC_RELAXED, __HIP_MEMORY_SCOPE_AGENT); }
__device__ __forceinline__ unsigned xb_xcc_id() { return (unsigned)__builtin_amdgcn_s_getreg((3 << 11) | 20) & 0xFu; }
#define XB_SPIN(cond, bar) do { unsigned _sp = 0; while (cond) { __builtin_amdgcn_s_sleep(1); \
    if ((++_sp & 255u) == 0u) { if (xb_ld(&(bar)[XB_TMO])) break; if (_sp > XB_SPIN_CAP) { atomicAdd(&(bar)[XB_TMO], 1u); break; } } } } while (0)

struct XcdBarrier {
    unsigned* bar; unsigned x;
    volatile LAS unsigned* st;
};

__device__ __forceinline__ XcdBarrier xcd_barrier_post(unsigned* bar, volatile LAS unsigned* st) {
    XcdBarrier b; b.bar = bar; b.x = xb_xcc_id(); b.st = st;
    if (threadIdx.x == 0) (void)xb_add(&bar[XB_XCNT(b.x)], 1u);
    return b;
}
__device__ __forceinline__ void xcd_barrier_complete(unsigned* bar, unsigned x, unsigned& nloc, unsigned& nx) {
    const unsigned G = gridDim.x * gridDim.y * gridDim.z;
    unsigned sum, cnt, mine, sp = 0u;
    for (;;) {
        sum = 0u; cnt = 0u; mine = 0u;
#pragma unroll
        for (unsigned j = 0; j < 16; ++j) { const unsigned c = xb_ld(&bar[XB_XCNT(j)]); sum += c; cnt += (c > 0u) ? 1u : 0u; mine = (j == x) ? c : mine; }
        if (sum == G) break;
        __builtin_amdgcn_s_sleep(1);
        if ((++sp & 255u) == 0u) { if (xb_ld(&bar[XB_TMO])) break; if (sp > XB_SPIN_CAP) { atomicAdd(&bar[XB_TMO], 1u); break; } }
    }
    nloc = mine > 0u ? mine : 1u; nx = cnt > 0u ? cnt : 1u;
}

__device__ __forceinline__ void xcd_barrier(const XcdBarrier& b) {
    asm volatile("s_waitcnt vmcnt(0)" ::: "memory");
    __syncthreads();
    if (threadIdx.x == 0) {
        unsigned* bar = b.bar;
        __builtin_amdgcn_s_waitcnt(0);
        unsigned nloc = b.st[0], nx = b.st[1];
        if (nloc == 0u) { xcd_barrier_complete(bar, b.x, nloc, nx); b.st[0] = nloc; b.st[1] = nx; }
        const unsigned old = xb_add(&bar[XB_XSUB(b.x)], 1u);
        const unsigned gen = old / nloc;
        if (old + 1u == (gen + 1u) * nloc) {
            __builtin_amdgcn_fence(__ATOMIC_RELEASE, "agent");
            asm volatile("s_waitcnt vmcnt(0)" ::: "memory");
            const unsigned og = xb_add(&bar[XB_TOP], 1u);
            const unsigned tg = og / nx;
            if (og + 1u == (tg + 1u) * nx) xb_add(&bar[XB_TOPGEN], 1u);
            else XB_SPIN(xb_ld(&bar[XB_TOPGEN]) == tg, bar);
            __builtin_amdgcn_fence(__ATOMIC_ACQUIRE, "agent");
            xb_add(&bar[XB_XGEN(b.x)], 1u);
            asm volatile("s_waitcnt vmcnt(0)" ::: "memory");
        } else {
            XB_SPIN(xb_ld(&bar[XB_XGEN(b.x)]) == gen, bar);
            __builtin_amdgcn_fence(__ATOMIC_ACQUIRE, "agent");
            asm volatile("s_waitcnt vmcnt(0)" ::: "memory");
        }
    }
    __syncthreads();
}

constexpr int DM = 2048;
constexpr int NB_CTX = 16, S_CTX = 256, NB_LAT = 2, S_LAT = 4096, DEPTH = 4;
constexpr int R_CTX = NB_CTX * S_CTX;
constexpr int R_LAT = NB_LAT * S_LAT;
constexpr int MROWS = R_CTX + R_LAT;
constexpr int DIN = 5632, DFF = 5632, DGU = 2 * DFF;
constexpr float ALPHA = 1.6817928305074292f;
constexpr int C_AQ = 0, C_AK = 512, C_AV = 1024, C_BQ = 1536, C_BF = 2048, C_BB = 2560, C_BI = 3072, C_BG = 3584, C_CQ = 4096, C_CK = 5120, C_CV = 5376;
constexpr size_t O_YP = 0, O_YS = 8388608, O_DK = 25165824, O_DV = 33554432, O_SK = 41943040, O_SV = 46137344, O_ST = 50331648, O_END = 58720256;

constexpr size_t MiB = 1u << 20;
constexpr size_t WS_CTL = 0, CTL_ZERO_BYTES = 1 * MiB;
constexpr size_t WS_MODS = 1 * MiB;
constexpr size_t WS_MISC = 2 * MiB;
constexpr size_t WS_W = 4 * MiB, W_LAYER = 96 * MiB;
constexpr size_t WO_IN = 0, WO_OUT = 22 * MiB, WO_GU = 30 * MiB, WO_DN = 74 * MiB;
constexpr size_t WS_H = 388 * MiB;
constexpr size_t WS_CAT = 436 * MiB;
constexpr size_t WS_X1 = 484 * MiB;
constexpr size_t WS_OA = 580 * MiB, WS_OBF = 604 * MiB, WS_OBB = 628 * MiB;
constexpr size_t WS_P = 652 * MiB;
constexpr size_t WS_ACT = WS_P, WS_YPRE = WS_P + 132 * MiB;
constexpr size_t WS_C16 = 916 * MiB;
constexpr size_t WS_QKV = 922 * MiB;
constexpr int QKV_LD = 3072, Q_QD = 0, Q_KD = 512, Q_VD = 1024, Q_QS = 1536, Q_KS = 2560, Q_VS = 2816;
constexpr size_t WS_HQ = 994 * MiB;
constexpr size_t WS_HKM = 1018 * MiB;
constexpr size_t WS_HKP = 1042 * MiB;
constexpr size_t WS_HVT = 1066 * MiB;
constexpr size_t WS_HDEC = 1090 * MiB;
constexpr size_t WS_SLOC = 1094 * MiB;
constexpr size_t WS_DSEG = 1110 * MiB;
constexpr size_t WS_END = 1111 * MiB;

constexpr int CW_BAR = 4096;

constexpr int RING_BYTES = 131072;
constexpr int LDSCTL_OFF = RING_BYTES, MISC_OFF = LDSCTL_OFF + 320;
constexpr int LDS_BYTES = 147456;

typedef unsigned v2u __attribute__((ext_vector_type(2)));
typedef GAS float gf32;
typedef GAS unsigned short gbf16;

__device__ __forceinline__ float silu_f(float a) { return a / (1.0f + __expf(-a)); }
__device__ __forceinline__ int mod_of_row(int row) { return row < R_CTX ? 0 : (row < R_CTX + S_LAT ? 1 : 2); }

struct EpiStoreF32 {
    static constexpr bool PERM = false, AFTER_DRAIN = false;
    gf32* C; int ldc;
    __device__ __forceinline__ void operator()(const pg8::f32x4 (&acc)[2][2][4][2], const pg8::Unit& u, int wr, int wc, int fr, int fq) const {
        const int row0 = u.pm * 256 + wr * 64 + fr, col0 = u.pn * 256 + wc * 32 + 4 * fq;
#pragma unroll
        for (int ai = 0; ai < 2; ++ai)
#pragma unroll
            for (int m = 0; m < 4; ++m) { gf32* rowp = C + (size_t)(row0 + ai * 128 + m * 16) * ldc + col0;
#pragma unroll
                for (int bj = 0; bj < 2; ++bj)
#pragma unroll
                    for (int n = 0; n < 2; ++n) *(GAS pg8::f32x4*)(rowp + bj * 128 + n * 16) = acc[ai][bj][m][n]; }
    }
};
struct EpiResid {
    static constexpr bool PERM = false, AFTER_DRAIN = false;
    const gf32* xa; const gf32* xb;
    const gf32* gates;
    gf32* out;
    __device__ __forceinline__ void operator()(const pg8::f32x4 (&acc)[2][2][4][2], const pg8::Unit& u, int wr, int wc, int fr, int fq) const {
        const int mod = u.pm >> 4;
        const gf32* xbase = (u.pm < 16) ? xa + (size_t)u.pm * 256 * DM : xb + (size_t)(u.pm - 16) * 256 * DM;
        const int r0 = wr * 64 + fr, col0 = u.pn * 256 + wc * 32 + 4 * fq;
        pg8::f32x4 gv[2][2];
#pragma unroll
        for (int bj = 0; bj < 2; ++bj)
#pragma unroll
            for (int n = 0; n < 2; ++n) gv[bj][n] = *(const GAS pg8::f32x4*)(gates + (size_t)mod * 6 * DM + col0 + bj * 128 + n * 16);
#pragma unroll
        for (int ai = 0; ai < 2; ++ai)
#pragma unroll
            for (int m = 0; m < 4; ++m) { const int r = r0 + ai * 128 + m * 16;
                const gf32* xp = xbase + (size_t)r * DM + col0; gf32* op = out + ((size_t)u.pm * 256 + r) * DM + col0;
#pragma unroll
                for (int bj = 0; bj < 2; ++bj)
#pragma unroll
                    for (int n = 0; n < 2; ++n) { const pg8::f32x4 xv = *(const GAS pg8::f32x4*)(xp + bj * 128 + n * 16);
                        *(GAS pg8::f32x4*)(op + bj * 128 + n * 16) = xv * ALPHA + gv[bj][n] * acc[ai][bj][m][n]; } }
    }
};
struct EpiSwiGLU {
    static constexpr bool PERM = true, AFTER_DRAIN = false;
    gbf16* act;
    __device__ __forceinline__ void operator()(const pg8::f32x4 (&acc)[2][2][4][2], const pg8::Unit& u, int wr, int wc, int fr, int fq) const {
        const int row0 = u.pm * 256 + wr * 64 + fr, col0 = u.pn * 128 + wc * 32 + 8 * fq;
#pragma unroll
        for (int ai = 0; ai < 2; ++ai)
#pragma unroll
            for (int m = 0; m < 4; ++m) { gbf16* rowp = act + (size_t)(row0 + ai * 128 + m * 16) * DFF + col0;
                float r[8];
#pragma unroll
                for (int n = 0; n < 2; ++n)
#pragma unroll
                    for (int j = 0; j < 4; ++j) { const float g = acc[ai][0][m][n][j], up = acc[ai][1][m][n][j]; r[n * 4 + j] = silu_f(g) * up; }
                pg8::u32x4 w; w.x = pg8::cvt_pk_bf16(r[0], r[1]); w.y = pg8::cvt_pk_bf16(r[2], r[3]); w.z = pg8::cvt_pk_bf16(r[4], r[5]); w.w = pg8::cvt_pk_bf16(r[6], r[7]);
                *(GAS pg8::u32x4*)rowp = w; }
    }
};

struct Args { const float* in[24]; float* out; unsigned char* ws; int ph_lo, ph_hi, single, pad; };
enum { I_XP = 0, I_XS, I_CDK, I_CDV, I_CSK, I_CSV, I_ST, I_C, I_CCTX, I_WMOD, I_BMOD, I_WIN, I_WOUT, I_DLAM, I_DNG, I_LBL, I_HNG, I_SINK, I_LN1G, I_LN1B, I_LN2G, I_LN2B, I_WGU, I_WDN };

struct Ctx {
    LAS unsigned char* lds; int tid, lane, wave, G, bid;
    const Args* ap; gf32* out; GAS unsigned char* ws;
    __device__ __forceinline__ const gf32* inp(int i) const { return (const gf32*)ap->in[i]; }
    __device__ __forceinline__ gf32* mods() const { return (gf32*)(ws + WS_MODS); }
    __device__ __forceinline__ gf32* lball() const { return (gf32*)(ws + WS_MISC); }
    __device__ __forceinline__ gf32* lamv() const { return (gf32*)(ws + WS_MISC + 16384); }
    __device__ __forceinline__ gf32* tabD() const { return (gf32*)(ws + WS_MISC + 20480); }
    __device__ __forceinline__ gf32* tabS() const { return (gf32*)(ws + WS_MISC + 32768); }
    __device__ __forceinline__ gbf16* wT(int l, size_t off) const { return (gbf16*)(ws + WS_W + (size_t)l * W_LAYER + off); }
    __device__ __forceinline__ gbf16* hbuf() const { return (gbf16*)(ws + WS_H); }
    __device__ __forceinline__ gbf16* cat() const { return (gbf16*)(ws + WS_CAT); }
    __device__ __forceinline__ gf32* x1() const { return (gf32*)(ws + WS_X1); }
    __device__ __forceinline__ gf32* oa() const { return (gf32*)(ws + WS_OA); }
    __device__ __forceinline__ gf32* obf() const { return (gf32*)(ws + WS_OBF); }
    __device__ __forceinline__ gf32* obb() const { return (gf32*)(ws + WS_OBB); }
    __device__ __forceinline__ gf32* proj() const { return (gf32*)(ws + WS_P); }
    __device__ __forceinline__ gbf16* act() const { return (gbf16*)(ws + WS_ACT); }
    __device__ __forceinline__ gf32* ypre() const { return (gf32*)(ws + WS_YPRE); }
    __device__ __forceinline__ gbf16* qkv() const { return (gbf16*)(ws + WS_QKV); }
    __device__ __forceinline__ gbf16* hq(int dir) const { return (gbf16*)(ws + WS_HQ) + (size_t)dir * MROWS * 512; }
    __device__ __forceinline__ gbf16* hkm(int dir) const { return (gbf16*)(ws + WS_HKM) + (size_t)dir * MROWS * 512; }
    __device__ __forceinline__ gbf16* hkp(int dir) const { return (gbf16*)(ws + WS_HKP) + (size_t)dir * 768 * 512 * 16; }
    __device__ __forceinline__ gbf16* hvt(int dir) const { return (gbf16*)(ws + WS_HVT) + (size_t)dir * 768 * 512 * 16; }
    __device__ __forceinline__ gf32* sloc() const { return (gf32*)(ws + WS_SLOC); }
    __device__ __forceinline__ gf32* dseg() const { return (gf32*)(ws + WS_DSEG); }
    __device__ __forceinline__ gf32* hdec(int dir) const { return (gf32*)(ws + WS_HDEC) + (size_t)dir * 768 * 512; }
    __device__ __forceinline__ gbf16* c16(size_t off) const { return (gbf16*)(ws + WS_C16 + off); }
};

__device__ __forceinline__ void transpose_item(const gf32* W, int K, int N, gbf16* WT, int k0, int n0, int drow0, LAS float* scr, int lane) {
#pragma unroll 8
    for (int i = 0; i < 32; ++i) { const int kk = 2 * i + (lane >> 5); scr[kk * 33 + (lane & 31)] = W[(size_t)(k0 + kk) * N + n0 + (lane & 31)]; }
    LDS_WAIT(); asm volatile("" ::: "memory");
    const int c = lane & 7;
#pragma unroll
    for (int j = 0; j < 4; ++j) { const int n = (lane >> 3) + 8 * j; const LAS float* s = scr + (8 * c) * 33 + n;
        v4u o; o.x = pk2(s[0 * 33], s[1 * 33]); o.y = pk2(s[2 * 33], s[3 * 33]); o.z = pk2(s[4 * 33], s[5 * 33]); o.w = pk2(s[6 * 33], s[7 * 33]);
        *(GAS v4u*)(WT + (size_t)(drow0 + n) * K + k0 + 8 * c) = o; }
    LDS_WAIT(); asm volatile("" ::: "memory");
}

__device__ __forceinline__ void p0_prologue(const Ctx& F) {
    {
        LAS float* sc = (LAS float*)F.lds;
        LAS float* red = (LAS float*)(F.lds + 24576);
        const gf32* c_ctx = F.inp(I_CCTX); const gf32* cc = F.inp(I_C);
        for (int i = F.tid; i < 3 * DM; i += 512) { const int mid = i / DM, k = i % DM; const float c = mid == 0 ? c_ctx[k] : cc[(mid - 1) * DM + k]; sc[i] = silu_f(c); }
        __syncthreads();
        for (int task = F.bid; task < DEPTH * 48; task += F.G) {
            const int l = task / 48, cb = task % 48, w = F.wave;
            const gf32* wp = F.inp(I_WMOD) + ((size_t)l * DM + 256 * w) * (6 * DM) + cb * 256 + F.lane * 4;
            f32x4 a0 = {0.f, 0.f, 0.f, 0.f}, a1 = a0, a2 = a0;
#pragma unroll 8
            for (int kk = 0; kk < 256; ++kk) { const f32x4 wv = *(const GAS f32x4*)(wp + (size_t)kk * (6 * DM));
                a0 += wv * sc[256 * w + kk]; a1 += wv * sc[DM + 256 * w + kk]; a2 += wv * sc[2 * DM + 256 * w + kk]; }
            *(LAS f32x4*)(red + (w * 3 + 0) * 256 + F.lane * 4) = a0; *(LAS f32x4*)(red + (w * 3 + 1) * 256 + F.lane * 4) = a1; *(LAS f32x4*)(red + (w * 3 + 2) * 256 + F.lane * 4) = a2;
            __syncthreads();
            for (int i = F.tid; i < 768; i += 512) { const int m = i >> 8, c = i & 255; float s = 0.f;
#pragma unroll
                for (int ww = 0; ww < 8; ++ww) s += red[(ww * 3 + m) * 256 + c];
                F.mods()[((size_t)l * 3 + m) * (6 * DM) + cb * 256 + c] = s + F.inp(I_BMOD)[(size_t)l * 6 * DM + cb * 256 + c]; }
            __syncthreads();
        }
    }
    if (F.bid == F.G - 1) {
        const gf32* lbl = F.inp(I_LBL);
        for (int i = F.tid; i < 1024; i += 512) { float lg[4], mx = -1e30f;
#pragma unroll
            for (int l = 0; l < 4; ++l) { lg[l] = lbl[l * 1024 + i]; mx = fmaxf(mx, lg[l]); }
            float s = 0.f;
#pragma unroll
            for (int l = 0; l < 4; ++l) { lg[l] = expf(lg[l] - mx); s += lg[l]; }
            const float w1 = lg[1] / s, w2 = lg[2] / s, w3 = lg[3] / s;
            F.lball()[0 * 1024 + i] = 0.f; F.lball()[1 * 1024 + i] = w1; F.lball()[2 * 1024 + i] = w1 + w2; F.lball()[3 * 1024 + i] = w1 + w2 + w3; }
        if (F.tid < 4) { const int l = F.tid; const gf32* lp = F.inp(I_DLAM) + l * 256; float s1 = 0.f, s2 = 0.f;
            for (int i = 0; i < 64; ++i) { s1 += lp[i] * lp[64 + i]; s2 += lp[128 + i] * lp[192 + i]; }
            const float li = 0.8f - 0.6f * expf(-0.3f * (float)l);
            F.lamv()[l * 2] = expf(s1) - expf(s2) + li; F.lamv()[l * 2 + 1] = li; }
        for (int i = F.tid; i < 64 * 16; i += 512) { const int pos = i / 16, j = i % 16; const float inv = powf(10000.f, -(float)j / 16.f), ang = (float)pos * inv; F.tabD()[i * 2] = cosf(ang); F.tabD()[i * 2 + 1] = sinf(ang); }
        for (int i = F.tid; i < 64 * 32; i += 512) { const int pos = i / 32, j = i % 32; const float inv = powf(10000.f, -(float)j / 32.f), ang = (float)pos * inv; F.tabS()[i * 2] = cosf(ang); F.tabS()[i * 2 + 1] = sinf(ang); }
    }
    {
        const gf32* src[4] = {F.inp(I_CDK), F.inp(I_CDV), F.inp(I_CSK), F.inp(I_CSV)};
        const size_t doff[4] = {0, 2 * MiB, 4 * MiB, 5 * MiB}; const int n8[4] = {131072, 131072, 65536, 65536};
#pragma unroll
        for (int a = 0; a < 4; ++a)
            for (int i = F.bid * 512 + F.tid; i < n8[a]; i += F.G * 512) { const f32x4 x0 = *(const GAS f32x4*)(src[a] + (size_t)i * 8), x1 = *(const GAS f32x4*)(src[a] + (size_t)i * 8 + 4);
                v4u o; o.x = pk2(x0[0], x0[1]); o.y = pk2(x0[2], x0[3]); o.z = pk2(x1[0], x1[1]); o.w = pk2(x1[2], x1[3]); *(GAS v4u*)(F.c16(doff[a]) + (size_t)i * 8) = o; }
    }
    {
        LAS float* scr = (LAS float*)(F.lds + 49152 + F.wave * 8448);
        const int gw = F.bid * 8 + F.wave, NGW = F.G * 8;
        constexpr int I_IN = 32 * 176, I_OUT = 32 * 64, I_GU = 32 * 352, I_DN = 88 * 64, I_L = I_IN + I_OUT + I_GU + I_DN;
        for (int it = gw; it < DEPTH * I_L; it += NGW) {
            const int l = it / I_L; int r = it % I_L;
            if (r < I_IN) { const int kb = r / 176, nb = r % 176; transpose_item(F.inp(I_WIN) + (size_t)l * DM * DIN, DM, DIN, F.wT(l, WO_IN), 64 * kb, 32 * nb, 32 * nb, scr, F.lane); continue; } r -= I_IN;
            if (r < I_OUT) { const int kb = r / 64, nb = r % 64; transpose_item(F.inp(I_WOUT) + (size_t)l * DM * DM, DM, DM, F.wT(l, WO_OUT), 64 * kb, 32 * nb, 32 * nb, scr, F.lane); continue; } r -= I_OUT;
            if (r < I_GU) { const int kb = r / 352, nb = r % 352, n0 = 32 * nb; const int j = n0 < DFF ? n0 : n0 - DFF; const int drow = 256 * (j >> 7) + (n0 < DFF ? 0 : 128) + (j & 127);
                transpose_item(F.inp(I_WGU) + (size_t)l * DM * DGU, DM, DGU, F.wT(l, WO_GU), 64 * kb, n0, drow, scr, F.lane); continue; } r -= I_GU;
            { const int kb = r / 64, nb = r % 64; transpose_item(F.inp(I_WDN) + (size_t)l * DFF * DM, DFF, DM, F.wT(l, WO_DN), 64 * kb, 32 * nb, 32 * nb, scr, F.lane); }
        }
    }
}

__device__ __forceinline__ void p1_h0(const Ctx& F) {
    const gf32* xp = F.inp(I_XP); const gf32* xs = F.inp(I_XS);
    for (int idx = F.bid * 512 + F.tid; idx < MROWS * 256; idx += F.G * 512) {
        const int row = idx >> 8, c8 = (idx & 255) * 8, mod = mod_of_row(row);
        const gf32* xr = row < R_CTX ? xp + (size_t)row * DM : xs + (size_t)(row - R_CTX) * DM;
        const gf32* sh = F.mods() + (size_t)(0 * 3 + mod) * 6 * DM; const gf32* sc = sh + DM;
        const f32x4 x0 = *(const GAS f32x4*)(xr + c8), x1 = *(const GAS f32x4*)(xr + c8 + 4), s0 = *(const GAS f32x4*)(sh + c8), s1 = *(const GAS f32x4*)(sh + c8 + 4), c0 = *(const GAS f32x4*)(sc + c8), c1 = *(const GAS f32x4*)(sc + c8 + 4);
        const f32x4 h0 = x0 * (c0 + 1.0f) + s0, h1 = x1 * (c1 + 1.0f) + s1;
        v4u o; o.x = pk2(h0[0], h0[1]); o.y = pk2(h0[2], h0[3]); o.z = pk2(h1[0], h1[1]); o.w = pk2(h1[2], h1[3]);
        *(GAS v4u*)(F.hbuf() + (size_t)row * DM + c8) = o;
    }
}

constexpr float LOG2E = 1.4426950408889634f;
constexpr float QSC_D = 0.125f * LOG2E, QSC_S = 0.08838834764831845f * LOG2E;
__device__ __forceinline__ void e1_postproj(const Ctx& F, int l) {
    const gf32* lb = F.lball() + l * 1024;
    for (int grp = F.bid; grp < MROWS / 16; grp += F.G) {
        const int row0 = grp * 16;
        for (int rr = F.wave; rr < 16; rr += 8) {
            const int row = row0 + rr, lane = F.lane;
            const gf32* pr = F.proj() + (size_t)row * DIN; gbf16* qk = F.qkv() + (size_t)row * QKV_LD;
            const bool lat = row >= R_CTX; const int t = (row - R_CTX) & (S_LAT - 1), rpos = t >> 6, cpos = t & 63;
            const f32x4 one0 = {1.f, 0.f, 1.f, 0.f};
#pragma unroll
            for (int u = 0; u < 2; ++u) {
                const int it = lane + 64 * u, blk = it >> 2, f = it & 3, cb = blk * 32, pos = (blk & 1) ? cpos : rpos;
                const f32x4 x1 = *(const GAS f32x4*)(pr + cb + 4 * f), x2 = *(const GAS f32x4*)(pr + cb + 16 + 4 * f);
                f32x4 t0 = one0, t1 = one0; if (lat) { t0 = *(const GAS f32x4*)(F.tabD() + (pos * 16 + 4 * f) * 2); t1 = *(const GAS f32x4*)(F.tabD() + (pos * 16 + 4 * f) * 2 + 4); }
                const f32x4 cs = {t0[0], t0[2], t1[0], t1[2]}, sn = {t0[1], t0[3], t1[1], t1[3]};
                const float sc = cb < 512 ? QSC_D : 1.0f;
                const f32x4 y1 = (x1 * cs - x2 * sn) * sc, y2 = (x2 * cs + x1 * sn) * sc;
                *(GAS v2u*)(qk + cb + 4 * f) = (v2u){pk2(y1[0], y1[1]), pk2(y1[2], y1[3])}; *(GAS v2u*)(qk + cb + 16 + 4 * f) = (v2u){pk2(y2[0], y2[1]), pk2(y2[2], y2[3])};
            }
#pragma unroll
            for (int u = 0; u < 3; ++u) {
                const int it = lane + 64 * u;
                if (it < 160) { const int blk = it >> 3, f = it & 7, cb = C_CQ + blk * 64, db = Q_QS + blk * 64, pos = (blk & 1) ? cpos : rpos;
                    const f32x4 x1 = *(const GAS f32x4*)(pr + cb + 4 * f), x2 = *(const GAS f32x4*)(pr + cb + 32 + 4 * f);
                    f32x4 t0 = one0, t1 = one0; if (lat) { t0 = *(const GAS f32x4*)(F.tabS() + (pos * 32 + 4 * f) * 2); t1 = *(const GAS f32x4*)(F.tabS() + (pos * 32 + 4 * f) * 2 + 4); }
                    const f32x4 cs = {t0[0], t0[2], t1[0], t1[2]}, sn = {t0[1], t0[3], t1[1], t1[3]};
                    const float sc = blk < 16 ? QSC_S : 1.0f;
                    const f32x4 y1 = (x1 * cs - x2 * sn) * sc, y2 = (x2 * cs + x1 * sn) * sc;
                    *(GAS v2u*)(qk + db + 4 * f) = (v2u){pk2(y1[0], y1[1]), pk2(y1[2], y1[3])}; *(GAS v2u*)(qk + db + 32 + 4 * f) = (v2u){pk2(y2[0], y2[1]), pk2(y2[2], y2[3])}; }
            }
            { const f32x4 a0 = *(const GAS f32x4*)(pr + C_AV + 4 * lane), a1 = *(const GAS f32x4*)(pr + C_AV + 256 + 4 * lane), a2 = *(const GAS f32x4*)(pr + C_CV + 4 * lane);
              *(GAS v2u*)(qk + Q_VD + 4 * lane) = (v2u){pk2(a0[0], a0[1]), pk2(a0[2], a0[3])}; *(GAS v2u*)(qk + Q_VD + 256 + 4 * lane) = (v2u){pk2(a1[0], a1[1]), pk2(a1[2], a1[3])};
              *(GAS v2u*)(qk + Q_VS + 4 * lane) = (v2u){pk2(a2[0], a2[1]), pk2(a2[2], a2[3])}; }
            if (!lat) {
                const int b = row >> 8, n = row & 255;
#pragma unroll
                for (int u = 0; u < 2; ++u) { const int i = lane + 64 * u, hh = i >> 5, c4 = (i & 31) * 4;
                    *(GAS f32x4*)(F.out + O_DK + ((((size_t)b * 4 + l) * 4 + hh) * 256 + n) * 128 + c4) = *(const GAS f32x4*)(pr + C_AK + hh * 128 + c4);
                    *(GAS f32x4*)(F.out + O_DV + ((((size_t)b * 4 + l) * 4 + hh) * 256 + n) * 128 + c4) = *(const GAS f32x4*)(pr + C_AV + hh * 128 + c4); }
                { const int kv = lane >> 5, c4 = (lane & 31) * 4;
                    *(GAS f32x4*)(F.out + O_SK + ((((size_t)b * 4 + l) * 2 + kv) * 256 + n) * 128 + c4) = *(const GAS f32x4*)(pr + C_CK + kv * 128 + c4);
                    *(GAS f32x4*)(F.out + O_SV + ((((size_t)b * 4 + l) * 2 + kv) * 256 + n) * 128 + c4) = *(const GAS f32x4*)(pr + C_CV + kv * 128 + c4); }
            }
        }
        {
            const int c = F.tid; const gf32* pc = F.proj() + (size_t)row0 * DIN;
            float qv[16], vv[16];
#pragma unroll
            for (int r = 0; r < 16; ++r) { qv[r] = silu_f(pc[(size_t)r * DIN + C_BQ + c]); vv[r] = pc[(size_t)r * DIN + C_BI + c]; }
#pragma unroll
            for (int dir = 0; dir < 2; ++dir) {
                const float lbv = lb[dir * 512 + c], lbm = fmaxf(lbv, 1e-30f), oml = 1.0f - lbv;
                float g[16], cum[16]; float run = 0.f;
#pragma unroll
                for (int p = 0; p < 16; ++p) { const int r = dir ? 15 - p : p; const float z = pc[(size_t)r * DIN + C_BF + dir * 512 + c];
                    g[p] = logf(lbm + oml / (1.0f + expf(-z))); run += g[p]; cum[p] = run; }
                const float last = run;
                unsigned kpw[8], vtw[8];
#pragma unroll
                for (int p = 0; p < 16; p += 2) {
                    float kp2[2];
#pragma unroll
                    for (int e = 0; e < 2; ++e) { const int pp = p + e, r = dir ? 15 - pp : pp; const float k = 1.0f - expf(g[pp]); const float cc = fmaxf(cum[pp], -80.0f);
                        F.hq(dir)[(size_t)(row0 + r) * 512 + c] = (bf16)f2bf(qv[r] * expf(cc)); F.hkm(dir)[(size_t)(row0 + r) * 512 + c] = (bf16)f2bf(k * expf(-cc));
                        kp2[e] = k * expf(last - cum[pp]); }
                    kpw[p >> 1] = pk2(kp2[0], kp2[1]); vtw[p >> 1] = pk2(vv[dir ? 15 - p : p], vv[dir ? 14 - p : p + 1]);
                }
                GAS v4u* kd = (GAS v4u*)(F.hkp(dir) + ((size_t)grp * 512 + c) * 16); GAS v4u* vd = (GAS v4u*)(F.hvt(dir) + ((size_t)grp * 512 + c) * 16);
                kd[0] = (v4u){kpw[0], kpw[1], kpw[2], kpw[3]}; kd[1] = (v4u){kpw[4], kpw[5], kpw[6], kpw[7]};
                vd[0] = (v4u){vtw[0], vtw[1], vtw[2], vtw[3]}; vd[1] = (v4u){vtw[4], vtw[5], vtw[6], vtw[7]};
                F.hdec(dir)[(size_t)grp * 512 + c] = expf(last);
            }
        }
    }
}

typedef float f32x16 __attribute__((ext_vector_type(16)));
typedef short s16x4 __attribute__((ext_vector_type(4)));
typedef __bf16 bf16x2_t __attribute__((ext_vector_type(2)));
typedef float f32x2_t __attribute__((ext_vector_type(2)));
__device__ __forceinline__ unsigned cvt2(float a, float b) { const f32x2_t f = {a, b}; return __builtin_bit_cast(unsigned, __builtin_convertvector(f, bf16x2_t)); }
#define MFMA32(a, b, c) __builtin_amdgcn_mfma_f32_32x32x16_bf16((a), (b), (c), 0, 0, 0)

struct AttnSeg { const gbf16* k; const gbf16* v; int stride; int ntiles; };
constexpr int KPB = 272, VPB = 320;
constexpr int KT_BYTES = 64 * KPB, VT_BYTES = 64 * VPB, ABUF_BYTES = KT_BYTES + VT_BYTES;
constexpr float ATT_THR = 8.0f;

template <int DQK, bool DIFF>
__device__ __forceinline__ void attn_mfma(const Ctx& F, const gbf16* qptr, int kcol, const AttnSeg s0, const AttnSeg s1, bool band, int qpos, int kpos0,
                                          float m_init, float l_init, float lam, float post_scale, const gf32* gvec, gbf16* outp  ) {
    int lane_ = (int)__builtin_amdgcn_mbcnt_hi(~0u, __builtin_amdgcn_mbcnt_lo(~0u, 0u)); asm volatile("" : "+v"(lane_));
    const int lane = lane_, tid = F.wave * 64 + lane, r32 = lane & 31, h = lane >> 5;
    __syncthreads();
    bf16x8 qf[DQK / 16];
#pragma unroll
    for (int ks = 0; ks < DQK / 16; ++ks) qf[ks] = *(const GAS bf16x8*)(qptr + (size_t)r32 * QKV_LD + 16 * ks + 8 * h);
#pragma unroll
    for (int ks = 0; ks < DQK / 16; ++ks) asm volatile("" : "+v"(qf[ks]));
    __builtin_amdgcn_s_waitcnt(0);
    f32x16 o[4];
#pragma unroll
    for (int t = 0; t < 4; ++t)
#pragma unroll
        for (int r = 0; r < 16; ++r) o[t][r] = 0.f;
    float m = m_init, l = l_init;
    const int nt = s0.ntiles + s1.ntiles;
    const int srow = tid >> 4, spc = tid & 15;
    v4u kreg[2], vreg[2];
#define ATT_ISSUE(ti) do { const bool s1_ = (ti) >= s0.ntiles; const int tt_ = s1_ ? (ti) - s0.ntiles : (ti); const gbf16* kb_ = s1_ ? s1.k : s0.k; const gbf16* vb_ = s1_ ? s1.v : s0.v; const int st_ = s1_ ? s1.stride : s0.stride; \
        _Pragma("unroll") for (int i_ = 0; i_ < 2; ++i_) { const size_t go_ = (size_t)(tt_ * 64 + srow + 32 * i_) * st_ + spc * 8; kreg[i_] = *(const GAS v4u*)(kb_ + go_); vreg[i_] = *(const GAS v4u*)(vb_ + go_); } } while (0)
#define ATT_WRITE(b) do { _Pragma("unroll") for (int i_ = 0; i_ < 2; ++i_) { *(LAS v4u*)(F.lds + (b) * ABUF_BYTES + (srow + 32 * i_) * KPB + spc * 16) = kreg[i_]; \
        *(LAS v4u*)(F.lds + (b) * ABUF_BYTES + KT_BYTES + (srow + 32 * i_) * VPB + spc * 16) = vreg[i_]; } } while (0)
    ATT_ISSUE(0); ATT_WRITE(0);
    __syncthreads();
    const int koff = r32 * KPB + (kcol + 8 * h) * 2;
    const int voff = KT_BYTES + (4 * h + ((lane & 15) >> 2)) * VPB + (16 * ((lane >> 4) & 1) + 4 * (lane & 3)) * 2;
    for (int ti = 0; ti < nt; ++ti) {
        const int buf = ti & 1;
        if (ti + 1 < nt) ATT_ISSUE(ti + 1);
        const LAS unsigned char* kb = F.lds + buf * ABUF_BYTES;
        f32x16 st[2];
#pragma unroll
        for (int kt = 0; kt < 2; ++kt)
#pragma unroll
            for (int r = 0; r < 16; ++r) st[kt][r] = 0.f;
        {
            constexpr int NG = 2 * (DQK / 64);
            bf16x8 kfa[4], kfb[4];
#define ATT_LDK(dst, g) do { const int kt_ = (g) / (DQK / 64), k0_ = ((g) % (DQK / 64)) * 4; _Pragma("unroll") for (int j_ = 0; j_ < 4; ++j_) dst[j_] = *(const LAS bf16x8*)(kb + koff + kt_ * 32 * KPB + (k0_ + j_) * 32); } while (0)
#define ATT_MMK(src, g) do { const int kt_ = (g) / (DQK / 64), k0_ = ((g) % (DQK / 64)) * 4; _Pragma("unroll") for (int j_ = 0; j_ < 4; ++j_) st[kt_] = MFMA32(src[j_], qf[k0_ + j_], st[kt_]); } while (0)
            ATT_LDK(kfa, 0); __builtin_amdgcn_sched_barrier(0);
#pragma unroll
            for (int g = 0; g < NG; g += 2) {
                ATT_LDK(kfb, g + 1); __builtin_amdgcn_sched_barrier(0);
                ATT_MMK(kfa, g);
                if (g + 2 < NG) { ATT_LDK(kfa, g + 2); __builtin_amdgcn_sched_barrier(0); }
                ATT_MMK(kfb, g + 1);
            }
#undef ATT_LDK
#undef ATT_MMK
        }
        if (band && ti < s0.ntiles) {
            const int kp = kpos0 + ti * 64 + 4 * h - (qpos + r32);
#pragma unroll
            for (int kt = 0; kt < 2; ++kt)
#pragma unroll
                for (int r = 0; r < 16; ++r) { const int d = kp + 32 * kt + (r & 3) + 8 * (r >> 2); if (d > 128 || d < -128) st[kt][r] = -1e30f; }
        }
        float mx = st[0][0];
#pragma unroll
        for (int kt = 0; kt < 2; ++kt)
#pragma unroll
            for (int r = 0; r < 16; ++r) mx = fmaxf(mx, st[kt][r]);
        mx = fmaxf(mx, __shfl_xor(mx, 32));
        if (__builtin_amdgcn_ballot_w64(mx > m + ATT_THR) != 0ull) {
            const float mn = fmaxf(m, mx), a = __builtin_amdgcn_exp2f(m - mn); l *= a; m = mn;
#pragma unroll
            for (int t = 0; t < 4; ++t)
#pragma unroll
                for (int r = 0; r < 16; ++r) o[t][r] *= a;
        }
        float rs = 0.f;
#pragma unroll
        for (int kt = 0; kt < 2; ++kt)
#pragma unroll
            for (int r = 0; r < 16; ++r) { const float p = __builtin_amdgcn_exp2f(st[kt][r] - m); st[kt][r] = p; rs += p; }
        rs += __shfl_xor(rs, 32); l += rs;
        {
            s16x4 va[8], vb[8];
#define ATT_LDV(dst, g) do { _Pragma("unroll") for (int t_ = 0; t_ < 4; ++t_) { dst[2 * t_] = __builtin_amdgcn_ds_read_tr16_b64_v4i16((LAS s16x4*)(kb + voff + (16 * (g)) * VPB + t_ * 64)); \
                dst[2 * t_ + 1] = __builtin_amdgcn_ds_read_tr16_b64_v4i16((LAS s16x4*)(kb + voff + (16 * (g) + 8) * VPB + t_ * 64)); } } while (0)
#define ATT_MMV(src, g) do { const int kt_ = (g) >> 1, s_ = (g) & 1; v4u pw_; pw_.x = cvt2(st[kt_][8 * s_], st[kt_][8 * s_ + 1]); pw_.y = cvt2(st[kt_][8 * s_ + 2], st[kt_][8 * s_ + 3]); pw_.z = cvt2(st[kt_][8 * s_ + 4], st[kt_][8 * s_ + 5]); pw_.w = cvt2(st[kt_][8 * s_ + 6], st[kt_][8 * s_ + 7]); \
            const bf16x8 pf_ = __builtin_bit_cast(bf16x8, pw_); _Pragma("unroll") for (int t_ = 0; t_ < 4; ++t_) o[t_] = MFMA32(__builtin_shufflevector(src[2 * t_], src[2 * t_ + 1], 0, 1, 2, 3, 4, 5, 6, 7), pf_, o[t_]); } while (0)
            ATT_LDV(va, 0); __builtin_amdgcn_sched_barrier(0);
            ATT_LDV(vb, 1); __builtin_amdgcn_sched_barrier(0);
            ATT_MMV(va, 0);
            ATT_LDV(va, 2); __builtin_amdgcn_sched_barrier(0);
            ATT_MMV(vb, 1);
            ATT_LDV(vb, 3); __builtin_amdgcn_sched_barrier(0);
            ATT_MMV(va, 2);
            ATT_MMV(vb, 3);
#undef ATT_LDV
#undef ATT_MMV
        }
        if (ti + 1 < nt) ATT_WRITE(buf ^ 1);
        __syncthreads();
    }
#undef ATT_ISSUE
#undef ATT_WRITE
    const float inv = 1.0f / l;
    if (DIFF) {
        LAS float* ex = (LAS float*)F.lds;
        if (F.wave >= 4) {
#pragma unroll
            for (int t = 0; t < 4; ++t)
#pragma unroll
                for (int r = 0; r < 16; ++r) ex[((F.wave - 4) * 64 + t * 16 + r) * 64 + lane] = o[t][r] * inv;
        }
        __syncthreads();
        if (F.wave < 4) {
            float ss = 0.f;
#pragma unroll
            for (int t = 0; t < 4; ++t)
#pragma unroll
                for (int r = 0; r < 16; ++r) { const float x = o[t][r] * inv - lam * ex[(F.wave * 64 + t * 16 + r) * 64 + lane]; o[t][r] = x; ss += x * x; }
            ss += __shfl_xor(ss, 32);
            const float sc = post_scale / sqrtf(ss * (1.0f / 128.0f) + 1e-6f);
            gbf16* op = outp + (size_t)r32 * DM;
#pragma unroll
            for (int t = 0; t < 4; ++t)
#pragma unroll
                for (int g4 = 0; g4 < 4; ++g4) { const int dv = 32 * t + 8 * g4 + 4 * h; const f32x4 gv = *(const GAS f32x4*)(gvec + dv);
                    v2u w; w.x = cvt2(o[t][4 * g4] * sc * gv[0], o[t][4 * g4 + 1] * sc * gv[1]); w.y = cvt2(o[t][4 * g4 + 2] * sc * gv[2], o[t][4 * g4 + 3] * sc * gv[3]); *(GAS v2u*)(op + dv) = w; }
        }
    } else {
        gbf16* op = outp + (size_t)r32 * DM;
#pragma unroll
        for (int t = 0; t < 4; ++t)
#pragma unroll
            for (int g4 = 0; g4 < 4; ++g4) { const int dv = 32 * t + 8 * g4 + 4 * h;
                v2u w; w.x = cvt2(o[t][4 * g4] * inv, o[t][4 * g4 + 1] * inv); w.y = cvt2(o[t][4 * g4 + 2] * inv, o[t][4 * g4 + 3] * inv); *(GAS v2u*)(op + dv) = w; }
    }
}

#define MFMA16(a, b, c) __builtin_amdgcn_mfma_f32_16x16x32_bf16((a), (b), (c), 0, 0, 0)
__device__ __forceinline__ bf16x8 frag2(v2u lo, v2u hi) { const v4u w = {lo.x, lo.y, hi.x, hi.y}; return __builtin_bit_cast(bf16x8, w); }
constexpr int HG_NS = 7, HG_SLOT = 17408;
#define HG_VMWAIT(n) asm volatile("s_waitcnt vmcnt(" #n ")" ::: "memory")
template <int MODE>
__device__ __forceinline__ void hgrn_mfma(const Ctx& F, int rb, int nchunks, int cc0, int ncc, int h, int dir, const gf32* s_in, gf32* s_out, gf32* ob, const gf32* fold_s, const gf32* fold_d, int nfold, gf32* d_out) {
    int lane_ = (int)__builtin_amdgcn_mbcnt_hi(~0u, __builtin_amdgcn_mbcnt_lo(~0u, 0u)); asm volatile("" : "+v"(lane_));
    const int lane = lane_, t16 = lane & 15, G = lane >> 4, w = F.wave, vcol = h * 128 + w * 16 + t16;
    __syncthreads();
    f32x4 S[8];
#pragma unroll
    for (int i = 0; i < 8; ++i)
#pragma unroll
        for (int r = 0; r < 4; ++r) S[i][r] = (MODE == 2) ? s_in[(size_t)(16 * i + 4 * G + r) * 128 + w * 16 + t16] : 0.f;
    if (MODE == 2) {
        for (int j = 0; j < nfold; ++j) {
#pragma unroll
            for (int i = 0; i < 8; ++i) { const f32x4 dj = *(const GAS f32x4*)(fold_d + (size_t)j * 128 + 16 * i + 4 * G);
#pragma unroll
                for (int r = 0; r < 4; ++r) S[i][r] = S[i][r] * dj[r] + fold_s[((size_t)j * 128 + 16 * i + 4 * G + r) * 128 + w * 16 + t16]; }
        }
    }
    f32x4 Dacc[8];
#pragma unroll
    for (int i = 0; i < 8; ++i) Dacc[i] = (f32x4){1.f, 1.f, 1.f, 1.f};
#pragma unroll
    for (int i = 0; i < 8; ++i) asm volatile("" : "+v"(S[i]));
    __builtin_amdgcn_s_waitcnt(0);
    const GAS unsigned char* srcA = (const GAS unsigned char*)((w < 4 ? F.hq(dir) : F.hkm(dir)) + h * 128);
    const GAS unsigned char* srcB = (const GAS unsigned char*)((w < 4 ? F.hkp(dir) : F.hvt(dir)) + (size_t)h * 128 * 16);
    const GAS unsigned char* srcC = (const GAS unsigned char*)(F.hdec(dir) + h * 128) + (lane & 31) * 16;
    const int rA = 4 * (w & 3) + (lane >> 4);
    const unsigned offA = (unsigned)((dir ? 15 - rA : rA) * 1024 + (((lane & 15) ^ rA) * 16));
    const int dB = 32 * (w & 3) + (lane >> 1);
    const unsigned offB = (unsigned)(dB * 32 + (((lane & 1) ^ ((dB >> 3) & 1)) * 16));
    const int dstA = (w < 4 ? 0 : 4096) + (w & 3) * 1024, dstB = (w < 4 ? 8192 : 12288) + (w & 3) * 1024;
#define HG_ISSUE(cj) do { const int ce_ = cc0 + ((cj) < ncc ? (cj) : ncc - 1); const int ch_ = dir ? nchunks - 1 - ce_ : ce_; const size_t gc_ = (size_t)(rb / 16 + ch_); \
        LAS unsigned char* sl_ = F.lds + ((cj) % HG_NS) * HG_SLOT; \
        if (MODE != 1) __builtin_amdgcn_global_load_lds((const GAS unsigned*)(srcA + (size_t)(rb + ch_ * 16) * 1024 + offA), (LAS unsigned*)(sl_ + dstA), 16, 0, 0); \
        __builtin_amdgcn_global_load_lds((const GAS unsigned*)(srcB + gc_ * 16384 + offB), (LAS unsigned*)(sl_ + dstB), 16, 0, 0); \
        if (w == 0) __builtin_amdgcn_global_load_lds((const GAS unsigned*)(srcC + gc_ * 2048), (LAS unsigned*)(sl_ + 16384), 16, 0, 0); } while (0)
    const int qoff = t16 * 256 + 8 * (G & 1);
    const int g1 = G >> 1;
    const int kpoff = 8192 + t16 * 32 + ((g1 ^ ((t16 >> 3) & 1)) * 16) + 8 * (G & 1);
    const int vtoff = 12288 + (w * 16 + t16) * 32 + ((g1 ^ ((t16 >> 3) & 1)) * 16) + 8 * (G & 1);
    const int dcoff = 16384 + 16 * G;
    const v2u z2 = {0u, 0u};
#pragma unroll
    for (int j = 0; j < HG_NS - 1; ++j) HG_ISSUE(j);
    for (int cc = 0; cc < ncc; ++cc) {
        if (MODE == 1) { if (w == 0) HG_VMWAIT(10); else HG_VMWAIT(5); }
        else if (cc < HG_NS - 1) { if (w == 0) HG_VMWAIT(15); else HG_VMWAIT(10); }
        else                     { if (w == 0) HG_VMWAIT(39); else HG_VMWAIT(34); }
        asm volatile("s_waitcnt lgkmcnt(0)" ::: "memory"); __builtin_amdgcn_s_barrier(); asm volatile("" ::: "memory");
        HG_ISSUE(cc + HG_NS - 1);
        const LAS unsigned char* sl = F.lds + (cc % HG_NS) * HG_SLOT;
        v2u q[8], k[8], kp[8]; f32x4 dec[8];
        if (MODE != 1) {
#pragma unroll
            for (int i = 0; i < 8; ++i) { const int po = (((2 * i + g1) ^ t16) * 16); q[i] = *(const LAS v2u*)(sl + qoff + po); k[i] = *(const LAS v2u*)(sl + 4096 + qoff + po); }
        }
        const v2u vt = *(const LAS v2u*)(sl + vtoff);
#pragma unroll
        for (int i = 0; i < 8; ++i) { kp[i] = *(const LAS v2u*)(sl + kpoff + i * 512); dec[i] = *(const LAS f32x4*)(sl + dcoff + i * 64); }
        __builtin_amdgcn_sched_barrier(0);
        const bf16x8 vb = frag2(vt, z2);
        if (MODE != 1) {
            f32x4 pt = {0.f, 0.f, 0.f, 0.f};
#pragma unroll
            for (int kk = 0; kk < 4; ++kk) pt = MFMA16(frag2(k[2 * kk], k[2 * kk + 1]), frag2(q[2 * kk], q[2 * kk + 1]), pt);
#pragma unroll
            for (int r = 0; r < 4; ++r) if (4 * G + r > t16) pt[r] = 0.f;
            const v2u pb = {cvt2(pt[0], pt[1]), cvt2(pt[2], pt[3])};
            f32x4 o = {0.f, 0.f, 0.f, 0.f};
            o = MFMA16(frag2(pb, z2), vb, o);
#pragma unroll
            for (int kk = 0; kk < 4; ++kk) { const v2u s0 = {cvt2(S[2 * kk][0], S[2 * kk][1]), cvt2(S[2 * kk][2], S[2 * kk][3])}, s1 = {cvt2(S[2 * kk + 1][0], S[2 * kk + 1][1]), cvt2(S[2 * kk + 1][2], S[2 * kk + 1][3])};
                o = MFMA16(frag2(q[2 * kk], q[2 * kk + 1]), frag2(s0, s1), o); }
            const int ce = cc0 + cc, ch = dir ? nchunks - 1 - ce : ce, crow = rb + ch * 16;
#pragma unroll
            for (int r = 0; r < 4; ++r) { const int pr_ = 4 * G + r; ob[(size_t)(crow + (dir ? 15 - pr_ : pr_)) * 512 + vcol] = o[r]; }
        }
#pragma unroll
        for (int i = 0; i < 8; ++i) { S[i] = S[i] * dec[i]; S[i] = MFMA16(frag2(kp[i], z2), vb, S[i]); if (MODE == 1) Dacc[i] = Dacc[i] * dec[i]; }
    }
#undef HG_ISSUE
    HG_VMWAIT(0);
    __syncthreads();
    if (MODE != 2) {
#pragma unroll
        for (int i = 0; i < 8; ++i)
#pragma unroll
            for (int r = 0; r < 4; ++r) s_out[(size_t)(16 * i + 4 * G + r) * 128 + w * 16 + t16] = S[i][r];
    }
    if (MODE == 1 && w == 0 && t16 == 0) {
#pragma unroll
        for (int i = 0; i < 8; ++i) *(GAS f32x4*)(d_out + 16 * i + 4 * G) = Dacc[i];
    }
}

__device__ __forceinline__ void hp_states(const Ctx& F, int l) {
    for (int i = F.bid; i < 256; i += F.G) {
        const int sq = i >> 4, seg = i & 15, b = sq >> 3, h = (sq >> 1) & 3, dir = sq & 1;
        if (seg == 15) continue;
        hgrn_mfma<1>(F, R_CTX + b * S_LAT, S_LAT / 16, seg * 16, 16, h, dir, nullptr, F.sloc() + ((size_t)sq * 16 + seg) * 16384, nullptr, nullptr, nullptr, 0, F.dseg() + ((size_t)sq * 16 + seg) * 128);
    }
}

#ifndef PROBE_MX_DUP
#define PROBE_MX_DUP 0
#endif
#define MXREP(cls) for (int rep_ = 0; rep_ < 1 + ((PROBE_MX_DUP >> (cls)) & 1); ++rep_)
__device__ __forceinline__ void mx_mixers(const Ctx& F, int l) {
    float lam = F.lamv()[l * 2], lam_init = F.lamv()[l * 2 + 1];
    asm volatile("" : "+v"(lam), "+v"(lam_init));
    const gbf16* qkv = F.qkv();
    constexpr int T_LH = 256, T_LD = 256, T_LB = 256, T_CD = 128, T_CS = 128, T_CH = 128;
    constexpr int NT = T_LH + T_LD + T_LB + T_CD + T_CS + T_CH;
    const AttnSeg none = {nullptr, nullptr, 0, 0};
    const int w = F.wave;
    for (int task = F.bid; task < NT; task += F.G) {
        int i = task;
        if (i < T_LH) {
            const int sq = i >> 4, seg = i & 15, b = sq >> 3, h = (sq >> 1) & 3, dir = sq & 1;
            const gf32* sin_ = F.inp(I_ST) + ((((size_t)b * 4 + l) * 2 + dir) * 4 + h) * 128 * 128;
            MXREP(0) hgrn_mfma<2>(F, R_CTX + b * S_LAT, S_LAT / 16, seg * 16, 16, h, dir, sin_, nullptr, dir ? F.obb() : F.obf(), F.sloc() + (size_t)sq * 16 * 16384, F.dseg() + (size_t)sq * 16 * 128, seg, nullptr);
            continue; } i -= T_LH;
        if (i < T_LD) {
            const int b = i >> 7, h = (i >> 5) & 3, qt = i & 31, map = w >> 2; const int rb = R_CTX + b * S_LAT, wrow = rb + qt * 128 + 32 * (w & 3);
            const AttnSeg s0 = {qkv + (size_t)rb * QKV_LD + Q_KD + h * 128, qkv + (size_t)rb * QKV_LD + Q_VD + h * 128, QKV_LD, S_LAT / 64};
            const size_t co = (((size_t)b * 4 + l) * 4 + h) * 256 * 128;
            const AttnSeg s1 = {F.c16(0) + co, F.c16(2 * MiB) + co, 128, 4};
            MXREP(1) attn_mfma<64, true>(F, qkv + (size_t)wrow * QKV_LD + Q_QD + h * 128 + map * 64, map * 64, s0, s1, false, 0, 0, -1e30f, 0.f, lam, 1.0f - lam_init, F.inp(I_DNG) + l * 128, F.cat() + (size_t)wrow * DM + h * 128);
            continue; } i -= T_LD;
        if (i < T_LB) {
            const int b = i >> 7, kv = (i >> 6) & 1, qt = i & 63, hh = kv * 4 + (w >> 1); const int rb = R_CTX + b * S_LAT, t0 = qt * 64, wrow = rb + t0 + 32 * (w & 1);
            const int ks = t0 - 128 < 0 ? 0 : t0 - 128, ke = t0 + 192 > S_LAT ? S_LAT : t0 + 192;
            const AttnSeg s0 = {qkv + (size_t)(rb + ks) * QKV_LD + Q_KS + kv * 128, qkv + (size_t)(rb + ks) * QKV_LD + Q_VS + kv * 128, QKV_LD, (ke - ks) / 64};
            const size_t co = (((size_t)b * 4 + l) * 2 + kv) * 256 * 128;
            const AttnSeg s1 = {F.c16(4 * MiB) + co, F.c16(5 * MiB) + co, 128, 4};
            MXREP(2) attn_mfma<128, false>(F, qkv + (size_t)wrow * QKV_LD + Q_QS + hh * 128, 0, s0, s1, true, t0 + 32 * (w & 1), ks, F.inp(I_SINK)[l * 8 + hh] * LOG2E, 1.0f, 0.f, 1.0f, nullptr, F.cat() + (size_t)wrow * DM + 1024 + hh * 128);
            continue; } i -= T_LB;
        if (i < T_CD) {
            const int b = i >> 3, h = (i >> 1) & 3, qt = i & 1, map = w >> 2, rb = b * 256, wrow = rb + qt * 128 + 32 * (w & 3);
            const AttnSeg s0 = {qkv + (size_t)rb * QKV_LD + Q_KD + h * 128, qkv + (size_t)rb * QKV_LD + Q_VD + h * 128, QKV_LD, 4};
            MXREP(3) attn_mfma<64, true>(F, qkv + (size_t)wrow * QKV_LD + Q_QD + h * 128 + map * 64, map * 64, s0, none, false, 0, 0, -1e30f, 0.f, lam, 1.0f - lam_init, F.inp(I_DNG) + l * 128, F.cat() + (size_t)wrow * DM + h * 128);
            continue; } i -= T_CD;
        if (i < T_CS) {
            const int b = i >> 3, kv = (i >> 2) & 1, qt = i & 3, hh = kv * 4 + (w >> 1), rb = b * 256, wrow = rb + qt * 64 + 32 * (w & 1);
            const AttnSeg s0 = {qkv + (size_t)rb * QKV_LD + Q_KS + kv * 128, qkv + (size_t)rb * QKV_LD + Q_VS + kv * 128, QKV_LD, 4};
            MXREP(4) attn_mfma<128, false>(F, qkv + (size_t)wrow * QKV_LD + Q_QS + hh * 128, 0, s0, none, false, 0, 0, F.inp(I_SINK)[l * 8 + hh] * LOG2E, 1.0f, 0.f, 1.0f, nullptr, F.cat() + (size_t)wrow * DM + 1024 + hh * 128);
            continue; } i -= T_CS;
        {
            const int b = i >> 3, h = (i >> 1) & 3, dir = i & 1;
            gf32* sout = F.out + O_ST + ((((size_t)b * 4 + l) * 2 + dir) * 4 + h) * 128 * 128;
            MXREP(5) hgrn_mfma<0>(F, b * 256, 16, 0, 16, h, dir, nullptr, sout, dir ? F.obb() : F.obf(), nullptr, nullptr, 0, nullptr);
        }
    }
}

__device__ __forceinline__ void mg_merge(const Ctx& F, int l) {
    const int head = F.lane >> 4, sub = F.lane & 15, col0 = head * 128 + sub * 8;
    for (int row = F.bid * 8 + F.wave; row < MROWS; row += F.G * 8) {
        const f32x4 a0 = *(const GAS f32x4*)(F.obf() + (size_t)row * 512 + col0) + *(const GAS f32x4*)(F.obb() + (size_t)row * 512 + col0);
        const f32x4 a1 = *(const GAS f32x4*)(F.obf() + (size_t)row * 512 + col0 + 4) + *(const GAS f32x4*)(F.obb() + (size_t)row * 512 + col0 + 4);
        float ss = (a0[0] * a0[0] + a0[1] * a0[1]) + (a0[2] * a0[2] + a0[3] * a0[3]) + (a1[0] * a1[0] + a1[1] * a1[1]) + (a1[2] * a1[2] + a1[3] * a1[3]);
        ss += __shfl_xor(ss, 1); ss += __shfl_xor(ss, 2); ss += __shfl_xor(ss, 4); ss += __shfl_xor(ss, 8);
        const float rinv = 1.0f / sqrtf(ss * (1.0f / 128.0f) + 1e-6f);
        const gf32* g = F.inp(I_HNG) + l * 128 + sub * 8; const gf32* hg = F.proj() + (size_t)row * DIN + C_BG + col0;
        const f32x4 g0 = *(const GAS f32x4*)g, g1 = *(const GAS f32x4*)(g + 4), h0 = *(const GAS f32x4*)hg, h1 = *(const GAS f32x4*)(hg + 4);
        float y[8];
#pragma unroll
        for (int i = 0; i < 4; ++i) { y[i] = a0[i] * rinv * g0[i] * silu_f(h0[i]); y[4 + i] = a1[i] * rinv * g1[i] * silu_f(h1[i]); }
        v4u w; w.x = pk2(y[0], y[1]); w.y = pk2(y[2], y[3]); w.z = pk2(y[4], y[5]); w.w = pk2(y[6], y[7]);
        *(GAS v4u*)(F.cat() + (size_t)row * DM + 512 + col0) = w;
    }
}

__device__ __forceinline__ void ln_phase(const Ctx& F, const gf32* g, const gf32* b, gf32* xo, const gf32* modsl  , int which_sh) {
    for (int row = F.bid * 8 + F.wave; row < MROWS; row += F.G * 8) {
        const gf32* yp = F.ypre() + (size_t)row * DM + F.lane * 4;
        f32x4 v[8]; float s = 0.f;
#pragma unroll
        for (int j = 0; j < 8; ++j) { v[j] = *(const GAS f32x4*)(yp + 256 * j); s += (v[j][0] + v[j][1]) + (v[j][2] + v[j][3]); }
#pragma unroll
        for (int o = 1; o < 64; o <<= 1) s += __shfl_xor(s, o);
        const float mean = s * (1.0f / DM); float s2 = 0.f;
#pragma unroll
        for (int j = 0; j < 8; ++j) { v[j] = v[j] - mean; s2 += (v[j][0] * v[j][0] + v[j][1] * v[j][1]) + (v[j][2] * v[j][2] + v[j][3] * v[j][3]); }
#pragma unroll
        for (int o = 1; o < 64; o <<= 1) s2 += __shfl_xor(s2, o);
        const float rstd = 1.0f / sqrtf(s2 * (1.0f / DM) + 1e-5f);
        const int mod = mod_of_row(row);
        const gf32* sh = modsl ? modsl + ((size_t)mod * 6 + which_sh) * DM : nullptr;
#pragma unroll
        for (int j = 0; j < 8; ++j) { const int c = F.lane * 4 + 256 * j;
            const f32x4 x = v[j] * rstd * *(const GAS f32x4*)(g + c) + *(const GAS f32x4*)(b + c);
            *(GAS f32x4*)(xo + (size_t)row * DM + c) = x;
            if (modsl) { const f32x4 hh = x * (*(const GAS f32x4*)(sh + DM + c) + 1.0f) + *(const GAS f32x4*)(sh + c);
                v2u w; w.x = pk2(hh[0], hh[1]); w.y = pk2(hh[2], hh[3]); *(GAS v2u*)(F.hbuf() + (size_t)row * DM + c) = w; } }
    }
}

constexpr int PH_PER_LAYER = 10, N_PHASES = 2 + DEPTH * PH_PER_LAYER;
__global__ void __launch_bounds__(512, 2) fwd_kernel(Args args) {
    extern __shared__ __attribute__((aligned(16))) unsigned char lds_raw[];
    Ctx F;
    F.lds = (LAS unsigned char*)lds_raw;
    F.tid = threadIdx.x; F.lane = F.tid & 63; F.wave = __builtin_amdgcn_readfirstlane(F.tid >> 6); F.G = gridDim.x; F.bid = blockIdx.x;
    F.ap = &args; F.out = (gf32*)args.out; F.ws = (GAS unsigned char*)args.ws;
    volatile LAS unsigned* MISC = (volatile LAS unsigned*)(F.lds + MISC_OFF);
    for (int u = F.tid; u < (LDS_BYTES - LDSCTL_OFF) / 4; u += 512) ((LAS unsigned*)(F.lds + LDSCTL_OFF))[u] = 0u;
    __syncthreads();
    XcdBarrier bar; bar.bar = (unsigned*)(args.ws + WS_CTL) + CW_BAR; bar.x = 0; bar.st = nullptr;
    if (args.single) bar = xcd_barrier_post((unsigned*)(args.ws + WS_CTL) + CW_BAR, MISC + 8);
    const int lo = args.ph_lo, hi = args.ph_hi;
#define IN(k) (lo <= (k) && (k) < hi)
#define FRESH() do { int ln_ = (int)__builtin_amdgcn_mbcnt_hi(~0u, __builtin_amdgcn_mbcnt_lo(~0u, 0u)); asm volatile("" : "+v"(ln_)); F.lane = ln_; asm volatile("" : "+s"(F.wave)); F.tid = F.wave * 64 + F.lane; \
    asm volatile("" : "+s"(F.bid), "+s"(F.G)); asm volatile("" : "+s"(F.ws), "+s"(F.out)); } while (0)
#define SEAM(k) do { if (IN((k) + 1)) xcd_barrier(bar); } while (0)

    if (IN(0)) { FRESH(); p0_prologue(F); SEAM(0); }
    if (IN(1)) { FRESH(); p1_h0(F); SEAM(1); }
    for (int l = 0; l < DEPTH; ++l) {
        const int k0 = 2 + l * PH_PER_LAYER;
        FRESH();
        const gf32* xa = l == 0 ? F.inp(I_XP) : F.out + O_YP; const gf32* xb = l == 0 ? F.inp(I_XS) : F.out + O_YS;
        if (IN(k0 + 0)) {
            pg8::Gemm g{(const pg8::bf16_t*)F.hbuf(), (const pg8::bf16_t*)F.wT(l, WO_IN), MROWS, DIN, DM}; pg8::StaticOrder S; S.init(MROWS, DIN, F.G, F.bid);
            EpiStoreF32 E{F.proj(), DIN};
            pg8::gemm_phase<EpiStoreF32, pg8::StaticOrder, true, true>(F.lds, g, S, E, F.wave);
            SEAM(k0 + 0); }
        if (IN(k0 + 1)) { FRESH(); e1_postproj(F, l); SEAM(k0 + 1); }
        if (IN(k0 + 2)) { FRESH(); hp_states(F, l); SEAM(k0 + 2); }
        if (IN(k0 + 3)) { FRESH(); mx_mixers(F, l); SEAM(k0 + 3); }
        if (IN(k0 + 4)) { FRESH(); mg_merge(F, l); SEAM(k0 + 4); }
        if (IN(k0 + 5)) {
            pg8::Gemm g{(const pg8::bf16_t*)F.cat(), (const pg8::bf16_t*)F.wT(l, WO_OUT), MROWS, DM, DM}; pg8::StaticOrder S; S.init(MROWS, DM, F.G, F.bid);
            EpiResid E{xa, xb, F.mods() + ((size_t)l * 3 * 6 + 2) * DM, F.ypre()};
            pg8::gemm_phase<EpiResid, pg8::StaticOrder, true, true>(F.lds, g, S, E, F.wave);
            SEAM(k0 + 5); }
        if (IN(k0 + 6)) { FRESH(); ln_phase(F, F.inp(I_LN1G) + l * DM, F.inp(I_LN1B) + l * DM, F.x1(), F.mods() + (size_t)l * 3 * 6 * DM, 3); SEAM(k0 + 6); }
        if (IN(k0 + 7)) {
            pg8::Gemm g{(const pg8::bf16_t*)F.hbuf(), (const pg8::bf16_t*)F.wT(l, WO_GU), MROWS, DGU, DM}; pg8::StaticOrder S; S.init(MROWS, DGU, F.G, F.bid);
            EpiSwiGLU E{F.act()};
            pg8::gemm_phase<EpiSwiGLU, pg8::StaticOrder, true, true>(F.lds, g, S, E, F.wave);
            SEAM(k0 + 7); }
        if (IN(k0 + 8)) {
            pg8::Gemm g{(const pg8::bf16_t*)F.act(), (const pg8::bf16_t*)F.wT(l, WO_DN), MROWS, DM, DFF}; pg8::StaticOrder S; S.init(MROWS, DM, F.G, F.bid);
            EpiResid E{F.x1(), F.x1() + (size_t)R_CTX * DM, F.mods() + ((size_t)l * 3 * 6 + 5) * DM, F.ypre()};
            pg8::gemm_phase<EpiResid, pg8::StaticOrder, true, true>(F.lds, g, S, E, F.wave);
            SEAM(k0 + 8); }
        if (IN(k0 + 9)) { FRESH(); ln_phase(F, F.inp(I_LN2G) + l * DM, F.inp(I_LN2B) + l * DM, F.out + O_YP, l + 1 < DEPTH ? F.mods() + (size_t)(l + 1) * 3 * 6 * DM : nullptr, 0); SEAM(k0 + 9); }
    }
#undef IN
#undef SEAM
#undef FRESH
}

#ifndef MK_SINGLE
#define MK_SINGLE 1
#endif
extern "C" void kernel_launch(void* const* d_in, const int* in_sizes, int n_in, void* d_out, int out_size, void* d_ws, size_t ws_size, hipStream_t stream) {
    static int grid = 0;
    if (grid == 0) {
        if (n_in != 24 || out_size != (int)O_END || ws_size < WS_END) { fprintf(stderr, "kernel_launch: unexpected sizes n_in %d out %d ws %zu\n", n_in, out_size, ws_size); grid = -1; return; }
        int dev = 0, cus = 0, per_cu = 0;
        if (hipGetDevice(&dev) != hipSuccess || hipDeviceGetAttribute(&cus, hipDeviceAttributeMultiprocessorCount, dev) != hipSuccess) { grid = -1; return; }
        if (hipFuncSetAttribute((const void*)fwd_kernel, hipFuncAttributeMaxDynamicSharedMemorySize, LDS_BYTES) != hipSuccess) { fprintf(stderr, "kernel_launch: hipFuncSetAttribute failed\n"); grid = -1; return; }
        if (hipOccupancyMaxActiveBlocksPerMultiprocessor(&per_cu, (const void*)fwd_kernel, 512, LDS_BYTES) != hipSuccess || per_cu < 1) fprintf(stderr, "kernel_launch: occupancy query says %d\n", per_cu);
        (void)hipGetLastError();
        grid = cus;
    }
    if (grid < 0) return;
    (void)hipMemsetAsync((char*)d_ws + WS_CTL, 0, CTL_ZERO_BYTES, stream);
    Args a{};
    for (int i = 0; i < 24; ++i) a.in[i] = (const float*)d_in[i];
    a.out = (float*)d_out; a.ws = (unsigned char*)d_ws; a.pad = 0;
#if MK_SINGLE
    a.ph_lo = 0; a.ph_hi = N_PHASES; a.single = 1;
    hipLaunchKernelGGL(fwd_kernel, dim3(grid), dim3(512), LDS_BYTES, stream, a);
#else
    a.single = 0;
    for (int p = 0; p < N_PHASES; ++p) { a.ph_lo = p; a.ph_hi = p + 1; hipLaunchKernelGGL(fwd_kernel, dim3(grid), dim3(512), LDS_BYTES, stream, a);
#ifdef PROBE_REP_MASK
        const int ty = p == 0 ? 10 : (p == 1 ? 11 : (p - 2) % PH_PER_LAYER);
        if ((PROBE_REP_MASK >> ty) & 1) for (int r = 0; r < PROBE_REP_N; ++r) hipLaunchKernelGGL(fwd_kernel, dim3(grid), dim3(512), LDS_BYTES, stream, a);
#endif
    }
#endif
}
```

```cpp
#include <hip/hip_runtime.h>
#include <cstdio>
#include <cstdint>
namespace pg8 {
#define PG8_LAS __attribute__((address_space(3)))
typedef unsigned short bf16_t;
typedef short bf16x8 __attribute__((ext_vector_type(8)));
typedef float f32x4 __attribute__((ext_vector_type(4)));
typedef unsigned u32x4 __attribute__((ext_vector_type(4)));
constexpr int BM = 256, BK = 64, HALF = 128, HTB = HALF * BK * 2  , STAGE_BYTES = 8 * HTB, NXCD = 8, WGM = 8;

__host__ __device__ __forceinline__ int lds_byte(int r, int c) { const int st = (r >> 4) * 2 + (c >> 5), rr = r & 15, cc = c & 31, ob = rr * 64 + cc * 2; return st * 1024 + (ob ^ (((ob >> 9) & 1) << 5)); }
__host__ __device__ __forceinline__ void stage_rc(int b, int& R, int& C) { const int st = b / 1024, sb = b % 1024, swz = sb ^ (((sb >> 9) & 1) << 5); R = (st >> 1) * 16 + swz / 64; C = (st & 1) * 32 + (swz % 64) / 2; }
__host__ __device__ __forceinline__ int perm32(int rho) { const int n = rho >> 4, i = rho & 15; return 8 * (i >> 2) + 4 * n + (i & 3); }

struct Unit { int pm, pn; };
struct Gemm { const bf16_t* A; const bf16_t* Bt; int M, N, K, ld; };

struct StaticOrder {
    int nM, nN, nwg, G, c;
    __host__ __device__ void init(int M, int N, int G_, int c_) { nM = M / BM; nN = N / BM; nwg = nM * nN; G = G_; c = c_; }
    __host__ __device__ bool next(int i, Unit& u) const {
        const long L = (long)i * G + c; if (L >= nwg) return false;
        int wgid = (int)L; { const int q = nwg / NXCD, r = nwg % NXCD, xcd = wgid % NXCD, off = wgid / NXCD; wgid = (xcd < r ? xcd * (q + 1) : r * (q + 1) + (xcd - r) * q) + off; }
        const int nig = WGM * nN, gid = wgid / nig, fm = gid * WGM, gsz = (nM - fm) < WGM ? (nM - fm) : WGM;
        u.pm = fm + ((wgid % nig) % gsz); u.pn = (wgid % nig) / gsz; return true;
    }
    __device__ __forceinline__ void a_ready(const Unit&) const {}
    __device__ __forceinline__ void done(const Unit&) const {}
};
__device__ __forceinline__ unsigned cvt_pk_bf16(float lo, float hi) { unsigned r; asm volatile("v_cvt_pk_bf16_f32 %0, %1, %2" : "=v"(r) : "v"(lo), "v"(hi)); return r; }
typedef float f32x2 __attribute__((ext_vector_type(2)));
template <class Epi, class Sched, bool ALIGN_EPI = false, bool SP2 = false>
__device__ __forceinline__ void gemm_phase(PG8_LAS unsigned char* lds, const Gemm g, const Sched& S, const Epi& E, int wid_in) {
    int lane_ = (int)__builtin_amdgcn_mbcnt_hi(~0u, __builtin_amdgcn_mbcnt_lo(~0u, 0u)); asm volatile("" : "+v"(lane_)); asm volatile("" : "+s"(wid_in));
    const int wid = wid_in, lane = lane_, tid = wid * 64 + lane, wr = wid >> 2, wc = wid & 3, fr = lane & 15, fq = lane >> 4;
    const int K = g.K, nt = K / BK, LD = g.ld;
    unsigned voffA[2], voffB[2];
#pragma unroll
    for (int i = 0; i < 2; ++i) { int R, C; stage_rc(tid * 16 + i * 8192, R, C); const int Rb = Epi::PERM ? ((R & ~31) + perm32(R & 31)) : R;
        voffA[i] = (unsigned)(R * LD + C) * 2u; voffB[i] = (unsigned)(Rb * LD + C) * 2u; }
    const size_t kstep = (size_t)(BK * 2);
    const size_t hstep = (size_t)HALF * LD * 2;
    const size_t tstep = 2 * hstep;
    const unsigned ldsw = (unsigned)wid * 1024u;
    const int aoff = lds_byte(wr * 64 + fr, fq * 8), boff = lds_byte(wc * 32 + fr, fq * 8);
#define PG8_SA(b, h) (((b) * 2 + (h)) * HTB)
#define PG8_SB(b, h) ((4 + (b) * 2 + (h)) * HTB)
#define PG8_STAGE(bufoff, gbase, voff) do { _Pragma("unroll") for (int _i = 0; _i < 2; ++_i) \
        __builtin_amdgcn_global_load_lds((const unsigned*)((const char*)(gbase) + (voff)[_i]), (PG8_LAS unsigned*)(lds + (bufoff) + ldsw + _i * 8192), 16, 0, 0); } while (0)
#define PG8_LDA(dst, b, h) do { _Pragma("unroll") for (int m = 0; m < 4; ++m) _Pragma("unroll") for (int k = 0; k < 2; ++k) dst[m][k] = *(const PG8_LAS bf16x8*)(lds + PG8_SA(b, h) + aoff + m * 2048 + k * 1024); } while (0)
#define PG8_LDB(dst, b, h) do { _Pragma("unroll") for (int n = 0; n < 2; ++n) _Pragma("unroll") for (int k = 0; k < 2; ++k) dst[n][k] = *(const PG8_LAS bf16x8*)(lds + PG8_SB(b, h) + boff + n * 2048 + k * 1024); } while (0)
#define PG8_MMA(ai, bj, At, Bt) do { __builtin_amdgcn_s_setprio(1); _Pragma("unroll") for (int m = 0; m < 4; ++m) _Pragma("unroll") for (int n = 0; n < 2; ++n) _Pragma("unroll") for (int k = 0; k < 2; ++k) \
        acc[ai][bj][m][n] = __builtin_amdgcn_mfma_f32_16x16x32_bf16(Bt[n][k], At[m][k], acc[ai][bj][m][n], 0, 0, 0); __builtin_amdgcn_s_setprio(0); } while (0)
#define PG8_WAIT_V(n) asm volatile("s_waitcnt vmcnt(" #n ")" ::: "memory")
#define PG8_WAIT_L(n) asm volatile("s_waitcnt lgkmcnt(" #n ")" ::: "memory")
#define PG8_BAR __builtin_amdgcn_s_barrier()
#define PG8_SCHED __builtin_amdgcn_sched_barrier(0)
    Unit cur, nxt; int ui = 0;
    if (!S.next(0, cur)) return;
    f32x4 acc[2][2][4][2];
#pragma unroll
    for (int a = 0; a < 2; ++a)
#pragma unroll
        for (int b = 0; b < 2; ++b)
#pragma unroll
            for (int m = 0; m < 4; ++m)
#pragma unroll
                for (int n = 0; n < 2; ++n) acc[a][b][m][n] = (f32x4){0.f, 0.f, 0.f, 0.f};
    bf16x8 At[4][2], B0[2][2], B1[2][2];
    const char* cA = (const char*)g.A + (size_t)cur.pm * tstep; const char* cB = (const char*)g.Bt + (size_t)cur.pn * tstep;
    S.a_ready(cur);
    if constexpr (SP2) {
        PG8_STAGE(PG8_SB(0, 0), cB, voffB); PG8_STAGE(PG8_SB(0, 1), cB + hstep, voffB); PG8_STAGE(PG8_SA(0, 0), cA, voffA); PG8_STAGE(PG8_SA(0, 1), cA + hstep, voffA);
        if (wr == 1) PG8_BAR;
        PG8_WAIT_V(2); PG8_BAR;
        PG8_STAGE(PG8_SB(1, 0), cB + kstep, voffB); PG8_STAGE(PG8_SA(1, 0), cA + kstep, voffA); PG8_STAGE(PG8_SB(1, 1), cB + hstep + kstep, voffB);
        PG8_WAIT_V(6); PG8_BAR;
    } else {
        PG8_STAGE(PG8_SB(0, 0), cB, voffB); PG8_STAGE(PG8_SA(0, 0), cA, voffA); PG8_STAGE(PG8_SB(0, 1), cB + hstep, voffB); PG8_STAGE(PG8_SA(0, 1), cA + hstep, voffA);
        if (wr == 1) PG8_BAR;
        PG8_WAIT_V(4); PG8_BAR;
        PG8_STAGE(PG8_SB(1, 0), cB + kstep, voffB); PG8_STAGE(PG8_SA(1, 0), cA + kstep, voffA); PG8_STAGE(PG8_SB(1, 1), cB + hstep + kstep, voffB);
        PG8_WAIT_V(6); PG8_BAR;
    }
    for (;;) {
        const bool has_next = S.next(ui + 1, nxt);
        const char* nA = has_next ? (const char*)g.A + (size_t)nxt.pm * tstep : cA; const char* nB = has_next ? (const char*)g.Bt + (size_t)nxt.pn * tstep : cB;
        for (int t = 0; t < nt; t += 2) {
            const bool last = (t == nt - 2);
            const char* a1 = cA + (size_t)(t + 1) * kstep;
            const char* a2 = last ? nA : cA + (size_t)(t + 2) * kstep; const char* b2 = last ? nB : cB + (size_t)(t + 2) * kstep;
            const char* a3 = a2 + kstep; const char* b3 = b2 + kstep;
            if (last && has_next) S.a_ready(nxt);
            if constexpr (SP2) {
            PG8_LDB(B0, 0, 0); PG8_LDB(B1, 0, 1); PG8_SCHED; PG8_LDA(At, 0, 0); PG8_STAGE(PG8_SA(1, 1), a1 + hstep, voffA);
            PG8_WAIT_V(8); PG8_WAIT_L(0); PG8_BAR; PG8_MMA(0, 0, At, B0); PG8_MMA(0, 1, At, B1); PG8_BAR; PG8_SCHED;
            PG8_LDA(At, 0, 1); PG8_STAGE(PG8_SB(0, 0), b2, voffB); PG8_STAGE(PG8_SB(0, 1), b2 + hstep, voffB); PG8_STAGE(PG8_SA(0, 0), a2, voffA);
            PG8_WAIT_V(8); PG8_WAIT_L(0); PG8_BAR; PG8_MMA(1, 0, At, B0); PG8_MMA(1, 1, At, B1); PG8_BAR; PG8_SCHED;
            PG8_LDB(B0, 1, 0); PG8_LDB(B1, 1, 1); PG8_SCHED; PG8_LDA(At, 1, 0); PG8_STAGE(PG8_SA(0, 1), a2 + hstep, voffA);
            PG8_WAIT_V(8); PG8_WAIT_L(0); PG8_BAR; PG8_MMA(0, 0, At, B0); PG8_MMA(0, 1, At, B1); PG8_BAR; PG8_SCHED;
            PG8_LDA(At, 1, 1); PG8_STAGE(PG8_SB(1, 0), b3, voffB); PG8_STAGE(PG8_SB(1, 1), b3 + hstep, voffB); PG8_STAGE(PG8_SA(1, 0), a3, voffA);
            PG8_WAIT_V(8); PG8_WAIT_L(0); PG8_BAR; PG8_MMA(1, 0, At, B0); PG8_MMA(1, 1, At, B1); PG8_BAR; PG8_SCHED;
            } else {
            PG8_LDB(B0, 0, 0); PG8_SCHED; PG8_LDA(At, 0, 0); PG8_STAGE(PG8_SA(1, 1), a1 + hstep, voffA);
            PG8_WAIT_L(8); PG8_BAR; PG8_WAIT_L(0); PG8_MMA(0, 0, At, B0); PG8_BAR; PG8_SCHED;
            PG8_LDB(B1, 0, 1); PG8_STAGE(PG8_SB(0, 0), b2, voffB);
            PG8_BAR; PG8_WAIT_L(0); PG8_MMA(0, 1, At, B1); PG8_BAR;
            PG8_LDA(At, 0, 1); PG8_STAGE(PG8_SA(0, 0), a2, voffA);
            PG8_BAR; PG8_WAIT_L(0); PG8_MMA(1, 0, At, B0); PG8_BAR; PG8_SCHED;
            PG8_STAGE(PG8_SB(0, 1), b2 + hstep, voffB);
            PG8_WAIT_V(6); PG8_BAR; PG8_MMA(1, 1, At, B1); PG8_BAR;
            PG8_LDB(B0, 1, 0); PG8_SCHED; PG8_LDA(At, 1, 0); PG8_STAGE(PG8_SA(0, 1), a2 + hstep, voffA);
            PG8_WAIT_L(8); PG8_BAR; PG8_WAIT_L(0); PG8_MMA(0, 0, At, B0); PG8_BAR; PG8_SCHED;
            PG8_LDB(B1, 1, 1); PG8_STAGE(PG8_SB(1, 0), b3, voffB);
            PG8_BAR; PG8_WAIT_L(0); PG8_MMA(0, 1, At, B1); PG8_BAR;
            PG8_LDA(At, 1, 1); PG8_STAGE(PG8_SA(1, 0), a3, voffA);
            PG8_BAR; PG8_WAIT_L(0); PG8_MMA(1, 0, At, B0); PG8_BAR; PG8_SCHED;
            PG8_STAGE(PG8_SB(1, 1), b3 + hstep, voffB);
            PG8_WAIT_V(6); PG8_BAR; PG8_MMA(1, 1, At, B1); PG8_BAR;
            }
        }
        if constexpr (ALIGN_EPI) { if (wr == 0) PG8_BAR; }
        if constexpr (!Epi::AFTER_DRAIN) { E(acc, cur, wr, wc, fr, fq); S.done(cur); }
        if (!has_next) break;
#pragma unroll
        for (int a = 0; a < 2; ++a)
#pragma unroll
            for (int b = 0; b < 2; ++b)
#pragma unroll
                for (int m = 0; m < 4; ++m)
#pragma unroll
                    for (int n = 0; n < 2; ++n) acc[a][b][m][n] = (f32x4){0.f, 0.f, 0.f, 0.f};
        cur = nxt; cA = nA; cB = nB; ++ui;
        if constexpr (ALIGN_EPI) { if (wr == 1) PG8_BAR; }
    }
    PG8_WAIT_V(0);
    if constexpr (!ALIGN_EPI) { if (wr == 0) PG8_BAR; }
    PG8_BAR;
    if constexpr (Epi::AFTER_DRAIN) { E.fused(acc, cur, wr, wc, fr, fq, lds, wid, lane); S.done(cur); }
#undef PG8_SA
#undef PG8_SB
#undef PG8_STAGE
#undef PG8_LDA
#undef PG8_LDB
#undef PG8_MMA
#undef PG8_WAIT_V
#undef PG8_WAIT_L
#undef PG8_BAR
#undef PG8_SCHED
}
}
#define GAS __attribute__((address_space(1)))
#define LAS __attribute__((address_space(3)))
typedef unsigned short bf16;
typedef unsigned v4u __attribute__((ext_vector_type(4)));
typedef float f32x4 __attribute__((ext_vector_type(4)));
typedef short bf16x8 __attribute__((ext_vector_type(8)));
typedef GAS unsigned gu32;
typedef GAS unsigned long long gu64;
#define RLX_AGENT __ATOMIC_RELAXED, __HIP_MEMORY_SCOPE_AGENT
#define LDS_WAIT() asm volatile("s_waitcnt lgkmcnt(0)" ::: "memory")
#define VM_WAIT() asm volatile("s_waitcnt vmcnt(0)" ::: "memory")
__device__ __forceinline__ unsigned long long rt() { return __builtin_amdgcn_s_memrealtime(); }
__device__ __forceinline__ unsigned f2bf(float f) { unsigned u = __builtin_bit_cast(unsigned, f); return (u + 0x7fffu + ((u >> 16) & 1u)) >> 16; }
__device__ __forceinline__ unsigned pk2(float lo, float hi) { return f2bf(lo) | (f2bf(hi) << 16); }
#define XB_TMO      128
#define XB_XCNT(j)  (256  + 64 * (j))
#define XB_XSUB(j)  (1280 + 64 * (j))
#define XB_XGEN(j)  (2304 + 64 * (j))
#define XB_TOP      3328
#define XB_TOPGEN   3392
#define XCD_BAR_WORDS 3456
#define XB_SPIN_CAP (1u << 24)

__device__ __forceinline__ unsigned xb_ld(unsigned* p)              { return __hip_atomic_load(p, __ATOMIC_RELAXED, __HIP_MEMORY_SCOPE_AGENT); }
__device__ __forceinline__ unsigned xb_add(unsigned* p, unsigned v) { return __hip_atomic_fetch_add(p, v, __ATOMIC_RELAXED, __HIP_MEMORY_SCOPE_AGENT); }
__device__ __forceinline__ unsigned xb_xcc_id() { return (unsigned)__builtin_amdgcn_s_getreg((3 << 11) | 20) & 0xFu; }
#define XB_SPIN(cond, bar) do { unsigned _sp = 0; while (cond) { __builtin_amdgcn_s_sleep(1); \
    if ((++_sp & 255u) == 0u) { if (xb_ld(&(bar)[XB_TMO])) break; if (_sp > XB_SPIN_CAP) { atomicAdd(&(bar)[XB_TMO], 1u); break; } } } } while (0)

struct XcdBarrier {
    unsigned* bar; unsigned x;
    volatile LAS unsigned* st;
};

__device__ __forceinline__ XcdBarrier xcd_barrier_post(unsigned* bar, volatile LAS unsigned* st) {
    XcdBarrier b; b.bar = bar; b.x = xb_xcc_id(); b.st = st;
    if (threadIdx.x == 0) (void)xb_add(&bar[XB_XCNT(b.x)], 1u);
    return b;
}
__device__ __forceinline__ void xcd_barrier_complete(unsigned* bar, unsigned x, unsigned& nloc, unsigned& nx) {
    const unsigned G = gridDim.x * gridDim.y * gridDim.z;
    unsigned sum, cnt, mine, sp = 0u;
    for (;;) {
        sum = 0u; cnt = 0u; mine = 0u;
#pragma unroll
        for (unsigned j = 0; j < 16; ++j) { const unsigned c = xb_ld(&bar[XB_XCNT(j)]); sum += c; cnt += (c > 0u) ? 1u : 0u; mine = (j == x) ? c : mine; }
        if (sum == G) break;
        __builtin_amdgcn_s_sleep(1);
        if ((++sp & 255u) == 0u) { if (xb_ld(&bar[XB_TMO])) break; if (sp > XB_SPIN_CAP) { atomicAdd(&bar[XB_TMO], 1u); break; } }
    }
    nloc = mine > 0u ? mine : 1u; nx = cnt > 0u ? cnt : 1u;
}

__device__ __forceinline__ void xcd_barrier(const XcdBarrier& b) {
    asm volatile("s_waitcnt vmcnt(0)" ::: "memory");
    __syncthreads();
    if (threadIdx.x == 0) {
        unsigned* bar = b.bar;
        __builtin_amdgcn_s_waitcnt(0);
        unsigned nloc = b.st[0], nx = b.st[1];
        if (nloc == 0u) { xcd_barrier_complete(bar, b.x, nloc, nx); b.st[0] = nloc; b.st[1] = nx; }
        const unsigned old = xb_add(&bar[XB_XSUB(b.x)], 1u);
        const unsigned gen = old / nloc;
        if (old + 1u == (gen + 1u) * nloc) {
            __builtin_amdgcn_fence(__ATOMIC_RELEASE, "agent");
            asm volatile("s_waitcnt vmcnt(0)" ::: "memory");
            const unsigned og = xb_add(&bar[XB_TOP], 1u);
            const unsigned tg = og / nx;
            if (og + 1u == (tg + 1u) * nx) xb_add(&bar[XB_TOPGEN], 1u);
            else XB_SPIN(xb_ld(&bar[XB_TOPGEN]) == tg, bar);
            __builtin_amdgcn_fence(__ATOMIC_ACQUIRE, "agent");
            xb_add(&bar[XB_XGEN(b.x)], 1u);
            asm volatile("s_waitcnt vmcnt(0)" ::: "memory");
        } else {
            XB_SPIN(xb_ld(&bar[XB_XGEN(b.x)]) == gen, bar);
            __builtin_amdgcn_fence(__ATOMIC_ACQUIRE, "agent");
            asm volatile("s_waitcnt vmcnt(0)" ::: "memory");
        }
    }
    __syncthreads();
}

constexpr int DM = 2048;
constexpr int NB_CTX = 16, S_CTX = 256, NB_LAT = 2, S_LAT = 4096, DEPTH = 4;
constexpr int R_CTX = NB_CTX * S_CTX;
constexpr int R_LAT = NB_LAT * S_LAT;
constexpr int MROWS = R_CTX + R_LAT;
constexpr int DIN = 5632, DFF = 5632, DGU = 2 * DFF;
constexpr float ALPHA = 1.6817928305074292f;
constexpr int C_AQ = 0, C_AK = 512, C_AV = 1024, C_BQ = 1536, C_BF = 2048, C_BB = 2560, C_BI = 3072, C_BG = 3584, C_CQ = 4096, C_CK = 5120, C_CV = 5376;
constexpr size_t O_YP = 0, O_YS = 8388608, O_DK = 25165824, O_DV = 33554432, O_SK = 41943040, O_SV = 46137344, O_ST = 50331648, O_END = 58720256;

constexpr size_t MiB = 1u << 20;
constexpr size_t WS_CTL = 0, CTL_ZERO_BYTES = 1 * MiB;
constexpr size_t WS_MODS = 1 * MiB;
constexpr size_t WS_MISC = 2 * MiB;
constexpr size_t WS_W = 4 * MiB, W_LAYER = 96 * MiB;
constexpr size_t WO_IN = 0, WO_OUT = 22 * MiB, WO_GU = 30 * MiB, WO_DN = 74 * MiB;
constexpr size_t WS_H = 388 * MiB;
constexpr size_t WS_CAT = 436 * MiB;
constexpr size_t WS_X1 = 484 * MiB;
constexpr size_t WS_OA = 580 * MiB, WS_OBF = 604 * MiB, WS_OBB = 628 * MiB;
constexpr size_t WS_P = 652 * MiB;
constexpr size_t WS_ACT = WS_P, WS_YPRE = WS_P + 132 * MiB;
constexpr size_t WS_C16 = 916 * MiB;
constexpr size_t WS_QKV = 922 * MiB;
constexpr int QKV_LD = 3072, Q_QD = 0, Q_KD = 512, Q_VD = 1024, Q_QS = 1536, Q_KS = 2560, Q_VS = 2816;
constexpr size_t WS_HQ = 994 * MiB;
constexpr size_t WS_HKM = 1018 * MiB;
constexpr size_t WS_HKP = 1042 * MiB;
constexpr size_t WS_HVT = 1066 * MiB;
constexpr size_t WS_HDEC = 1090 * MiB;
constexpr size_t WS_SLOC = 1094 * MiB;
constexpr size_t WS_DSEG = 1110 * MiB;
constexpr size_t WS_YPRE2 = 1111 * MiB;
constexpr size_t WS_END = 1143 * MiB;

constexpr int CW_BAR = 4096;

constexpr int RING_BYTES = 131072;
constexpr int LDSCTL_OFF = RING_BYTES, MISC_OFF = LDSCTL_OFF + 320;
constexpr int LDS_BYTES = 147456;

typedef unsigned v2u __attribute__((ext_vector_type(2)));
typedef GAS float gf32;
typedef GAS unsigned short gbf16;

__device__ __forceinline__ float silu_f(float a) { return a / (1.0f + __expf(-a)); }
__device__ __forceinline__ int mod_of_row(int row) { return row < R_CTX ? 0 : (row < R_CTX + S_LAT ? 1 : 2); }

struct EpiStoreF32 {
    static constexpr bool PERM = false, AFTER_DRAIN = false;
    gf32* C; int ldc;
    __device__ __forceinline__ void operator()(const pg8::f32x4 (&acc)[2][2][4][2], const pg8::Unit& u, int wr, int wc, int fr, int fq) const {
        const int row0 = u.pm * 256 + wr * 64 + fr, col0 = u.pn * 256 + wc * 32 + 4 * fq;
#pragma unroll
        for (int ai = 0; ai < 2; ++ai)
#pragma unroll
            for (int m = 0; m < 4; ++m) { gf32* rowp = C + (size_t)(row0 + ai * 128 + m * 16) * ldc + col0;
#pragma unroll
                for (int bj = 0; bj < 2; ++bj)
#pragma unroll
                    for (int n = 0; n < 2; ++n) *(GAS pg8::f32x4*)(rowp + bj * 128 + n * 16) = acc[ai][bj][m][n]; }
    }
};
struct EpiResid {
    static constexpr bool PERM = false, AFTER_DRAIN = false;
    const gf32* xa; const gf32* xb;
    const gf32* gates;
    gf32* out; int pm_off; int gate_only;
    __device__ __forceinline__ void operator()(const pg8::f32x4 (&acc)[2][2][4][2], const pg8::Unit& u, int wr, int wc, int fr, int fq) const {
        const int pm = u.pm + pm_off, mod = pm >> 4;
        const gf32* xbase = (pm < 16) ? xa + (size_t)pm * 256 * DM : xb + (size_t)(pm - 16) * 256 * DM;
        const int r0 = wr * 64 + fr, col0 = u.pn * 256 + wc * 32 + 4 * fq;
        pg8::f32x4 gv[2][2];
#pragma unroll
        for (int bj = 0; bj < 2; ++bj)
#pragma unroll
            for (int n = 0; n < 2; ++n) gv[bj][n] = *(const GAS pg8::f32x4*)(gates + (size_t)mod * 6 * DM + col0 + bj * 128 + n * 16);
#pragma unroll
        for (int ai = 0; ai < 2; ++ai)
#pragma unroll
            for (int m = 0; m < 4; ++m) { const int r = r0 + ai * 128 + m * 16;
                const gf32* xp = xbase + (size_t)r * DM + col0; gf32* op = out + ((size_t)(gate_only ? u.pm : pm) * 256 + r) * DM + col0;
#pragma unroll
                for (int bj = 0; bj < 2; ++bj)
#pragma unroll
                    for (int n = 0; n < 2; ++n) { pg8::f32x4 v = gv[bj][n] * acc[ai][bj][m][n];
                        if (!gate_only) v += *(const GAS pg8::f32x4*)(xp + bj * 128 + n * 16) * ALPHA;
                        *(GAS pg8::f32x4*)(op + bj * 128 + n * 16) = v; } }
    }
};
struct EpiSwiGLU {
    static constexpr bool PERM = true, AFTER_DRAIN = false;
    gbf16* act;
    __device__ __forceinline__ void operator()(const pg8::f32x4 (&acc)[2][2][4][2], const pg8::Unit& u, int wr, int wc, int fr, int fq) const {
        const int row0 = u.pm * 256 + wr * 64 + fr, col0 = u.pn * 128 + wc * 32 + 8 * fq;
#pragma unroll
        for (int ai = 0; ai < 2; ++ai)
#pragma unroll
            for (int m = 0; m < 4; ++m) { gbf16* rowp = act + (size_t)(row0 + ai * 128 + m * 16) * DFF + col0;
                float r[8];
#pragma unroll
                for (int n = 0; n < 2; ++n)
#pragma unroll
                    for (int j = 0; j < 4; ++j) { const float g = acc[ai][0][m][n][j], up = acc[ai][1][m][n][j]; r[n * 4 + j] = silu_f(g) * up; }
                pg8::u32x4 w; w.x = pg8::cvt_pk_bf16(r[0], r[1]); w.y = pg8::cvt_pk_bf16(r[2], r[3]); w.z = pg8::cvt_pk_bf16(r[4], r[5]); w.w = pg8::cvt_pk_bf16(r[6], r[7]);
                *(GAS pg8::u32x4*)rowp = w; }
    }
};

struct Args { const float* in[24]; float* out; unsigned char* ws; int ph_lo, ph_hi, single, pad; };
enum { I_XP = 0, I_XS, I_CDK, I_CDV, I_CSK, I_CSV, I_ST, I_C, I_CCTX, I_WMOD, I_BMOD, I_WIN, I_WOUT, I_DLAM, I_DNG, I_LBL, I_HNG, I_SINK, I_LN1G, I_LN1B, I_LN2G, I_LN2B, I_WGU, I_WDN };

struct Ctx {
    LAS unsigned char* lds; int tid, lane, wave, G, bid;
    const Args* ap; gf32* out; GAS unsigned char* ws;
    __device__ __forceinline__ const gf32* inp(int i) const { return (const gf32*)ap->in[i]; }
    __device__ __forceinline__ gf32* mods() const { return (gf32*)(ws + WS_MODS); }
    __device__ __forceinline__ gf32* lball() const { return (gf32*)(ws + WS_MISC); }
    __device__ __forceinline__ gf32* lamv() const { return (gf32*)(ws + WS_MISC + 16384); }
    __device__ __forceinline__ gf32* tabD() const { return (gf32*)(ws + WS_MISC + 20480); }
    __device__ __forceinline__ gf32* tabS() const { return (gf32*)(ws + WS_MISC + 32768); }
    __device__ __forceinline__ gbf16* wT(int l, size_t off) const { return (gbf16*)(ws + WS_W + (size_t)l * W_LAYER + off); }
    __device__ __forceinline__ gbf16* hbuf() const { return (gbf16*)(ws + WS_H); }
    __device__ __forceinline__ gbf16* cat() const { return (gbf16*)(ws + WS_CAT); }
    __device__ __forceinline__ gf32* x1() const { return (gf32*)(ws + WS_X1); }
    __device__ __forceinline__ gf32* oa() const { return (gf32*)(ws + WS_OA); }
    __device__ __forceinline__ gf32* obf() const { return (gf32*)(ws + WS_OBF); }
    __device__ __forceinline__ gf32* obb() const { return (gf32*)(ws + WS_OBB); }
    __device__ __forceinline__ gf32* proj() const { return (gf32*)(ws + WS_P); }
    __device__ __forceinline__ gbf16* act() const { return (gbf16*)(ws + WS_ACT); }
    __device__ __forceinline__ gf32* ypre() const { return (gf32*)(ws + WS_YPRE); }
    __device__ __forceinline__ gf32* ypre2() const { return (gf32*)(ws + WS_YPRE2); }
    __device__ __forceinline__ gbf16* qkv() const { return (gbf16*)(ws + WS_QKV); }
    __device__ __forceinline__ gbf16* hq(int dir) const { return (gbf16*)(ws + WS_HQ) + (size_t)dir * MROWS * 512; }
    __device__ __forceinline__ gbf16* hkm(int dir) const { return (gbf16*)(ws + WS_HKM) + (size_t)dir * MROWS * 512; }
    __device__ __forceinline__ gbf16* hkp(int dir) const { return (gbf16*)(ws + WS_HKP) + (size_t)dir * 768 * 512 * 16; }
    __device__ __forceinline__ gbf16* hvt(int dir) const { return (gbf16*)(ws + WS_HVT) + (size_t)dir * 768 * 512 * 16; }
    __device__ __forceinline__ gf32* sloc() const { return (gf32*)(ws + WS_SLOC); }
    __device__ __forceinline__ gf32* dseg() const { return (gf32*)(ws + WS_DSEG); }
    __device__ __forceinline__ gf32* hdec(int dir) const { return (gf32*)(ws + WS_HDEC) + (size_t)dir * 768 * 512; }
    __device__ __forceinline__ gbf16* c16(size_t off) const { return (gbf16*)(ws + WS_C16 + off); }
};

__device__ __forceinline__ void transpose_item(const gf32* W, int K, int N, gbf16* WT, int k0, int n0, int drow0, LAS float* scr, int lane) {
#pragma unroll 8
    for (int i = 0; i < 32; ++i) { const int kk = 2 * i + (lane >> 5); scr[kk * 33 + (lane & 31)] = W[(size_t)(k0 + kk) * N + n0 + (lane & 31)]; }
    LDS_WAIT(); asm volatile("" ::: "memory");
    const int c = lane & 7;
#pragma unroll
    for (int j = 0; j < 4; ++j) { const int n = (lane >> 3) + 8 * j; const LAS float* s = scr + (8 * c) * 33 + n;
        v4u o; o.x = pk2(s[0 * 33], s[1 * 33]); o.y = pk2(s[2 * 33], s[3 * 33]); o.z = pk2(s[4 * 33], s[5 * 33]); o.w = pk2(s[6 * 33], s[7 * 33]);
        *(GAS v4u*)(WT + (size_t)(drow0 + n) * K + k0 + 8 * c) = o; }
    LDS_WAIT(); asm volatile("" ::: "memory");
}

__device__ __forceinline__ void p0_prologue(const Ctx& F) {
    {
        LAS float* sc = (LAS float*)F.lds;
        LAS float* red = (LAS float*)(F.lds + 24576);
        const gf32* c_ctx = F.inp(I_CCTX); const gf32* cc = F.inp(I_C);
        for (int i = F.tid; i < 3 * DM; i += 512) { const int mid = i / DM, k = i % DM; const float c = mid == 0 ? c_ctx[k] : cc[(mid - 1) * DM + k]; sc[i] = silu_f(c); }
        __syncthreads();
        for (int task = F.bid; task < DEPTH * 48; task += F.G) {
            const int l = task / 48, cb = task % 48, w = F.wave;
            const gf32* wp = F.inp(I_WMOD) + ((size_t)l * DM + 256 * w) * (6 * DM) + cb * 256 + F.lane * 4;
            f32x4 a0 = {0.f, 0.f, 0.f, 0.f}, a1 = a0, a2 = a0;
#pragma unroll 8
            for (int kk = 0; kk < 256; ++kk) { const f32x4 wv = *(const GAS f32x4*)(wp + (size_t)kk * (6 * DM));
                a0 += wv * sc[256 * w + kk]; a1 += wv * sc[DM + 256 * w + kk]; a2 += wv * sc[2 * DM + 256 * w + kk]; }
            *(LAS f32x4*)(red + (w * 3 + 0) * 256 + F.lane * 4) = a0; *(LAS f32x4*)(red + (w * 3 + 1) * 256 + F.lane * 4) = a1; *(LAS f32x4*)(red + (w * 3 + 2) * 256 + F.lane * 4) = a2;
            __syncthreads();
            for (int i = F.tid; i < 768; i += 512) { const int m = i >> 8, c = i & 255; float s = 0.f;
#pragma unroll
                for (int ww = 0; ww < 8; ++ww) s += red[(ww * 3 + m) * 256 + c];
                F.mods()[((size_t)l * 3 + m) * (6 * DM) + cb * 256 + c] = s + F.inp(I_BMOD)[(size_t)l * 6 * DM + cb * 256 + c]; }
            __syncthreads();
        }
    }
    if (F.bid == F.G - 1) {
        const gf32* lbl = F.inp(I_LBL);
        for (int i = F.tid; i < 1024; i += 512) { float lg[4], mx = -1e30f;
#pragma unroll
            for (int l = 0; l < 4; ++l) { lg[l] = lbl[l * 1024 + i]; mx = fmaxf(mx, lg[l]); }
            float s = 0.f;
#pragma unroll
            for (int l = 0; l < 4; ++l) { lg[l] = expf(lg[l] - mx); s += lg[l]; }
            const float w1 = lg[1] / s, w2 = lg[2] / s, w3 = lg[3] / s;
            F.lball()[0 * 1024 + i] = 0.f; F.lball()[1 * 1024 + i] = w1; F.lball()[2 * 1024 + i] = w1 + w2; F.lball()[3 * 1024 + i] = w1 + w2 + w3; }
        if (F.tid < 4) { const int l = F.tid; const gf32* lp = F.inp(I_DLAM) + l * 256; float s1 = 0.f, s2 = 0.f;
            for (int i = 0; i < 64; ++i) { s1 += lp[i] * lp[64 + i]; s2 += lp[128 + i] * lp[192 + i]; }
            const float li = 0.8f - 0.6f * expf(-0.3f * (float)l);
            F.lamv()[l * 2] = expf(s1) - expf(s2) + li; F.lamv()[l * 2 + 1] = li; }
        for (int i = F.tid; i < 64 * 16; i += 512) { const int pos = i / 16, j = i % 16; const float inv = powf(10000.f, -(float)j / 16.f), ang = (float)pos * inv; F.tabD()[i * 2] = cosf(ang); F.tabD()[i * 2 + 1] = sinf(ang); }
        for (int i = F.tid; i < 64 * 32; i += 512) { const int pos = i / 32, j = i % 32; const float inv = powf(10000.f, -(float)j / 32.f), ang = (float)pos * inv; F.tabS()[i * 2] = cosf(ang); F.tabS()[i * 2 + 1] = sinf(ang); }
    }
    {
        const gf32* src[4] = {F.inp(I_CDK), F.inp(I_CDV), F.inp(I_CSK), F.inp(I_CSV)};
        const size_t doff[4] = {0, 2 * MiB, 4 * MiB, 5 * MiB}; const int n8[4] = {131072, 131072, 65536, 65536};
#pragma unroll
        for (int a = 0; a < 4; ++a)
            for (int i = F.bid * 512 + F.tid; i < n8[a]; i += F.G * 512) { const f32x4 x0 = *(const GAS f32x4*)(src[a] + (size_t)i * 8), x1 = *(const GAS f32x4*)(src[a] + (size_t)i * 8 + 4);
                v4u o; o.x = pk2(x0[0], x0[1]); o.y = pk2(x0[2], x0[3]); o.z = pk2(x1[0], x1[1]); o.w = pk2(x1[2], x1[3]); *(GAS v4u*)(F.c16(doff[a]) + (size_t)i * 8) = o; }
    }
    {
        LAS float* scr = (LAS float*)(F.lds + 49152 + F.wave * 8448);
        const int gw = F.bid * 8 + F.wave, NGW = F.G * 8;
        constexpr int I_IN = 32 * 176, I_OUT = 32 * 64, I_GU = 32 * 352, I_DN = 88 * 64, I_L = I_IN + I_OUT + I_GU + I_DN;
        for (int it = gw; it < DEPTH * I_L; it += NGW) {
            const int l = it / I_L; int r = it % I_L;
            if (r < I_IN) { const int kb = r / 176, nb = r % 176; transpose_item(F.inp(I_WIN) + (size_t)l * DM * DIN, DM, DIN, F.wT(l, WO_IN), 64 * kb, 32 * nb, 32 * nb, scr, F.lane); continue; } r -= I_IN;
            if (r < I_OUT) { const int kb = r / 64, nb = r % 64; transpose_item(F.inp(I_WOUT) + (size_t)l * DM * DM, DM, DM, F.wT(l, WO_OUT), 64 * kb, 32 * nb, 32 * nb, scr, F.lane); continue; } r -= I_OUT;
            if (r < I_GU) { const int kb = r / 352, nb = r % 352, n0 = 32 * nb; const int j = n0 < DFF ? n0 : n0 - DFF; const int drow = 256 * (j >> 7) + (n0 < DFF ? 0 : 128) + (j & 127);
                transpose_item(F.inp(I_WGU) + (size_t)l * DM * DGU, DM, DGU, F.wT(l, WO_GU), 64 * kb, n0, drow, scr, F.lane); continue; } r -= I_GU;
            { const int kb = r / 64, nb = r % 64; transpose_item(F.inp(I_WDN) + (size_t)l * DFF * DM, DFF, DM, F.wT(l, WO_DN), 64 * kb, 32 * nb, 32 * nb, scr, F.lane); }
        }
    }
}

__device__ __forceinline__ void p1_h0(const Ctx& F) {
    const gf32* xp = F.inp(I_XP); const gf32* xs = F.inp(I_XS);
    for (int idx = F.bid * 512 + F.tid; idx < MROWS * 256; idx += F.G * 512) {
        const int row = idx >> 8, c8 = (idx & 255) * 8, mod = mod_of_row(row);
        const gf32* xr = row < R_CTX ? xp + (size_t)row * DM : xs + (size_t)(row - R_CTX) * DM;
        const gf32* sh = F.mods() + (size_t)(0 * 3 + mod) * 6 * DM; const gf32* sc = sh + DM;
        const f32x4 x0 = *(const GAS f32x4*)(xr + c8), x1 = *(const GAS f32x4*)(xr + c8 + 4), s0 = *(const GAS f32x4*)(sh + c8), s1 = *(const GAS f32x4*)(sh + c8 + 4), c0 = *(const GAS f32x4*)(sc + c8), c1 = *(const GAS f32x4*)(sc + c8 + 4);
        const f32x4 h0 = x0 * (c0 + 1.0f) + s0, h1 = x1 * (c1 + 1.0f) + s1;
        v4u o; o.x = pk2(h0[0], h0[1]); o.y = pk2(h0[2], h0[3]); o.z = pk2(h1[0], h1[1]); o.w = pk2(h1[2], h1[3]);
        *(GAS v4u*)(F.hbuf() + (size_t)row * DM + c8) = o;
    }
}

constexpr float LOG2E = 1.4426950408889634f;
constexpr float QSC_D = 0.125f * LOG2E, QSC_S = 0.08838834764831845f * LOG2E;
__device__ __forceinline__ void e1_postproj(const Ctx& F, int l) {
    const gf32* lb = F.lball() + l * 1024;
    for (int grp = F.bid; grp < MROWS / 16; grp += F.G) {
        const int row0 = grp * 16;
        for (int rr = F.wave; rr < 16; rr += 8) {
            const int row = row0 + rr, lane = F.lane;
            const gf32* pr = F.proj() + (size_t)row * DIN; gbf16* qk = F.qkv() + (size_t)row * QKV_LD;
            const bool lat = row >= R_CTX; const int t = (row - R_CTX) & (S_LAT - 1), rpos = t >> 6, cpos = t & 63;
            const f32x4 one0 = {1.f, 0.f, 1.f, 0.f};
#pragma unroll
            for (int u = 0; u < 2; ++u) {
                const int it = lane + 64 * u, blk = it >> 2, f = it & 3, cb = blk * 32, pos = (blk & 1) ? cpos : rpos;
                const f32x4 x1 = *(const GAS f32x4*)(pr + cb + 4 * f), x2 = *(const GAS f32x4*)(pr + cb + 16 + 4 * f);
                f32x4 t0 = one0, t1 = one0; if (lat) { t0 = *(const GAS f32x4*)(F.tabD() + (pos * 16 + 4 * f) * 2); t1 = *(const GAS f32x4*)(F.tabD() + (pos * 16 + 4 * f) * 2 + 4); }
                const f32x4 cs = {t0[0], t0[2], t1[0], t1[2]}, sn = {t0[1], t0[3], t1[1], t1[3]};
                const float sc = cb < 512 ? QSC_D : 1.0f;
                const f32x4 y1 = (x1 * cs - x2 * sn) * sc, y2 = (x2 * cs + x1 * sn) * sc;
                *(GAS v2u*)(qk + cb + 4 * f) = (v2u){pk2(y1[0], y1[1]), pk2(y1[2], y1[3])}; *(GAS v2u*)(qk + cb + 16 + 4 * f) = (v2u){pk2(y2[0], y2[1]), pk2(y2[2], y2[3])};
            }
#pragma unroll
            for (int u = 0; u < 3; ++u) {
                const int it = lane + 64 * u;
                if (it < 160) { const int blk = it >> 3, f = it & 7, cb = C_CQ + blk * 64, db = Q_QS + blk * 64, pos = (blk & 1) ? cpos : rpos;
                    const f32x4 x1 = *(const GAS f32x4*)(pr + cb + 4 * f), x2 = *(const GAS f32x4*)(pr + cb + 32 + 4 * f);
                    f32x4 t0 = one0, t1 = one0; if (lat) { t0 = *(const GAS f32x4*)(F.tabS() + (pos * 32 + 4 * f) * 2); t1 = *(const GAS f32x4*)(F.tabS() + (pos * 32 + 4 * f) * 2 + 4); }
                    const f32x4 cs = {t0[0], t0[2], t1[0], t1[2]}, sn = {t0[1], t0[3], t1[1], t1[3]};
                    const float sc = blk < 16 ? QSC_S : 1.0f;
                    const f32x4 y1 = (x1 * cs - x2 * sn) * sc, y2 = (x2 * cs + x1 * sn) * sc;
                    *(GAS v2u*)(qk + db + 4 * f) = (v2u){pk2(y1[0], y1[1]), pk2(y1[2], y1[3])}; *(GAS v2u*)(qk + db + 32 + 4 * f) = (v2u){pk2(y2[0], y2[1]), pk2(y2[2], y2[3])}; }
            }
            { const f32x4 a0 = *(const GAS f32x4*)(pr + C_AV + 4 * lane), a1 = *(const GAS f32x4*)(pr + C_AV + 256 + 4 * lane), a2 = *(const GAS f32x4*)(pr + C_CV + 4 * lane);
              *(GAS v2u*)(qk + Q_VD + 4 * lane) = (v2u){pk2(a0[0], a0[1]), pk2(a0[2], a0[3])}; *(GAS v2u*)(qk + Q_VD + 256 + 4 * lane) = (v2u){pk2(a1[0], a1[1]), pk2(a1[2], a1[3])};
              *(GAS v2u*)(qk + Q_VS + 4 * lane) = (v2u){pk2(a2[0], a2[1]), pk2(a2[2], a2[3])}; }
            if (!lat) {
                const int b = row >> 8, n = row & 255;
#pragma unroll
                for (int u = 0; u < 2; ++u) { const int i = lane + 64 * u, hh = i >> 5, c4 = (i & 31) * 4;
                    *(GAS f32x4*)(F.out + O_DK + ((((size_t)b * 4 + l) * 4 + hh) * 256 + n) * 128 + c4) = *(const GAS f32x4*)(pr + C_AK + hh * 128 + c4);
                    *(GAS f32x4*)(F.out + O_DV + ((((size_t)b * 4 + l) * 4 + hh) * 256 + n) * 128 + c4) = *(const GAS f32x4*)(pr + C_AV + hh * 128 + c4); }
                { const int kv = lane >> 5, c4 = (lane & 31) * 4;
                    *(GAS f32x4*)(F.out + O_SK + ((((size_t)b * 4 + l) * 2 + kv) * 256 + n) * 128 + c4) = *(const GAS f32x4*)(pr + C_CK + kv * 128 + c4);
                    *(GAS f32x4*)(F.out + O_SV + ((((size_t)b * 4 + l) * 2 + kv) * 256 + n) * 128 + c4) = *(const GAS f32x4*)(pr + C_CV + kv * 128 + c4); }
            }
        }
        {
            const int c = F.tid; const gf32* pc = F.proj() + (size_t)row0 * DIN;
            float qv[16], vv[16];
#pragma unroll
            for (int r = 0; r < 16; ++r) { qv[r] = silu_f(pc[(size_t)r * DIN + C_BQ + c]); vv[r] = pc[(size_t)r * DIN + C_BI + c]; }
#pragma unroll
            for (int dir = 0; dir < 2; ++dir) {
                const float lbv = lb[dir * 512 + c], lbm = fmaxf(lbv, 1e-30f), oml = 1.0f - lbv;
                float g[16], cum[16]; float run = 0.f;
#pragma unroll
                for (int p = 0; p < 16; ++p) { const int r = dir ? 15 - p : p; const float z = pc[(size_t)r * DIN + C_BF + dir * 512 + c];
                    g[p] = logf(lbm + oml / (1.0f + expf(-z))); run += g[p]; cum[p] = run; }
                const float last = run;
                unsigned kpw[8], vtw[8];
#pragma unroll
                for (int p = 0; p < 16; p += 2) {
                    float kp2[2];
#pragma unroll
                    for (int e = 0; e < 2; ++e) { const int pp = p + e, r = dir ? 15 - pp : pp; const float k = 1.0f - expf(g[pp]); const float cc = fmaxf(cum[pp], -80.0f);
                        F.hq(dir)[(size_t)(row0 + r) * 512 + c] = (bf16)f2bf(qv[r] * expf(cc)); F.hkm(dir)[(size_t)(row0 + r) * 512 + c] = (bf16)f2bf(k * expf(-cc));
                        kp2[e] = k * expf(last - cum[pp]); }
                    kpw[p >> 1] = pk2(kp2[0], kp2[1]); vtw[p >> 1] = pk2(vv[dir ? 15 - p : p], vv[dir ? 14 - p : p + 1]);
                }
                GAS v4u* kd = (GAS v4u*)(F.hkp(dir) + ((size_t)grp * 512 + c) * 16); GAS v4u* vd = (GAS v4u*)(F.hvt(dir) + ((size_t)grp * 512 + c) * 16);
                kd[0] = (v4u){kpw[0], kpw[1], kpw[2], kpw[3]}; kd[1] = (v4u){kpw[4], kpw[5], kpw[6], kpw[7]};
                vd[0] = (v4u){vtw[0], vtw[1], vtw[2], vtw[3]}; vd[1] = (v4u){vtw[4], vtw[5], vtw[6], vtw[7]};
                F.hdec(dir)[(size_t)grp * 512 + c] = expf(last);
            }
        }
    }
}

typedef float f32x16 __attribute__((ext_vector_type(16)));
typedef short s16x4 __attribute__((ext_vector_type(4)));
typedef __bf16 bf16x2_t __attribute__((ext_vector_type(2)));
typedef float f32x2_t __attribute__((ext_vector_type(2)));
__device__ __forceinline__ unsigned cvt2(float a, float b) { const f32x2_t f = {a, b}; return __builtin_bit_cast(unsigned, __builtin_convertvector(f, bf16x2_t)); }
#define MFMA32(a, b, c) __builtin_amdgcn_mfma_f32_32x32x16_bf16((a), (b), (c), 0, 0, 0)

struct AttnSeg { const gbf16* k; const gbf16* v; int stride; int ntiles; };
constexpr int KPB = 272, VPB = 320;
constexpr int KT_BYTES = 64 * KPB, VT_BYTES = 64 * VPB, ABUF_BYTES = KT_BYTES + VT_BYTES;
constexpr float ATT_THR = 8.0f;

template <int DQK, bool DIFF>
__device__ __forceinline__ void attn_mfma(const Ctx& F, const gbf16* qptr, int kcol, const AttnSeg s0, const AttnSeg s1, bool band, int qpos, int kpos0,
                                          float m_init, float l_init, float lam, float post_scale, const gf32* gvec, gbf16* outp  ) {
    int lane_ = (int)__builtin_amdgcn_mbcnt_hi(~0u, __builtin_amdgcn_mbcnt_lo(~0u, 0u)); asm volatile("" : "+v"(lane_));
    const int lane = lane_, tid = F.wave * 64 + lane, r32 = lane & 31, h = lane >> 5;
    __syncthreads();
    bf16x8 qf[DQK / 16];
#pragma unroll
    for (int ks = 0; ks < DQK / 16; ++ks) qf[ks] = *(const GAS bf16x8*)(qptr + (size_t)r32 * QKV_LD + 16 * ks + 8 * h);
#pragma unroll
    for (int ks = 0; ks < DQK / 16; ++ks) asm volatile("" : "+v"(qf[ks]));
    __builtin_amdgcn_s_waitcnt(0);
    f32x16 o[4];
#pragma unroll
    for (int t = 0; t < 4; ++t)
#pragma unroll
        for (int r = 0; r < 16; ++r) o[t][r] = 0.f;
    float m = m_init, l = l_init;
    const int nt = s0.ntiles + s1.ntiles;
    const int srow = tid >> 4, spc = tid & 15;
    v4u kreg[2], vreg[2];
#define ATT_ISSUE(ti) do { const bool s1_ = (ti) >= s0.ntiles; const int tt_ = s1_ ? (ti) - s0.ntiles : (ti); const gbf16* kb_ = s1_ ? s1.k : s0.k; const gbf16* vb_ = s1_ ? s1.v : s0.v; const int st_ = s1_ ? s1.stride : s0.stride; \
        _Pragma("unroll") for (int i_ = 0; i_ < 2; ++i_) { const size_t go_ = (size_t)(tt_ * 64 + srow + 32 * i_) * st_ + spc * 8; kreg[i_] = *(const GAS v4u*)(kb_ + go_); vreg[i_] = *(const GAS v4u*)(vb_ + go_); } } while (0)
#define ATT_WRITE(b) do { _Pragma("unroll") for (int i_ = 0; i_ < 2; ++i_) { *(LAS v4u*)(F.lds + (b) * ABUF_BYTES + (srow + 32 * i_) * KPB + spc * 16) = kreg[i_]; \
        *(LAS v4u*)(F.lds + (b) * ABUF_BYTES + KT_BYTES + (srow + 32 * i_) * VPB + spc * 16) = vreg[i_]; } } while (0)
    ATT_ISSUE(0); ATT_WRITE(0);
    __syncthreads();
    const int koff = r32 * KPB + (kcol + 8 * h) * 2;
    const int voff = KT_BYTES + (4 * h + ((lane & 15) >> 2)) * VPB + (16 * ((lane >> 4) & 1) + 4 * (lane & 3)) * 2;
    for (int ti = 0; ti < nt; ++ti) {
        const int buf = ti & 1;
        if (ti + 1 < nt) ATT_ISSUE(ti + 1);
        const LAS unsigned char* kb = F.lds + buf * ABUF_BYTES;
        f32x16 st[2];
#pragma unroll
        for (int kt = 0; kt < 2; ++kt)
#pragma unroll
            for (int r = 0; r < 16; ++r) st[kt][r] = 0.f;
        {
            constexpr int NG = 2 * (DQK / 64);
            bf16x8 kfa[4], kfb[4];
#define ATT_LDK(dst, g) do { const int kt_ = (g) / (DQK / 64), k0_ = ((g) % (DQK / 64)) * 4; _Pragma("unroll") for (int j_ = 0; j_ < 4; ++j_) dst[j_] = *(const LAS bf16x8*)(kb + koff + kt_ * 32 * KPB + (k0_ + j_) * 32); } while (0)
#define ATT_MMK(src, g) do { const int kt_ = (g) / (DQK / 64), k0_ = ((g) % (DQK / 64)) * 4; _Pragma("unroll") for (int j_ = 0; j_ < 4; ++j_) st[kt_] = MFMA32(src[j_], qf[k0_ + j_], st[kt_]); } while (0)
            ATT_LDK(kfa, 0); __builtin_amdgcn_sched_barrier(0);
#pragma unroll
            for (int g = 0; g < NG; g += 2) {
                ATT_LDK(kfb, g + 1); __builtin_amdgcn_sched_barrier(0);
                ATT_MMK(kfa, g);
                if (g + 2 < NG) { ATT_LDK(kfa, g + 2); __builtin_amdgcn_sched_barrier(0); }
                ATT_MMK(kfb, g + 1);
            }
#undef ATT_LDK
#undef ATT_MMK
        }
        if (band && ti < s0.ntiles) {
            const int kp = kpos0 + ti * 64 + 4 * h - (qpos + r32);
#pragma unroll
            for (int kt = 0; kt < 2; ++kt)
#pragma unroll
                for (int r = 0; r < 16; ++r) { const int d = kp + 32 * kt + (r & 3) + 8 * (r >> 2); if (d > 128 || d < -128) st[kt][r] = -1e30f; }
        }
        float mx = st[0][0];
#pragma unroll
        for (int kt = 0; kt < 2; ++kt)
#pragma unroll
            for (int r = 0; r < 16; ++r) mx = fmaxf(mx, st[kt][r]);
        mx = fmaxf(mx, __shfl_xor(mx, 32));
        if (__builtin_amdgcn_ballot_w64(mx > m + ATT_THR) != 0ull) {
            const float mn = fmaxf(m, mx), a = __builtin_amdgcn_exp2f(m - mn); l *= a; m = mn;
#pragma unroll
            for (int t = 0; t < 4; ++t)
#pragma unroll
                for (int r = 0; r < 16; ++r) o[t][r] *= a;
        }
        float rs = 0.f;
#pragma unroll
        for (int kt = 0; kt < 2; ++kt)
#pragma unroll
            for (int r = 0; r < 16; ++r) { const float p = __builtin_amdgcn_exp2f(st[kt][r] - m); st[kt][r] = p; rs += p; }
        rs += __shfl_xor(rs, 32); l += rs;
        {
            s16x4 va[8], vb[8];
#define ATT_LDV(dst, g) do { _Pragma("unroll") for (int t_ = 0; t_ < 4; ++t_) { dst[2 * t_] = __builtin_amdgcn_ds_read_tr16_b64_v4i16((LAS s16x4*)(kb + voff + (16 * (g)) * VPB + t_ * 64)); \
                dst[2 * t_ + 1] = __builtin_amdgcn_ds_read_tr16_b64_v4i16((LAS s16x4*)(kb + voff + (16 * (g) + 8) * VPB + t_ * 64)); } } while (0)
#define ATT_MMV(src, g) do { const int kt_ = (g) >> 1, s_ = (g) & 1; v4u pw_; pw_.x = cvt2(st[kt_][8 * s_], st[kt_][8 * s_ + 1]); pw_.y = cvt2(st[kt_][8 * s_ + 2], st[kt_][8 * s_ + 3]); pw_.z = cvt2(st[kt_][8 * s_ + 4], st[kt_][8 * s_ + 5]); pw_.w = cvt2(st[kt_][8 * s_ + 6], st[kt_][8 * s_ + 7]); \
            const bf16x8 pf_ = __builtin_bit_cast(bf16x8, pw_); _Pragma("unroll") for (int t_ = 0; t_ < 4; ++t_) o[t_] = MFMA32(__builtin_shufflevector(src[2 * t_], src[2 * t_ + 1], 0, 1, 2, 3, 4, 5, 6, 7), pf_, o[t_]); } while (0)
            ATT_LDV(va, 0); __builtin_amdgcn_sched_barrier(0);
            ATT_LDV(vb, 1); __builtin_amdgcn_sched_barrier(0);
            ATT_MMV(va, 0);
            ATT_LDV(va, 2); __builtin_amdgcn_sched_barrier(0);
            ATT_MMV(vb, 1);
            ATT_LDV(vb, 3); __builtin_amdgcn_sched_barrier(0);
            ATT_MMV(va, 2);
            ATT_MMV(vb, 3);
#undef ATT_LDV
#undef ATT_MMV
        }
        if (ti + 1 < nt) ATT_WRITE(buf ^ 1);
        __syncthreads();
    }
#undef ATT_ISSUE
#undef ATT_WRITE
    const float inv = 1.0f / l;
    if (DIFF) {
        LAS float* ex = (LAS float*)F.lds;
        if (F.wave >= 4) {
#pragma unroll
            for (int t = 0; t < 4; ++t)
#pragma unroll
                for (int r = 0; r < 16; ++r) ex[((F.wave - 4) * 64 + t * 16 + r) * 64 + lane] = o[t][r] * inv;
        }
        __syncthreads();
        if (F.wave < 4) {
            float ss = 0.f;
#pragma unroll
            for (int t = 0; t < 4; ++t)
#pragma unroll
                for (int r = 0; r < 16; ++r) { const float x = o[t][r] * inv - lam * ex[(F.wave * 64 + t * 16 + r) * 64 + lane]; o[t][r] = x; ss += x * x; }
            ss += __shfl_xor(ss, 32);
            const float sc = post_scale / sqrtf(ss * (1.0f / 128.0f) + 1e-6f);
            gbf16* op = outp + (size_t)r32 * DM;
#pragma unroll
            for (int t = 0; t < 4; ++t)
#pragma unroll
                for (int g4 = 0; g4 < 4; ++g4) { const int dv = 32 * t + 8 * g4 + 4 * h; const f32x4 gv = *(const GAS f32x4*)(gvec + dv);
                    v2u w; w.x = cvt2(o[t][4 * g4] * sc * gv[0], o[t][4 * g4 + 1] * sc * gv[1]); w.y = cvt2(o[t][4 * g4 + 2] * sc * gv[2], o[t][4 * g4 + 3] * sc * gv[3]); *(GAS v2u*)(op + dv) = w; }
        }
    } else {
        gbf16* op = outp + (size_t)r32 * DM;
#pragma unroll
        for (int t = 0; t < 4; ++t)
#pragma unroll
            for (int g4 = 0; g4 < 4; ++g4) { const int dv = 32 * t + 8 * g4 + 4 * h;
                v2u w; w.x = cvt2(o[t][4 * g4] * inv, o[t][4 * g4 + 1] * inv); w.y = cvt2(o[t][4 * g4 + 2] * inv, o[t][4 * g4 + 3] * inv); *(GAS v2u*)(op + dv) = w; }
    }
}

#define MFMA16(a, b, c) __builtin_amdgcn_mfma_f32_16x16x32_bf16((a), (b), (c), 0, 0, 0)
__device__ __forceinline__ bf16x8 frag2(v2u lo, v2u hi) { const v4u w = {lo.x, lo.y, hi.x, hi.y}; return __builtin_bit_cast(bf16x8, w); }
constexpr int HG_NS = 7, HG_SLOT = 17408;
#define HG_VMWAIT(n) asm volatile("s_waitcnt vmcnt(" #n ")" ::: "memory")
template <int MODE>
__device__ __forceinline__ void hgrn_mfma(const Ctx& F, int rb, int nchunks, int cc0, int ncc, int h, int dir, const gf32* s_in, gf32* s_out, gf32* ob, const gf32* fold_s, const gf32* fold_d, int nfold, gf32* d_out) {
    int lane_ = (int)__builtin_amdgcn_mbcnt_hi(~0u, __builtin_amdgcn_mbcnt_lo(~0u, 0u)); asm volatile("" : "+v"(lane_));
    const int lane = lane_, t16 = lane & 15, G = lane >> 4, w = F.wave, vcol = h * 128 + w * 16 + t16;
    __syncthreads();
    f32x4 S[8];
#pragma unroll
    for (int i = 0; i < 8; ++i)
#pragma unroll
        for (int r = 0; r < 4; ++r) S[i][r] = (MODE == 2) ? s_in[(size_t)(16 * i + 4 * G + r) * 128 + w * 16 + t16] : 0.f;
    if (MODE == 2) {
        for (int j = 0; j < nfold; ++j) {
#pragma unroll
            for (int i = 0; i < 8; ++i) { const f32x4 dj = *(const GAS f32x4*)(fold_d + (size_t)j * 128 + 16 * i + 4 * G);
#pragma unroll
                for (int r = 0; r < 4; ++r) S[i][r] = S[i][r] * dj[r] + fold_s[((size_t)j * 128 + 16 * i + 4 * G + r) * 128 + w * 16 + t16]; }
        }
    }
    f32x4 Dacc[8];
#pragma unroll
    for (int i = 0; i < 8; ++i) Dacc[i] = (f32x4){1.f, 1.f, 1.f, 1.f};
#pragma unroll
    for (int i = 0; i < 8; ++i) asm volatile("" : "+v"(S[i]));
    __builtin_amdgcn_s_waitcnt(0);
    const GAS unsigned char* srcA = (const GAS unsigned char*)((w < 4 ? F.hq(dir) : F.hkm(dir)) + h * 128);
    const GAS unsigned char* srcB = (const GAS unsigned char*)((w < 4 ? F.hkp(dir) : F.hvt(dir)) + (size_t)h * 128 * 16);
    const GAS unsigned char* srcC = (const GAS unsigned char*)(F.hdec(dir) + h * 128) + (lane & 31) * 16;
    const int rA = 4 * (w & 3) + (lane >> 4);
    const unsigned offA = (unsigned)((dir ? 15 - rA : rA) * 1024 + (((lane & 15) ^ rA) * 16));
    const int dB = 32 * (w & 3) + (lane >> 1);
    const unsigned offB = (unsigned)(dB * 32 + (((lane & 1) ^ ((dB >> 3) & 1)) * 16));
    const int dstA = (w < 4 ? 0 : 4096) + (w & 3) * 1024, dstB = (w < 4 ? 8192 : 12288) + (w & 3) * 1024;
#define HG_ISSUE(cj) do { const int ce_ = cc0 + ((cj) < ncc ? (cj) : ncc - 1); const int ch_ = dir ? nchunks - 1 - ce_ : ce_; const size_t gc_ = (size_t)(rb / 16 + ch_); \
        LAS unsigned char* sl_ = F.lds + ((cj) % HG_NS) * HG_SLOT; \
        if (MODE != 1) __builtin_amdgcn_global_load_lds((const GAS unsigned*)(srcA + (size_t)(rb + ch_ * 16) * 1024 + offA), (LAS unsigned*)(sl_ + dstA), 16, 0, 0); \
        __builtin_amdgcn_global_load_lds((const GAS unsigned*)(srcB + gc_ * 16384 + offB), (LAS unsigned*)(sl_ + dstB), 16, 0, 0); \
        if (w == 0) __builtin_amdgcn_global_load_lds((const GAS unsigned*)(srcC + gc_ * 2048), (LAS unsigned*)(sl_ + 16384), 16, 0, 0); } while (0)
    const int qoff = t16 * 256 + 8 * (G & 1);
    const int g1 = G >> 1;
    const int kpoff = 8192 + t16 * 32 + ((g1 ^ ((t16 >> 3) & 1)) * 16) + 8 * (G & 1);
    const int vtoff = 12288 + (w * 16 + t16) * 32 + ((g1 ^ ((t16 >> 3) & 1)) * 16) + 8 * (G & 1);
    const int dcoff = 16384 + 16 * G;
    const v2u z2 = {0u, 0u};
#pragma unroll
    for (int j = 0; j < HG_NS - 1; ++j) HG_ISSUE(j);
    for (int cc = 0; cc < ncc; ++cc) {
        if (MODE == 1) { if (w == 0) HG_VMWAIT(10); else HG_VMWAIT(5); }
        else if (cc < HG_NS - 1) { if (w == 0) HG_VMWAIT(15); else HG_VMWAIT(10); }
        else                     { if (w == 0) HG_VMWAIT(39); else HG_VMWAIT(34); }
        asm volatile("s_waitcnt lgkmcnt(0)" ::: "memory"); __builtin_amdgcn_s_barrier(); asm volatile("" ::: "memory");
        HG_ISSUE(cc + HG_NS - 1);
        const LAS unsigned char* sl = F.lds + (cc % HG_NS) * HG_SLOT;
        v2u q[8], k[8], kp[8]; f32x4 dec[8];
        if (MODE != 1) {
#pragma unroll
            for (int i = 0; i < 8; ++i) { const int po = (((2 * i + g1) ^ t16) * 16); q[i] = *(const LAS v2u*)(sl + qoff + po); k[i] = *(const LAS v2u*)(sl + 4096 + qoff + po); }
        }
        const v2u vt = *(const LAS v2u*)(sl + vtoff);
#pragma unroll
        for (int i = 0; i < 8; ++i) { kp[i] = *(const LAS v2u*)(sl + kpoff + i * 512); dec[i] = *(const LAS f32x4*)(sl + dcoff + i * 64); }
        __builtin_amdgcn_sched_barrier(0);
        const bf16x8 vb = frag2(vt, z2);
        if (MODE != 1) {
            f32x4 pt = {0.f, 0.f, 0.f, 0.f};
#pragma unroll
            for (int kk = 0; kk < 4; ++kk) pt = MFMA16(frag2(k[2 * kk], k[2 * kk + 1]), frag2(q[2 * kk], q[2 * kk + 1]), pt);
#pragma unroll
            for (int r = 0; r < 4; ++r) if (4 * G + r > t16) pt[r] = 0.f;
            const v2u pb = {cvt2(pt[0], pt[1]), cvt2(pt[2], pt[3])};
            f32x4 o = {0.f, 0.f, 0.f, 0.f};
            o = MFMA16(frag2(pb, z2), vb, o);
#pragma unroll
            for (int kk = 0; kk < 4; ++kk) { const v2u s0 = {cvt2(S[2 * kk][0], S[2 * kk][1]), cvt2(S[2 * kk][2], S[2 * kk][3])}, s1 = {cvt2(S[2 * kk + 1][0], S[2 * kk + 1][1]), cvt2(S[2 * kk + 1][2], S[2 * kk + 1][3])};
                o = MFMA16(frag2(q[2 * kk], q[2 * kk + 1]), frag2(s0, s1), o); }
            const int ce = cc0 + cc, ch = dir ? nchunks - 1 - ce : ce, crow = rb + ch * 16;
#pragma unroll
            for (int r = 0; r < 4; ++r) { const int pr_ = 4 * G + r; ob[(size_t)(crow + (dir ? 15 - pr_ : pr_)) * 512 + vcol] = o[r]; }
        }
#pragma unroll
        for (int i = 0; i < 8; ++i) { S[i] = S[i] * dec[i]; S[i] = MFMA16(frag2(kp[i], z2), vb, S[i]); if (MODE == 1) Dacc[i] = Dacc[i] * dec[i]; }
    }
#undef HG_ISSUE
    HG_VMWAIT(0);
    __syncthreads();
    if (MODE != 2) {
#pragma unroll
        for (int i = 0; i < 8; ++i)
#pragma unroll
            for (int r = 0; r < 4; ++r) s_out[(size_t)(16 * i + 4 * G + r) * 128 + w * 16 + t16] = S[i][r];
    }
    if (MODE == 1 && w == 0 && t16 == 0) {
#pragma unroll
        for (int i = 0; i < 8; ++i) *(GAS f32x4*)(d_out + 16 * i + 4 * G) = Dacc[i];
    }
}

__device__ __forceinline__ void hp_states(const Ctx& F, int l) {
    for (int i = F.bid; i < 256; i += F.G) {
        const int sq = i >> 4, seg = i & 15, b = sq >> 3, h = (sq >> 1) & 3, dir = sq & 1;
        if (seg == 15) continue;
        hgrn_mfma<1>(F, R_CTX + b * S_LAT, S_LAT / 16, seg * 16, 16, h, dir, nullptr, F.sloc() + ((size_t)sq * 16 + seg) * 16384, nullptr, nullptr, nullptr, 0, F.dseg() + ((size_t)sq * 16 + seg) * 128);
    }
}

#ifndef PROBE_MX_DUP
#define PROBE_MX_DUP 0
#endif
#define MXREP(cls) for (int rep_ = 0; rep_ < 1 + ((PROBE_MX_DUP >> (cls)) & 1); ++rep_)
__device__ __forceinline__ void mx_mixers(const Ctx& F, int l) {
    float lam = F.lamv()[l * 2], lam_init = F.lamv()[l * 2 + 1];
    asm volatile("" : "+v"(lam), "+v"(lam_init));
    const gbf16* qkv = F.qkv();
    constexpr int T_LH = 256, T_LD = 256, T_LB = 256, T_CD = 128, T_CS = 128, T_CH = 128;
    constexpr int NT = T_LH + T_LD + T_LB + T_CD + T_CS + T_CH;
    const AttnSeg none = {nullptr, nullptr, 0, 0};
    const int w = F.wave;
    for (int task = F.bid; task < NT; task += F.G) {
        int i = task;
        if (i < T_LH) {
            const int sq = i >> 4, seg = i & 15, b = sq >> 3, h = (sq >> 1) & 3, dir = sq & 1;
            const gf32* sin_ = F.inp(I_ST) + ((((size_t)b * 4 + l) * 2 + dir) * 4 + h) * 128 * 128;
            MXREP(0) hgrn_mfma<2>(F, R_CTX + b * S_LAT, S_LAT / 16, seg * 16, 16, h, dir, sin_, nullptr, dir ? F.obb() : F.obf(), F.sloc() + (size_t)sq * 16 * 16384, F.dseg() + (size_t)sq * 16 * 128, seg, nullptr);
            continue; } i -= T_LH;
        if (i < T_LD) {
            const int b = i >> 7, h = (i >> 5) & 3, qt = i & 31, map = w >> 2; const int rb = R_CTX + b * S_LAT, wrow = rb + qt * 128 + 32 * (w & 3);
            const AttnSeg s0 = {qkv + (size_t)rb * QKV_LD + Q_KD + h * 128, qkv + (size_t)rb * QKV_LD + Q_VD + h * 128, QKV_LD, S_LAT / 64};
            const size_t co = (((size_t)b * 4 + l) * 4 + h) * 256 * 128;
            const AttnSeg s1 = {F.c16(0) + co, F.c16(2 * MiB) + co, 128, 4};
            MXREP(1) attn_mfma<64, true>(F, qkv + (size_t)wrow * QKV_LD + Q_QD + h * 128 + map * 64, map * 64, s0, s1, false, 0, 0, -1e30f, 0.f, lam, 1.0f - lam_init, F.inp(I_DNG) + l * 128, F.cat() + (size_t)wrow * DM + h * 128);
            continue; } i -= T_LD;
        if (i < T_LB) {
            const int b = i >> 7, kv = (i >> 6) & 1, qt = i & 63, hh = kv * 4 + (w >> 1); const int rb = R_CTX + b * S_LAT, t0 = qt * 64, wrow = rb + t0 + 32 * (w & 1);
            const int ks = t0 - 128 < 0 ? 0 : t0 - 128, ke = t0 + 192 > S_LAT ? S_LAT : t0 + 192;
            const AttnSeg s0 = {qkv + (size_t)(rb + ks) * QKV_LD + Q_KS + kv * 128, qkv + (size_t)(rb + ks) * QKV_LD + Q_VS + kv * 128, QKV_LD, (ke - ks) / 64};
            const size_t co = (((size_t)b * 4 + l) * 2 + kv) * 256 * 128;
            const AttnSeg s1 = {F.c16(4 * MiB) + co, F.c16(5 * MiB) + co, 128, 4};
            MXREP(2) attn_mfma<128, false>(F, qkv + (size_t)wrow * QKV_LD + Q_QS + hh * 128, 0, s0, s1, true, t0 + 32 * (w & 1), ks, F.inp(I_SINK)[l * 8 + hh] * LOG2E, 1.0f, 0.f, 1.0f, nullptr, F.cat() + (size_t)wrow * DM + 1024 + hh * 128);
            continue; } i -= T_LB;
        if (i < T_CD) {
            const int b = i >> 3, h = (i >> 1) & 3, qt = i & 1, map = w >> 2, rb = b * 256, wrow = rb + qt * 128 + 32 * (w & 3);
            const AttnSeg s0 = {qkv + (size_t)rb * QKV_LD + Q_KD + h * 128, qkv + (size_t)rb * QKV_LD + Q_VD + h * 128, QKV_LD, 4};
            MXREP(3) attn_mfma<64, true>(F, qkv + (size_t)wrow * QKV_LD + Q_QD + h * 128 + map * 64, map * 64, s0, none, false, 0, 0, -1e30f, 0.f, lam, 1.0f - lam_init, F.inp(I_DNG) + l * 128, F.cat() + (size_t)wrow * DM + h * 128);
            continue; } i -= T_CD;
        if (i < T_CS) {
            const int b = i >> 3, kv = (i >> 2) & 1, qt = i & 3, hh = kv * 4 + (w >> 1), rb = b * 256, wrow = rb + qt * 64 + 32 * (w & 1);
            const AttnSeg s0 = {qkv + (size_t)rb * QKV_LD + Q_KS + kv * 128, qkv + (size_t)rb * QKV_LD + Q_VS + kv * 128, QKV_LD, 4};
            MXREP(4) attn_mfma<128, false>(F, qkv + (size_t)wrow * QKV_LD + Q_QS + hh * 128, 0, s0, none, false, 0, 0, F.inp(I_SINK)[l * 8 + hh] * LOG2E, 1.0f, 0.f, 1.0f, nullptr, F.cat() + (size_t)wrow * DM + 1024 + hh * 128);
            continue; } i -= T_CS;
        {
            const int b = i >> 3, h = (i >> 1) & 3, dir = i & 1;
            gf32* sout = F.out + O_ST + ((((size_t)b * 4 + l) * 2 + dir) * 4 + h) * 128 * 128;
            MXREP(5) hgrn_mfma<0>(F, b * 256, 16, 0, 16, h, dir, nullptr, sout, dir ? F.obb() : F.obf(), nullptr, nullptr, 0, nullptr);
        }
    }
}

__device__ __forceinline__ void mg_merge(const Ctx& F, int l) {
    const int head = F.lane >> 4, sub = F.lane & 15, col0 = head * 128 + sub * 8;
    for (int row = F.bid * 8 + F.wave; row < MROWS; row += F.G * 8) {
        const f32x4 a0 = *(const GAS f32x4*)(F.obf() + (size_t)row * 512 + col0) + *(const GAS f32x4*)(F.obb() + (size_t)row * 512 + col0);
        const f32x4 a1 = *(const GAS f32x4*)(F.obf() + (size_t)row * 512 + col0 + 4) + *(const GAS f32x4*)(F.obb() + (size_t)row * 512 + col0 + 4);
        float ss = (a0[0] * a0[0] + a0[1] * a0[1]) + (a0[2] * a0[2] + a0[3] * a0[3]) + (a1[0] * a1[0] + a1[1] * a1[1]) + (a1[2] * a1[2] + a1[3] * a1[3]);
        ss += __shfl_xor(ss, 1); ss += __shfl_xor(ss, 2); ss += __shfl_xor(ss, 4); ss += __shfl_xor(ss, 8);
        const float rinv = 1.0f / sqrtf(ss * (1.0f / 128.0f) + 1e-6f);
        const gf32* g = F.inp(I_HNG) + l * 128 + sub * 8; const gf32* hg = F.proj() + (size_t)row * DIN + C_BG + col0;
        const f32x4 g0 = *(const GAS f32x4*)g, g1 = *(const GAS f32x4*)(g + 4), h0 = *(const GAS f32x4*)hg, h1 = *(const GAS f32x4*)(hg + 4);
        float y[8];
#pragma unroll
        for (int i = 0; i < 4; ++i) { y[i] = a0[i] * rinv * g0[i] * silu_f(h0[i]); y[4 + i] = a1[i] * rinv * g1[i] * silu_f(h1[i]); }
        v4u w; w.x = pk2(y[0], y[1]); w.y = pk2(y[2], y[3]); w.z = pk2(y[4], y[5]); w.w = pk2(y[6], y[7]);
        *(GAS v4u*)(F.cat() + (size_t)row * DM + 512 + col0) = w;
    }
}

__device__ __forceinline__ void ln_phase(const Ctx& F, const gf32* g, const gf32* b, gf32* xo, const gf32* modsl  , int which_sh) {
    constexpr int SPLIT_ROW0 = 8192;
    for (int row = F.bid * 8 + F.wave; row < MROWS; row += F.G * 8) {
        const gf32* yp = F.ypre() + (size_t)row * DM + F.lane * 4;
        f32x4 v[8]; float s = 0.f;
#pragma unroll
        for (int j = 0; j < 8; ++j) { v[j] = *(const GAS f32x4*)(yp + 256 * j); if (row >= SPLIT_ROW0) v[j] += *(const GAS f32x4*)(F.ypre2() + (size_t)(row - SPLIT_ROW0) * DM + F.lane * 4 + 256 * j); s += (v[j][0] + v[j][1]) + (v[j][2] + v[j][3]); }
#pragma unroll
        for (int o = 1; o < 64; o <<= 1) s += __shfl_xor(s, o);
        const float mean = s * (1.0f / DM); float s2 = 0.f;
#pragma unroll
        for (int j = 0; j < 8; ++j) { v[j] = v[j] - mean; s2 += (v[j][0] * v[j][0] + v[j][1] * v[j][1]) + (v[j][2] * v[j][2] + v[j][3] * v[j][3]); }
#pragma unroll
        for (int o = 1; o < 64; o <<= 1) s2 += __shfl_xor(s2, o);
        const float rstd = 1.0f / sqrtf(s2 * (1.0f / DM) + 1e-5f);
        const int mod = mod_of_row(row);
        const gf32* sh = modsl ? modsl + ((size_t)mod * 6 + which_sh) * DM : nullptr;
#pragma unroll
        for (int j = 0; j < 8; ++j) { const int c = F.lane * 4 + 256 * j;
            const f32x4 x = v[j] * rstd * *(const GAS f32x4*)(g + c) + *(const GAS f32x4*)(b + c);
            *(GAS f32x4*)(xo + (size_t)row * DM + c) = x;
            if (modsl) { const f32x4 hh = x * (*(const GAS f32x4*)(sh + DM + c) + 1.0f) + *(const GAS f32x4*)(sh + c);
                v2u w; w.x = pk2(hh[0], hh[1]); w.y = pk2(hh[2], hh[3]); *(GAS v2u*)(F.hbuf() + (size_t)row * DM + c) = w; } }
    }
}

constexpr int PH_PER_LAYER = 10, N_PHASES = 2 + DEPTH * PH_PER_LAYER;
__global__ void __launch_bounds__(512, 2) fwd_kernel(Args args) {
    extern __shared__ __attribute__((aligned(16))) unsigned char lds_raw[];
    Ctx F;
    F.lds = (LAS unsigned char*)lds_raw;
    F.tid = threadIdx.x; F.lane = F.tid & 63; F.wave = __builtin_amdgcn_readfirstlane(F.tid >> 6); F.G = gridDim.x; F.bid = blockIdx.x;
    F.ap = &args; F.out = (gf32*)args.out; F.ws = (GAS unsigned char*)args.ws;
    volatile LAS unsigned* MISC = (volatile LAS unsigned*)(F.lds + MISC_OFF);
    for (int u = F.tid; u < (LDS_BYTES - LDSCTL_OFF) / 4; u += 512) ((LAS unsigned*)(F.lds + LDSCTL_OFF))[u] = 0u;
    __syncthreads();
    XcdBarrier bar; bar.bar = (unsigned*)(args.ws + WS_CTL) + CW_BAR; bar.x = 0; bar.st = nullptr;
    if (args.single) bar = xcd_barrier_post((unsigned*)(args.ws + WS_CTL) + CW_BAR, MISC + 8);
    const int lo = args.ph_lo, hi = args.ph_hi;
#define IN(k) (lo <= (k) && (k) < hi)
#define FRESH() do { int ln_ = (int)__builtin_amdgcn_mbcnt_hi(~0u, __builtin_amdgcn_mbcnt_lo(~0u, 0u)); asm volatile("" : "+v"(ln_)); F.lane = ln_; asm volatile("" : "+s"(F.wave)); F.tid = F.wave * 64 + F.lane; \
    asm volatile("" : "+s"(F.bid), "+s"(F.G)); asm volatile("" : "+s"(F.ws), "+s"(F.out)); } while (0)
#define SEAM(k) do { if (IN((k) + 1)) xcd_barrier(bar); } while (0)

    if (IN(0)) { FRESH(); p0_prologue(F); SEAM(0); }
    if (IN(1)) { FRESH(); p1_h0(F); SEAM(1); }
    for (int l = 0; l < DEPTH; ++l) {
        const int k0 = 2 + l * PH_PER_LAYER;
        FRESH();
        const gf32* xa = l == 0 ? F.inp(I_XP) : F.out + O_YP; const gf32* xb = l == 0 ? F.inp(I_XS) : F.out + O_YS;
        if (IN(k0 + 0)) {
            pg8::Gemm g{(const pg8::bf16_t*)F.hbuf(), (const pg8::bf16_t*)F.wT(l, WO_IN), MROWS, DIN, DM, DM}; pg8::StaticOrder S; S.init(MROWS, DIN, F.G, F.bid);
            EpiStoreF32 E{F.proj(), DIN};
            pg8::gemm_phase<EpiStoreF32, pg8::StaticOrder, true, true>(F.lds, g, S, E, F.wave);
            SEAM(k0 + 0); }
        if (IN(k0 + 1)) { FRESH(); e1_postproj(F, l); SEAM(k0 + 1); }
        if (IN(k0 + 2)) { FRESH(); hp_states(F, l); SEAM(k0 + 2); }
        if (IN(k0 + 3)) { FRESH(); mx_mixers(F, l); SEAM(k0 + 3); }
        if (IN(k0 + 4)) { FRESH(); mg_merge(F, l); SEAM(k0 + 4); }
        if (IN(k0 + 5)) {
            { pg8::Gemm g{(const pg8::bf16_t*)F.cat(), (const pg8::bf16_t*)F.wT(l, WO_OUT), 8192, DM, DM, DM}; pg8::StaticOrder S; S.init(8192, DM, F.G, F.bid);
              EpiResid E{xa, xb, F.mods() + ((size_t)l * 3 * 6 + 2) * DM, F.ypre(), 0, 0};
              pg8::gemm_phase<EpiResid, pg8::StaticOrder, true, true>(F.lds, g, S, E, F.wave); }
            __syncthreads();
            { const int kh = F.bid >> 7; pg8::Gemm g{(const pg8::bf16_t*)(F.cat() + (size_t)8192 * DM + kh * (DM / 2)), (const pg8::bf16_t*)(F.wT(l, WO_OUT) + kh * (DM / 2)), 4096, DM, DM / 2, DM}; pg8::StaticOrder S; S.init(4096, DM, 128, F.bid & 127);
              EpiResid E{xa, xb, F.mods() + ((size_t)l * 3 * 6 + 2) * DM, kh ? F.ypre2() : F.ypre(), 32, kh};
              pg8::gemm_phase<EpiResid, pg8::StaticOrder, true, true>(F.lds, g, S, E, F.wave); }
            SEAM(k0 + 5); }
        if (IN(k0 + 6)) { FRESH(); ln_phase(F, F.inp(I_LN1G) + l * DM, F.inp(I_LN1B) + l * DM, F.x1(), F.mods() + (size_t)l * 3 * 6 * DM, 3); SEAM(k0 + 6); }
        if (IN(k0 + 7)) {
            pg8::Gemm g{(const pg8::bf16_t*)F.hbuf(), (const pg8::bf16_t*)F.wT(l, WO_GU), MROWS, DGU, DM, DM}; pg8::StaticOrder S; S.init(MROWS, DGU, F.G, F.bid);
            EpiSwiGLU E{F.act()};
            pg8::gemm_phase<EpiSwiGLU, pg8::StaticOrder, true, true>(F.lds, g, S, E, F.wave);
            SEAM(k0 + 7); }
        if (IN(k0 + 8)) {
            { pg8::Gemm g{(const pg8::bf16_t*)F.act(), (const pg8::bf16_t*)F.wT(l, WO_DN), 8192, DM, DFF, DFF}; pg8::StaticOrder S; S.init(8192, DM, F.G, F.bid);
              EpiResid E{F.x1(), F.x1() + (size_t)R_CTX * DM, F.mods() + ((size_t)l * 3 * 6 + 5) * DM, F.ypre(), 0, 0};
              pg8::gemm_phase<EpiResid, pg8::StaticOrder, true, true>(F.lds, g, S, E, F.wave); }
            __syncthreads();
            { const int kh = F.bid >> 7; pg8::Gemm g{(const pg8::bf16_t*)(F.act() + (size_t)8192 * DFF + kh * (DFF / 2)), (const pg8::bf16_t*)(F.wT(l, WO_DN) + kh * (DFF / 2)), 4096, DM, DFF / 2, DFF}; pg8::StaticOrder S; S.init(4096, DM, 128, F.bid & 127);
              EpiResid E{F.x1(), F.x1() + (size_t)R_CTX * DM, F.mods() + ((size_t)l * 3 * 6 + 5) * DM, kh ? F.ypre2() : F.ypre(), 32, kh};
              pg8::gemm_phase<EpiResid, pg8::StaticOrder, true, true>(F.lds, g, S, E, F.wave); }
            SEAM(k0 + 8); }
        if (IN(k0 + 9)) { FRESH(); ln_phase(F, F.inp(I_LN2G) + l * DM, F.inp(I_LN2B) + l * DM, F.out + O_YP, l + 1 < DEPTH ? F.mods() + (size_t)(l + 1) * 3 * 6 * DM : nullptr, 0); SEAM(k0 + 9); }
    }
#undef IN
#undef SEAM
#undef FRESH
}

#ifndef MK_SINGLE
#define MK_SINGLE 1
#endif
extern "C" void kernel_launch(void* const* d_in, const int* in_sizes, int n_in, void* d_out, int out_size, void* d_ws, size_t ws_size, hipStream_t stream) {
    static int grid = 0;
    if (grid == 0) {
        if (n_in != 24 || out_size != (int)O_END || ws_size < WS_END) { fprintf(stderr, "kernel_launch: unexpected sizes n_in %d out %d ws %zu\n", n_in, out_size, ws_size); grid = -1; return; }
        int dev = 0, cus = 0, per_cu = 0;
        if (hipGetDevice(&dev) != hipSuccess || hipDeviceGetAttribute(&cus, hipDeviceAttributeMultiprocessorCount, dev) != hipSuccess) { grid = -1; return; }
        if (hipFuncSetAttribute((const void*)fwd_kernel, hipFuncAttributeMaxDynamicSharedMemorySize, LDS_BYTES) != hipSuccess) { fprintf(stderr, "kernel_launch: hipFuncSetAttribute failed\n"); grid = -1; return; }
        if (hipOccupancyMaxActiveBlocksPerMultiprocessor(&per_cu, (const void*)fwd_kernel, 512, LDS_BYTES) != hipSuccess || per_cu < 1) fprintf(stderr, "kernel_launch: occupancy query says %d\n", per_cu);
        (void)hipGetLastError();
        grid = cus;
    }
    if (grid < 0) return;
    (void)hipMemsetAsync((char*)d_ws + WS_CTL, 0, CTL_ZERO_BYTES, stream);
    Args a{};
    for (int i = 0; i < 24; ++i) a.in[i] = (const float*)d_in[i];
    a.out = (float*)d_out; a.ws = (unsigned char*)d_ws; a.pad = 0;
#if MK_SINGLE
    a.ph_lo = 0; a.ph_hi = N_PHASES; a.single = 1;
    hipLaunchKernelGGL(fwd_kernel, dim3(grid), dim3(512), LDS_BYTES, stream, a);
#else
    a.single = 0;
    for (int p = 0; p < N_PHASES; ++p) { a.ph_lo = p; a.ph_hi = p + 1; hipLaunchKernelGGL(fwd_kernel, dim3(grid), dim3(512), LDS_BYTES, stream, a);
#ifdef PROBE_REP_MASK
        const int ty = p == 0 ? 10 : (p == 1 ? 11 : (p - 2) % PH_PER_LAYER);
        if ((PROBE_REP_MASK >> ty) & 1) for (int r = 0; r < PROBE_REP_N; ++r) hipLaunchKernelGGL(fwd_kernel, dim3(grid), dim3(512), LDS_BYTES, stream, a);
#endif
    }
#endif
}
```

```cpp
#include <hip/hip_runtime.h>
#include <cstdio>
#include <cstdint>
namespace pg8 {
#define PG8_LAS __attribute__((address_space(3)))
typedef unsigned short bf16_t;
typedef short bf16x8 __attribute__((ext_vector_type(8)));
typedef float f32x4 __attribute__((ext_vector_type(4)));
typedef unsigned u32x4 __attribute__((ext_vector_type(4)));
constexpr int BM = 256, BK = 64, HALF = 128, HTB = HALF * BK * 2  , STAGE_BYTES = 8 * HTB, NXCD = 8, WGM = 8;

__host__ __device__ __forceinline__ int lds_byte(int r, int c) { const int st = (r >> 4) * 2 + (c >> 5), rr = r & 15, cc = c & 31, ob = rr * 64 + cc * 2; return st * 1024 + (ob ^ (((ob >> 9) & 1) << 5)); }
__host__ __device__ __forceinline__ void stage_rc(int b, int& R, int& C) { const int st = b / 1024, sb = b % 1024, swz = sb ^ (((sb >> 9) & 1) << 5); R = (st >> 1) * 16 + swz / 64; C = (st & 1) * 32 + (swz % 64) / 2; }
__host__ __device__ __forceinline__ int perm32(int rho) { const int n = rho >> 4, i = rho & 15; return 8 * (i >> 2) + 4 * n + (i & 3); }

struct Unit { int pm, pn; };
struct Gemm { const bf16_t* A; const bf16_t* Bt; int M, N, K, ld; };

struct StaticOrder {
    int nM, nN, nwg, G, c;
    __host__ __device__ void init(int M, int N, int G_, int c_) { nM = M / BM; nN = N / BM; nwg = nM * nN; G = G_; c = c_; }
    __host__ __device__ bool next(int i, Unit& u) const {
        const long L = (long)i * G + c; if (L >= nwg) return false;
        int wgid = (int)L; { const int q = nwg / NXCD, r = nwg % NXCD, xcd = wgid % NXCD, off = wgid / NXCD; wgid = (xcd < r ? xcd * (q + 1) : r * (q + 1) + (xcd - r) * q) + off; }
        const int nig = WGM * nN, gid = wgid / nig, fm = gid * WGM, gsz = (nM - fm) < WGM ? (nM - fm) : WGM;
        u.pm = fm + ((wgid % nig) % gsz); u.pn = (wgid % nig) / gsz; return true;
    }
    __device__ __forceinline__ void a_ready(const Unit&) const {}
    __device__ __forceinline__ void done(const Unit&) const {}
};
__device__ __forceinline__ unsigned cvt_pk_bf16(float lo, float hi) { unsigned r; asm volatile("v_cvt_pk_bf16_f32 %0, %1, %2" : "=v"(r) : "v"(lo), "v"(hi)); return r; }
typedef float f32x2 __attribute__((ext_vector_type(2)));
template <class Epi, class Sched, bool ALIGN_EPI = false, bool SP2 = false>
__device__ __forceinline__ void gemm_phase(PG8_LAS unsigned char* lds, const Gemm g, const Sched& S, const Epi& E, int wid_in) {
    int lane_ = (int)__builtin_amdgcn_mbcnt_hi(~0u, __builtin_amdgcn_mbcnt_lo(~0u, 0u)); asm volatile("" : "+v"(lane_)); asm volatile("" : "+s"(wid_in));
    const int wid = wid_in, lane = lane_, tid = wid * 64 + lane, wr = wid >> 2, wc = wid & 3, fr = lane & 15, fq = lane >> 4;
    const int K = g.K, nt = K / BK, LD = g.ld;
    unsigned voffA[2], voffB[2];
#pragma unroll
    for (int i = 0; i < 2; ++i) { int R, C; stage_rc(tid * 16 + i * 8192, R, C); const int Rb = Epi::PERM ? ((R & ~31) + perm32(R & 31)) : R;
        voffA[i] = (unsigned)(R * LD + C) * 2u; voffB[i] = (unsigned)(Rb * LD + C) * 2u; }
    const size_t kstep = (size_t)(BK * 2);
    const size_t hstep = (size_t)HALF * LD * 2;
    const size_t tstep = 2 * hstep;
    const unsigned ldsw = (unsigned)wid * 1024u;
    const int aoff = lds_byte(wr * 64 + fr, fq * 8), boff = lds_byte(wc * 32 + fr, fq * 8);
#define PG8_SA(b, h) (((b) * 2 + (h)) * HTB)
#define PG8_SB(b, h) ((4 + (b) * 2 + (h)) * HTB)
#define PG8_STAGE(bufoff, gbase, voff) do { _Pragma("unroll") for (int _i = 0; _i < 2; ++_i) \
        __builtin_amdgcn_global_load_lds((const unsigned*)((const char*)(gbase) + (voff)[_i]), (PG8_LAS unsigned*)(lds + (bufoff) + ldsw + _i * 8192), 16, 0, 0); } while (0)
#define PG8_LDA(dst, b, h) do { _Pragma("unroll") for (int m = 0; m < 4; ++m) _Pragma("unroll") for (int k = 0; k < 2; ++k) dst[m][k] = *(const PG8_LAS bf16x8*)(lds + PG8_SA(b, h) + aoff + m * 2048 + k * 1024); } while (0)
#define PG8_LDB(dst, b, h) do { _Pragma("unroll") for (int n = 0; n < 2; ++n) _Pragma("unroll") for (int k = 0; k < 2; ++k) dst[n][k] = *(const PG8_LAS bf16x8*)(lds + PG8_SB(b, h) + boff + n * 2048 + k * 1024); } while (0)
#define PG8_MMA(ai, bj, At, Bt) do { __builtin_amdgcn_s_setprio(1); _Pragma("unroll") for (int m = 0; m < 4; ++m) _Pragma("unroll") for (int n = 0; n < 2; ++n) _Pragma("unroll") for (int k = 0; k < 2; ++k) \
        acc[ai][bj][m][n] = __builtin_amdgcn_mfma_f32_16x16x32_bf16(Bt[n][k], At[m][k], acc[ai][bj][m][n], 0, 0, 0); __builtin_amdgcn_s_setprio(0); } while (0)
#define PG8_WAIT_V(n) asm volatile("s_waitcnt vmcnt(" #n ")" ::: "memory")
#define PG8_WAIT_L(n) asm volatile("s_waitcnt lgkmcnt(" #n ")" ::: "memory")
#define PG8_BAR __builtin_amdgcn_s_barrier()
#define PG8_SCHED __builtin_amdgcn_sched_barrier(0)
    Unit cur, nxt; int ui = 0;
    if (!S.next(0, cur)) return;
    f32x4 acc[2][2][4][2];
#pragma unroll
    for (int a = 0; a < 2; ++a)
#pragma unroll
        for (int b = 0; b < 2; ++b)
#pragma unroll
            for (int m = 0; m < 4; ++m)
#pragma unroll
                for (int n = 0; n < 2; ++n) acc[a][b][m][n] = (f32x4){0.f, 0.f, 0.f, 0.f};
    bf16x8 At[4][2], B0[2][2], B1[2][2];
    const char* cA = (const char*)g.A + (size_t)cur.pm * tstep; const char* cB = (const char*)g.Bt + (size_t)cur.pn * tstep;
    S.a_ready(cur);
    if constexpr (SP2) {
        PG8_STAGE(PG8_SB(0, 0), cB, voffB); PG8_STAGE(PG8_SB(0, 1), cB + hstep, voffB); PG8_STAGE(PG8_SA(0, 0), cA, voffA); PG8_STAGE(PG8_SA(0, 1), cA + hstep, voffA);
        if (wr == 1) PG8_BAR;
        PG8_WAIT_V(2); PG8_BAR;
        PG8_STAGE(PG8_SB(1, 0), cB + kstep, voffB); PG8_STAGE(PG8_SA(1, 0), cA + kstep, voffA); PG8_STAGE(PG8_SB(1, 1), cB + hstep + kstep, voffB);
        PG8_WAIT_V(6); PG8_BAR;
    } else {
        PG8_STAGE(PG8_SB(0, 0), cB, voffB); PG8_STAGE(PG8_SA(0, 0), cA, voffA); PG8_STAGE(PG8_SB(0, 1), cB + hstep, voffB); PG8_STAGE(PG8_SA(0, 1), cA + hstep, voffA);
        if (wr == 1) PG8_BAR;
        PG8_WAIT_V(4); PG8_BAR;
        PG8_STAGE(PG8_SB(1, 0), cB + kstep, voffB); PG8_STAGE(PG8_SA(1, 0), cA + kstep, voffA); PG8_STAGE(PG8_SB(1, 1), cB + hstep + kstep, voffB);
        PG8_WAIT_V(6); PG8_BAR;
    }
    for (;;) {
        const bool has_next = S.next(ui + 1, nxt);
        const char* nA = has_next ? (const char*)g.A + (size_t)nxt.pm * tstep : cA; const char* nB = has_next ? (const char*)g.Bt + (size_t)nxt.pn * tstep : cB;
        for (int t = 0; t < nt; t += 2) {
            const bool last = (t == nt - 2);
            const char* a1 = cA + (size_t)(t + 1) * kstep;
            const char* a2 = last ? nA : cA + (size_t)(t + 2) * kstep; const char* b2 = last ? nB : cB + (size_t)(t + 2) * kstep;
            const char* a3 = a2 + kstep; const char* b3 = b2 + kstep;
            if (last && has_next) S.a_ready(nxt);
            if constexpr (SP2) {
            PG8_LDB(B0, 0, 0); PG8_LDB(B1, 0, 1); PG8_SCHED; PG8_LDA(At, 0, 0); PG8_STAGE(PG8_SA(1, 1), a1 + hstep, voffA);
            PG8_WAIT_V(8); PG8_WAIT_L(0); PG8_BAR; PG8_MMA(0, 0, At, B0); PG8_MMA(0, 1, At, B1); PG8_BAR; PG8_SCHED;
            PG8_LDA(At, 0, 1); PG8_STAGE(PG8_SB(0, 0), b2, voffB); PG8_STAGE(PG8_SB(0, 1), b2 + hstep, voffB); PG8_STAGE(PG8_SA(0, 0), a2, voffA);
            PG8_WAIT_V(8); PG8_WAIT_L(0); PG8_BAR; PG8_MMA(1, 0, At, B0); PG8_MMA(1, 1, At, B1); PG8_BAR; PG8_SCHED;
            PG8_LDB(B0, 1, 0); PG8_LDB(B1, 1, 1); PG8_SCHED; PG8_LDA(At, 1, 0); PG8_STAGE(PG8_SA(0, 1), a2 + hstep, voffA);
            PG8_WAIT_V(8); PG8_WAIT_L(0); PG8_BAR; PG8_MMA(0, 0, At, B0); PG8_MMA(0, 1, At, B1); PG8_BAR; PG8_SCHED;
            PG8_LDA(At, 1, 1); PG8_STAGE(PG8_SB(1, 0), b3, voffB); PG8_STAGE(PG8_SB(1, 1), b3 + hstep, voffB); PG8_STAGE(PG8_SA(1, 0), a3, voffA);
            PG8_WAIT_V(8); PG8_WAIT_L(0); PG8_BAR; PG8_MMA(1, 0, At, B0); PG8_MMA(1, 1, At, B1); PG8_BAR; PG8_SCHED;
            } else {
            PG8_LDB(B0, 0, 0); PG8_SCHED; PG8_LDA(At, 0, 0); PG8_STAGE(PG8_SA(1, 1), a1 + hstep, voffA);
            PG8_WAIT_L(8); PG8_BAR; PG8_WAIT_L(0); PG8_MMA(0, 0, At, B0); PG8_BAR; PG8_SCHED;
            PG8_LDB(B1, 0, 1); PG8_STAGE(PG8_SB(0, 0), b2, voffB);
            PG8_BAR; PG8_WAIT_L(0); PG8_MMA(0, 1, At, B1); PG8_BAR;
            PG8_LDA(At, 0, 1); PG8_STAGE(PG8_SA(0, 0), a2, voffA);
            PG8_BAR; PG8_WAIT_L(0); PG8_MMA(1, 0, At, B0); PG8_BAR; PG8_SCHED;
            PG8_STAGE(PG8_SB(0, 1), b2 + hstep, voffB);
            PG8_WAIT_V(6); PG8_BAR; PG8_MMA(1, 1, At, B1); PG8_BAR;
            PG8_LDB(B0, 1, 0); PG8_SCHED; PG8_LDA(At, 1, 0); PG8_STAGE(PG8_SA(0, 1), a2 + hstep, voffA);
            PG8_WAIT_L(8); PG8_BAR; PG8_WAIT_L(0); PG8_MMA(0, 0, At, B0); PG8_BAR; PG8_SCHED;
            PG8_LDB(B1, 1, 1); PG8_STAGE(PG8_SB(1, 0), b3, voffB);
            PG8_BAR; PG8_WAIT_L(0); PG8_MMA(0, 1, At, B1); PG8_BAR;
            PG8_LDA(At, 1, 1); PG8_STAGE(PG8_SA(1, 0), a3, voffA);
            PG8_BAR; PG8_WAIT_L(0); PG8_MMA(1, 0, At, B0); PG8_BAR; PG8_SCHED;
            PG8_STAGE(PG8_SB(1, 1), b3 + hstep, voffB);
            PG8_WAIT_V(6); PG8_BAR; PG8_MMA(1, 1, At, B1); PG8_BAR;
            }
        }
        if constexpr (ALIGN_EPI) { if (wr == 0) PG8_BAR; }
        if constexpr (!Epi::AFTER_DRAIN) { E(acc, cur, wr, wc, fr, fq); S.done(cur); }
        if (!has_next) break;
#pragma unroll
        for (int a = 0; a < 2; ++a)
#pragma unroll
            for (int b = 0; b < 2; ++b)
#pragma unroll
                for (int m = 0; m < 4; ++m)
#pragma unroll
                    for (int n = 0; n < 2; ++n) acc[a][b][m][n] = (f32x4){0.f, 0.f, 0.f, 0.f};
        cur = nxt; cA = nA; cB = nB; ++ui;
        if constexpr (ALIGN_EPI) { if (wr == 1) PG8_BAR; }
    }
    PG8_WAIT_V(0);
    if constexpr (!ALIGN_EPI) { if (wr == 0) PG8_BAR; }
    PG8_BAR;
    if constexpr (Epi::AFTER_DRAIN) { E.fused(acc, cur, wr, wc, fr, fq, lds, wid, lane); S.done(cur); }
#undef PG8_SA
#undef PG8_SB
#undef PG8_STAGE
#undef PG8_LDA
#undef PG8_LDB
#undef PG8_MMA
#undef PG8_WAIT_V
#undef PG8_WAIT_L
#undef PG8_BAR
#undef PG8_SCHED
}
}
#define GAS __attribute__((address_space(1)))
#define LAS __attribute__((address_space(3)))
typedef unsigned short bf16;
typedef unsigned v4u __attribute__((ext_vector_type(4)));
typedef float f32x4 __attribute__((ext_vector_type(4)));
typedef short bf16x8 __attribute__((ext_vector_type(8)));
typedef GAS unsigned gu32;
typedef GAS unsigned long long gu64;
#define RLX_AGENT __ATOMIC_RELAXED, __HIP_MEMORY_SCOPE_AGENT
#define LDS_WAIT() asm volatile("s_waitcnt lgkmcnt(0)" ::: "memory")
#define VM_WAIT() asm volatile("s_waitcnt vmcnt(0)" ::: "memory")
__device__ __forceinline__ unsigned long long rt() { return __builtin_amdgcn_s_memrealtime(); }
__device__ __forceinline__ unsigned f2bf(float f) { unsigned u = __builtin_bit_cast(unsigned, f); return (u + 0x7fffu + ((u >> 16) & 1u)) >> 16; }
__device__ __forceinline__ unsigned pk2(float lo, float hi) { return f2bf(lo) | (f2bf(hi) << 16); }
#define XB_TMO      128
#define XB_XCNT(j)  (256  + 64 * (j))
#define XB_XSUB(j)  (1280 + 64 * (j))
#define XB_XGEN(j)  (2304 + 64 * (j))
#define XB_TOP      3328
#define XB_TOPGEN   3392
#define XCD_BAR_WORDS 3456
#define XB_SPIN_CAP (1u << 24)

__device__ __forceinline__ unsigned xb_ld(unsigned* p)              { return __hip_atomic_load(p, __ATOMIC_RELAXED, __HIP_MEMORY_SCOPE_AGENT); }
__device__ __forceinline__ unsigned xb_add(unsigned* p, unsigned v) { return __hip_atomic_fetch_add(p, v, __ATOMIC_RELAXED, __HIP_MEMORY_SCOPE_AGENT); }
__device__ __forceinline__ unsigned xb_xcc_id() { return (unsigned)__builtin_amdgcn_s_getreg((3 << 11) | 20) & 0xFu; }
#define XB_SPIN(cond, bar) do { unsigned _sp = 0; while (cond) { __builtin_amdgcn_s_sleep(1); \
    if ((++_sp & 255u) == 0u) { if (xb_ld(&(bar)[XB_TMO])) break; if (_sp > XB_SPIN_CAP) { atomicAdd(&(bar)[XB_TMO], 1u); break; } } } } while (0)

struct XcdBarrier {
    unsigned* bar; unsigned x;
    volatile LAS unsigned* st;
};

__device__ __forceinline__ XcdBarrier xcd_barrier_post(unsigned* bar, volatile LAS unsigned* st) {
    XcdBarrier b; b.bar = bar; b.x = xb_xcc_id(); b.st = st;
    if (threadIdx.x == 0) (void)xb_add(&bar[XB_XCNT(b.x)], 1u);
    return b;
}
__device__ __forceinline__ void xcd_barrier_complete(unsigned* bar, unsigned x, unsigned& nloc, unsigned& nx) {
    const unsigned G = gridDim.x * gridDim.y * gridDim.z;
    unsigned sum, cnt, mine, sp = 0u;
    for (;;) {
        sum = 0u; cnt = 0u; mine = 0u;
#pragma unroll
        for (unsigned j = 0; j < 16; ++j) { const unsigned c = xb_ld(&bar[XB_XCNT(j)]); sum += c; cnt += (c > 0u) ? 1u : 0u; mine = (j == x) ? c : mine; }
        if (sum == G) break;
        __builtin_amdgcn_s_sleep(1);
        if ((++sp & 255u) == 0u) { if (xb_ld(&bar[XB_TMO])) break; if (sp > XB_SPIN_CAP) { atomicAdd(&bar[XB_TMO], 1u); break; } }
    }
    nloc = mine > 0u ? mine : 1u; nx = cnt > 0u ? cnt : 1u;
}

__device__ __forceinline__ void xcd_barrier(const XcdBarrier& b) {
    asm volatile("s_waitcnt vmcnt(0)" ::: "memory");
    __syncthreads();
    if (threadIdx.x == 0) {
        unsigned* bar = b.bar;
        __builtin_amdgcn_s_waitcnt(0);
        unsigned nloc = b.st[0], nx = b.st[1];
        if (nloc == 0u) { xcd_barrier_complete(bar, b.x, nloc, nx); b.st[0] = nloc; b.st[1] = nx; }
        const unsigned old = xb_add(&bar[XB_XSUB(b.x)], 1u);
        const unsigned gen = old / nloc;
        if (old + 1u == (gen + 1u) * nloc) {
            __builtin_amdgcn_fence(__ATOMIC_RELEASE, "agent");
            asm volatile("s_waitcnt vmcnt(0)" ::: "memory");
            const unsigned og = xb_add(&bar[XB_TOP], 1u);
            const unsigned tg = og / nx;
            if (og + 1u == (tg + 1u) * nx) xb_add(&bar[XB_TOPGEN], 1u);
            else XB_SPIN(xb_ld(&bar[XB_TOPGEN]) == tg, bar);
            __builtin_amdgcn_fence(__ATOMIC_ACQUIRE, "agent");
            xb_add(&bar[XB_XGEN(b.x)], 1u);
            asm volatile("s_waitcnt vmcnt(0)" ::: "memory");
        } else {
            XB_SPIN(xb_ld(&bar[XB_XGEN(b.x)]) == gen, bar);
            __builtin_amdgcn_fence(__ATOMIC_ACQUIRE, "agent");
            asm volatile("s_waitcnt vmcnt(0)" ::: "memory");
        }
    }
    __syncthreads();
}

constexpr int DM = 2048;
constexpr int NB_CTX = 16, S_CTX = 256, NB_LAT = 2, S_LAT = 4096, DEPTH = 4;
constexpr int R_CTX = NB_CTX * S_CTX;
constexpr int R_LAT = NB_LAT * S_LAT;
constexpr int MROWS = R_CTX + R_LAT;
constexpr int DIN = 5632, DFF = 5632, DGU = 2 * DFF;
constexpr float ALPHA = 1.6817928305074292f;
constexpr int C_AQ = 0, C_AK = 512, C_AV = 1024, C_BQ = 1536, C_BF = 2048, C_BB = 2560, C_BI = 3072, C_BG = 3584, C_CQ = 4096, C_CK = 5120, C_CV = 5376;
constexpr size_t O_YP = 0, O_YS = 8388608, O_DK = 25165824, O_DV = 33554432, O_SK = 41943040, O_SV = 46137344, O_ST = 50331648, O_END = 58720256;

constexpr size_t MiB = 1u << 20;
constexpr size_t WS_CTL = 0, CTL_ZERO_BYTES = 1 * MiB;
constexpr size_t WS_MODS = 1 * MiB;
constexpr size_t WS_MISC = 2 * MiB;
constexpr size_t WS_W = 4 * MiB, W_LAYER = 96 * MiB;
constexpr size_t WO_IN = 0, WO_OUT = 22 * MiB, WO_GU = 30 * MiB, WO_DN = 74 * MiB;
constexpr size_t WS_H = 388 * MiB;
constexpr size_t WS_CAT = 436 * MiB;
constexpr size_t WS_X1 = 484 * MiB;
constexpr size_t WS_OA = 580 * MiB, WS_OBF = 604 * MiB, WS_OBB = 628 * MiB;
constexpr size_t WS_P = 652 * MiB;
constexpr size_t WS_ACT = WS_P, WS_YPRE = WS_P + 132 * MiB;
constexpr size_t WS_C16 = 916 * MiB;
constexpr size_t WS_QKV = 922 * MiB;
constexpr int HP_LD = 2560;
constexpr int QKV_LD = 3072, Q_QD = 0, Q_KD = 512, Q_VD = 1024, Q_QS = 1536, Q_KS = 2560, Q_VS = 2816;
constexpr size_t WS_HQ = 994 * MiB;
constexpr size_t WS_HKM = 1018 * MiB;
constexpr size_t WS_HKP = 1042 * MiB;
constexpr size_t WS_HVT = 1066 * MiB;
constexpr size_t WS_HDEC = 1090 * MiB;
constexpr size_t WS_SLOC = 1094 * MiB;
constexpr size_t WS_DSEG = 1110 * MiB;
constexpr size_t WS_YPRE2 = 1111 * MiB;
constexpr size_t WS_END = 1143 * MiB;

constexpr int CW_BAR = 4096;

constexpr int RING_BYTES = 131072;
constexpr int LDSCTL_OFF = RING_BYTES, MISC_OFF = LDSCTL_OFF + 320;
constexpr int LDS_BYTES = 147456;

typedef unsigned v2u __attribute__((ext_vector_type(2)));
typedef GAS float gf32;
typedef GAS unsigned short gbf16;

__device__ __forceinline__ float silu_f(float a) { return a / (1.0f + __expf(-a)); }
__device__ __forceinline__ int mod_of_row(int row) { return row < R_CTX ? 0 : (row < R_CTX + S_LAT ? 1 : 2); }

constexpr float LOG2E = 1.4426950408889634f;
constexpr float QSC_D = 0.125f * LOG2E, QSC_S = 0.08838834764831845f * LOG2E;
struct EpiProj {
    static constexpr bool PERM = false, AFTER_DRAIN = false;
    gbf16* qkv; gf32* hproj; gf32* out; const gf32* tabD; const gf32* tabS; int l;
    __device__ __forceinline__ void operator()(const pg8::f32x4 (&acc)[2][2][4][2], const pg8::Unit& u, int wr, int wc, int fr, int fq) const {
        const int pn = u.pn, pm = u.pm, rbase = pm * 256 + wr * 64 + fr;
        if (pn >= 6 && pn < 16) {
#pragma unroll
            for (int ai = 0; ai < 2; ++ai)
#pragma unroll
                for (int m = 0; m < 4; ++m) { gf32* rowp = hproj + (size_t)(rbase + ai * 128 + m * 16) * HP_LD + (pn - 6) * 256 + wc * 32 + 4 * fq;
#pragma unroll
                    for (int bj = 0; bj < 2; ++bj)
#pragma unroll
                        for (int n = 0; n < 2; ++n) *(GAS pg8::f32x4*)(rowp + bj * 128 + n * 16) = acc[ai][bj][m][n]; }
            return;
        }
        const bool lat = pm >= 16, swar = pn >= 16 && pn <= 20, isv = pn == 4 || pn == 5 || pn == 21, rope = lat && !isv;
        const float sc = pn < 2 ? QSC_D : (pn >= 16 && pn < 20 ? QSC_S : 1.0f);
        const int o1 = swar ? pn * 256 + 64 * (wc >> 1) + 16 * (wc & 1) + 4 * fq : pn * 256 + 32 * wc + 4 * fq, dn = swar ? 32 : 16;
        const int qoff = pn < 6 ? 0 : Q_QS - C_CQ;
        const int ppar = swar ? (wc >> 1) & 1 : wc & 1;
        const gf32* tab = swar ? tabS + (16 * (wc & 1) + 4 * fq) * 2 : tabD + 4 * fq * 2; const int tstr = swar ? 64 : 32;
        size_t cbase = 0; int nh = 0; bool tocache = false;
        if (!lat) { if (pn == 2 || pn == 3) { cbase = O_DK; nh = 4; tocache = true; } else if (pn == 4 || pn == 5) { cbase = O_DV; nh = 4; tocache = true; } else if (pn == 20) { cbase = O_SK; nh = 2; tocache = true; } else if (pn == 21) { cbase = O_SV; nh = 2; tocache = true; } }
        const int hd0 = (pn == 2 || pn == 3) ? 2 * (pn - 2) : ((pn == 4 || pn == 5) ? 2 * (pn - 4) : 0);
        const int cc1 = o1 & 127;
#pragma unroll
        for (int ai = 0; ai < 2; ++ai)
#pragma unroll
            for (int m = 0; m < 4; ++m) {
                const int row = rbase + ai * 128 + m * 16;
                pg8::f32x4 cs = {1.f, 1.f, 1.f, 1.f}, sn = {0.f, 0.f, 0.f, 0.f};
                if (rope) { const int t = (row - R_CTX) & (S_LAT - 1), pos = ppar ? (t & 63) : (t >> 6);
                    const pg8::f32x4 t0 = *(const GAS pg8::f32x4*)(tab + pos * tstr), t1 = *(const GAS pg8::f32x4*)(tab + pos * tstr + 4);
                    cs = (pg8::f32x4){t0[0], t0[2], t1[0], t1[2]}; sn = (pg8::f32x4){t0[1], t0[3], t1[1], t1[3]}; }
                gbf16* qrow = qkv + (size_t)row * QKV_LD + qoff + o1;
#pragma unroll
                for (int bj = 0; bj < 2; ++bj) {
                    const pg8::f32x4 x1 = acc[ai][bj][m][0], x2 = acc[ai][bj][m][1];
                    const pg8::f32x4 y1 = (x1 * cs - x2 * sn) * sc, y2 = (x2 * cs + x1 * sn) * sc;
                    *(GAS v2u*)(qrow + bj * 128) = (v2u){pg8::cvt_pk_bf16(y1[0], y1[1]), pg8::cvt_pk_bf16(y1[2], y1[3])};
                    *(GAS v2u*)(qrow + bj * 128 + dn) = (v2u){pg8::cvt_pk_bf16(y2[0], y2[1]), pg8::cvt_pk_bf16(y2[2], y2[3])};
                    if (tocache) { gf32* cp = out + cbase + ((((size_t)pm * 4 + l) * nh + hd0 + bj) * 256 + (row & 255)) * 128 + cc1;
                        *(GAS pg8::f32x4*)cp = x1; *(GAS pg8::f32x4*)(cp + dn) = x2; }
                }
            }
    }
};
struct EpiResid {
    static constexpr bool PERM = false, AFTER_DRAIN = false;
    const gf32* xa; const gf32* xb;
    const gf32* gates;
    gf32* out; int pm_off; int gate_only;
    __device__ __forceinline__ void operator()(const pg8::f32x4 (&acc)[2][2][4][2], const pg8::Unit& u, int wr, int wc, int fr, int fq) const {
        const int pm = u.pm + pm_off, mod = pm >> 4;
        const gf32* xbase = (pm < 16) ? xa + (size_t)pm * 256 * DM : xb + (size_t)(pm - 16) * 256 * DM;
        const int r0 = wr * 64 + fr, col0 = u.pn * 256 + wc * 32 + 4 * fq;
        pg8::f32x4 gv[2][2];
#pragma unroll
        for (int bj = 0; bj < 2; ++bj)
#pragma unroll
            for (int n = 0; n < 2; ++n) gv[bj][n] = *(const GAS pg8::f32x4*)(gates + (size_t)mod * 6 * DM + col0 + bj * 128 + n * 16);
#pragma unroll
        for (int ai = 0; ai < 2; ++ai)
#pragma unroll
            for (int m = 0; m < 4; ++m) { const int r = r0 + ai * 128 + m * 16;
                const gf32* xp = xbase + (size_t)r * DM + col0; gf32* op = out + ((size_t)(gate_only ? u.pm : pm) * 256 + r) * DM + col0;
#pragma unroll
                for (int bj = 0; bj < 2; ++bj)
#pragma unroll
                    for (int n = 0; n < 2; ++n) { pg8::f32x4 v = gv[bj][n] * acc[ai][bj][m][n];
                        if (!gate_only) v += *(const GAS pg8::f32x4*)(xp + bj * 128 + n * 16) * ALPHA;
                        *(GAS pg8::f32x4*)(op + bj * 128 + n * 16) = v; } }
    }
};
struct EpiSwiGLU {
    static constexpr bool PERM = true, AFTER_DRAIN = false;
    gbf16* act;
    __device__ __forceinline__ void operator()(const pg8::f32x4 (&acc)[2][2][4][2], const pg8::Unit& u, int wr, int wc, int fr, int fq) const {
        const int row0 = u.pm * 256 + wr * 64 + fr, col0 = u.pn * 128 + wc * 32 + 8 * fq;
#pragma unroll
        for (int ai = 0; ai < 2; ++ai)
#pragma unroll
            for (int m = 0; m < 4; ++m) { gbf16* rowp = act + (size_t)(row0 + ai * 128 + m * 16) * DFF + col0;
                float r[8];
#pragma unroll
                for (int n = 0; n < 2; ++n)
#pragma unroll
                    for (int j = 0; j < 4; ++j) { const float g = acc[ai][0][m][n][j], up = acc[ai][1][m][n][j]; r[n * 4 + j] = silu_f(g) * up; }
                pg8::u32x4 w; w.x = pg8::cvt_pk_bf16(r[0], r[1]); w.y = pg8::cvt_pk_bf16(r[2], r[3]); w.z = pg8::cvt_pk_bf16(r[4], r[5]); w.w = pg8::cvt_pk_bf16(r[6], r[7]);
                *(GAS pg8::u32x4*)rowp = w; }
    }
};

struct Args { const float* in[24]; float* out; unsigned char* ws; int ph_lo, ph_hi, single, pad; };
enum { I_XP = 0, I_XS, I_CDK, I_CDV, I_CSK, I_CSV, I_ST, I_C, I_CCTX, I_WMOD, I_BMOD, I_WIN, I_WOUT, I_DLAM, I_DNG, I_LBL, I_HNG, I_SINK, I_LN1G, I_LN1B, I_LN2G, I_LN2B, I_WGU, I_WDN };

struct Ctx {
    LAS unsigned char* lds; int tid, lane, wave, G, bid;
    const Args* ap; gf32* out; GAS unsigned char* ws;
    __device__ __forceinline__ const gf32* inp(int i) const { return (const gf32*)ap->in[i]; }
    __device__ __forceinline__ gf32* mods() const { return (gf32*)(ws + WS_MODS); }
    __device__ __forceinline__ gf32* lball() const { return (gf32*)(ws + WS_MISC); }
    __device__ __forceinline__ gf32* lamv() const { return (gf32*)(ws + WS_MISC + 16384); }
    __device__ __forceinline__ gf32* tabD() const { return (gf32*)(ws + WS_MISC + 20480); }
    __device__ __forceinline__ gf32* tabS() const { return (gf32*)(ws + WS_MISC + 32768); }
    __device__ __forceinline__ gbf16* wT(int l, size_t off) const { return (gbf16*)(ws + WS_W + (size_t)l * W_LAYER + off); }
    __device__ __forceinline__ gbf16* hbuf() const { return (gbf16*)(ws + WS_H); }
    __device__ __forceinline__ gbf16* cat() const { return (gbf16*)(ws + WS_CAT); }
    __device__ __forceinline__ gf32* x1() const { return (gf32*)(ws + WS_X1); }
    __device__ __forceinline__ gf32* oa() const { return (gf32*)(ws + WS_OA); }
    __device__ __forceinline__ gf32* obf() const { return (gf32*)(ws + WS_OBF); }
    __device__ __forceinline__ gf32* obb() const { return (gf32*)(ws + WS_OBB); }
    __device__ __forceinline__ gf32* hproj() const { return (gf32*)(ws + WS_P); }
    __device__ __forceinline__ gbf16* act() const { return (gbf16*)(ws + WS_ACT); }
    __device__ __forceinline__ gf32* ypre() const { return (gf32*)(ws + WS_YPRE); }
    __device__ __forceinline__ gf32* ypre2() const { return (gf32*)(ws + WS_YPRE2); }
    __device__ __forceinline__ gbf16* qkv() const { return (gbf16*)(ws + WS_QKV); }
    __device__ __forceinline__ gbf16* hq(int dir) const { return (gbf16*)(ws + WS_HQ) + (size_t)dir * MROWS * 512; }
    __device__ __forceinline__ gbf16* hkm(int dir) const { return (gbf16*)(ws + WS_HKM) + (size_t)dir * MROWS * 512; }
    __device__ __forceinline__ gbf16* hkp(int dir) const { return (gbf16*)(ws + WS_HKP) + (size_t)dir * 768 * 512 * 16; }
    __device__ __forceinline__ gbf16* hvt(int dir) const { return (gbf16*)(ws + WS_HVT) + (size_t)dir * 768 * 512 * 16; }
    __device__ __forceinline__ gf32* sloc() const { return (gf32*)(ws + WS_SLOC); }
    __device__ __forceinline__ gf32* dseg() const { return (gf32*)(ws + WS_DSEG); }
    __device__ __forceinline__ gf32* hdec(int dir) const { return (gf32*)(ws + WS_HDEC) + (size_t)dir * 768 * 512; }
    __device__ __forceinline__ gbf16* c16(size_t off) const { return (gbf16*)(ws + WS_C16 + off); }
};

template <bool SWAP64>
__device__ __forceinline__ void transpose_item(const gf32* W, int K, int N, gbf16* WT, int k0, int n0, int drow0, LAS float* scr, int lane) {
#pragma unroll 8
    for (int i = 0; i < 32; ++i) { const int kk = 2 * i + (lane >> 5); scr[kk * 33 + (lane & 31)] = W[(size_t)(k0 + kk) * N + n0 + (lane & 31)]; }
    LDS_WAIT(); asm volatile("" ::: "memory");
    const int c = lane & 7;
#pragma unroll
    for (int j = 0; j < 4; ++j) { const int n = (lane >> 3) + 8 * j; const LAS float* sp = scr + (8 * c) * 33 + n;
        int drow = drow0 + n;
        if (SWAP64) { const int o = (n0 & 63) + n, a = (o >> 4) & 1, nn = o >> 5, ii = o & 15; drow = (n0 & ~63) + 32 * a + 16 * nn + ii; }
        v4u o4; o4.x = pk2(sp[0 * 33], sp[1 * 33]); o4.y = pk2(sp[2 * 33], sp[3 * 33]); o4.z = pk2(sp[4 * 33], sp[5 * 33]); o4.w = pk2(sp[6 * 33], sp[7 * 33]);
        *(GAS v4u*)(WT + (size_t)drow * K + k0 + 8 * c) = o4; }
    LDS_WAIT(); asm volatile("" ::: "memory");
}

__device__ __forceinline__ void p0_prologue(const Ctx& F) {
    {
        LAS float* sc = (LAS float*)F.lds;
        LAS float* red = (LAS float*)(F.lds + 24576);
        const gf32* c_ctx = F.inp(I_CCTX); const gf32* cc = F.inp(I_C);
        for (int i = F.tid; i < 3 * DM; i += 512) { const int mid = i / DM, k = i % DM; const float c = mid == 0 ? c_ctx[k] : cc[(mid - 1) * DM + k]; sc[i] = silu_f(c); }
        __syncthreads();
        for (int task = F.bid; task < DEPTH * 48; task += F.G) {
            const int l = task / 48, cb = task % 48, w = F.wave;
            const gf32* wp = F.inp(I_WMOD) + ((size_t)l * DM + 256 * w) * (6 * DM) + cb * 256 + F.lane * 4;
            f32x4 a0 = {0.f, 0.f, 0.f, 0.f}, a1 = a0, a2 = a0;
#pragma unroll 8
            for (int kk = 0; kk < 256; ++kk) { const f32x4 wv = *(const GAS f32x4*)(wp + (size_t)kk * (6 * DM));
                a0 += wv * sc[256 * w + kk]; a1 += wv * sc[DM + 256 * w + kk]; a2 += wv * sc[2 * DM + 256 * w + kk]; }
            *(LAS f32x4*)(red + (w * 3 + 0) * 256 + F.lane * 4) = a0; *(LAS f32x4*)(red + (w * 3 + 1) * 256 + F.lane * 4) = a1; *(LAS f32x4*)(red + (w * 3 + 2) * 256 + F.lane * 4) = a2;
            __syncthreads();
            for (int i = F.tid; i < 768; i += 512) { const int m = i >> 8, c = i & 255; float s = 0.f;
#pragma unroll
                for (int ww = 0; ww < 8; ++ww) s += red[(ww * 3 + m) * 256 + c];
                F.mods()[((size_t)l * 3 + m) * (6 * DM) + cb * 256 + c] = s + F.inp(I_BMOD)[(size_t)l * 6 * DM + cb * 256 + c]; }
            __syncthreads();
        }
    }
    if (F.bid == F.G - 1) {
        const gf32* lbl = F.inp(I_LBL);
        for (int i = F.tid; i < 1024; i += 512) { float lg[4], mx = -1e30f;
#pragma unroll
            for (int l = 0; l < 4; ++l) { lg[l] = lbl[l * 1024 + i]; mx = fmaxf(mx, lg[l]); }
            float s = 0.f;
#pragma unroll
            for (int l = 0; l < 4; ++l) { lg[l] = expf(lg[l] - mx); s += lg[l]; }
            const float w1 = lg[1] / s, w2 = lg[2] / s, w3 = lg[3] / s;
            F.lball()[0 * 1024 + i] = 0.f; F.lball()[1 * 1024 + i] = w1; F.lball()[2 * 1024 + i] = w1 + w2; F.lball()[3 * 1024 + i] = w1 + w2 + w3; }
        if (F.tid < 4) { const int l = F.tid; const gf32* lp = F.inp(I_DLAM) + l * 256; float s1 = 0.f, s2 = 0.f;
            for (int i = 0; i < 64; ++i) { s1 += lp[i] * lp[64 + i]; s2 += lp[128 + i] * lp[192 + i]; }
            const float li = 0.8f - 0.6f * expf(-0.3f * (float)l);
            F.lamv()[l * 2] = expf(s1) - expf(s2) + li; F.lamv()[l * 2 + 1] = li; }
        for (int i = F.tid; i < 64 * 16; i += 512) { const int pos = i / 16, j = i % 16; const float inv = powf(10000.f, -(float)j / 16.f), ang = (float)pos * inv; F.tabD()[i * 2] = cosf(ang); F.tabD()[i * 2 + 1] = sinf(ang); }
        for (int i = F.tid; i < 64 * 32; i += 512) { const int pos = i / 32, j = i % 32; const float inv = powf(10000.f, -(float)j / 32.f), ang = (float)pos * inv; F.tabS()[i * 2] = cosf(ang); F.tabS()[i * 2 + 1] = sinf(ang); }
    }
    {
        const gf32* src[4] = {F.inp(I_CDK), F.inp(I_CDV), F.inp(I_CSK), F.inp(I_CSV)};
        const size_t doff[4] = {0, 2 * MiB, 4 * MiB, 5 * MiB}; const int n8[4] = {131072, 131072, 65536, 65536};
#pragma unroll
        for (int a = 0; a < 4; ++a)
            for (int i = F.bid * 512 + F.tid; i < n8[a]; i += F.G * 512) { const f32x4 x0 = *(const GAS f32x4*)(src[a] + (size_t)i * 8), x1 = *(const GAS f32x4*)(src[a] + (size_t)i * 8 + 4);
                v4u o; o.x = pk2(x0[0], x0[1]); o.y = pk2(x0[2], x0[3]); o.z = pk2(x1[0], x1[1]); o.w = pk2(x1[2], x1[3]); *(GAS v4u*)(F.c16(doff[a]) + (size_t)i * 8) = o; }
    }
    {
        LAS float* scr = (LAS float*)(F.lds + 49152 + F.wave * 8448);
        const int gw = F.bid * 8 + F.wave, NGW = F.G * 8;
        constexpr int I_IN = 32 * 176, I_OUT = 32 * 64, I_GU = 32 * 352, I_DN = 88 * 64, I_L = I_IN + I_OUT + I_GU + I_DN;
        for (int it = gw; it < DEPTH * I_L; it += NGW) {
            const int l = it / I_L; int r = it % I_L;
            if (r < I_IN) { const int kb = r / 176, nb = r % 176, n0 = 32 * nb;
                if (n0 >= C_CQ && n0 < C_CV) transpose_item<true>(F.inp(I_WIN) + (size_t)l * DM * DIN, DM, DIN, F.wT(l, WO_IN), 64 * kb, n0, n0, scr, F.lane);
                else transpose_item<false>(F.inp(I_WIN) + (size_t)l * DM * DIN, DM, DIN, F.wT(l, WO_IN), 64 * kb, n0, n0, scr, F.lane);
                continue; } r -= I_IN;
            if (r < I_OUT) { const int kb = r / 64, nb = r % 64; transpose_item<false>(F.inp(I_WOUT) + (size_t)l * DM * DM, DM, DM, F.wT(l, WO_OUT), 64 * kb, 32 * nb, 32 * nb, scr, F.lane); continue; } r -= I_OUT;
            if (r < I_GU) { const int kb = r / 352, nb = r % 352, n0 = 32 * nb; const int j = n0 < DFF ? n0 : n0 - DFF; const int drow = 256 * (j >> 7) + (n0 < DFF ? 0 : 128) + (j & 127);
                transpose_item<false>(F.inp(I_WGU) + (size_t)l * DM * DGU, DM, DGU, F.wT(l, WO_GU), 64 * kb, n0, drow, scr, F.lane); continue; } r -= I_GU;
            { const int kb = r / 64, nb = r % 64; transpose_item<false>(F.inp(I_WDN) + (size_t)l * DFF * DM, DFF, DM, F.wT(l, WO_DN), 64 * kb, 32 * nb, 32 * nb, scr, F.lane); }
        }
    }
}

__device__ __forceinline__ void p1_h0(const Ctx& F) {
    const gf32* xp = F.inp(I_XP); const gf32* xs = F.inp(I_XS);
    for (int idx = F.bid * 512 + F.tid; idx < MROWS * 256; idx += F.G * 512) {
        const int row = idx >> 8, c8 = (idx & 255) * 8, mod = mod_of_row(row);
        const gf32* xr = row < R_CTX ? xp + (size_t)row * DM : xs + (size_t)(row - R_CTX) * DM;
        const gf32* sh = F.mods() + (size_t)(0 * 3 + mod) * 6 * DM; const gf32* sc = sh + DM;
        const f32x4 x0 = *(const GAS f32x4*)(xr + c8), x1 = *(const GAS f32x4*)(xr + c8 + 4), s0 = *(const GAS f32x4*)(sh + c8), s1 = *(const GAS f32x4*)(sh + c8 + 4), c0 = *(const GAS f32x4*)(sc + c8), c1 = *(const GAS f32x4*)(sc + c8 + 4);
        const f32x4 h0 = x0 * (c0 + 1.0f) + s0, h1 = x1 * (c1 + 1.0f) + s1;
        v4u o; o.x = pk2(h0[0], h0[1]); o.y = pk2(h0[2], h0[3]); o.z = pk2(h1[0], h1[1]); o.w = pk2(h1[2], h1[3]);
        *(GAS v4u*)(F.hbuf() + (size_t)row * DM + c8) = o;
    }
}

__device__ __forceinline__ void e1_postproj(const Ctx& F, int l) {
    const gf32* lb = F.lball() + l * 1024;
    for (int grp = F.bid; grp < MROWS / 16; grp += F.G) {
        const int row0 = grp * 16;
        {
            const int c = F.tid; const gf32* pc = F.hproj() + (size_t)row0 * HP_LD;
            float qv[16], vv[16];
#pragma unroll
            for (int r = 0; r < 16; ++r) { qv[r] = silu_f(pc[(size_t)r * HP_LD + c]); vv[r] = pc[(size_t)r * HP_LD + 1536 + c]; }
#pragma unroll
            for (int dir = 0; dir < 2; ++dir) {
                const float lbv = lb[dir * 512 + c], lbm = fmaxf(lbv, 1e-30f), oml = 1.0f - lbv;
                float g[16], cum[16]; float run = 0.f;
#pragma unroll
                for (int p = 0; p < 16; ++p) { const int r = dir ? 15 - p : p; const float z = pc[(size_t)r * HP_LD + 512 + dir * 512 + c];
                    g[p] = logf(lbm + oml / (1.0f + expf(-z))); run += g[p]; cum[p] = run; }
                const float last = run;
                unsigned kpw[8], vtw[8];
#pragma unroll
                for (int p = 0; p < 16; p += 2) {
                    float kp2[2];
#pragma unroll
                    for (int e = 0; e < 2; ++e) { const int pp = p + e, r = dir ? 15 - pp : pp; const float k = 1.0f - expf(g[pp]); const float cc = fmaxf(cum[pp], -80.0f);
                        F.hq(dir)[(size_t)(row0 + r) * 512 + c] = (bf16)f2bf(qv[r] * expf(cc)); F.hkm(dir)[(size_t)(row0 + r) * 512 + c] = (bf16)f2bf(k * expf(-cc));
                        kp2[e] = k * expf(last - cum[pp]); }
                    kpw[p >> 1] = pk2(kp2[0], kp2[1]); vtw[p >> 1] = pk2(vv[dir ? 15 - p : p], vv[dir ? 14 - p : p + 1]);
                }
                GAS v4u* kd = (GAS v4u*)(F.hkp(dir) + ((size_t)grp * 512 + c) * 16); GAS v4u* vd = (GAS v4u*)(F.hvt(dir) + ((size_t)grp * 512 + c) * 16);
                kd[0] = (v4u){kpw[0], kpw[1], kpw[2], kpw[3]}; kd[1] = (v4u){kpw[4], kpw[5], kpw[6], kpw[7]};
                vd[0] = (v4u){vtw[0], vtw[1], vtw[2], vtw[3]}; vd[1] = (v4u){vtw[4], vtw[5], vtw[6], vtw[7]};
                F.hdec(dir)[(size_t)grp * 512 + c] = expf(last);
            }
        }
    }
}

typedef float f32x16 __attribute__((ext_vector_type(16)));
typedef short s16x4 __attribute__((ext_vector_type(4)));
typedef __bf16 bf16x2_t __attribute__((ext_vector_type(2)));
typedef float f32x2_t __attribute__((ext_vector_type(2)));
__device__ __forceinline__ unsigned cvt2(float a, float b) { const f32x2_t f = {a, b}; return __builtin_bit_cast(unsigned, __builtin_convertvector(f, bf16x2_t)); }
#define MFMA32(a, b, c) __builtin_amdgcn_mfma_f32_32x32x16_bf16((a), (b), (c), 0, 0, 0)

struct AttnSeg { const gbf16* k; const gbf16* v; int stride; int ntiles; };
constexpr int AT_NS = 4, AT_SLOT = 32768;
constexpr float ATT_THR = 8.0f;
#define AT_VMWAIT(n) asm volatile("s_waitcnt vmcnt(" #n ")" ::: "memory")
__device__ __forceinline__ void glds16_asm(const GAS void* gsrc, unsigned lds_dst) {
    unsigned keep;
    asm volatile("s_mov_b32 %0, m0\n\ts_mov_b32 m0, %2\n\ts_nop 0\n\tglobal_load_lds_dwordx4 %1, off\n\ts_mov_b32 m0, %0" : "=&s"(keep) : "v"(gsrc), "s"(lds_dst) : "memory");
}

template <int DQK, bool DIFF>
__device__ __forceinline__ void attn_mfma(const Ctx& F, const gbf16* qptr, int kcol, const AttnSeg s0, const AttnSeg s1, bool band, int qpos, int kpos0,
                                          float m_init, float l_init, float lam, float post_scale, const gf32* gvec, gbf16* outp  ) {
    int lane_ = (int)__builtin_amdgcn_mbcnt_hi(~0u, __builtin_amdgcn_mbcnt_lo(~0u, 0u)); asm volatile("" : "+v"(lane_));
    const int lane = lane_, w = F.wave, r32 = lane & 31, h = lane >> 5;
    __syncthreads();
    bf16x8 qf[DQK / 16];
#pragma unroll
    for (int ks = 0; ks < DQK / 16; ++ks) qf[ks] = *(const GAS bf16x8*)(qptr + (size_t)r32 * QKV_LD + 16 * ks + 8 * h);
#pragma unroll
    for (int ks = 0; ks < DQK / 16; ++ks) asm volatile("" : "+v"(qf[ks]));
    __builtin_amdgcn_s_waitcnt(0);
    f32x16 o[4];
#pragma unroll
    for (int t = 0; t < 4; ++t)
#pragma unroll
        for (int r = 0; r < 16; ++r) o[t][r] = 0.f;
    float m = m_init, l = l_init;
    const int nt = s0.ntiles + s1.ntiles;
    const int srow0 = 8 * w + (lane >> 4), spc = lane & 15;
    const unsigned lds_base = (unsigned)(__UINTPTR_TYPE__)F.lds;
#define AT_ISSUE(tj) do { const int te_ = (tj) < nt ? (tj) : nt - 1; const bool s1_ = te_ >= s0.ntiles; const int tt_ = s1_ ? te_ - s0.ntiles : te_; \
        const GAS unsigned char* kb_ = (const GAS unsigned char*)(s1_ ? s1.k : s0.k); const GAS unsigned char* vb_ = (const GAS unsigned char*)(s1_ ? s1.v : s0.v); const int st_ = (s1_ ? s1.stride : s0.stride) * 2; \
        const unsigned sl_ = lds_base + (unsigned)(((tj) % AT_NS) * AT_SLOT + w * 2048); \
        _Pragma("unroll") for (int j_ = 0; j_ < 2; ++j_) { const int row_ = srow0 + 4 * j_; const size_t ro_ = (size_t)(tt_ * 64 + row_) * st_; \
            glds16_asm(kb_ + ro_ + ((spc ^ (row_ & 15)) * 16), sl_ + j_ * 1024); \
            glds16_asm(vb_ + ro_ + ((spc ^ ((row_ & 3) << 2)) * 16), sl_ + 16384 + j_ * 1024); } } while (0)
    const int kc0 = kcol / 8 + h;
    const int krow = r32 * 256, ksw = r32 & 15;
    const int vq = (lane & 15) >> 2, vp = lane & 3, vc16 = (lane >> 4) & 1;
    const int vrow = 16384 + (4 * h + vq) * 256 + 8 * (vp & 1);
    int vpo[4];
#pragma unroll
    for (int t = 0; t < 4; ++t) vpo[t] = ((4 * (t ^ vq) + 2 * vc16 + (vp >> 1)) * 16);
#pragma unroll
    for (int j = 0; j < AT_NS - 1; ++j) AT_ISSUE(j);
    for (int ti = 0; ti < nt; ++ti) {
        AT_VMWAIT(8);
        asm volatile("s_waitcnt lgkmcnt(0)" ::: "memory"); __builtin_amdgcn_s_barrier(); asm volatile("" ::: "memory");
        AT_ISSUE(ti + AT_NS - 1);
        const LAS unsigned char* kb = F.lds + (ti % AT_NS) * AT_SLOT;
        f32x16 st[2];
#pragma unroll
        for (int kt = 0; kt < 2; ++kt)
#pragma unroll
            for (int r = 0; r < 16; ++r) st[kt][r] = 0.f;
        {
            constexpr int NG = 2 * (DQK / 64);
            bf16x8 kfa[4], kfb[4];
#define ATT_LDK(dst, g) do { const int kt_ = (g) / (DQK / 64), k0_ = ((g) % (DQK / 64)) * 4; _Pragma("unroll") for (int j_ = 0; j_ < 4; ++j_) dst[j_] = *(const LAS bf16x8*)(kb + kt_ * 8192 + krow + (((kc0 + 2 * (k0_ + j_)) ^ ksw) * 16)); } while (0)
#define ATT_MMK(src, g) do { const int kt_ = (g) / (DQK / 64), k0_ = ((g) % (DQK / 64)) * 4; _Pragma("unroll") for (int j_ = 0; j_ < 4; ++j_) st[kt_] = MFMA32(src[j_], qf[k0_ + j_], st[kt_]); } while (0)
            ATT_LDK(kfa, 0); __builtin_amdgcn_sched_barrier(0);
#pragma unroll
            for (int g = 0; g < NG; g += 2) {
                ATT_LDK(kfb, g + 1); __builtin_amdgcn_sched_barrier(0);
                ATT_MMK(kfa, g);
                if (g + 2 < NG) { ATT_LDK(kfa, g + 2); __builtin_amdgcn_sched_barrier(0); }
                ATT_MMK(kfb, g + 1);
            }
#undef ATT_LDK
#undef ATT_MMK
        }
        if (band && ti < s0.ntiles) {
            const int kp = kpos0 + ti * 64 + 4 * h - (qpos + r32);
#pragma unroll
            for (int kt = 0; kt < 2; ++kt)
#pragma unroll
                for (int r = 0; r < 16; ++r) { const int d = kp + 32 * kt + (r & 3) + 8 * (r >> 2); if (d > 128 || d < -128) st[kt][r] = -1e30f; }
        }
        float mx = st[0][0];
#pragma unroll
        for (int kt = 0; kt < 2; ++kt)
#pragma unroll
            for (int r = 0; r < 16; ++r) mx = fmaxf(mx, st[kt][r]);
        mx = fmaxf(mx, __shfl_xor(mx, 32));
        if (__builtin_amdgcn_ballot_w64(mx > m + ATT_THR) != 0ull) {
            const float mn = fmaxf(m, mx), a = __builtin_amdgcn_exp2f(m - mn); l *= a; m = mn;
#pragma unroll
            for (int t = 0; t < 4; ++t)
#pragma unroll
                for (int r = 0; r < 16; ++r) o[t][r] *= a;
        }
        float rs = 0.f;
#pragma unroll
        for (int kt = 0; kt < 2; ++kt)
#pragma unroll
            for (int r = 0; r < 16; ++r) { const float p = __builtin_amdgcn_exp2f(st[kt][r] - m); st[kt][r] = p; rs += p; }
        rs += __shfl_xor(rs, 32); l += rs;
        {
            s16x4 va[8], vb[8];
#define ATT_LDV(dst, g) do { _Pragma("unroll") for (int t_ = 0; t_ < 4; ++t_) { dst[2 * t_] = __builtin_amdgcn_ds_read_tr16_b64_v4i16((LAS s16x4*)(kb + vrow + (16 * (g)) * 256 + vpo[t_])); \
                dst[2 * t_ + 1] = __builtin_amdgcn_ds_read_tr16_b64_v4i16((LAS s16x4*)(kb + vrow + (16 * (g) + 8) * 256 + vpo[t_])); } } while (0)
#define ATT_MMV(src, g) do { const int kt_ = (g) >> 1, s_ = (g) & 1; v4u pw_; pw_.x = cvt2(st[kt_][8 * s_], st[kt_][8 * s_ + 1]); pw_.y = cvt2(st[kt_][8 * s_ + 2], st[kt_][8 * s_ + 3]); pw_.z = cvt2(st[kt_][8 * s_ + 4], st[kt_][8 * s_ + 5]); pw_.w = cvt2(st[kt_][8 * s_ + 6], st[kt_][8 * s_ + 7]); \
            const bf16x8 pf_ = __builtin_bit_cast(bf16x8, pw_); _Pragma("unroll") for (int t_ = 0; t_ < 4; ++t_) o[t_] = MFMA32(__builtin_shufflevector(src[2 * t_], src[2 * t_ + 1], 0, 1, 2, 3, 4, 5, 6, 7), pf_, o[t_]); } while (0)
            ATT_LDV(va, 0); __builtin_amdgcn_sched_barrier(0);
            ATT_LDV(vb, 1); __builtin_amdgcn_sched_barrier(0);
            ATT_MMV(va, 0);
            ATT_LDV(va, 2); __builtin_amdgcn_sched_barrier(0);
            ATT_MMV(vb, 1);
            ATT_LDV(vb, 3); __builtin_amdgcn_sched_barrier(0);
            ATT_MMV(va, 2);
            ATT_MMV(vb, 3);
#undef ATT_LDV
#undef ATT_MMV
        }
    }
#undef AT_ISSUE
    AT_VMWAIT(0);
    __syncthreads();
    const float inv = 1.0f / l;
    if (DIFF) {
        LAS float* ex = (LAS float*)F.lds;
        if (F.wave >= 4) {
#pragma unroll
            for (int t = 0; t < 4; ++t)
#pragma unroll
                for (int r = 0; r < 16; ++r) ex[((F.wave - 4) * 64 + t * 16 + r) * 64 + lane] = o[t][r] * inv;
        }
        __syncthreads();
        if (F.wave < 4) {
            float ss = 0.f;
#pragma unroll
            for (int t = 0; t < 4; ++t)
#pragma unroll
                for (int r = 0; r < 16; ++r) { const float x = o[t][r] * inv - lam * ex[(F.wave * 64 + t * 16 + r) * 64 + lane]; o[t][r] = x; ss += x * x; }
            ss += __shfl_xor(ss, 32);
            const float sc = post_scale / sqrtf(ss * (1.0f / 128.0f) + 1e-6f);
            gbf16* op = outp + (size_t)r32 * DM;
#pragma unroll
            for (int t = 0; t < 4; ++t)
#pragma unroll
                for (int g4 = 0; g4 < 4; ++g4) { const int dv = 32 * t + 8 * g4 + 4 * h; const f32x4 gv = *(const GAS f32x4*)(gvec + dv);
                    v2u w2; w2.x = cvt2(o[t][4 * g4] * sc * gv[0], o[t][4 * g4 + 1] * sc * gv[1]); w2.y = cvt2(o[t][4 * g4 + 2] * sc * gv[2], o[t][4 * g4 + 3] * sc * gv[3]); *(GAS v2u*)(op + dv) = w2; }
        }
    } else {
        gbf16* op = outp + (size_t)r32 * DM;
#pragma unroll
        for (int t = 0; t < 4; ++t)
#pragma unroll
            for (int g4 = 0; g4 < 4; ++g4) { const int dv = 32 * t + 8 * g4 + 4 * h;
                v2u w2; w2.x = cvt2(o[t][4 * g4] * inv, o[t][4 * g4 + 1] * inv); w2.y = cvt2(o[t][4 * g4 + 2] * inv, o[t][4 * g4 + 3] * inv); *(GAS v2u*)(op + dv) = w2; }
    }
}

#define MFMA16(a, b, c) __builtin_amdgcn_mfma_f32_16x16x32_bf16((a), (b), (c), 0, 0, 0)
__device__ __forceinline__ bf16x8 frag2(v2u lo, v2u hi) { const v4u w = {lo.x, lo.y, hi.x, hi.y}; return __builtin_bit_cast(bf16x8, w); }
constexpr int HG_NS = 7, HG_SLOT = 17408;
#define HG_VMWAIT(n) asm volatile("s_waitcnt vmcnt(" #n ")" ::: "memory")
template <int MODE>
__device__ __forceinline__ void hgrn_mfma(const Ctx& F, int rb, int nchunks, int cc0, int ncc, int h, int dir, const gf32* s_in, gf32* s_out, gf32* ob, const gf32* fold_s, const gf32* fold_d, int nfold, gf32* d_out) {
    int lane_ = (int)__builtin_amdgcn_mbcnt_hi(~0u, __builtin_amdgcn_mbcnt_lo(~0u, 0u)); asm volatile("" : "+v"(lane_));
    const int lane = lane_, t16 = lane & 15, G = lane >> 4, w = F.wave, vcol = h * 128 + w * 16 + t16;
    __syncthreads();
    f32x4 S[8];
#pragma unroll
    for (int i = 0; i < 8; ++i)
#pragma unroll
        for (int r = 0; r < 4; ++r) S[i][r] = (MODE == 2) ? s_in[(size_t)(16 * i + 4 * G + r) * 128 + w * 16 + t16] : 0.f;
    if (MODE == 2) {
        for (int j = 0; j < nfold; ++j) {
#pragma unroll
            for (int i = 0; i < 8; ++i) { const f32x4 dj = *(const GAS f32x4*)(fold_d + (size_t)j * 128 + 16 * i + 4 * G);
#pragma unroll
                for (int r = 0; r < 4; ++r) S[i][r] = S[i][r] * dj[r] + fold_s[((size_t)j * 128 + 16 * i + 4 * G + r) * 128 + w * 16 + t16]; }
        }
    }
    f32x4 Dacc[8];
#pragma unroll
    for (int i = 0; i < 8; ++i) Dacc[i] = (f32x4){1.f, 1.f, 1.f, 1.f};
#pragma unroll
    for (int i = 0; i < 8; ++i) asm volatile("" : "+v"(S[i]));
    __builtin_amdgcn_s_waitcnt(0);
    const GAS unsigned char* srcA = (const GAS unsigned char*)((w < 4 ? F.hq(dir) : F.hkm(dir)) + h * 128);
    const GAS unsigned char* srcB = (const GAS unsigned char*)((w < 4 ? F.hkp(dir) : F.hvt(dir)) + (size_t)h * 128 * 16);
    const GAS unsigned char* srcC = (const GAS unsigned char*)(F.hdec(dir) + h * 128) + (lane & 31) * 16;
    const int rA = 4 * (w & 3) + (lane >> 4);
    const unsigned offA = (unsigned)((dir ? 15 - rA : rA) * 1024 + (((lane & 15) ^ rA) * 16));
    const int dB = 32 * (w & 3) + (lane >> 1);
    const unsigned offB = (unsigned)(dB * 32 + (((lane & 1) ^ ((dB >> 3) & 1)) * 16));
    const int dstA = (w < 4 ? 0 : 4096) + (w & 3) * 1024, dstB = (w < 4 ? 8192 : 12288) + (w & 3) * 1024;
#define HG_ISSUE(cj) do { const int ce_ = cc0 + ((cj) < ncc ? (cj) : ncc - 1); const int ch_ = dir ? nchunks - 1 - ce_ : ce_; const size_t gc_ = (size_t)(rb / 16 + ch_); \
        LAS unsigned char* sl_ = F.lds + ((cj) % HG_NS) * HG_SLOT; \
        if (MODE != 1) __builtin_amdgcn_global_load_lds((const GAS unsigned*)(srcA + (size_t)(rb + ch_ * 16) * 1024 + offA), (LAS unsigned*)(sl_ + dstA), 16, 0, 0); \
        __builtin_amdgcn_global_load_lds((const GAS unsigned*)(srcB + gc_ * 16384 + offB), (LAS unsigned*)(sl_ + dstB), 16, 0, 0); \
        if (w == 0) __builtin_amdgcn_global_load_lds((const GAS unsigned*)(srcC + gc_ * 2048), (LAS unsigned*)(sl_ + 16384), 16, 0, 0); } while (0)
    const int qoff = t16 * 256 + 8 * (G & 1);
    const int g1 = G >> 1;
    const int kpoff = 8192 + t16 * 32 + ((g1 ^ ((t16 >> 3) & 1)) * 16) + 8 * (G & 1);
    const int vtoff = 12288 + (w * 16 + t16) * 32 + ((g1 ^ ((t16 >> 3) & 1)) * 16) + 8 * (G & 1);
    const int dcoff = 16384 + 16 * G;
    const v2u z2 = {0u, 0u};
#pragma unroll
    for (int j = 0; j < HG_NS - 1; ++j) HG_ISSUE(j);
    for (int cc = 0; cc < ncc; ++cc) {
        if (MODE == 1) { if (w == 0) HG_VMWAIT(10); else HG_VMWAIT(5); }
        else if (cc < HG_NS - 1) { if (w == 0) HG_VMWAIT(15); else HG_VMWAIT(10); }
        else                     { if (w == 0) HG_VMWAIT(39); else HG_VMWAIT(34); }
        asm volatile("s_waitcnt lgkmcnt(0)" ::: "memory"); __builtin_amdgcn_s_barrier(); asm volatile("" ::: "memory");
        HG_ISSUE(cc + HG_NS - 1);
        const LAS unsigned char* sl = F.lds + (cc % HG_NS) * HG_SLOT;
        v2u q[8], k[8], kp[8]; f32x4 dec[8];
        if (MODE != 1) {
#pragma unroll
            for (int i = 0; i < 8; ++i) { const int po = (((2 * i + g1) ^ t16) * 16); q[i] = *(const LAS v2u*)(sl + qoff + po); k[i] = *(const LAS v2u*)(sl + 4096 + qoff + po); }
        }
        const v2u vt = *(const LAS v2u*)(sl + vtoff);
#pragma unroll
        for (int i = 0; i < 8; ++i) { kp[i] = *(const LAS v2u*)(sl + kpoff + i * 512); dec[i] = *(const LAS f32x4*)(sl + dcoff + i * 64); }
        __builtin_amdgcn_sched_barrier(0);
        const bf16x8 vb = frag2(vt, z2);
        if (MODE != 1) {
            f32x4 pt = {0.f, 0.f, 0.f, 0.f};
#pragma unroll
            for (int kk = 0; kk < 4; ++kk) pt = MFMA16(frag2(k[2 * kk], k[2 * kk + 1]), frag2(q[2 * kk], q[2 * kk + 1]), pt);
#pragma unroll
            for (int r = 0; r < 4; ++r) if (4 * G + r > t16) pt[r] = 0.f;
            const v2u pb = {cvt2(pt[0], pt[1]), cvt2(pt[2], pt[3])};
            f32x4 o = {0.f, 0.f, 0.f, 0.f};
            o = MFMA16(frag2(pb, z2), vb, o);
#pragma unroll
            for (int kk = 0; kk < 4; ++kk) { const v2u s0 = {cvt2(S[2 * kk][0], S[2 * kk][1]), cvt2(S[2 * kk][2], S[2 * kk][3])}, s1 = {cvt2(S[2 * kk + 1][0], S[2 * kk + 1][1]), cvt2(S[2 * kk + 1][2], S[2 * kk + 1][3])};
                o = MFMA16(frag2(q[2 * kk], q[2 * kk + 1]), frag2(s0, s1), o); }
            const int ce = cc0 + cc, ch = dir ? nchunks - 1 - ce : ce, crow = rb + ch * 16;
#pragma unroll
            for (int r = 0; r < 4; ++r) { const int pr_ = 4 * G + r; ob[(size_t)(crow + (dir ? 15 - pr_ : pr_)) * 512 + vcol] = o[r]; }
        }
#pragma unroll
        for (int i = 0; i < 8; ++i) { S[i] = S[i] * dec[i]; S[i] = MFMA16(frag2(kp[i], z2), vb, S[i]); if (MODE == 1) Dacc[i] = Dacc[i] * dec[i]; }
    }
#undef HG_ISSUE
    HG_VMWAIT(0);
    __syncthreads();
    if (MODE != 2) {
#pragma unroll
        for (int i = 0; i < 8; ++i)
#pragma unroll
            for (int r = 0; r < 4; ++r) s_out[(size_t)(16 * i + 4 * G + r) * 128 + w * 16 + t16] = S[i][r];
    }
    if (MODE == 1 && w == 0 && t16 == 0) {
#pragma unroll
        for (int i = 0; i < 8; ++i) *(GAS f32x4*)(d_out + 16 * i + 4 * G) = Dacc[i];
    }
}

__device__ __forceinline__ void hp_states(const Ctx& F, int l) {
    for (int i = F.bid; i < 256; i += F.G) {
        const int sq = i >> 4, seg = i & 15, b = sq >> 3, h = (sq >> 1) & 3, dir = sq & 1;
        if (seg == 15) continue;
        hgrn_mfma<1>(F, R_CTX + b * S_LAT, S_LAT / 16, seg * 16, 16, h, dir, nullptr, F.sloc() + ((size_t)sq * 16 + seg) * 16384, nullptr, nullptr, nullptr, 0, F.dseg() + ((size_t)sq * 16 + seg) * 128);
    }
}

#ifndef PROBE_MX_DUP
#define PROBE_MX_DUP 0
#endif
#define MXREP(cls) for (int rep_ = 0; rep_ < 1 + ((PROBE_MX_DUP >> (cls)) & 1); ++rep_)
__device__ __forceinline__ void mx_mixers(const Ctx& F, int l) {
    float lam = F.lamv()[l * 2], lam_init = F.lamv()[l * 2 + 1];
    asm volatile("" : "+v"(lam), "+v"(lam_init));
    const gbf16* qkv = F.qkv();
    constexpr int T_LH = 256, T_LD = 256, T_LB = 256, T_CD = 128, T_CS = 128, T_CH = 128;
    constexpr int NT = T_LH + T_LD + T_LB + T_CD + T_CS + T_CH;
    const AttnSeg none = {nullptr, nullptr, 0, 0};
    const int w = F.wave;
    for (int task = F.bid; task < NT; task += F.G) {
        int i = task;
        if (i < T_LH) {
            const int sq = i >> 4, seg = i & 15, b = sq >> 3, h = (sq >> 1) & 3, dir = sq & 1;
            const gf32* sin_ = F.inp(I_ST) + ((((size_t)b * 4 + l) * 2 + dir) * 4 + h) * 128 * 128;
            MXREP(0) hgrn_mfma<2>(F, R_CTX + b * S_LAT, S_LAT / 16, seg * 16, 16, h, dir, sin_, nullptr, dir ? F.obb() : F.obf(), F.sloc() + (size_t)sq * 16 * 16384, F.dseg() + (size_t)sq * 16 * 128, seg, nullptr);
            continue; } i -= T_LH;
        if (i < T_LD) {
            const int b = i >> 7, h = (i >> 5) & 3, qt = i & 31, map = w >> 2; const int rb = R_CTX + b * S_LAT, wrow = rb + qt * 128 + 32 * (w & 3);
            const AttnSeg s0 = {qkv + (size_t)rb * QKV_LD + Q_KD + h * 128, qkv + (size_t)rb * QKV_LD + Q_VD + h * 128, QKV_LD, S_LAT / 64};
            const size_t co = (((size_t)b * 4 + l) * 4 + h) * 256 * 128;
            const AttnSeg s1 = {F.c16(0) + co, F.c16(2 * MiB) + co, 128, 4};
            MXREP(1) attn_mfma<64, true>(F, qkv + (size_t)wrow * QKV_LD + Q_QD + h * 128 + map * 64, map * 64, s0, s1, false, 0, 0, -1e30f, 0.f, lam, 1.0f - lam_init, F.inp(I_DNG) + l * 128, F.cat() + (size_t)wrow * DM + h * 128);
            continue; } i -= T_LD;
        if (i < T_LB) {
            const int b = i >> 7, kv = (i >> 6) & 1, qt = i & 63, hh = kv * 4 + (w >> 1); const int rb = R_CTX + b * S_LAT, t0 = qt * 64, wrow = rb + t0 + 32 * (w & 1);
            const int ks = t0 - 128 < 0 ? 0 : t0 - 128, ke = t0 + 192 > S_LAT ? S_LAT : t0 + 192;
            const AttnSeg s0 = {qkv + (size_t)(rb + ks) * QKV_LD + Q_KS + kv * 128, qkv + (size_t)(rb + ks) * QKV_LD + Q_VS + kv * 128, QKV_LD, (ke - ks) / 64};
            const size_t co = (((size_t)b * 4 + l) * 2 + kv) * 256 * 128;
            const AttnSeg s1 = {F.c16(4 * MiB) + co, F.c16(5 * MiB) + co, 128, 4};
            MXREP(2) attn_mfma<128, false>(F, qkv + (size_t)wrow * QKV_LD + Q_QS + hh * 128, 0, s0, s1, true, t0 + 32 * (w & 1), ks, F.inp(I_SINK)[l * 8 + hh] * LOG2E, 1.0f, 0.f, 1.0f, nullptr, F.cat() + (size_t)wrow * DM + 1024 + hh * 128);
            continue; } i -= T_LB;
        if (i < T_CD) {
            const int b = i >> 3, h = (i >> 1) & 3, qt = i & 1, map = w >> 2, rb = b * 256, wrow = rb + qt * 128 + 32 * (w & 3);
            const AttnSeg s0 = {qkv + (size_t)rb * QKV_LD + Q_KD + h * 128, qkv + (size_t)rb * QKV_LD + Q_VD + h * 128, QKV_LD, 4};
            MXREP(3) attn_mfma<64, true>(F, qkv + (size_t)wrow * QKV_LD + Q_QD + h * 128 + map * 64, map * 64, s0, none, false, 0, 0, -1e30f, 0.f, lam, 1.0f - lam_init, F.inp(I_DNG) + l * 128, F.cat() + (size_t)wrow * DM + h * 128);
            continue; } i -= T_CD;
        if (i < T_CS) {
            const int b = i >> 3, kv = (i >> 2) & 1, qt = i & 3, hh = kv * 4 + (w >> 1), rb = b * 256, wrow = rb + qt * 64 + 32 * (w & 1);
            const AttnSeg s0 = {qkv + (size_t)rb * QKV_LD + Q_KS + kv * 128, qkv + (size_t)rb * QKV_LD + Q_VS + kv * 128, QKV_LD, 4};
            MXREP(4) attn_mfma<128, false>(F, qkv + (size_t)wrow * QKV_LD + Q_QS + hh * 128, 0, s0, none, false, 0, 0, F.inp(I_SINK)[l * 8 + hh] * LOG2E, 1.0f, 0.f, 1.0f, nullptr, F.cat() + (size_t)wrow * DM + 1024 + hh * 128);
            continue; } i -= T_CS;
        {
            const int b = i >> 3, h = (i >> 1) & 3, dir = i & 1;
            gf32* sout = F.out + O_ST + ((((size_t)b * 4 + l) * 2 + dir) * 4 + h) * 128 * 128;
            MXREP(5) hgrn_mfma<0>(F, b * 256, 16, 0, 16, h, dir, nullptr, sout, dir ? F.obb() : F.obf(), nullptr, nullptr, 0, nullptr);
        }
    }
}

__device__ __forceinline__ void mg_merge(const Ctx& F, int l) {
    const int head = F.lane >> 4, sub = F.lane & 15, col0 = head * 128 + sub * 8;
    for (int row = F.bid * 8 + F.wave; row < MROWS; row += F.G * 8) {
        const f32x4 a0 = *(const GAS f32x4*)(F.obf() + (size_t)row * 512 + col0) + *(const GAS f32x4*)(F.obb() + (size_t)row * 512 + col0);
        const f32x4 a1 = *(const GAS f32x4*)(F.obf() + (size_t)row * 512 + col0 + 4) + *(const GAS f32x4*)(F.obb() + (size_t)row * 512 + col0 + 4);
        float ss = (a0[0] * a0[0] + a0[1] * a0[1]) + (a0[2] * a0[2] + a0[3] * a0[3]) + (a1[0] * a1[0] + a1[1] * a1[1]) + (a1[2] * a1[2] + a1[3] * a1[3]);
        ss += __shfl_xor(ss, 1); ss += __shfl_xor(ss, 2); ss += __shfl_xor(ss, 4); ss += __shfl_xor(ss, 8);
        const float rinv = 1.0f / sqrtf(ss * (1.0f / 128.0f) + 1e-6f);
        const gf32* g = F.inp(I_HNG) + l * 128 + sub * 8; const gf32* hg = F.hproj() + (size_t)row * HP_LD + 2048 + col0;
        const f32x4 g0 = *(const GAS f32x4*)g, g1 = *(const GAS f32x4*)(g + 4), h0 = *(const GAS f32x4*)hg, h1 = *(const GAS f32x4*)(hg + 4);
        float y[8];
#pragma unroll
        for (int i = 0; i < 4; ++i) { y[i] = a0[i] * rinv * g0[i] * silu_f(h0[i]); y[4 + i] = a1[i] * rinv * g1[i] * silu_f(h1[i]); }
        v4u w; w.x = pk2(y[0], y[1]); w.y = pk2(y[2], y[3]); w.z = pk2(y[4], y[5]); w.w = pk2(y[6], y[7]);
        *(GAS v4u*)(F.cat() + (size_t)row * DM + 512 + col0) = w;
    }
}

__device__ __forceinline__ void ln_phase(const Ctx& F, const gf32* g, const gf32* b, gf32* xo, const gf32* modsl  , int which_sh) {
    constexpr int SPLIT_ROW0 = 8192;
    for (int row = F.bid * 8 + F.wave; row < MROWS; row += F.G * 8) {
        const gf32* yp = F.ypre() + (size_t)row * DM + F.lane * 4;
        f32x4 v[8]; float s = 0.f;
#pragma unroll
        for (int j = 0; j < 8; ++j) { v[j] = *(const GAS f32x4*)(yp + 256 * j); if (row >= SPLIT_ROW0) v[j] += *(const GAS f32x4*)(F.ypre2() + (size_t)(row - SPLIT_ROW0) * DM + F.lane * 4 + 256 * j); s += (v[j][0] + v[j][1]) + (v[j][2] + v[j][3]); }
#pragma unroll
        for (int o = 1; o < 64; o <<= 1) s += __shfl_xor(s, o);
        const float mean = s * (1.0f / DM); float s2 = 0.f;
#pragma unroll
        for (int j = 0; j < 8; ++j) { v[j] = v[j] - mean; s2 += (v[j][0] * v[j][0] + v[j][1] * v[j][1]) + (v[j][2] * v[j][2] + v[j][3] * v[j][3]); }
#pragma unroll
        for (int o = 1; o < 64; o <<= 1) s2 += __shfl_xor(s2, o);
        const float rstd = 1.0f / sqrtf(s2 * (1.0f / DM) + 1e-5f);
        const int mod = mod_of_row(row);
        const gf32* sh = modsl ? modsl + ((size_t)mod * 6 + which_sh) * DM : nullptr;
#pragma unroll
        for (int j = 0; j < 8; ++j) { const int c = F.lane * 4 + 256 * j;
            const f32x4 x = v[j] * rstd * *(const GAS f32x4*)(g + c) + *(const GAS f32x4*)(b + c);
            *(GAS f32x4*)(xo + (size_t)row * DM + c) = x;
            if (modsl) { const f32x4 hh = x * (*(const GAS f32x4*)(sh + DM + c) + 1.0f) + *(const GAS f32x4*)(sh + c);
                v2u w; w.x = pk2(hh[0], hh[1]); w.y = pk2(hh[2], hh[3]); *(GAS v2u*)(F.hbuf() + (size_t)row * DM + c) = w; } }
    }
}

constexpr int PH_PER_LAYER = 10, N_PHASES = 2 + DEPTH * PH_PER_LAYER;
__global__ void __launch_bounds__(512, 2) fwd_kernel(Args args) {
    extern __shared__ __attribute__((aligned(16))) unsigned char lds_raw[];
    Ctx F;
    F.lds = (LAS unsigned char*)lds_raw;
    F.tid = threadIdx.x; F.lane = F.tid & 63; F.wave = __builtin_amdgcn_readfirstlane(F.tid >> 6); F.G = gridDim.x; F.bid = blockIdx.x;
    F.ap = &args; F.out = (gf32*)args.out; F.ws = (GAS unsigned char*)args.ws;
    volatile LAS unsigned* MISC = (volatile LAS unsigned*)(F.lds + MISC_OFF);
    for (int u = F.tid; u < (LDS_BYTES - LDSCTL_OFF) / 4; u += 512) ((LAS unsigned*)(F.lds + LDSCTL_OFF))[u] = 0u;
    __syncthreads();
    XcdBarrier bar; bar.bar = (unsigned*)(args.ws + WS_CTL) + CW_BAR; bar.x = 0; bar.st = nullptr;
    if (args.single) bar = xcd_barrier_post((unsigned*)(args.ws + WS_CTL) + CW_BAR, MISC + 8);
    const int lo = args.ph_lo, hi = args.ph_hi;
#define IN(k) (lo <= (k) && (k) < hi)
#define FRESH() do { int ln_ = (int)__builtin_amdgcn_mbcnt_hi(~0u, __builtin_amdgcn_mbcnt_lo(~0u, 0u)); asm volatile("" : "+v"(ln_)); F.lane = ln_; asm volatile("" : "+s"(F.wave)); F.tid = F.wave * 64 + F.lane; \
    asm volatile("" : "+s"(F.bid), "+s"(F.G)); asm volatile("" : "+s"(F.ws), "+s"(F.out)); } while (0)
#define SEAM(k) do { if (IN((k) + 1)) xcd_barrier(bar); } while (0)

    if (IN(0)) { FRESH(); p0_prologue(F); SEAM(0); }
    if (IN(1)) { FRESH(); p1_h0(F); SEAM(1); }
    for (int l = 0; l < DEPTH; ++l) {
        const int k0 = 2 + l * PH_PER_LAYER;
        FRESH();
        const gf32* xa = l == 0 ? F.inp(I_XP) : F.out + O_YP; const gf32* xb = l == 0 ? F.inp(I_XS) : F.out + O_YS;
        if (IN(k0 + 0)) {
            pg8::Gemm g{(const pg8::bf16_t*)F.hbuf(), (const pg8::bf16_t*)F.wT(l, WO_IN), MROWS, DIN, DM, DM}; pg8::StaticOrder S; S.init(MROWS, DIN, F.G, F.bid);
            EpiProj E{F.qkv(), F.hproj(), F.out, F.tabD(), F.tabS(), l};
            pg8::gemm_phase<EpiProj, pg8::StaticOrder, true, true>(F.lds, g, S, E, F.wave);
            SEAM(k0 + 0); }
        if (IN(k0 + 1)) { FRESH(); e1_postproj(F, l); SEAM(k0 + 1); }
        if (IN(k0 + 2)) { FRESH(); hp_states(F, l); SEAM(k0 + 2); }
        if (IN(k0 + 3)) { FRESH(); mx_mixers(F, l); SEAM(k0 + 3); }
        if (IN(k0 + 4)) { FRESH(); mg_merge(F, l); SEAM(k0 + 4); }
        if (IN(k0 + 5)) {
            { pg8::Gemm g{(const pg8::bf16_t*)F.cat(), (const pg8::bf16_t*)F.wT(l, WO_OUT), 8192, DM, DM, DM}; pg8::StaticOrder S; S.init(8192, DM, F.G, F.bid);
              EpiResid E{xa, xb, F.mods() + ((size_t)l * 3 * 6 + 2) * DM, F.ypre(), 0, 0};
              pg8::gemm_phase<EpiResid, pg8::StaticOrder, true, true>(F.lds, g, S, E, F.wave); }
            __syncthreads();
            { const int kh = F.bid >> 7; pg8::Gemm g{(const pg8::bf16_t*)(F.cat() + (size_t)8192 * DM + kh * (DM / 2)), (const pg8::bf16_t*)(F.wT(l, WO_OUT) + kh * (DM / 2)), 4096, DM, DM / 2, DM}; pg8::StaticOrder S; S.init(4096, DM, 128, F.bid & 127);
              EpiResid E{xa, xb, F.mods() + ((size_t)l * 3 * 6 + 2) * DM, kh ? F.ypre2() : F.ypre(), 32, kh};
              pg8::gemm_phase<EpiResid, pg8::StaticOrder, true, true>(F.lds, g, S, E, F.wave); }
            SEAM(k0 + 5); }
        if (IN(k0 + 6)) { FRESH(); ln_phase(F, F.inp(I_LN1G) + l * DM, F.inp(I_LN1B) + l * DM, F.x1(), F.mods() + (size_t)l * 3 * 6 * DM, 3); SEAM(k0 + 6); }
        if (IN(k0 + 7)) {
            pg8::Gemm g{(const pg8::bf16_t*)F.hbuf(), (const pg8::bf16_t*)F.wT(l, WO_GU), MROWS, DGU, DM, DM}; pg8::StaticOrder S; S.init(MROWS, DGU, F.G, F.bid);
            EpiSwiGLU E{F.act()};
            pg8::gemm_phase<EpiSwiGLU, pg8::StaticOrder, true, true>(F.lds, g, S, E, F.wave);
            SEAM(k0 + 7); }
        if (IN(k0 + 8)) {
            { pg8::Gemm g{(const pg8::bf16_t*)F.act(), (const pg8::bf16_t*)F.wT(l, WO_DN), 8192, DM, DFF, DFF}; pg8::StaticOrder S; S.init(8192, DM, F.G, F.bid);
              EpiResid E{F.x1(), F.x1() + (size_t)R_CTX * DM, F.mods() + ((size_t)l * 3 * 6 + 5) * DM, F.ypre(), 0, 0};
              pg8::gemm_phase<EpiResid, pg8::StaticOrder, true, true>(F.lds, g, S, E, F.wave); }
            __syncthreads();
            { const int kh = F.bid >> 7; pg8::Gemm g{(const pg8::bf16_t*)(F.act() + (size_t)8192 * DFF + kh * (DFF / 2)), (const pg8::bf16_t*)(F.wT(l, WO_DN) + kh * (DFF / 2)), 4096, DM, DFF / 2, DFF}; pg8::StaticOrder S; S.init(4096, DM, 128, F.bid & 127);
              EpiResid E{F.x1(), F.x1() + (size_t)R_CTX * DM, F.mods() + ((size_t)l * 3 * 6 + 5) * DM, kh ? F.ypre2() : F.ypre(), 32, kh};
              pg8::gemm_phase<EpiResid, pg8::StaticOrder, true, true>(F.lds, g, S, E, F.wave); }
            SEAM(k0 + 8); }
        if (IN(k0 + 9)) { FRESH(); ln_phase(F, F.inp(I_LN2G) + l * DM, F.inp(I_LN2B) + l * DM, F.out + O_YP, l + 1 < DEPTH ? F.mods() + (size_t)(l + 1) * 3 * 6 * DM : nullptr, 0); SEAM(k0 + 9); }
    }
#undef IN
#undef SEAM
#undef FRESH
}

#ifndef MK_SINGLE
#define MK_SINGLE 1
#endif
extern "C" void kernel_launch(void* const* d_in, const int* in_sizes, int n_in, void* d_out, int out_size, void* d_ws, size_t ws_size, hipStream_t stream) {
    static int grid = 0;
    if (grid == 0) {
        if (n_in != 24 || out_size != (int)O_END || ws_size < WS_END) { fprintf(stderr, "kernel_launch: unexpected sizes n_in %d out %d ws %zu\n", n_in, out_size, ws_size); grid = -1; return; }
        int dev = 0, cus = 0, per_cu = 0;
        if (hipGetDevice(&dev) != hipSuccess || hipDeviceGetAttribute(&cus, hipDeviceAttributeMultiprocessorCount, dev) != hipSuccess) { grid = -1; return; }
        if (hipFuncSetAttribute((const void*)fwd_kernel, hipFuncAttributeMaxDynamicSharedMemorySize, LDS_BYTES) != hipSuccess) { fprintf(stderr, "kernel_launch: hipFuncSetAttribute failed\n"); grid = -1; return; }
        if (hipOccupancyMaxActiveBlocksPerMultiprocessor(&per_cu, (const void*)fwd_kernel, 512, LDS_BYTES) != hipSuccess || per_cu < 1) fprintf(stderr, "kernel_launch: occupancy query says %d\n", per_cu);
        (void)hipGetLastError();
        grid = cus;
    }
    if (grid < 0) return;
    (void)hipMemsetAsync((char*)d_ws + WS_CTL, 0, CTL_ZERO_BYTES, stream);
    Args a{};
    for (int i = 0; i < 24; ++i) a.in[i] = (const float*)d_in[i];
    a.out = (float*)d_out; a.ws = (unsigned char*)d_ws; a.pad = 0;
#if MK_SINGLE
    a.ph_lo = 0; a.ph_hi = N_PHASES; a.single = 1;
    hipLaunchKernelGGL(fwd_kernel, dim3(grid), dim3(512), LDS_BYTES, stream, a);
#else
    a.single = 0;
    for (int p = 0; p < N_PHASES; ++p) { a.ph_lo = p; a.ph_hi = p + 1; hipLaunchKernelGGL(fwd_kernel, dim3(grid), dim3(512), LDS_BYTES, stream, a);
#ifdef PROBE_REP_MASK
        const int ty = p == 0 ? 10 : (p == 1 ? 11 : (p - 2) % PH_PER_LAYER);
        if ((PROBE_REP_MASK >> ty) & 1) for (int r = 0; r < PROBE_REP_N; ++r) hipLaunchKernelGGL(fwd_kernel, dim3(grid), dim3(512), LDS_BYTES, stream, a);
#endif
    }
#endif
}
```

```cpp
#include <hip/hip_runtime.h>
#include <cstdio>
#include <cstdint>
namespace pg8 {
#define PG8_LAS __attribute__((address_space(3)))
typedef unsigned short bf16_t;
typedef short bf16x8 __attribute__((ext_vector_type(8)));
typedef float f32x4 __attribute__((ext_vector_type(4)));
typedef unsigned u32x4 __attribute__((ext_vector_type(4)));
constexpr int BM = 256, BK = 64, HALF = 128, HTB = HALF * BK * 2  , STAGE_BYTES = 8 * HTB, NXCD = 8, WGM = 8;

__host__ __device__ __forceinline__ int lds_byte(int r, int c) { const int st = (r >> 4) * 2 + (c >> 5), rr = r & 15, cc = c & 31, ob = rr * 64 + cc * 2; return st * 1024 + (ob ^ (((ob >> 9) & 1) << 5)); }
__host__ __device__ __forceinline__ void stage_rc(int b, int& R, int& C) { const int st = b / 1024, sb = b % 1024, swz = sb ^ (((sb >> 9) & 1) << 5); R = (st >> 1) * 16 + swz / 64; C = (st & 1) * 32 + (swz % 64) / 2; }
__host__ __device__ __forceinline__ int perm32(int rho) { const int n = rho >> 4, i = rho & 15; return 8 * (i >> 2) + 4 * n + (i & 3); }

struct Unit { int pm, pn; };
struct Gemm { const bf16_t* A; const bf16_t* Bt; int M, N, K, ld; };

struct StaticOrder {
    int nM, nN, nwg, G, c;
    __host__ __device__ void init(int M, int N, int G_, int c_) { nM = M / BM; nN = N / BM; nwg = nM * nN; G = G_; c = c_; }
    __host__ __device__ bool next(int i, Unit& u) const {
        const long L = (long)i * G + c; if (L >= nwg) return false;
        int wgid = (int)L; { const int q = nwg / NXCD, r = nwg % NXCD, xcd = wgid % NXCD, off = wgid / NXCD; wgid = (xcd < r ? xcd * (q + 1) : r * (q + 1) + (xcd - r) * q) + off; }
        const int nig = WGM * nN, gid = wgid / nig, fm = gid * WGM, gsz = (nM - fm) < WGM ? (nM - fm) : WGM;
        u.pm = fm + ((wgid % nig) % gsz); u.pn = (wgid % nig) / gsz; return true;
    }
    __device__ __forceinline__ void a_ready(const Unit&) const {}
    __device__ __forceinline__ void done(const Unit&) const {}
};
__device__ __forceinline__ unsigned cvt_pk_bf16(float lo, float hi) { unsigned r; asm volatile("v_cvt_pk_bf16_f32 %0, %1, %2" : "=v"(r) : "v"(lo), "v"(hi)); return r; }
typedef float f32x2 __attribute__((ext_vector_type(2)));
template <class Epi, class Sched, bool ALIGN_EPI = false, bool SP2 = false>
__device__ __forceinline__ void gemm_phase(PG8_LAS unsigned char* lds, const Gemm g, const Sched& S, const Epi& E, int wid_in) {
    int lane_ = (int)__builtin_amdgcn_mbcnt_hi(~0u, __builtin_amdgcn_mbcnt_lo(~0u, 0u)); asm volatile("" : "+v"(lane_)); asm volatile("" : "+s"(wid_in));
    const int wid = wid_in, lane = lane_, tid = wid * 64 + lane, wr = wid >> 2, wc = wid & 3, fr = lane & 15, fq = lane >> 4;
    const int K = g.K, nt = K / BK, LD = g.ld;
    unsigned voffA[2], voffB[2];
#pragma unroll
    for (int i = 0; i < 2; ++i) { int R, C; stage_rc(tid * 16 + i * 8192, R, C); const int Rb = Epi::PERM ? ((R & ~31) + perm32(R & 31)) : R;
        voffA[i] = (unsigned)(R * LD + C) * 2u; voffB[i] = (unsigned)(Rb * LD + C) * 2u; }
    const size_t kstep = (size_t)(BK * 2);
    const size_t hstep = (size_t)HALF * LD * 2;
    const size_t tstep = 2 * hstep;
    const unsigned ldsw = (unsigned)wid * 1024u;
    const int aoff = lds_byte(wr * 64 + fr, fq * 8), boff = lds_byte(wc * 32 + fr, fq * 8);
#define PG8_SA(b, h) (((b) * 2 + (h)) * HTB)
#define PG8_SB(b, h) ((4 + (b) * 2 + (h)) * HTB)
#define PG8_STAGE(bufoff, gbase, voff) do { _Pragma("unroll") for (int _i = 0; _i < 2; ++_i) \
        __builtin_amdgcn_global_load_lds((const unsigned*)((const char*)(gbase) + (voff)[_i]), (PG8_LAS unsigned*)(lds + (bufoff) + ldsw + _i * 8192), 16, 0, 0); } while (0)
#define PG8_LDA(dst, b, h) do { _Pragma("unroll") for (int m = 0; m < 4; ++m) _Pragma("unroll") for (int k = 0; k < 2; ++k) dst[m][k] = *(const PG8_LAS bf16x8*)(lds + PG8_SA(b, h) + aoff + m * 2048 + k * 1024); } while (0)
#define PG8_LDB(dst, b, h) do { _Pragma("unroll") for (int n = 0; n < 2; ++n) _Pragma("unroll") for (int k = 0; k < 2; ++k) dst[n][k] = *(const PG8_LAS bf16x8*)(lds + PG8_SB(b, h) + boff + n * 2048 + k * 1024); } while (0)
#define PG8_MMA(ai, bj, At, Bt) do { __builtin_amdgcn_s_setprio(1); _Pragma("unroll") for (int m = 0; m < 4; ++m) _Pragma("unroll") for (int n = 0; n < 2; ++n) _Pragma("unroll") for (int k = 0; k < 2; ++k) \
        acc[ai][bj][m][n] = __builtin_amdgcn_mfma_f32_16x16x32_bf16(Bt[n][k], At[m][k], acc[ai][bj][m][n], 0, 0, 0); __builtin_amdgcn_s_setprio(0); } while (0)
#define PG8_WAIT_V(n) asm volatile("s_waitcnt vmcnt(" #n ")" ::: "memory")
#define PG8_WAIT_L(n) asm volatile("s_waitcnt lgkmcnt(" #n ")" ::: "memory")
#define PG8_BAR __builtin_amdgcn_s_barrier()
#define PG8_SCHED __builtin_amdgcn_sched_barrier(0)
    Unit cur, nxt; int ui = 0;
    if (!S.next(0, cur)) return;
    f32x4 acc[2][2][4][2];
#pragma unroll
    for (int a = 0; a < 2; ++a)
#pragma unroll
        for (int b = 0; b < 2; ++b)
#pragma unroll
            for (int m = 0; m < 4; ++m)
#pragma unroll
                for (int n = 0; n < 2; ++n) acc[a][b][m][n] = (f32x4){0.f, 0.f, 0.f, 0.f};
    bf16x8 At[4][2], B0[2][2], B1[2][2];
    const char* cA = (const char*)g.A + (size_t)cur.pm * tstep; const char* cB = (const char*)g.Bt + (size_t)cur.pn * tstep;
    S.a_ready(cur);
    if constexpr (SP2) {
        PG8_STAGE(PG8_SB(0, 0), cB, voffB); PG8_STAGE(PG8_SB(0, 1), cB + hstep, voffB); PG8_STAGE(PG8_SA(0, 0), cA, voffA); PG8_STAGE(PG8_SA(0, 1), cA + hstep, voffA);
        if (wr == 1) PG8_BAR;
        PG8_WAIT_V(2); PG8_BAR;
        PG8_STAGE(PG8_SB(1, 0), cB + kstep, voffB); PG8_STAGE(PG8_SA(1, 0), cA + kstep, voffA); PG8_STAGE(PG8_SB(1, 1), cB + hstep + kstep, voffB);
        PG8_WAIT_V(6); PG8_BAR;
    } else {
        PG8_STAGE(PG8_SB(0, 0), cB, voffB); PG8_STAGE(PG8_SA(0, 0), cA, voffA); PG8_STAGE(PG8_SB(0, 1), cB + hstep, voffB); PG8_STAGE(PG8_SA(0, 1), cA + hstep, voffA);
        if (wr == 1) PG8_BAR;
        PG8_WAIT_V(4); PG8_BAR;
        PG8_STAGE(PG8_SB(1, 0), cB + kstep, voffB); PG8_STAGE(PG8_SA(1, 0), cA + kstep, voffA); PG8_STAGE(PG8_SB(1, 1), cB + hstep + kstep, voffB);
        PG8_WAIT_V(6); PG8_BAR;
    }
    for (;;) {
        const bool has_next = S.next(ui + 1, nxt);
        const char* nA = has_next ? (const char*)g.A + (size_t)nxt.pm * tstep : cA; const char* nB = has_next ? (const char*)g.Bt + (size_t)nxt.pn * tstep : cB;
        for (int t = 0; t < nt; t += 2) {
            const bool last = (t == nt - 2);
            const char* a1 = cA + (size_t)(t + 1) * kstep;
            const char* a2 = last ? nA : cA + (size_t)(t + 2) * kstep; const char* b2 = last ? nB : cB + (size_t)(t + 2) * kstep;
            const char* a3 = a2 + kstep; const char* b3 = b2 + kstep;
            if (last && has_next) S.a_ready(nxt);
            if constexpr (SP2) {
            PG8_LDB(B0, 0, 0); PG8_LDB(B1, 0, 1); PG8_SCHED; PG8_LDA(At, 0, 0); PG8_STAGE(PG8_SA(1, 1), a1 + hstep, voffA);
            PG8_WAIT_V(8); PG8_WAIT_L(0); PG8_BAR; PG8_MMA(0, 0, At, B0); PG8_MMA(0, 1, At, B1); PG8_BAR; PG8_SCHED;
            PG8_LDA(At, 0, 1); PG8_STAGE(PG8_SB(0, 0), b2, voffB); PG8_STAGE(PG8_SB(0, 1), b2 + hstep, voffB); PG8_STAGE(PG8_SA(0, 0), a2, voffA);
            PG8_WAIT_V(8); PG8_WAIT_L(0); PG8_BAR; PG8_MMA(1, 0, At, B0); PG8_MMA(1, 1, At, B1); PG8_BAR; PG8_SCHED;
            PG8_LDB(B0, 1, 0); PG8_LDB(B1, 1, 1); PG8_SCHED; PG8_LDA(At, 1, 0); PG8_STAGE(PG8_SA(0, 1), a2 + hstep, voffA);
            PG8_WAIT_V(8); PG8_WAIT_L(0); PG8_BAR; PG8_MMA(0, 0, At, B0); PG8_MMA(0, 1, At, B1); PG8_BAR; PG8_SCHED;
            PG8_LDA(At, 1, 1); PG8_STAGE(PG8_SB(1, 0), b3, voffB); PG8_STAGE(PG8_SB(1, 1), b3 + hstep, voffB); PG8_STAGE(PG8_SA(1, 0), a3, voffA);
            PG8_WAIT_V(8); PG8_WAIT_L(0); PG8_BAR; PG8_MMA(1, 0, At, B0); PG8_MMA(1, 1, At, B1); PG8_BAR; PG8_SCHED;
            } else {
            PG8_LDB(B0, 0, 0); PG8_SCHED; PG8_LDA(At, 0, 0); PG8_STAGE(PG8_SA(1, 1), a1 + hstep, voffA);
            PG8_WAIT_L(8); PG8_BAR; PG8_WAIT_L(0); PG8_MMA(0, 0, At, B0); PG8_BAR; PG8_SCHED;
            PG8_LDB(B1, 0, 1); PG8_STAGE(PG8_SB(0, 0), b2, voffB);
            PG8_BAR; PG8_WAIT_L(0); PG8_MMA(0, 1, At, B1); PG8_BAR;
            PG8_LDA(At, 0, 1); PG8_STAGE(PG8_SA(0, 0), a2, voffA);
            PG8_BAR; PG8_WAIT_L(0); PG8_MMA(1, 0, At, B0); PG8_BAR; PG8_SCHED;
            PG8_STAGE(PG8_SB(0, 1), b2 + hstep, voffB);
            PG8_WAIT_V(6); PG8_BAR; PG8_MMA(1, 1, At, B1); PG8_BAR;
            PG8_LDB(B0, 1, 0); PG8_SCHED; PG8_LDA(At, 1, 0); PG8_STAGE(PG8_SA(0, 1), a2 + hstep, voffA);
            PG8_WAIT_L(8); PG8_BAR; PG8_WAIT_L(0); PG8_MMA(0, 0, At, B0); PG8_BAR; PG8_SCHED;
            PG8_LDB(B1, 1, 1); PG8_STAGE(PG8_SB(1, 0), b3, voffB);
            PG8_BAR; PG8_WAIT_L(0); PG8_MMA(0, 1, At, B1); PG8_BAR;
            PG8_LDA(At, 1, 1); PG8_STAGE(PG8_SA(1, 0), a3, voffA);
            PG8_BAR; PG8_WAIT_L(0); PG8_MMA(1, 0, At, B0); PG8_BAR; PG8_SCHED;
            PG8_STAGE(PG8_SB(1, 1), b3 + hstep, voffB);
            PG8_WAIT_V(6); PG8_BAR; PG8_MMA(1, 1, At, B1); PG8_BAR;
            }
        }
        if constexpr (ALIGN_EPI) { if (wr == 0) PG8_BAR; }
        if constexpr (!Epi::AFTER_DRAIN) { E(acc, cur, wr, wc, fr, fq); S.done(cur); }
        if (!has_next) break;
#pragma unroll
        for (int a = 0; a < 2; ++a)
#pragma unroll
            for (int b = 0; b < 2; ++b)
#pragma unroll
                for (int m = 0; m < 4; ++m)
#pragma unroll
                    for (int n = 0; n < 2; ++n) acc[a][b][m][n] = (f32x4){0.f, 0.f, 0.f, 0.f};
        cur = nxt; cA = nA; cB = nB; ++ui;
        if constexpr (ALIGN_EPI) { if (wr == 1) PG8_BAR; }
    }
    PG8_WAIT_V(0);
    if constexpr (!ALIGN_EPI) { if (wr == 0) PG8_BAR; }
    PG8_BAR;
    if constexpr (Epi::AFTER_DRAIN) { E.fused(acc, cur, wr, wc, fr, fq, lds, wid, lane); S.done(cur); }
#undef PG8_SA
#undef PG8_SB
#undef PG8_STAGE
#undef PG8_LDA
#undef PG8_LDB
#undef PG8_MMA
#undef PG8_WAIT_V
#undef PG8_WAIT_L
#undef PG8_BAR
#undef PG8_SCHED
}
}
#define GAS __attribute__((address_space(1)))
#define LAS __attribute__((address_space(3)))
typedef unsigned short bf16;
typedef unsigned v4u __attribute__((ext_vector_type(4)));
typedef float f32x4 __attribute__((ext_vector_type(4)));
typedef short bf16x8 __attribute__((ext_vector_type(8)));
typedef GAS unsigned gu32;
typedef GAS unsigned long long gu64;
#define RLX_AGENT __ATOMIC_RELAXED, __HIP_MEMORY_SCOPE_AGENT
#define LDS_WAIT() asm volatile("s_waitcnt lgkmcnt(0)" ::: "memory")
#define VM_WAIT() asm volatile("s_waitcnt vmcnt(0)" ::: "memory")
__device__ __forceinline__ unsigned long long rt() { return __builtin_amdgcn_s_memrealtime(); }
__device__ __forceinline__ unsigned f2bf(float f) { unsigned u = __builtin_bit_cast(unsigned, f); return (u + 0x7fffu + ((u >> 16) & 1u)) >> 16; }
__device__ __forceinline__ unsigned pk2(float lo, float hi) { return f2bf(lo) | (f2bf(hi) << 16); }
#define XB_TMO      128
#define XB_XCNT(j)  (256  + 64 * (j))
#define XB_XSUB(j)  (1280 + 64 * (j))
#define XB_XGEN(j)  (2304 + 64 * (j))
#define XB_TOP      3328
#define XB_TOPGEN   3392
#define XCD_BAR_WORDS 3456
#define XB_SPIN_CAP (1u << 24)

__device__ __forceinline__ unsigned xb_ld(unsigned* p)              { return __hip_atomic_load(p, __ATOMIC_RELAXED, __HIP_MEMORY_SCOPE_AGENT); }
__device__ __forceinline__ unsigned xb_add(unsigned* p, unsigned v) { return __hip_atomic_fetch_add(p, v, __ATOMIC_RELAXED, __HIP_MEMORY_SCOPE_AGENT); }
__device__ __forceinline__ unsigned xb_xcc_id() { return (unsigned)__builtin_amdgcn_s_getreg((3 << 11) | 20) & 0xFu; }
#define XB_SPIN(cond, bar) do { unsigned _sp = 0; while (cond) { __builtin_amdgcn_s_sleep(1); \
    if ((++_sp & 255u) == 0u) { if (xb_ld(&(bar)[XB_TMO])) break; if (_sp > XB_SPIN_CAP) { atomicAdd(&(bar)[XB_TMO], 1u); break; } } } } while (0)

struct XcdBarrier {
    unsigned* bar; unsigned x;
    volatile LAS unsigned* st;
};

__device__ __forceinline__ XcdBarrier xcd_barrier_post(unsigned* bar, volatile LAS unsigned* st) {
    XcdBarrier b; b.bar = bar; b.x = xb_xcc_id(); b.st = st;
    if (threadIdx.x == 0) (void)xb_add(&bar[XB_XCNT(b.x)], 1u);
    return b;
}
__device__ __forceinline__ void xcd_barrier_complete(unsigned* bar, unsigned x, unsigned& nloc, unsigned& nx) {
    const unsigned G = gridDim.x * gridDim.y * gridDim.z;
    unsigned sum, cnt, mine, sp = 0u;
    for (;;) {
        sum = 0u; cnt = 0u; mine = 0u;
#pragma unroll
        for (unsigned j = 0; j < 16; ++j) { const unsigned c = xb_ld(&bar[XB_XCNT(j)]); sum += c; cnt += (c > 0u) ? 1u : 0u; mine = (j == x) ? c : mine; }
        if (sum == G) break;
        __builtin_amdgcn_s_sleep(1);
        if ((++sp & 255u) == 0u) { if (xb_ld(&bar[XB_TMO])) break; if (sp > XB_SPIN_CAP) { atomicAdd(&bar[XB_TMO], 1u); break; } }
    }
    nloc = mine > 0u ? mine : 1u; nx = cnt > 0u ? cnt : 1u;
}

__device__ __forceinline__ void xcd_barrier(const XcdBarrier& b) {
    asm volatile("s_waitcnt vmcnt(0)" ::: "memory");
    __syncthreads();
    if (threadIdx.x == 0) {
        unsigned* bar = b.bar;
        __builtin_amdgcn_s_waitcnt(0);
        unsigned nloc = b.st[0], nx = b.st[1];
        if (nloc == 0u) { xcd_barrier_complete(bar, b.x, nloc, nx); b.st[0] = nloc; b.st[1] = nx; }
        const unsigned old = xb_add(&bar[XB_XSUB(b.x)], 1u);
        const unsigned gen = old / nloc;
        if (old + 1u == (gen + 1u) * nloc) {
            __builtin_amdgcn_fence(__ATOMIC_RELEASE, "agent");
            asm volatile("s_waitcnt vmcnt(0)" ::: "memory");
            const unsigned og = xb_add(&bar[XB_TOP], 1u);
            const unsigned tg = og / nx;
            if (og + 1u == (tg + 1u) * nx) xb_add(&bar[XB_TOPGEN], 1u);
            else XB_SPIN(xb_ld(&bar[XB_TOPGEN]) == tg, bar);
            __builtin_amdgcn_fence(__ATOMIC_ACQUIRE, "agent");
            xb_add(&bar[XB_XGEN(b.x)], 1u);
            asm volatile("s_waitcnt vmcnt(0)" ::: "memory");
        } else {
            XB_SPIN(xb_ld(&bar[XB_XGEN(b.x)]) == gen, bar);
            __builtin_amdgcn_fence(__ATOMIC_ACQUIRE, "agent");
            asm volatile("s_waitcnt vmcnt(0)" ::: "memory");
        }
    }
    __syncthreads();
}

constexpr int DM = 2048;
constexpr int NB_CTX = 16, S_CTX = 256, NB_LAT = 2, S_LAT = 4096, DEPTH = 4;
constexpr int R_CTX = NB_CTX * S_CTX;
constexpr int R_LAT = NB_LAT * S_LAT;
constexpr int MROWS = R_CTX + R_LAT;
constexpr int DIN = 5632, DFF = 5632, DGU = 2 * DFF;
constexpr float ALPHA = 1.6817928305074292f;
constexpr int C_AQ = 0, C_AK = 512, C_AV = 1024, C_BQ = 1536, C_BF = 2048, C_BB = 2560, C_BI = 3072, C_BG = 3584, C_CQ = 4096, C_CK = 5120, C_CV = 5376;
constexpr size_t O_YP = 0, O_YS = 8388608, O_DK = 25165824, O_DV = 33554432, O_SK = 41943040, O_SV = 46137344, O_ST = 50331648, O_END = 58720256;

constexpr size_t MiB = 1u << 20;
constexpr size_t WS_CTL = 0, CTL_ZERO_BYTES = 1 * MiB;
constexpr size_t WS_MODS = 1 * MiB;
constexpr size_t WS_MISC = 2 * MiB;
constexpr size_t WS_W = 4 * MiB, W_LAYER = 96 * MiB;
constexpr size_t WO_IN = 0, WO_OUT = 22 * MiB, WO_GU = 30 * MiB, WO_DN = 74 * MiB;
constexpr size_t WS_H = 388 * MiB;
constexpr size_t WS_CAT = 436 * MiB;
constexpr size_t WS_X1 = 484 * MiB;
constexpr size_t WS_OA = 580 * MiB, WS_OBF = 604 * MiB, WS_OBB = 628 * MiB;
constexpr size_t WS_P = 652 * MiB;
constexpr size_t WS_ACT = WS_P, WS_YPRE = WS_P + 132 * MiB;
constexpr size_t WS_C16 = 916 * MiB;
constexpr size_t WS_QKV = 922 * MiB;
constexpr int HP_LD = 2560;
constexpr int QKV_LD = 3072, Q_QD = 0, Q_KD = 512, Q_VD = 1024, Q_QS = 1536, Q_KS = 2560, Q_VS = 2816;
constexpr size_t WS_HQ = 994 * MiB;
constexpr size_t WS_HKM = 1018 * MiB;
constexpr size_t WS_HKP = 1042 * MiB;
constexpr size_t WS_HVT = 1066 * MiB;
constexpr size_t WS_HDEC = 1090 * MiB;
constexpr size_t WS_SLOC = 1094 * MiB;
constexpr size_t WS_DSEG = 1110 * MiB;
constexpr size_t WS_YPRE2 = 1111 * MiB;
constexpr size_t WS_END = 1143 * MiB;

constexpr int CW_BAR = 4096;

constexpr int RING_BYTES = 131072;
constexpr int LDSCTL_OFF = RING_BYTES, MISC_OFF = LDSCTL_OFF + 320;
constexpr int LDS_BYTES = 147456;

typedef unsigned v2u __attribute__((ext_vector_type(2)));
typedef GAS float gf32;
typedef GAS unsigned short gbf16;

__device__ __forceinline__ float silu_f(float a) { return a / (1.0f + __expf(-a)); }
__device__ __forceinline__ int mod_of_row(int row) { return row < R_CTX ? 0 : (row < R_CTX + S_LAT ? 1 : 2); }

constexpr float LOG2E = 1.4426950408889634f;
constexpr float QSC_D = 0.125f * LOG2E, QSC_S = 0.08838834764831845f * LOG2E;
struct EpiProj {
    static constexpr bool PERM = false, AFTER_DRAIN = false;
    gbf16* qkv; gf32* hproj; gf32* out; const gf32* tabD; const gf32* tabS; int l;
    __device__ __forceinline__ void operator()(const pg8::f32x4 (&acc)[2][2][4][2], const pg8::Unit& u, int wr, int wc, int fr, int fq) const {
        const int pn = u.pn, pm = u.pm, rbase = pm * 256 + wr * 64 + fr;
        if (pn >= 6 && pn < 16) {
#pragma unroll
            for (int ai = 0; ai < 2; ++ai)
#pragma unroll
                for (int m = 0; m < 4; ++m) { gf32* rowp = hproj + (size_t)(rbase + ai * 128 + m * 16) * HP_LD + (pn - 6) * 256 + wc * 32 + 4 * fq;
#pragma unroll
                    for (int bj = 0; bj < 2; ++bj)
#pragma unroll
                        for (int n = 0; n < 2; ++n) *(GAS pg8::f32x4*)(rowp + bj * 128 + n * 16) = acc[ai][bj][m][n]; }
            return;
        }
        const bool lat = pm >= 16, swar = pn >= 16 && pn <= 20, isv = pn == 4 || pn == 5 || pn == 21, rope = lat && !isv;
        const float sc = pn < 2 ? QSC_D : (pn >= 16 && pn < 20 ? QSC_S : 1.0f);
        const int o1 = swar ? pn * 256 + 64 * (wc >> 1) + 16 * (wc & 1) + 4 * fq : pn * 256 + 32 * wc + 4 * fq, dn = swar ? 32 : 16;
        const int qoff = pn < 6 ? 0 : Q_QS - C_CQ;
        const int ppar = swar ? (wc >> 1) & 1 : wc & 1;
        const gf32* tab = swar ? tabS + (16 * (wc & 1) + 4 * fq) * 2 : tabD + 4 * fq * 2; const int tstr = swar ? 64 : 32;
        size_t cbase = 0; int nh = 0; bool tocache = false;
        if (!lat) { if (pn == 2 || pn == 3) { cbase = O_DK; nh = 4; tocache = true; } else if (pn == 4 || pn == 5) { cbase = O_DV; nh = 4; tocache = true; } else if (pn == 20) { cbase = O_SK; nh = 2; tocache = true; } else if (pn == 21) { cbase = O_SV; nh = 2; tocache = true; } }
        const int hd0 = (pn == 2 || pn == 3) ? 2 * (pn - 2) : ((pn == 4 || pn == 5) ? 2 * (pn - 4) : 0);
        const int cc1 = o1 & 127;
#pragma unroll
        for (int ai = 0; ai < 2; ++ai)
#pragma unroll
            for (int m = 0; m < 4; ++m) {
                const int row = rbase + ai * 128 + m * 16;
                pg8::f32x4 cs = {1.f, 1.f, 1.f, 1.f}, sn = {0.f, 0.f, 0.f, 0.f};
                if (rope) { const int t = (row - R_CTX) & (S_LAT - 1), pos = ppar ? (t & 63) : (t >> 6);
                    const pg8::f32x4 t0 = *(const GAS pg8::f32x4*)(tab + pos * tstr), t1 = *(const GAS pg8::f32x4*)(tab + pos * tstr + 4);
                    cs = (pg8::f32x4){t0[0], t0[2], t1[0], t1[2]}; sn = (pg8::f32x4){t0[1], t0[3], t1[1], t1[3]}; }
                gbf16* qrow = qkv + (size_t)row * QKV_LD + qoff + o1;
#pragma unroll
                for (int bj = 0; bj < 2; ++bj) {
                    const pg8::f32x4 x1 = acc[ai][bj][m][0], x2 = acc[ai][bj][m][1];
                    const pg8::f32x4 y1 = (x1 * cs - x2 * sn) * sc, y2 = (x2 * cs + x1 * sn) * sc;
                    *(GAS v2u*)(qrow + bj * 128) = (v2u){pg8::cvt_pk_bf16(y1[0], y1[1]), pg8::cvt_pk_bf16(y1[2], y1[3])};
                    *(GAS v2u*)(qrow + bj * 128 + dn) = (v2u){pg8::cvt_pk_bf16(y2[0], y2[1]), pg8::cvt_pk_bf16(y2[2], y2[3])};
                    if (tocache) { gf32* cp = out + cbase + ((((size_t)pm * 4 + l) * nh + hd0 + bj) * 256 + (row & 255)) * 128 + cc1;
                        *(GAS pg8::f32x4*)cp = x1; *(GAS pg8::f32x4*)(cp + dn) = x2; }
                }
            }
    }
};
#ifndef Y_BF16
#define Y_BF16 1
#endif
#if Y_BF16
typedef gbf16 gy_t;
#else
typedef gf32 gy_t;
#endif
__device__ __forceinline__ f32x4 bf2lo(unsigned a, unsigned b) { return (f32x4){__builtin_bit_cast(float, a << 16), __builtin_bit_cast(float, a & 0xffff0000u), __builtin_bit_cast(float, b << 16), __builtin_bit_cast(float, b & 0xffff0000u)}; }
struct EpiResid {
    static constexpr bool PERM = Y_BF16 != 0, AFTER_DRAIN = false;
    const gf32* xa; const gf32* xb;
    const gy_t* yprev; const gf32* stats; const gf32* lng; const gf32* lnb;
    const gf32* gates;
    gy_t* out; int pm_off; int gate_only; int mode;
    __device__ __forceinline__ void operator()(const pg8::f32x4 (&acc)[2][2][4][2], const pg8::Unit& u, int wr, int wc, int fr, int fq) const {
        asm volatile("" : "+v"(fr), "+v"(fq));
        const int pm = u.pm + pm_off, mod = pm >> 4;
        const int r0 = pm * 256 + wr * 64 + fr, or0 = (gate_only ? u.pm : pm) * 256 + wr * 64 + fr;
        const bool m1 = mode == 1 && !gate_only, m0 = mode == 0 && !gate_only;
        const gf32* xbase = (pm < 16) ? xa + (size_t)pm * 256 * DM : xb + (size_t)(pm - 16) * 256 * DM;
        float mu[2][4], rs[2][4];
#pragma unroll
        for (int ai = 0; ai < 2; ++ai)
#pragma unroll
            for (int m = 0; m < 4; ++m) { mu[ai][m] = 0.f; rs[ai][m] = 0.f;
                if (m1) { const pg8::f32x2 st = *(const GAS pg8::f32x2*)(stats + 2 * (size_t)(r0 + ai * 128 + m * 16)); mu[ai][m] = st[0]; rs[ai][m] = st[1] * ALPHA; } }
#pragma unroll
        for (int bj = 0; bj < 2; ++bj) {
            const int cb = u.pn * 256 + bj * 128 + wc * 32;
            const int c0 = cb + (PERM ? 8 * fq : 4 * fq), dn = PERM ? 4 : 16;
            pg8::f32x4 gv[2], ga[2], be[2];
#pragma unroll
            for (int n = 0; n < 2; ++n) { gv[n] = *(const GAS pg8::f32x4*)(gates + (size_t)mod * 6 * DM + c0 + n * dn);
                ga[n] = (pg8::f32x4){0.f, 0.f, 0.f, 0.f}; be[n] = ga[n];
                if (m1) { ga[n] = *(const GAS pg8::f32x4*)(lng + c0 + n * dn); be[n] = *(const GAS pg8::f32x4*)(lnb + c0 + n * dn) * ALPHA; } }
#pragma unroll
            for (int ai = 0; ai < 2; ++ai)
#pragma unroll
                for (int m = 0; m < 4; ++m) { const int rr = ai * 128 + m * 16;
                    pg8::f32x4 v0 = gv[0] * acc[ai][bj][m][0], v1 = gv[1] * acc[ai][bj][m][1];
                    if (m0) { const gf32* xp = xbase + (size_t)(wr * 64 + fr + rr) * DM + c0;
                        v0 += *(const GAS pg8::f32x4*)xp * ALPHA; v1 += *(const GAS pg8::f32x4*)(xp + dn) * ALPHA; }
                    if (m1) { const gy_t* yp = yprev + (size_t)(r0 + rr) * DM + c0; pg8::f32x4 y0, y1;
#if Y_BF16
                        const v4u w = *(const GAS v4u*)yp; y0 = bf2lo(w.x, w.y); y1 = bf2lo(w.z, w.w);
#else
                        y0 = *(const GAS pg8::f32x4*)yp; y1 = *(const GAS pg8::f32x4*)(yp + dn);
#endif
                        v0 += (y0 - mu[ai][m]) * rs[ai][m] * ga[0] + be[0]; v1 += (y1 - mu[ai][m]) * rs[ai][m] * ga[1] + be[1]; }
                    gy_t* op = out + (size_t)(or0 + rr) * DM + c0;
#if Y_BF16
                    pg8::u32x4 w; w.x = pg8::cvt_pk_bf16(v0[0], v0[1]); w.y = pg8::cvt_pk_bf16(v0[2], v0[3]); w.z = pg8::cvt_pk_bf16(v1[0], v1[1]); w.w = pg8::cvt_pk_bf16(v1[2], v1[3]);
                    *(GAS pg8::u32x4*)op = w;
#else
                    *(GAS pg8::f32x4*)op = v0; *(GAS pg8::f32x4*)(op + dn) = v1;
#endif
                }
        }
    }
};
struct EpiSwiGLU {
    static constexpr bool PERM = true, AFTER_DRAIN = false;
    gbf16* act;
    __device__ __forceinline__ void operator()(const pg8::f32x4 (&acc)[2][2][4][2], const pg8::Unit& u, int wr, int wc, int fr, int fq) const {
        const int row0 = u.pm * 256 + wr * 64 + fr, col0 = u.pn * 128 + wc * 32 + 8 * fq;
#pragma unroll
        for (int ai = 0; ai < 2; ++ai)
#pragma unroll
            for (int m = 0; m < 4; ++m) { gbf16* rowp = act + (size_t)(row0 + ai * 128 + m * 16) * DFF + col0;
                float r[8];
#pragma unroll
                for (int n = 0; n < 2; ++n)
#pragma unroll
                    for (int j = 0; j < 4; ++j) { const float g = acc[ai][0][m][n][j], up = acc[ai][1][m][n][j]; r[n * 4 + j] = silu_f(g) * up; }
                pg8::u32x4 w; w.x = pg8::cvt_pk_bf16(r[0], r[1]); w.y = pg8::cvt_pk_bf16(r[2], r[3]); w.z = pg8::cvt_pk_bf16(r[4], r[5]); w.w = pg8::cvt_pk_bf16(r[6], r[7]);
                *(GAS pg8::u32x4*)rowp = w; }
    }
};

struct Args { const float* in[24]; float* out; unsigned char* ws; int ph_lo, ph_hi, single, pad; };
enum { I_XP = 0, I_XS, I_CDK, I_CDV, I_CSK, I_CSV, I_ST, I_C, I_CCTX, I_WMOD, I_BMOD, I_WIN, I_WOUT, I_DLAM, I_DNG, I_LBL, I_HNG, I_SINK, I_LN1G, I_LN1B, I_LN2G, I_LN2B, I_WGU, I_WDN };

struct Ctx {
    LAS unsigned char* lds; int tid, lane, wave, G, bid;
    const Args* ap; gf32* out; GAS unsigned char* ws;
    __device__ __forceinline__ const gf32* inp(int i) const { return (const gf32*)ap->in[i]; }
    __device__ __forceinline__ gf32* mods() const { return (gf32*)(ws + WS_MODS); }
    __device__ __forceinline__ gf32* lball() const { return (gf32*)(ws + WS_MISC); }
    __device__ __forceinline__ gf32* lamv() const { return (gf32*)(ws + WS_MISC + 16384); }
    __device__ __forceinline__ gf32* tabD() const { return (gf32*)(ws + WS_MISC + 20480); }
    __device__ __forceinline__ gf32* tabS() const { return (gf32*)(ws + WS_MISC + 32768); }
    __device__ __forceinline__ gbf16* wT(int l, size_t off) const { return (gbf16*)(ws + WS_W + (size_t)l * W_LAYER + off); }
    __device__ __forceinline__ gbf16* hbuf() const { return (gbf16*)(ws + WS_H); }
    __device__ __forceinline__ gbf16* cat() const { return (gbf16*)(ws + WS_CAT); }
    __device__ __forceinline__ GAS void* ybuf(int i) const { return (GAS void*)(ws + (i == 0 ? WS_X1 : (i == 1 ? WS_YPRE : WS_YPRE2))); }
    __device__ __forceinline__ gf32* stats() const { return (gf32*)(ws + WS_MISC + 1 * MiB); }
    __device__ __forceinline__ gf32* oa() const { return (gf32*)(ws + WS_OA); }
    __device__ __forceinline__ gf32* obf() const { return (gf32*)(ws + WS_OBF); }
    __device__ __forceinline__ gf32* obb() const { return (gf32*)(ws + WS_OBB); }
    __device__ __forceinline__ gf32* hproj() const { return (gf32*)(ws + WS_P); }
    __device__ __forceinline__ gbf16* act() const { return (gbf16*)(ws + WS_ACT); }
    __device__ __forceinline__ gbf16* qkv() const { return (gbf16*)(ws + WS_QKV); }
    __device__ __forceinline__ gbf16* hq(int dir) const { return (gbf16*)(ws + WS_HQ) + (size_t)dir * MROWS * 512; }
    __device__ __forceinline__ gbf16* hkm(int dir) const { return (gbf16*)(ws + WS_HKM) + (size_t)dir * MROWS * 512; }
    __device__ __forceinline__ gbf16* hkp(int dir) const { return (gbf16*)(ws + WS_HKP) + (size_t)dir * 768 * 512 * 16; }
    __device__ __forceinline__ gbf16* hvt(int dir) const { return (gbf16*)(ws + WS_HVT) + (size_t)dir * 768 * 512 * 16; }
    __device__ __forceinline__ gf32* sloc() const { return (gf32*)(ws + WS_SLOC); }
    __device__ __forceinline__ gf32* dseg() const { return (gf32*)(ws + WS_DSEG); }
    __device__ __forceinline__ gf32* hdec(int dir) const { return (gf32*)(ws + WS_HDEC) + (size_t)dir * 768 * 512; }
    __device__ __forceinline__ gbf16* c16(size_t off) const { return (gbf16*)(ws + WS_C16 + off); }
};

template <bool SWAP64>
__device__ __forceinline__ void transpose_item(const gf32* W, int K, int N, gbf16* WT, int k0, int n0, int drow0, LAS float* scr, int lane) {
#pragma unroll 8
    for (int i = 0; i < 32; ++i) { const int kk = 2 * i + (lane >> 5); scr[kk * 33 + (lane & 31)] = W[(size_t)(k0 + kk) * N + n0 + (lane & 31)]; }
    LDS_WAIT(); asm volatile("" ::: "memory");
    const int c = lane & 7;
#pragma unroll
    for (int j = 0; j < 4; ++j) { const int n = (lane >> 3) + 8 * j; const LAS float* sp = scr + (8 * c) * 33 + n;
        int drow = drow0 + n;
        if (SWAP64) { const int o = (n0 & 63) + n, a = (o >> 4) & 1, nn = o >> 5, ii = o & 15; drow = (n0 & ~63) + 32 * a + 16 * nn + ii; }
        v4u o4; o4.x = pk2(sp[0 * 33], sp[1 * 33]); o4.y = pk2(sp[2 * 33], sp[3 * 33]); o4.z = pk2(sp[4 * 33], sp[5 * 33]); o4.w = pk2(sp[6 * 33], sp[7 * 33]);
        *(GAS v4u*)(WT + (size_t)drow * K + k0 + 8 * c) = o4; }
    LDS_WAIT(); asm volatile("" ::: "memory");
}

__device__ __forceinline__ void p0_prologue(const Ctx& F) {
    {
        LAS float* sc = (LAS float*)F.lds;
        LAS float* red = (LAS float*)(F.lds + 24576);
        const gf32* c_ctx = F.inp(I_CCTX); const gf32* cc = F.inp(I_C);
        for (int i = F.tid; i < 3 * DM; i += 512) { const int mid = i / DM, k = i % DM; const float c = mid == 0 ? c_ctx[k] : cc[(mid - 1) * DM + k]; sc[i] = silu_f(c); }
        __syncthreads();
        for (int task = F.bid; task < DEPTH * 48; task += F.G) {
            const int l = task / 48, cb = task % 48, w = F.wave;
            const gf32* wp = F.inp(I_WMOD) + ((size_t)l * DM + 256 * w) * (6 * DM) + cb * 256 + F.lane * 4;
            f32x4 a0 = {0.f, 0.f, 0.f, 0.f}, a1 = a0, a2 = a0;
#pragma unroll 8
            for (int kk = 0; kk < 256; ++kk) { const f32x4 wv = *(const GAS f32x4*)(wp + (size_t)kk * (6 * DM));
                a0 += wv * sc[256 * w + kk]; a1 += wv * sc[DM + 256 * w + kk]; a2 += wv * sc[2 * DM + 256 * w + kk]; }
            *(LAS f32x4*)(red + (w * 3 + 0) * 256 + F.lane * 4) = a0; *(LAS f32x4*)(red + (w * 3 + 1) * 256 + F.lane * 4) = a1; *(LAS f32x4*)(red + (w * 3 + 2) * 256 + F.lane * 4) = a2;
            __syncthreads();
            for (int i = F.tid; i < 768; i += 512) { const int m = i >> 8, c = i & 255; float s = 0.f;
#pragma unroll
                for (int ww = 0; ww < 8; ++ww) s += red[(ww * 3 + m) * 256 + c];
                F.mods()[((size_t)l * 3 + m) * (6 * DM) + cb * 256 + c] = s + F.inp(I_BMOD)[(size_t)l * 6 * DM + cb * 256 + c]; }
            __syncthreads();
        }
    }
    if (F.bid == F.G - 1) {
        const gf32* lbl = F.inp(I_LBL);
        for (int i = F.tid; i < 1024; i += 512) { float lg[4], mx = -1e30f;
#pragma unroll
            for (int l = 0; l < 4; ++l) { lg[l] = lbl[l * 1024 + i]; mx = fmaxf(mx, lg[l]); }
            float s = 0.f;
#pragma unroll
            for (int l = 0; l < 4; ++l) { lg[l] = expf(lg[l] - mx); s += lg[l]; }
            const float w1 = lg[1] / s, w2 = lg[2] / s, w3 = lg[3] / s;
            F.lball()[0 * 1024 + i] = 0.f; F.lball()[1 * 1024 + i] = w1; F.lball()[2 * 1024 + i] = w1 + w2; F.lball()[3 * 1024 + i] = w1 + w2 + w3; }
        if (F.tid < 4) { const int l = F.tid; const gf32* lp = F.inp(I_DLAM) + l * 256; float s1 = 0.f, s2 = 0.f;
            for (int i = 0; i < 64; ++i) { s1 += lp[i] * lp[64 + i]; s2 += lp[128 + i] * lp[192 + i]; }
            const float li = 0.8f - 0.6f * expf(-0.3f * (float)l);
            F.lamv()[l * 2] = expf(s1) - expf(s2) + li; F.lamv()[l * 2 + 1] = li; }
        for (int i = F.tid; i < 64 * 16; i += 512) { const int pos = i / 16, j = i % 16; const float inv = powf(10000.f, -(float)j / 16.f), ang = (float)pos * inv; F.tabD()[i * 2] = cosf(ang); F.tabD()[i * 2 + 1] = sinf(ang); }
        for (int i = F.tid; i < 64 * 32; i += 512) { const int pos = i / 32, j = i % 32; const float inv = powf(10000.f, -(float)j / 32.f), ang = (float)pos * inv; F.tabS()[i * 2] = cosf(ang); F.tabS()[i * 2 + 1] = sinf(ang); }
    }
    {
        const gf32* src[4] = {F.inp(I_CDK), F.inp(I_CDV), F.inp(I_CSK), F.inp(I_CSV)};
        const size_t doff[4] = {0, 2 * MiB, 4 * MiB, 5 * MiB}; const int n8[4] = {131072, 131072, 65536, 65536};
#pragma unroll
        for (int a = 0; a < 4; ++a)
            for (int i = F.bid * 512 + F.tid; i < n8[a]; i += F.G * 512) { const f32x4 x0 = *(const GAS f32x4*)(src[a] + (size_t)i * 8), x1 = *(const GAS f32x4*)(src[a] + (size_t)i * 8 + 4);
                v4u o; o.x = pk2(x0[0], x0[1]); o.y = pk2(x0[2], x0[3]); o.z = pk2(x1[0], x1[1]); o.w = pk2(x1[2], x1[3]); *(GAS v4u*)(F.c16(doff[a]) + (size_t)i * 8) = o; }
    }
    {
        LAS float* scr = (LAS float*)(F.lds + 49152 + F.wave * 8448);
        const int gw = F.bid * 8 + F.wave, NGW = F.G * 8;
        constexpr int I_IN = 32 * 176, I_OUT = 32 * 64, I_GU = 32 * 352, I_DN = 88 * 64, I_L = I_IN + I_OUT + I_GU + I_DN;
        for (int it = gw; it < DEPTH * I_L; it += NGW) {
            const int l = it / I_L; int r = it % I_L;
            if (r < I_IN) { const int kb = r / 176, nb = r % 176, n0 = 32 * nb;
                if (n0 >= C_CQ && n0 < C_CV) transpose_item<true>(F.inp(I_WIN) + (size_t)l * DM * DIN, DM, DIN, F.wT(l, WO_IN), 64 * kb, n0, n0, scr, F.lane);
                else transpose_item<false>(F.inp(I_WIN) + (size_t)l * DM * DIN, DM, DIN, F.wT(l, WO_IN), 64 * kb, n0, n0, scr, F.lane);
                continue; } r -= I_IN;
            if (r < I_OUT) { const int kb = r / 64, nb = r % 64; transpose_item<false>(F.inp(I_WOUT) + (size_t)l * DM * DM, DM, DM, F.wT(l, WO_OUT), 64 * kb, 32 * nb, 32 * nb, scr, F.lane); continue; } r -= I_OUT;
            if (r < I_GU) { const int kb = r / 352, nb = r % 352, n0 = 32 * nb; const int j = n0 < DFF ? n0 : n0 - DFF; const int drow = 256 * (j >> 7) + (n0 < DFF ? 0 : 128) + (j & 127);
                transpose_item<false>(F.inp(I_WGU) + (size_t)l * DM * DGU, DM, DGU, F.wT(l, WO_GU), 64 * kb, n0, drow, scr, F.lane); continue; } r -= I_GU;
            { const int kb = r / 64, nb = r % 64; transpose_item<false>(F.inp(I_WDN) + (size_t)l * DFF * DM, DFF, DM, F.wT(l, WO_DN), 64 * kb, 32 * nb, 32 * nb, scr, F.lane); }
        }
    }
}

__device__ __forceinline__ void p1_h0(const Ctx& F) {
    const gf32* xp = F.inp(I_XP); const gf32* xs = F.inp(I_XS);
    for (int idx = F.bid * 512 + F.tid; idx < MROWS * 256; idx += F.G * 512) {
        const int row = idx >> 8, c8 = (idx & 255) * 8, mod = mod_of_row(row);
        const gf32* xr = row < R_CTX ? xp + (size_t)row * DM : xs + (size_t)(row - R_CTX) * DM;
        const gf32* sh = F.mods() + (size_t)(0 * 3 + mod) * 6 * DM; const gf32* sc = sh + DM;
        const f32x4 x0 = *(const GAS f32x4*)(xr + c8), x1 = *(const GAS f32x4*)(xr + c8 + 4), s0 = *(const GAS f32x4*)(sh + c8), s1 = *(const GAS f32x4*)(sh + c8 + 4), c0 = *(const GAS f32x4*)(sc + c8), c1 = *(const GAS f32x4*)(sc + c8 + 4);
        const f32x4 h0 = x0 * (c0 + 1.0f) + s0, h1 = x1 * (c1 + 1.0f) + s1;
        v4u o; o.x = pk2(h0[0], h0[1]); o.y = pk2(h0[2], h0[3]); o.z = pk2(h1[0], h1[1]); o.w = pk2(h1[2], h1[3]);
        *(GAS v4u*)(F.hbuf() + (size_t)row * DM + c8) = o;
    }
}

__device__ __forceinline__ void e1_postproj(const Ctx& F, int l) {
    const gf32* lb = F.lball() + l * 1024;
    for (int grp = F.bid; grp < MROWS / 16; grp += F.G) {
        const int row0 = grp * 16;
        {
            const int c = F.tid; const gf32* pc = F.hproj() + (size_t)row0 * HP_LD;
            float qv[16], vv[16];
#pragma unroll
            for (int r = 0; r < 16; ++r) { qv[r] = silu_f(pc[(size_t)r * HP_LD + c]); vv[r] = pc[(size_t)r * HP_LD + 1536 + c]; }
#pragma unroll
            for (int dir = 0; dir < 2; ++dir) {
                const float lbv = lb[dir * 512 + c], lbm = fmaxf(lbv, 1e-30f), oml = 1.0f - lbv;
                float g[16], cum[16]; float run = 0.f;
#pragma unroll
                for (int p = 0; p < 16; ++p) { const int r = dir ? 15 - p : p; const float z = pc[(size_t)r * HP_LD + 512 + dir * 512 + c];
                    g[p] = logf(lbm + oml / (1.0f + expf(-z))); run += g[p]; cum[p] = run; }
                const float last = run;
                unsigned kpw[8], vtw[8];
#pragma unroll
                for (int p = 0; p < 16; p += 2) {
                    float kp2[2];
#pragma unroll
                    for (int e = 0; e < 2; ++e) { const int pp = p + e, r = dir ? 15 - pp : pp; const float k = 1.0f - expf(g[pp]); const float cc = fmaxf(cum[pp], -80.0f);
                        F.hq(dir)[(size_t)(row0 + r) * 512 + c] = (bf16)f2bf(qv[r] * expf(cc)); F.hkm(dir)[(size_t)(row0 + r) * 512 + c] = (bf16)f2bf(k * expf(-cc));
                        kp2[e] = k * expf(last - cum[pp]); }
                    kpw[p >> 1] = pk2(kp2[0], kp2[1]); vtw[p >> 1] = pk2(vv[dir ? 15 - p : p], vv[dir ? 14 - p : p + 1]);
                }
                GAS v4u* kd = (GAS v4u*)(F.hkp(dir) + ((size_t)grp * 512 + c) * 16); GAS v4u* vd = (GAS v4u*)(F.hvt(dir) + ((size_t)grp * 512 + c) * 16);
                kd[0] = (v4u){kpw[0], kpw[1], kpw[2], kpw[3]}; kd[1] = (v4u){kpw[4], kpw[5], kpw[6], kpw[7]};
                vd[0] = (v4u){vtw[0], vtw[1], vtw[2], vtw[3]}; vd[1] = (v4u){vtw[4], vtw[5], vtw[6], vtw[7]};
                F.hdec(dir)[(size_t)grp * 512 + c] = expf(last);
            }
        }
    }
}

typedef float f32x16 __attribute__((ext_vector_type(16)));
typedef short s16x4 __attribute__((ext_vector_type(4)));
typedef __bf16 bf16x2_t __attribute__((ext_vector_type(2)));
typedef float f32x2_t __attribute__((ext_vector_type(2)));
__device__ __forceinline__ unsigned cvt2(float a, float b) { const f32x2_t f = {a, b}; return __builtin_bit_cast(unsigned, __builtin_convertvector(f, bf16x2_t)); }
#define MFMA32(a, b, c) __builtin_amdgcn_mfma_f32_32x32x16_bf16((a), (b), (c), 0, 0, 0)

struct AttnSeg { const gbf16* k; const gbf16* v; int stride; int ntiles; };
constexpr int AT_NS = 4, AT_SLOT = 32768;
constexpr float ATT_THR = 8.0f;
#define AT_VMWAIT(n) asm volatile("s_waitcnt vmcnt(" #n ")" ::: "memory")
__device__ __forceinline__ void glds16_asm(const GAS void* gsrc, unsigned lds_dst) {
    unsigned keep;
    asm volatile("s_mov_b32 %0, m0\n\ts_mov_b32 m0, %2\n\ts_nop 0\n\tglobal_load_lds_dwordx4 %1, off\n\ts_mov_b32 m0, %0" : "=&s"(keep) : "v"(gsrc), "s"(lds_dst) : "memory");
}

template <int DQK, bool DIFF>
__device__ __forceinline__ void attn_mfma(const Ctx& F, const gbf16* qptr, int kcol, const AttnSeg s0, const AttnSeg s1, bool band, int qpos, int kpos0,
                                          float m_init, float l_init, float lam, float post_scale, const gf32* gvec, gbf16* outp  ) {
    int lane_ = (int)__builtin_amdgcn_mbcnt_hi(~0u, __builtin_amdgcn_mbcnt_lo(~0u, 0u)); asm volatile("" : "+v"(lane_));
    const int lane = lane_, w = F.wave, r32 = lane & 31, h = lane >> 5;
    __syncthreads();
    bf16x8 qf[DQK / 16];
#pragma unroll
    for (int ks = 0; ks < DQK / 16; ++ks) qf[ks] = *(const GAS bf16x8*)(qptr + (size_t)r32 * QKV_LD + 16 * ks + 8 * h);
#pragma unroll
    for (int ks = 0; ks < DQK / 16; ++ks) asm volatile("" : "+v"(qf[ks]));
    __builtin_amdgcn_s_waitcnt(0);
    f32x16 o[4];
#pragma unroll
    for (int t = 0; t < 4; ++t)
#pragma unroll
        for (int r = 0; r < 16; ++r) o[t][r] = 0.f;
    float m = m_init, l = l_init;
    const int nt = s0.ntiles + s1.ntiles;
    const int srow0 = 8 * w + (lane >> 4), spc = lane & 15;
    const unsigned lds_base = (unsigned)(__UINTPTR_TYPE__)F.lds;
#define AT_ISSUE(tj) do { const int te_ = (tj) < nt ? (tj) : nt - 1; const bool s1_ = te_ >= s0.ntiles; const int tt_ = s1_ ? te_ - s0.ntiles : te_; \
        const GAS unsigned char* kb_ = (const GAS unsigned char*)(s1_ ? s1.k : s0.k); const GAS unsigned char* vb_ = (const GAS unsigned char*)(s1_ ? s1.v : s0.v); const int st_ = (s1_ ? s1.stride : s0.stride) * 2; \
        const unsigned sl_ = lds_base + (unsigned)(((tj) % AT_NS) * AT_SLOT + w * 2048); \
        _Pragma("unroll") for (int j_ = 0; j_ < 2; ++j_) { const int row_ = srow0 + 4 * j_; const size_t ro_ = (size_t)(tt_ * 64 + row_) * st_; \
            glds16_asm(kb_ + ro_ + ((spc ^ (row_ & 15)) * 16), sl_ + j_ * 1024); \
            glds16_asm(vb_ + ro_ + ((spc ^ ((row_ & 3) << 2)) * 16), sl_ + 16384 + j_ * 1024); } } while (0)
    const int kc0 = kcol / 8 + h;
    const int krow = r32 * 256, ksw = r32 & 15;
    const int vq = (lane & 15) >> 2, vp = lane & 3, vc16 = (lane >> 4) & 1;
    const int vrow = 16384 + (4 * h + vq) * 256 + 8 * (vp & 1);
    int vpo[4];
#pragma unroll
    for (int t = 0; t < 4; ++t) vpo[t] = ((4 * (t ^ vq) + 2 * vc16 + (vp >> 1)) * 16);
#pragma unroll
    for (int j = 0; j < AT_NS - 1; ++j) AT_ISSUE(j);
    for (int ti = 0; ti < nt; ++ti) {
        AT_VMWAIT(8);
        asm volatile("s_waitcnt lgkmcnt(0)" ::: "memory"); __builtin_amdgcn_s_barrier(); asm volatile("" ::: "memory");
        AT_ISSUE(ti + AT_NS - 1);
        const LAS unsigned char* kb = F.lds + (ti % AT_NS) * AT_SLOT;
        f32x16 st[2];
#pragma unroll
        for (int kt = 0; kt < 2; ++kt)
#pragma unroll
            for (int r = 0; r < 16; ++r) st[kt][r] = 0.f;
        {
            constexpr int NG = 2 * (DQK / 64);
            bf16x8 kfa[4], kfb[4];
#define ATT_LDK(dst, g) do { const int kt_ = (g) / (DQK / 64), k0_ = ((g) % (DQK / 64)) * 4; _Pragma("unroll") for (int j_ = 0; j_ < 4; ++j_) dst[j_] = *(const LAS bf16x8*)(kb + kt_ * 8192 + krow + (((kc0 + 2 * (k0_ + j_)) ^ ksw) * 16)); } while (0)
#define ATT_MMK(src, g) do { const int kt_ = (g) / (DQK / 64), k0_ = ((g) % (DQK / 64)) * 4; _Pragma("unroll") for (int j_ = 0; j_ < 4; ++j_) st[kt_] = MFMA32(src[j_], qf[k0_ + j_], st[kt_]); } while (0)
            ATT_LDK(kfa, 0); __builtin_amdgcn_sched_barrier(0);
#pragma unroll
            for (int g = 0; g < NG; g += 2) {
                ATT_LDK(kfb, g + 1); __builtin_amdgcn_sched_barrier(0);
                ATT_MMK(kfa, g);
                if (g + 2 < NG) { ATT_LDK(kfa, g + 2); __builtin_amdgcn_sched_barrier(0); }
                ATT_MMK(kfb, g + 1);
            }
#undef ATT_LDK
#undef ATT_MMK
        }
        if (band && ti < s0.ntiles) {
            const int kp = kpos0 + ti * 64 + 4 * h - (qpos + r32);
#pragma unroll
            for (int kt = 0; kt < 2; ++kt)
#pragma unroll
                for (int r = 0; r < 16; ++r) { const int d = kp + 32 * kt + (r & 3) + 8 * (r >> 2); if (d > 128 || d < -128) st[kt][r] = -1e30f; }
        }
        float mx = st[0][0];
#pragma unroll
        for (int kt = 0; kt < 2; ++kt)
#pragma unroll
            for (int r = 0; r < 16; ++r) mx = fmaxf(mx, st[kt][r]);
        mx = fmaxf(mx, __shfl_xor(mx, 32));
        if (__builtin_amdgcn_ballot_w64(mx > m + ATT_THR) != 0ull) {
            const float mn = fmaxf(m, mx), a = __builtin_amdgcn_exp2f(m - mn); l *= a; m = mn;
#pragma unroll
            for (int t = 0; t < 4; ++t)
#pragma unroll
                for (int r = 0; r < 16; ++r) o[t][r] *= a;
        }
        float rs = 0.f;
#pragma unroll
        for (int kt = 0; kt < 2; ++kt)
#pragma unroll
            for (int r = 0; r < 16; ++r) { const float p = __builtin_amdgcn_exp2f(st[kt][r] - m); st[kt][r] = p; rs += p; }
        rs += __shfl_xor(rs, 32); l += rs;
        {
            s16x4 va[8], vb[8];
#define ATT_LDV(dst, g) do { _Pragma("unroll") for (int t_ = 0; t_ < 4; ++t_) { dst[2 * t_] = __builtin_amdgcn_ds_read_tr16_b64_v4i16((LAS s16x4*)(kb + vrow + (16 * (g)) * 256 + vpo[t_])); \
                dst[2 * t_ + 1] = __builtin_amdgcn_ds_read_tr16_b64_v4i16((LAS s16x4*)(kb + vrow + (16 * (g) + 8) * 256 + vpo[t_])); } } while (0)
#define ATT_MMV(src, g) do { const int kt_ = (g) >> 1, s_ = (g) & 1; v4u pw_; pw_.x = cvt2(st[kt_][8 * s_], st[kt_][8 * s_ + 1]); pw_.y = cvt2(st[kt_][8 * s_ + 2], st[kt_][8 * s_ + 3]); pw_.z = cvt2(st[kt_][8 * s_ + 4], st[kt_][8 * s_ + 5]); pw_.w = cvt2(st[kt_][8 * s_ + 6], st[kt_][8 * s_ + 7]); \
            const bf16x8 pf_ = __builtin_bit_cast(bf16x8, pw_); _Pragma("unroll") for (int t_ = 0; t_ < 4; ++t_) o[t_] = MFMA32(__builtin_shufflevector(src[2 * t_], src[2 * t_ + 1], 0, 1, 2, 3, 4, 5, 6, 7), pf_, o[t_]); } while (0)
            ATT_LDV(va, 0); __builtin_amdgcn_sched_barrier(0);
            ATT_LDV(vb, 1); __builtin_amdgcn_sched_barrier(0);
            ATT_MMV(va, 0);
            ATT_LDV(va, 2); __builtin_amdgcn_sched_barrier(0);
            ATT_MMV(vb, 1);
            ATT_LDV(vb, 3); __builtin_amdgcn_sched_barrier(0);
            ATT_MMV(va, 2);
            ATT_MMV(vb, 3);
#undef ATT_LDV
#undef ATT_MMV
        }
    }
#undef AT_ISSUE
    AT_VMWAIT(0);
    __syncthreads();
    const float inv = 1.0f / l;
    if (DIFF) {
        LAS float* ex = (LAS float*)F.lds;
        if (F.wave >= 4) {
#pragma unroll
            for (int t = 0; t < 4; ++t)
#pragma unroll
                for (int r = 0; r < 16; ++r) ex[((F.wave - 4) * 64 + t * 16 + r) * 64 + lane] = o[t][r] * inv;
        }
        __syncthreads();
        if (F.wave < 4) {
            float ss = 0.f;
#pragma unroll
            for (int t = 0; t < 4; ++t)
#pragma unroll
                for (int r = 0; r < 16; ++r) { const float x = o[t][r] * inv - lam * ex[(F.wave * 64 + t * 16 + r) * 64 + lane]; o[t][r] = x; ss += x * x; }
            ss += __shfl_xor(ss, 32);
            const float sc = post_scale / sqrtf(ss * (1.0f / 128.0f) + 1e-6f);
            gbf16* op = outp + (size_t)r32 * DM;
#pragma unroll
            for (int t = 0; t < 4; ++t)
#pragma unroll
                for (int g4 = 0; g4 < 4; ++g4) { const int dv = 32 * t + 8 * g4 + 4 * h; const f32x4 gv = *(const GAS f32x4*)(gvec + dv);
                    v2u w2; w2.x = cvt2(o[t][4 * g4] * sc * gv[0], o[t][4 * g4 + 1] * sc * gv[1]); w2.y = cvt2(o[t][4 * g4 + 2] * sc * gv[2], o[t][4 * g4 + 3] * sc * gv[3]); *(GAS v2u*)(op + dv) = w2; }
        }
    } else {
        gbf16* op = outp + (size_t)r32 * DM;
#pragma unroll
        for (int t = 0; t < 4; ++t)
#pragma unroll
            for (int g4 = 0; g4 < 4; ++g4) { const int dv = 32 * t + 8 * g4 + 4 * h;
                v2u w2; w2.x = cvt2(o[t][4 * g4] * inv, o[t][4 * g4 + 1] * inv); w2.y = cvt2(o[t][4 * g4 + 2] * inv, o[t][4 * g4 + 3] * inv); *(GAS v2u*)(op + dv) = w2; }
    }
}

#define MFMA16(a, b, c) __builtin_amdgcn_mfma_f32_16x16x32_bf16((a), (b), (c), 0, 0, 0)
__device__ __forceinline__ bf16x8 frag2(v2u lo, v2u hi) { const v4u w = {lo.x, lo.y, hi.x, hi.y}; return __builtin_bit_cast(bf16x8, w); }
constexpr int HG_NS = 7, HG_SLOT = 17408;
#define HG_VMWAIT(n) asm volatile("s_waitcnt vmcnt(" #n ")" ::: "memory")
template <int MODE>
__device__ __forceinline__ void hgrn_mfma(const Ctx& F, int rb, int nchunks, int cc0, int ncc, int h, int dir, const gf32* s_in, gf32* s_out, gf32* ob, const gf32* fold_s, const gf32* fold_d, int nfold, gf32* d_out) {
    int lane_ = (int)__builtin_amdgcn_mbcnt_hi(~0u, __builtin_amdgcn_mbcnt_lo(~0u, 0u)); asm volatile("" : "+v"(lane_));
    const int lane = lane_, t16 = lane & 15, G = lane >> 4, w = F.wave, vcol = h * 128 + w * 16 + t16;
    __syncthreads();
    f32x4 S[8];
#pragma unroll
    for (int i = 0; i < 8; ++i)
#pragma unroll
        for (int r = 0; r < 4; ++r) S[i][r] = (MODE == 2) ? s_in[(size_t)(16 * i + 4 * G + r) * 128 + w * 16 + t16] : 0.f;
    if (MODE == 2) {
        for (int j = 0; j < nfold; ++j) {
#pragma unroll
            for (int i = 0; i < 8; ++i) { const f32x4 dj = *(const GAS f32x4*)(fold_d + (size_t)j * 128 + 16 * i + 4 * G);
#pragma unroll
                for (int r = 0; r < 4; ++r) S[i][r] = S[i][r] * dj[r] + fold_s[((size_t)j * 128 + 16 * i + 4 * G + r) * 128 + w * 16 + t16]; }
        }
    }
    f32x4 Dacc[8];
#pragma unroll
    for (int i = 0; i < 8; ++i) Dacc[i] = (f32x4){1.f, 1.f, 1.f, 1.f};
#pragma unroll
    for (int i = 0; i < 8; ++i) asm volatile("" : "+v"(S[i]));
    __builtin_amdgcn_s_waitcnt(0);
    const GAS unsigned char* srcA = (const GAS unsigned char*)((w < 4 ? F.hq(dir) : F.hkm(dir)) + h * 128);
    const GAS unsigned char* srcB = (const GAS unsigned char*)((w < 4 ? F.hkp(dir) : F.hvt(dir)) + (size_t)h * 128 * 16);
    const GAS unsigned char* srcC = (const GAS unsigned char*)(F.hdec(dir) + h * 128) + (lane & 31) * 16;
    const int rA = 4 * (w & 3) + (lane >> 4);
    const unsigned offA = (unsigned)((dir ? 15 - rA : rA) * 1024 + (((lane & 15) ^ rA) * 16));
    const int dB = 32 * (w & 3) + (lane >> 1);
    const unsigned offB = (unsigned)(dB * 32 + (((lane & 1) ^ ((dB >> 3) & 1)) * 16));
    const int dstA = (w < 4 ? 0 : 4096) + (w & 3) * 1024, dstB = (w < 4 ? 8192 : 12288) + (w & 3) * 1024;
#define HG_ISSUE(cj) do { const int ce_ = cc0 + ((cj) < ncc ? (cj) : ncc - 1); const int ch_ = dir ? nchunks - 1 - ce_ : ce_; const size_t gc_ = (size_t)(rb / 16 + ch_); \
        LAS unsigned char* sl_ = F.lds + ((cj) % HG_NS) * HG_SLOT; \
        if (MODE != 1) __builtin_amdgcn_global_load_lds((const GAS unsigned*)(srcA + (size_t)(rb + ch_ * 16) * 1024 + offA), (LAS unsigned*)(sl_ + dstA), 16, 0, 0); \
        __builtin_amdgcn_global_load_lds((const GAS unsigned*)(srcB + gc_ * 16384 + offB), (LAS unsigned*)(sl_ + dstB), 16, 0, 0); \
        if (w == 0) __builtin_amdgcn_global_load_lds((const GAS unsigned*)(srcC + gc_ * 2048), (LAS unsigned*)(sl_ + 16384), 16, 0, 0); } while (0)
    const int qoff = t16 * 256 + 8 * (G & 1);
    const int g1 = G >> 1;
    const int kpoff = 8192 + t16 * 32 + ((g1 ^ ((t16 >> 3) & 1)) * 16) + 8 * (G & 1);
    const int vtoff = 12288 + (w * 16 + t16) * 32 + ((g1 ^ ((t16 >> 3) & 1)) * 16) + 8 * (G & 1);
    const int dcoff = 16384 + 16 * G;
    const v2u z2 = {0u, 0u};
#pragma unroll
    for (int j = 0; j < HG_NS - 1; ++j) HG_ISSUE(j);
    for (int cc = 0; cc < ncc; ++cc) {
        if (MODE == 1) { if (w == 0) HG_VMWAIT(10); else HG_VMWAIT(5); }
        else if (cc < HG_NS - 1) { if (w == 0) HG_VMWAIT(15); else HG_VMWAIT(10); }
        else                     { if (w == 0) HG_VMWAIT(39); else HG_VMWAIT(34); }
        asm volatile("s_waitcnt lgkmcnt(0)" ::: "memory"); __builtin_amdgcn_s_barrier(); asm volatile("" ::: "memory");
        HG_ISSUE(cc + HG_NS - 1);
        const LAS unsigned char* sl = F.lds + (cc % HG_NS) * HG_SLOT;
        v2u q[8], k[8], kp[8]; f32x4 dec[8];
        if (MODE != 1) {
#pragma unroll
            for (int i = 0; i < 8; ++i) { const int po = (((2 * i + g1) ^ t16) * 16); q[i] = *(const LAS v2u*)(sl + qoff + po); k[i] = *(const LAS v2u*)(sl + 4096 + qoff + po); }
        }
        const v2u vt = *(const LAS v2u*)(sl + vtoff);
#pragma unroll
        for (int i = 0; i < 8; ++i) { kp[i] = *(const LAS v2u*)(sl + kpoff + i * 512); dec[i] = *(const LAS f32x4*)(sl + dcoff + i * 64); }
        __builtin_amdgcn_sched_barrier(0);
        const bf16x8 vb = frag2(vt, z2);
        if (MODE != 1) {
            f32x4 pt = {0.f, 0.f, 0.f, 0.f};
#pragma unroll
            for (int kk = 0; kk < 4; ++kk) pt = MFMA16(frag2(k[2 * kk], k[2 * kk + 1]), frag2(q[2 * kk], q[2 * kk + 1]), pt);
#pragma unroll
            for (int r = 0; r < 4; ++r) if (4 * G + r > t16) pt[r] = 0.f;
            const v2u pb = {cvt2(pt[0], pt[1]), cvt2(pt[2], pt[3])};
            f32x4 o = {0.f, 0.f, 0.f, 0.f};
            o = MFMA16(frag2(pb, z2), vb, o);
#pragma unroll
            for (int kk = 0; kk < 4; ++kk) { const v2u s0 = {cvt2(S[2 * kk][0], S[2 * kk][1]), cvt2(S[2 * kk][2], S[2 * kk][3])}, s1 = {cvt2(S[2 * kk + 1][0], S[2 * kk + 1][1]), cvt2(S[2 * kk + 1][2], S[2 * kk + 1][3])};
                o = MFMA16(frag2(q[2 * kk], q[2 * kk + 1]), frag2(s0, s1), o); }
            const int ce = cc0 + cc, ch = dir ? nchunks - 1 - ce : ce, crow = rb + ch * 16;
#pragma unroll
            for (int r = 0; r < 4; ++r) { const int pr_ = 4 * G + r; ob[(size_t)(crow + (dir ? 15 - pr_ : pr_)) * 512 + vcol] = o[r]; }
        }
#pragma unroll
        for (int i = 0; i < 8; ++i) { S[i] = S[i] * dec[i]; S[i] = MFMA16(frag2(kp[i], z2), vb, S[i]); if (MODE == 1) Dacc[i] = Dacc[i] * dec[i]; }
    }
#undef HG_ISSUE
    HG_VMWAIT(0);
    __syncthreads();
    if (MODE != 2) {
#pragma unroll
        for (int i = 0; i < 8; ++i)
#pragma unroll
            for (int r = 0; r < 4; ++r) s_out[(size_t)(16 * i + 4 * G + r) * 128 + w * 16 + t16] = S[i][r];
    }
    if (MODE == 1 && w == 0 && t16 == 0) {
#pragma unroll
        for (int i = 0; i < 8; ++i) *(GAS f32x4*)(d_out + 16 * i + 4 * G) = Dacc[i];
    }
}

__device__ __forceinline__ void hp_states(const Ctx& F, int l) {
    for (int i = F.bid; i < 256; i += F.G) {
        const int sq = i >> 4, seg = i & 15, b = sq >> 3, h = (sq >> 1) & 3, dir = sq & 1;
        if (seg == 15) continue;
        hgrn_mfma<1>(F, R_CTX + b * S_LAT, S_LAT / 16, seg * 16, 16, h, dir, nullptr, F.sloc() + ((size_t)sq * 16 + seg) * 16384, nullptr, nullptr, nullptr, 0, F.dseg() + ((size_t)sq * 16 + seg) * 128);
    }
}

#ifndef PROBE_MX_DUP
#define PROBE_MX_DUP 0
#endif
#define MXREP(cls) for (int rep_ = 0; rep_ < 1 + ((PROBE_MX_DUP >> (cls)) & 1); ++rep_)
__device__ __forceinline__ void mx_mixers(const Ctx& F, int l) {
    float lam = F.lamv()[l * 2], lam_init = F.lamv()[l * 2 + 1];
    asm volatile("" : "+v"(lam), "+v"(lam_init));
    const gbf16* qkv = F.qkv();
    constexpr int T_LH = 256, T_LD = 256, T_LB = 256, T_CD = 128, T_CS = 128, T_CH = 128;
    constexpr int NT = T_LH + T_LD + T_LB + T_CD + T_CS + T_CH;
    const AttnSeg none = {nullptr, nullptr, 0, 0};
    const int w = F.wave;
    const int perm = (F.G == 256) ? ((F.bid & 7) * 32 + (F.bid >> 3)) - F.bid : 0;
    for (int task = F.bid; task < NT; task += F.G) {
        int i = task;
        if (i >= T_LH && i < T_LH + T_LD + T_LB) i += perm;
        if (i < T_LH) {
            const int sq = i >> 4, seg = i & 15, b = sq >> 3, h = (sq >> 1) & 3, dir = sq & 1;
            const gf32* sin_ = F.inp(I_ST) + ((((size_t)b * 4 + l) * 2 + dir) * 4 + h) * 128 * 128;
            MXREP(0) hgrn_mfma<2>(F, R_CTX + b * S_LAT, S_LAT / 16, seg * 16, 16, h, dir, sin_, nullptr, dir ? F.obb() : F.obf(), F.sloc() + (size_t)sq * 16 * 16384, F.dseg() + (size_t)sq * 16 * 128, seg, nullptr);
            continue; } i -= T_LH;
        if (i < T_LD) {
            const int b = i >> 7, h = (i >> 5) & 3, qt = i & 31, map = w >> 2; const int rb = R_CTX + b * S_LAT, wrow = rb + qt * 128 + 32 * (w & 3);
            const AttnSeg s0 = {qkv + (size_t)rb * QKV_LD + Q_KD + h * 128, qkv + (size_t)rb * QKV_LD + Q_VD + h * 128, QKV_LD, S_LAT / 64};
            const size_t co = (((size_t)b * 4 + l) * 4 + h) * 256 * 128;
            const AttnSeg s1 = {F.c16(0) + co, F.c16(2 * MiB) + co, 128, 4};
            MXREP(1) attn_mfma<64, true>(F, qkv + (size_t)wrow * QKV_LD + Q_QD + h * 128 + map * 64, map * 64, s0, s1, false, 0, 0, -1e30f, 0.f, lam, 1.0f - lam_init, F.inp(I_DNG) + l * 128, F.cat() + (size_t)wrow * DM + h * 128);
            continue; } i -= T_LD;
        if (i < T_LB) {
            const int b = i >> 7, kv = (i >> 6) & 1, qt = i & 63, hh = kv * 4 + (w >> 1); const int rb = R_CTX + b * S_LAT, t0 = qt * 64, wrow = rb + t0 + 32 * (w & 1);
            const int ks = t0 - 128 < 0 ? 0 : t0 - 128, ke = t0 + 192 > S_LAT ? S_LAT : t0 + 192;
            const AttnSeg s0 = {qkv + (size_t)(rb + ks) * QKV_LD + Q_KS + kv * 128, qkv + (size_t)(rb + ks) * QKV_LD + Q_VS + kv * 128, QKV_LD, (ke - ks) / 64};
            const size_t co = (((size_t)b * 4 + l) * 2 + kv) * 256 * 128;
            const AttnSeg s1 = {F.c16(4 * MiB) + co, F.c16(5 * MiB) + co, 128, 4};
            MXREP(2) attn_mfma<128, false>(F, qkv + (size_t)wrow * QKV_LD + Q_QS + hh * 128, 0, s0, s1, true, t0 + 32 * (w & 1), ks, F.inp(I_SINK)[l * 8 + hh] * LOG2E, 1.0f, 0.f, 1.0f, nullptr, F.cat() + (size_t)wrow * DM + 1024 + hh * 128);
            continue; } i -= T_LB;
        if (i < T_CD) {
            const int b = i >> 3, h = (i >> 1) & 3, qt = i & 1, map = w >> 2, rb = b * 256, wrow = rb + qt * 128 + 32 * (w & 3);
            const AttnSeg s0 = {qkv + (size_t)rb * QKV_LD + Q_KD + h * 128, qkv + (size_t)rb * QKV_LD + Q_VD + h * 128, QKV_LD, 4};
            MXREP(3) attn_mfma<64, true>(F, qkv + (size_t)wrow * QKV_LD + Q_QD + h * 128 + map * 64, map * 64, s0, none, false, 0, 0, -1e30f, 0.f, lam, 1.0f - lam_init, F.inp(I_DNG) + l * 128, F.cat() + (size_t)wrow * DM + h * 128);
            continue; } i -= T_CD;
        if (i < T_CS) {
            const int b = i >> 3, kv = (i >> 2) & 1, qt = i & 3, hh = kv * 4 + (w >> 1), rb = b * 256, wrow = rb + qt * 64 + 32 * (w & 1);
            const AttnSeg s0 = {qkv + (size_t)rb * QKV_LD + Q_KS + kv * 128, qkv + (size_t)rb * QKV_LD + Q_VS + kv * 128, QKV_LD, 4};
            MXREP(4) attn_mfma<128, false>(F, qkv + (size_t)wrow * QKV_LD + Q_QS + hh * 128, 0, s0, none, false, 0, 0, F.inp(I_SINK)[l * 8 + hh] * LOG2E, 1.0f, 0.f, 1.0f, nullptr, F.cat() + (size_t)wrow * DM + 1024 + hh * 128);
            continue; } i -= T_CS;
        {
            const int b = i >> 3, h = (i >> 1) & 3, dir = i & 1;
            gf32* sout = F.out + O_ST + ((((size_t)b * 4 + l) * 2 + dir) * 4 + h) * 128 * 128;
            MXREP(5) hgrn_mfma<0>(F, b * 256, 16, 0, 16, h, dir, nullptr, sout, dir ? F.obb() : F.obf(), nullptr, nullptr, 0, nullptr);
        }
    }
}

__device__ __forceinline__ void mg_merge(const Ctx& F, int l) {
    const int head = F.lane >> 4, sub = F.lane & 15, col0 = head * 128 + sub * 8;
    for (int row = F.bid * 8 + F.wave; row < MROWS; row += F.G * 8) {
        const f32x4 a0 = *(const GAS f32x4*)(F.obf() + (size_t)row * 512 + col0) + *(const GAS f32x4*)(F.obb() + (size_t)row * 512 + col0);
        const f32x4 a1 = *(const GAS f32x4*)(F.obf() + (size_t)row * 512 + col0 + 4) + *(const GAS f32x4*)(F.obb() + (size_t)row * 512 + col0 + 4);
        float ss = (a0[0] * a0[0] + a0[1] * a0[1]) + (a0[2] * a0[2] + a0[3] * a0[3]) + (a1[0] * a1[0] + a1[1] * a1[1]) + (a1[2] * a1[2] + a1[3] * a1[3]);
        ss += __shfl_xor(ss, 1); ss += __shfl_xor(ss, 2); ss += __shfl_xor(ss, 4); ss += __shfl_xor(ss, 8);
        const float rinv = 1.0f / sqrtf(ss * (1.0f / 128.0f) + 1e-6f);
        const gf32* g = F.inp(I_HNG) + l * 128 + sub * 8; const gf32* hg = F.hproj() + (size_t)row * HP_LD + 2048 + col0;
        const f32x4 g0 = *(const GAS f32x4*)g, g1 = *(const GAS f32x4*)(g + 4), h0 = *(const GAS f32x4*)hg, h1 = *(const GAS f32x4*)(hg + 4);
        float y[8];
#pragma unroll
        for (int i = 0; i < 4; ++i) { y[i] = a0[i] * rinv * g0[i] * silu_f(h0[i]); y[4 + i] = a1[i] * rinv * g1[i] * silu_f(h1[i]); }
        v4u w; w.x = pk2(y[0], y[1]); w.y = pk2(y[2], y[3]); w.z = pk2(y[4], y[5]); w.w = pk2(y[6], y[7]);
        *(GAS v4u*)(F.cat() + (size_t)row * DM + 512 + col0) = w;
    }
}

__device__ __forceinline__ void ln_phase(const Ctx& F, gy_t* Y, const gy_t* Y2, const gf32* g, const gf32* b, gf32* fout, const gf32* modsl  , int which_sh) {
    constexpr int SPLIT_ROW0 = 8192;
    for (int row = F.bid * 8 + F.wave; row < MROWS; row += F.G * 8) {
        f32x4 v[8]; float s = 0.f;
#if Y_BF16
        const gy_t* yp = Y + (size_t)row * DM + F.lane * 8;
#pragma unroll
        for (int jj = 0; jj < 4; ++jj) { const v4u w = *(const GAS v4u*)(yp + 512 * jj); v[2 * jj] = bf2lo(w.x, w.y); v[2 * jj + 1] = bf2lo(w.z, w.w); }
        if (row >= SPLIT_ROW0) {
#pragma unroll
            for (int jj = 0; jj < 4; ++jj) { const v4u w = *(const GAS v4u*)(Y2 + (size_t)(row - SPLIT_ROW0) * DM + F.lane * 8 + 512 * jj); v[2 * jj] += bf2lo(w.x, w.y); v[2 * jj + 1] += bf2lo(w.z, w.w);
                v4u o; o.x = pk2(v[2 * jj][0], v[2 * jj][1]); o.y = pk2(v[2 * jj][2], v[2 * jj][3]); o.z = pk2(v[2 * jj + 1][0], v[2 * jj + 1][1]); o.w = pk2(v[2 * jj + 1][2], v[2 * jj + 1][3]);
                *(GAS v4u*)(Y + (size_t)row * DM + F.lane * 8 + 512 * jj) = o; v[2 * jj] = bf2lo(o.x, o.y); v[2 * jj + 1] = bf2lo(o.z, o.w); }
        }
#else
        const gy_t* yp = Y + (size_t)row * DM + F.lane * 8;
#pragma unroll
        for (int jj = 0; jj < 4; ++jj) { v[2 * jj] = *(const GAS f32x4*)(yp + 512 * jj); v[2 * jj + 1] = *(const GAS f32x4*)(yp + 512 * jj + 4); }
        if (row >= SPLIT_ROW0) {
#pragma unroll
            for (int jj = 0; jj < 4; ++jj) { const gy_t* y2 = Y2 + (size_t)(row - SPLIT_ROW0) * DM + F.lane * 8 + 512 * jj; v[2 * jj] += *(const GAS f32x4*)y2; v[2 * jj + 1] += *(const GAS f32x4*)(y2 + 4);
                *(GAS f32x4*)(Y + (size_t)row * DM + F.lane * 8 + 512 * jj) = v[2 * jj]; *(GAS f32x4*)(Y + (size_t)row * DM + F.lane * 8 + 512 * jj + 4) = v[2 * jj + 1]; }
        }
#endif
#pragma unroll
        for (int j = 0; j < 8; ++j) s += (v[j][0] + v[j][1]) + (v[j][2] + v[j][3]);
#pragma unroll
        for (int o = 1; o < 64; o <<= 1) s += __shfl_xor(s, o);
        const float mean = s * (1.0f / DM); float s2 = 0.f;
#pragma unroll
        for (int j = 0; j < 8; ++j) { v[j] = v[j] - mean; s2 += (v[j][0] * v[j][0] + v[j][1] * v[j][1]) + (v[j][2] * v[j][2] + v[j][3] * v[j][3]); }
#pragma unroll
        for (int o = 1; o < 64; o <<= 1) s2 += __shfl_xor(s2, o);
        const float rstd = 1.0f / sqrtf(s2 * (1.0f / DM) + 1e-5f);
        if (F.lane == 0) *(GAS pg8::f32x2*)(F.stats() + 2 * (size_t)row) = (pg8::f32x2){mean, rstd};
        const int mod = mod_of_row(row);
        const gf32* sh = modsl ? modsl + ((size_t)mod * 6 + which_sh) * DM : nullptr;
#pragma unroll
        for (int jj = 0; jj < 4; ++jj) { const int c = F.lane * 8 + 512 * jj;
            const f32x4 x0 = v[2 * jj] * rstd * *(const GAS f32x4*)(g + c) + *(const GAS f32x4*)(b + c), x1 = v[2 * jj + 1] * rstd * *(const GAS f32x4*)(g + c + 4) + *(const GAS f32x4*)(b + c + 4);
            if (fout) { *(GAS f32x4*)(fout + (size_t)row * DM + c) = x0; *(GAS f32x4*)(fout + (size_t)row * DM + c + 4) = x1; }
            if (modsl) { const f32x4 h0 = x0 * (*(const GAS f32x4*)(sh + DM + c) + 1.0f) + *(const GAS f32x4*)(sh + c), h1 = x1 * (*(const GAS f32x4*)(sh + DM + c + 4) + 1.0f) + *(const GAS f32x4*)(sh + c + 4);
                v4u w; w.x = pk2(h0[0], h0[1]); w.y = pk2(h0[2], h0[3]); w.z = pk2(h1[0], h1[1]); w.w = pk2(h1[2], h1[3]); *(GAS v4u*)(F.hbuf() + (size_t)row * DM + c) = w; } }
    }
}

constexpr int PH_PER_LAYER = 10, N_PHASES = 2 + DEPTH * PH_PER_LAYER;
__global__ void __launch_bounds__(512, 2) fwd_kernel(Args args) {
    extern __shared__ __attribute__((aligned(16))) unsigned char lds_raw[];
    Ctx F;
    F.lds = (LAS unsigned char*)lds_raw;
    F.tid = threadIdx.x; F.lane = F.tid & 63; F.wave = __builtin_amdgcn_readfirstlane(F.tid >> 6); F.G = gridDim.x; F.bid = blockIdx.x;
    F.ap = &args; F.out = (gf32*)args.out; F.ws = (GAS unsigned char*)args.ws;
    volatile LAS unsigned* MISC = (volatile LAS unsigned*)(F.lds + MISC_OFF);
    for (int u = F.tid; u < (LDS_BYTES - LDSCTL_OFF) / 4; u += 512) ((LAS unsigned*)(F.lds + LDSCTL_OFF))[u] = 0u;
    __syncthreads();
    XcdBarrier bar; bar.bar = (unsigned*)(args.ws + WS_CTL) + CW_BAR; bar.x = 0; bar.st = nullptr;
    if (args.single) bar = xcd_barrier_post((unsigned*)(args.ws + WS_CTL) + CW_BAR, MISC + 8);
    const int lo = args.ph_lo, hi = args.ph_hi;
#define IN(k) (lo <= (k) && (k) < hi)
#define FRESH() do { int ln_ = (int)__builtin_amdgcn_mbcnt_hi(~0u, __builtin_amdgcn_mbcnt_lo(~0u, 0u)); asm volatile("" : "+v"(ln_)); F.lane = ln_; asm volatile("" : "+s"(F.wave)); F.tid = F.wave * 64 + F.lane; \
    asm volatile("" : "+s"(F.bid), "+s"(F.G)); asm volatile("" : "+s"(F.ws), "+s"(F.out)); } while (0)
#define SEAM(k) do { if (IN((k) + 1)) xcd_barrier(bar); } while (0)

    if (IN(0)) { FRESH(); p0_prologue(F); SEAM(0); }
    if (IN(1)) { FRESH(); p1_h0(F); SEAM(1); }
    for (int l = 0; l < DEPTH; ++l) {
        const int k0 = 2 + l * PH_PER_LAYER;
        FRESH();
        gy_t* ya = (gy_t*)F.ybuf(0); gy_t* yb = (gy_t*)F.ybuf(1); gy_t* y2 = (gy_t*)F.ybuf(2);
        if (IN(k0 + 0)) {
            pg8::Gemm g{(const pg8::bf16_t*)F.hbuf(), (const pg8::bf16_t*)F.wT(l, WO_IN), MROWS, DIN, DM, DM}; pg8::StaticOrder S; S.init(MROWS, DIN, F.G, F.bid);
            EpiProj E{F.qkv(), F.hproj(), F.out, F.tabD(), F.tabS(), l};
            pg8::gemm_phase<EpiProj, pg8::StaticOrder, true, true>(F.lds, g, S, E, F.wave);
            SEAM(k0 + 0); }
        if (IN(k0 + 1)) { FRESH(); e1_postproj(F, l); SEAM(k0 + 1); }
        if (IN(k0 + 2)) { FRESH(); hp_states(F, l); SEAM(k0 + 2); }
        if (IN(k0 + 3)) { FRESH(); mx_mixers(F, l); SEAM(k0 + 3); }
        if (IN(k0 + 4)) { FRESH(); mg_merge(F, l); SEAM(k0 + 4); }
        if (IN(k0 + 5)) {
            EpiResid E{F.inp(I_XP), F.inp(I_XS), yb, F.stats(), F.inp(I_LN2G) + (l ? l - 1 : 0) * DM, F.inp(I_LN2B) + (l ? l - 1 : 0) * DM, F.mods() + ((size_t)l * 3 * 6 + 2) * DM, ya, 0, 0, l ? 1 : 0};
            { pg8::Gemm g{(const pg8::bf16_t*)F.cat(), (const pg8::bf16_t*)F.wT(l, WO_OUT), 8192, DM, DM, DM}; pg8::StaticOrder S; S.init(8192, DM, F.G, F.bid);
              pg8::gemm_phase<EpiResid, pg8::StaticOrder, true, true>(F.lds, g, S, E, F.wave); }
            __syncthreads();
            { const int kh = F.bid >> 7; pg8::Gemm g{(const pg8::bf16_t*)(F.cat() + (size_t)8192 * DM + kh * (DM / 2)), (const pg8::bf16_t*)(F.wT(l, WO_OUT) + kh * (DM / 2)), 4096, DM, DM / 2, DM}; pg8::StaticOrder S; S.init(4096, DM, 128, F.bid & 127);
              E.out = kh ? y2 : ya; E.pm_off = 32; E.gate_only = kh;
              pg8::gemm_phase<EpiResid, pg8::StaticOrder, true, true>(F.lds, g, S, E, F.wave); }
            SEAM(k0 + 5); }
        if (IN(k0 + 6)) { FRESH(); ln_phase(F, ya, y2, F.inp(I_LN1G) + l * DM, F.inp(I_LN1B) + l * DM, nullptr, F.mods() + (size_t)l * 3 * 6 * DM, 3); SEAM(k0 + 6); }
        if (IN(k0 + 7)) {
            pg8::Gemm g{(const pg8::bf16_t*)F.hbuf(), (const pg8::bf16_t*)F.wT(l, WO_GU), MROWS, DGU, DM, DM}; pg8::StaticOrder S; S.init(MROWS, DGU, F.G, F.bid);
            EpiSwiGLU E{F.act()};
            pg8::gemm_phase<EpiSwiGLU, pg8::StaticOrder, true, true>(F.lds, g, S, E, F.wave);
            SEAM(k0 + 7); }
        if (IN(k0 + 8)) {
            EpiResid E{nullptr, nullptr, ya, F.stats(), F.inp(I_LN1G) + l * DM, F.inp(I_LN1B) + l * DM, F.mods() + ((size_t)l * 3 * 6 + 5) * DM, yb, 0, 0, 1};
            { pg8::Gemm g{(const pg8::bf16_t*)F.act(), (const pg8::bf16_t*)F.wT(l, WO_DN), 8192, DM, DFF, DFF}; pg8::StaticOrder S; S.init(8192, DM, F.G, F.bid);
              pg8::gemm_phase<EpiResid, pg8::StaticOrder, true, true>(F.lds, g, S, E, F.wave); }
            __syncthreads();
            { const int kh = F.bid >> 7; pg8::Gemm g{(const pg8::bf16_t*)(F.act() + (size_t)8192 * DFF + kh * (DFF / 2)), (const pg8::bf16_t*)(F.wT(l, WO_DN) + kh * (DFF / 2)), 4096, DM, DFF / 2, DFF}; pg8::StaticOrder S; S.init(4096, DM, 128, F.bid & 127);
              E.out = kh ? y2 : yb; E.pm_off = 32; E.gate_only = kh;
              pg8::gemm_phase<EpiResid, pg8::StaticOrder, true, true>(F.lds, g, S, E, F.wave); }
            SEAM(k0 + 8); }
        if (IN(k0 + 9)) { FRESH(); ln_phase(F, yb, y2, F.inp(I_LN2G) + l * DM, F.inp(I_LN2B) + l * DM, l + 1 < DEPTH ? nullptr : F.out + O_YP, l + 1 < DEPTH ? F.mods() + (size_t)(l + 1) * 3 * 6 * DM : nullptr, 0); SEAM(k0 + 9); }
    }
#undef IN
#undef SEAM
#undef FRESH
}

#ifndef MK_SINGLE
#define MK_SINGLE 1
#endif
extern "C" void kernel_launch(void* const* d_in, const int* in_sizes, int n_in, void* d_out, int out_size, void* d_ws, size_t ws_size, hipStream_t stream) {
    static int grid = 0;
    if (grid == 0) {
        if (n_in != 24 || out_size != (int)O_END || ws_size < WS_END) { fprintf(stderr, "kernel_launch: unexpected sizes n_in %d out %d ws %zu\n", n_in, out_size, ws_size); grid = -1; return; }
        int dev = 0, cus = 0, per_cu = 0;
        if (hipGetDevice(&dev) != hipSuccess || hipDeviceGetAttribute(&cus, hipDeviceAttributeMultiprocessorCount, dev) != hipSuccess) { grid = -1; return; }
        if (hipFuncSetAttribute((const void*)fwd_kernel, hipFuncAttributeMaxDynamicSharedMemorySize, LDS_BYTES) != hipSuccess) { fprintf(stderr, "kernel_launch: hipFuncSetAttribute failed\n"); grid = -1; return; }
        if (hipOccupancyMaxActiveBlocksPerMultiprocessor(&per_cu, (const void*)fwd_kernel, 512, LDS_BYTES) != hipSuccess || per_cu < 1) fprintf(stderr, "kernel_launch: occupancy query says %d\n", per_cu);
        (void)hipGetLastError();
        grid = cus;
    }
    if (grid < 0) return;
    (void)hipMemsetAsync((char*)d_ws + WS_CTL, 0, CTL_ZERO_BYTES, stream);
    Args a{};
    for (int i = 0; i < 24; ++i) a.in[i] = (const float*)d_in[i];
    a.out = (float*)d_out; a.ws = (unsigned char*)d_ws; a.pad = 0;
#if MK_SINGLE
    a.ph_lo = 0; a.ph_hi = N_PHASES; a.single = 1;
    hipLaunchKernelGGL(fwd_kernel, dim3(grid), dim3(512), LDS_BYTES, stream, a);
#else
    a.single = 0;
    for (int p = 0; p < N_PHASES; ++p) { a.ph_lo = p; a.ph_hi = p + 1; hipLaunchKernelGGL(fwd_kernel, dim3(grid), dim3(512), LDS_BYTES, stream, a);
#ifdef PROBE_REP_MASK
        const int ty = p == 0 ? 10 : (p == 1 ? 11 : (p - 2) % PH_PER_LAYER);
        if ((PROBE_REP_MASK >> ty) & 1) for (int r = 0; r < PROBE_REP_N; ++r) hipLaunchKernelGGL(fwd_kernel, dim3(grid), dim3(512), LDS_BYTES, stream, a);
#endif
    }
#endif
}
```

```cpp
#include <hip/hip_runtime.h>
#include <cstdio>
#include <cstdint>
namespace pg8 {
#define PG8_LAS __attribute__((address_space(3)))
typedef unsigned short bf16_t;
typedef short bf16x8 __attribute__((ext_vector_type(8)));
typedef float f32x4 __attribute__((ext_vector_type(4)));
typedef unsigned u32x4 __attribute__((ext_vector_type(4)));
constexpr int BM = 256, BK = 64, HALF = 128, HTB = HALF * BK * 2  , STAGE_BYTES = 8 * HTB, NXCD = 8, WGM = 8;

__host__ __device__ __forceinline__ int lds_byte(int r, int c) { const int st = (r >> 4) * 2 + (c >> 5), rr = r & 15, cc = c & 31, ob = rr * 64 + cc * 2; return st * 1024 + (ob ^ (((ob >> 9) & 1) << 5)); }
__host__ __device__ __forceinline__ void stage_rc(int b, int& R, int& C) { const int st = b / 1024, sb = b % 1024, swz = sb ^ (((sb >> 9) & 1) << 5); R = (st >> 1) * 16 + swz / 64; C = (st & 1) * 32 + (swz % 64) / 2; }
__host__ __device__ __forceinline__ int perm32(int rho) { const int n = rho >> 4, i = rho & 15; return 8 * (i >> 2) + 4 * n + (i & 3); }

struct Unit { int pm, pn; };
struct Gemm { const bf16_t* A; const bf16_t* Bt; int M, N, K, ld; };

struct StaticOrder {
    int nM, nN, nwg, G, c;
    __host__ __device__ void init(int M, int N, int G_, int c_) { nM = M / BM; nN = N / BM; nwg = nM * nN; G = G_; c = c_; }
    __host__ __device__ bool next(int i, Unit& u) const {
        const long L = (long)i * G + c; if (L >= nwg) return false;
        int wgid = (int)L; { const int q = nwg / NXCD, r = nwg % NXCD, xcd = wgid % NXCD, off = wgid / NXCD; wgid = (xcd < r ? xcd * (q + 1) : r * (q + 1) + (xcd - r) * q) + off; }
        const int nig = WGM * nN, gid = wgid / nig, fm = gid * WGM, gsz = (nM - fm) < WGM ? (nM - fm) : WGM;
        u.pm = fm + ((wgid % nig) % gsz); u.pn = (wgid % nig) / gsz; return true;
    }
    __device__ __forceinline__ void a_ready(const Unit&) const {}
    __device__ __forceinline__ void done(const Unit&) const {}
};
__device__ __forceinline__ unsigned cvt_pk_bf16(float lo, float hi) { unsigned r; asm volatile("v_cvt_pk_bf16_f32 %0, %1, %2" : "=v"(r) : "v"(lo), "v"(hi)); return r; }
typedef float f32x2 __attribute__((ext_vector_type(2)));
template <class Epi, class Sched, bool ALIGN_EPI = false, bool SP2 = false>
__device__ __forceinline__ void gemm_phase(PG8_LAS unsigned char* lds, const Gemm g, const Sched& S, const Epi& E, int wid_in) {
    int lane_ = (int)__builtin_amdgcn_mbcnt_hi(~0u, __builtin_amdgcn_mbcnt_lo(~0u, 0u)); asm volatile("" : "+v"(lane_)); asm volatile("" : "+s"(wid_in));
    const int wid = wid_in, lane = lane_, tid = wid * 64 + lane, wr = wid >> 2, wc = wid & 3, fr = lane & 15, fq = lane >> 4;
    const int K = g.K, nt = K / BK, LD = g.ld;
    unsigned voffA[2], voffB[2];
#pragma unroll
    for (int i = 0; i < 2; ++i) { int R, C; stage_rc(tid * 16 + i * 8192, R, C); const int Rb = Epi::PERM ? ((R & ~31) + perm32(R & 31)) : R;
        voffA[i] = (unsigned)(R * LD + C) * 2u; voffB[i] = (unsigned)(Rb * LD + C) * 2u; }
    const size_t kstep = (size_t)(BK * 2);
    const size_t hstep = (size_t)HALF * LD * 2;
    const size_t tstep = 2 * hstep;
    const unsigned ldsw = (unsigned)wid * 1024u;
    const int aoff = lds_byte(wr * 64 + fr, fq * 8), boff = lds_byte(wc * 32 + fr, fq * 8);
#define PG8_SA(b, h) (((b) * 2 + (h)) * HTB)
#define PG8_SB(b, h) ((4 + (b) * 2 + (h)) * HTB)
#define PG8_STAGE(bufoff, gbase, voff) do { _Pragma("unroll") for (int _i = 0; _i < 2; ++_i) \
        __builtin_amdgcn_global_load_lds((const unsigned*)((const char*)(gbase) + (voff)[_i]), (PG8_LAS unsigned*)(lds + (bufoff) + ldsw + _i * 8192), 16, 0, 0); } while (0)
#define PG8_LDA(dst, b, h) do { _Pragma("unroll") for (int m = 0; m < 4; ++m) _Pragma("unroll") for (int k = 0; k < 2; ++k) dst[m][k] = *(const PG8_LAS bf16x8*)(lds + PG8_SA(b, h) + aoff + m * 2048 + k * 1024); } while (0)
#define PG8_LDB(dst, b, h) do { _Pragma("unroll") for (int n = 0; n < 2; ++n) _Pragma("unroll") for (int k = 0; k < 2; ++k) dst[n][k] = *(const PG8_LAS bf16x8*)(lds + PG8_SB(b, h) + boff + n * 2048 + k * 1024); } while (0)
#define PG8_MMA(ai, bj, At, Bt) do { __builtin_amdgcn_s_setprio(1); _Pragma("unroll") for (int m = 0; m < 4; ++m) _Pragma("unroll") for (int n = 0; n < 2; ++n) _Pragma("unroll") for (int k = 0; k < 2; ++k) \
        acc[ai][bj][m][n] = __builtin_amdgcn_mfma_f32_16x16x32_bf16(Bt[n][k], At[m][k], acc[ai][bj][m][n], 0, 0, 0); __builtin_amdgcn_s_setprio(0); } while (0)
#define PG8_WAIT_V(n) asm volatile("s_waitcnt vmcnt(" #n ")" ::: "memory")
#define PG8_WAIT_L(n) asm volatile("s_waitcnt lgkmcnt(" #n ")" ::: "memory")
#define PG8_BAR __builtin_amdgcn_s_barrier()
#define PG8_SCHED __builtin_amdgcn_sched_barrier(0)
    Unit cur, nxt; int ui = 0;
    if (!S.next(0, cur)) return;
    f32x4 acc[2][2][4][2];
#pragma unroll
    for (int a = 0; a < 2; ++a)
#pragma unroll
        for (int b = 0; b < 2; ++b)
#pragma unroll
            for (int m = 0; m < 4; ++m)
#pragma unroll
                for (int n = 0; n < 2; ++n) acc[a][b][m][n] = (f32x4){0.f, 0.f, 0.f, 0.f};
    bf16x8 At[4][2], B0[2][2], B1[2][2];
    const char* cA = (const char*)g.A + (size_t)cur.pm * tstep; const char* cB = (const char*)g.Bt + (size_t)cur.pn * tstep;
    S.a_ready(cur);
    if constexpr (SP2) {
        PG8_STAGE(PG8_SB(0, 0), cB, voffB); PG8_STAGE(PG8_SB(0, 1), cB + hstep, voffB); PG8_STAGE(PG8_SA(0, 0), cA, voffA); PG8_STAGE(PG8_SA(0, 1), cA + hstep, voffA);
        if (wr == 1) PG8_BAR;
        PG8_WAIT_V(2); PG8_BAR;
        PG8_STAGE(PG8_SB(1, 0), cB + kstep, voffB); PG8_STAGE(PG8_SA(1, 0), cA + kstep, voffA); PG8_STAGE(PG8_SB(1, 1), cB + hstep + kstep, voffB);
        PG8_WAIT_V(6); PG8_BAR;
    } else {
        PG8_STAGE(PG8_SB(0, 0), cB, voffB); PG8_STAGE(PG8_SA(0, 0), cA, voffA); PG8_STAGE(PG8_SB(0, 1), cB + hstep, voffB); PG8_STAGE(PG8_SA(0, 1), cA + hstep, voffA);
        if (wr == 1) PG8_BAR;
        PG8_WAIT_V(4); PG8_BAR;
        PG8_STAGE(PG8_SB(1, 0), cB + kstep, voffB); PG8_STAGE(PG8_SA(1, 0), cA + kstep, voffA); PG8_STAGE(PG8_SB(1, 1), cB + hstep + kstep, voffB);
        PG8_WAIT_V(6); PG8_BAR;
    }
    for (;;) {
        const bool has_next = S.next(ui + 1, nxt);
        const char* nA = has_next ? (const char*)g.A + (size_t)nxt.pm * tstep : cA; const char* nB = has_next ? (const char*)g.Bt + (size_t)nxt.pn * tstep : cB;
        for (int t = 0; t < nt; t += 2) {
            const bool last = (t == nt - 2);
            const char* a1 = cA + (size_t)(t + 1) * kstep;
            const char* a2 = last ? nA : cA + (size_t)(t + 2) * kstep; const char* b2 = last ? nB : cB + (size_t)(t + 2) * kstep;
            const char* a3 = a2 + kstep; const char* b3 = b2 + kstep;
            if (last && has_next) S.a_ready(nxt);
            if constexpr (SP2) {
            PG8_LDB(B0, 0, 0); PG8_LDB(B1, 0, 1); PG8_SCHED; PG8_LDA(At, 0, 0); PG8_STAGE(PG8_SA(1, 1), a1 + hstep, voffA);
            PG8_WAIT_V(8); PG8_WAIT_L(0); PG8_BAR; PG8_MMA(0, 0, At, B0); PG8_MMA(0, 1, At, B1); PG8_BAR; PG8_SCHED;
            PG8_LDA(At, 0, 1); PG8_STAGE(PG8_SB(0, 0), b2, voffB); PG8_STAGE(PG8_SB(0, 1), b2 + hstep, voffB); PG8_STAGE(PG8_SA(0, 0), a2, voffA);
            PG8_WAIT_V(8); PG8_WAIT_L(0); PG8_BAR; PG8_MMA(1, 0, At, B0); PG8_MMA(1, 1, At, B1); PG8_BAR; PG8_SCHED;
            PG8_LDB(B0, 1, 0); PG8_LDB(B1, 1, 1); PG8_SCHED; PG8_LDA(At, 1, 0); PG8_STAGE(PG8_SA(0, 1), a2 + hstep, voffA);
            PG8_WAIT_V(8); PG8_WAIT_L(0); PG8_BAR; PG8_MMA(0, 0, At, B0); PG8_MMA(0, 1, At, B1); PG8_BAR; PG8_SCHED;
            PG8_LDA(At, 1, 1); PG8_STAGE(PG8_SB(1, 0), b3, voffB); PG8_STAGE(PG8_SB(1, 1), b3 + hstep, voffB); PG8_STAGE(PG8_SA(1, 0), a3, voffA);
            PG8_WAIT_V(8); PG8_WAIT_L(0); PG8_BAR; PG8_MMA(1, 0, At, B0); PG8_MMA(1, 1, At, B1); PG8_BAR; PG8_SCHED;
            } else {
            PG8_LDB(B0, 0, 0); PG8_SCHED; PG8_LDA(At, 0, 0); PG8_STAGE(PG8_SA(1, 1), a1 + hstep, voffA);
            PG8_WAIT_L(8); PG8_BAR; PG8_WAIT_L(0); PG8_MMA(0, 0, At, B0); PG8_BAR; PG8_SCHED;
            PG8_LDB(B1, 0, 1); PG8_STAGE(PG8_SB(0, 0), b2, voffB);
            PG8_BAR; PG8_WAIT_L(0); PG8_MMA(0, 1, At, B1); PG8_BAR;
            PG8_LDA(At, 0, 1); PG8_STAGE(PG8_SA(0, 0), a2, voffA);
            PG8_BAR; PG8_WAIT_L(0); PG8_MMA(1, 0, At, B0); PG8_BAR; PG8_SCHED;
            PG8_STAGE(PG8_SB(0, 1), b2 + hstep, voffB);
            PG8_WAIT_V(6); PG8_BAR; PG8_MMA(1, 1, At, B1); PG8_BAR;
            PG8_LDB(B0, 1, 0); PG8_SCHED; PG8_LDA(At, 1, 0); PG8_STAGE(PG8_SA(0, 1), a2 + hstep, voffA);
            PG8_WAIT_L(8); PG8_BAR; PG8_WAIT_L(0); PG8_MMA(0, 0, At, B0); PG8_BAR; PG8_SCHED;
            PG8_LDB(B1, 1, 1); PG8_STAGE(PG8_SB(1, 0), b3, voffB);
            PG8_BAR; PG8_WAIT_L(0); PG8_MMA(0, 1, At, B1); PG8_BAR;
            PG8_LDA(At, 1, 1); PG8_STAGE(PG8_SA(1, 0), a3, voffA);
            PG8_BAR; PG8_WAIT_L(0); PG8_MMA(1, 0, At, B0); PG8_BAR; PG8_SCHED;
            PG8_STAGE(PG8_SB(1, 1), b3 + hstep, voffB);
            PG8_WAIT_V(6); PG8_BAR; PG8_MMA(1, 1, At, B1); PG8_BAR;
            }
        }
        if constexpr (ALIGN_EPI) { if (wr == 0) PG8_BAR; }
        if constexpr (!Epi::AFTER_DRAIN) { E(acc, cur, wr, wc, fr, fq); S.done(cur); }
        if (!has_next) break;
#pragma unroll
        for (int a = 0; a < 2; ++a)
#pragma unroll
            for (int b = 0; b < 2; ++b)
#pragma unroll
                for (int m = 0; m < 4; ++m)
#pragma unroll
                    for (int n = 0; n < 2; ++n) acc[a][b][m][n] = (f32x4){0.f, 0.f, 0.f, 0.f};
        cur = nxt; cA = nA; cB = nB; ++ui;
        if constexpr (ALIGN_EPI) { if (wr == 1) PG8_BAR; }
    }
    PG8_WAIT_V(0);
    if constexpr (!ALIGN_EPI) { if (wr == 0) PG8_BAR; }
    PG8_BAR;
    if constexpr (Epi::AFTER_DRAIN) { E.fused(acc, cur, wr, wc, fr, fq, lds, wid, lane); S.done(cur); }
#undef PG8_SA
#undef PG8_SB
#undef PG8_STAGE
#undef PG8_LDA
#undef PG8_LDB
#undef PG8_MMA
#undef PG8_WAIT_V
#undef PG8_WAIT_L
#undef PG8_BAR
#undef PG8_SCHED
}
}
#define GAS __attribute__((address_space(1)))
#define LAS __attribute__((address_space(3)))
typedef unsigned short bf16;
typedef unsigned v4u __attribute__((ext_vector_type(4)));
typedef float f32x4 __attribute__((ext_vector_type(4)));
typedef short bf16x8 __attribute__((ext_vector_type(8)));
typedef GAS unsigned gu32;
typedef GAS unsigned long long gu64;
#define RLX_AGENT __ATOMIC_RELAXED, __HIP_MEMORY_SCOPE_AGENT
#define LDS_WAIT() asm volatile("s_waitcnt lgkmcnt(0)" ::: "memory")
#define VM_WAIT() asm volatile("s_waitcnt vmcnt(0)" ::: "memory")
__device__ __forceinline__ unsigned long long rt() { return __builtin_amdgcn_s_memrealtime(); }
__device__ __forceinline__ unsigned f2bf(float f) { unsigned u = __builtin_bit_cast(unsigned, f); return (u + 0x7fffu + ((u >> 16) & 1u)) >> 16; }
__device__ __forceinline__ unsigned pk2(float lo, float hi) { return f2bf(lo) | (f2bf(hi) << 16); }
#define XB_TMO      128
#define XB_XCNT(j)  (256  + 64 * (j))
#define XB_XSUB(j)  (1280 + 64 * (j))
#define XB_XGEN(j)  (2304 + 64 * (j))
#define XB_TOP      3328
#define XB_TOPGEN   3392
#define XCD_BAR_WORDS 3456
#define XB_SPIN_CAP (1u << 24)

__device__ __forceinline__ unsigned xb_ld(unsigned* p)              { return __hip_atomic_load(p, __ATOMIC_RELAXED, __HIP_MEMORY_SCOPE_AGENT); }
__device__ __forceinline__ unsigned xb_add(unsigned* p, unsigned v) { return __hip_atomic_fetch_add(p, v, __ATOMIC_RELAXED, __HIP_MEMORY_SCOPE_AGENT); }
__device__ __forceinline__ unsigned xb_xcc_id() { return (unsigned)__builtin_amdgcn_s_getreg((3 << 11) | 20) & 0xFu; }
#define XB_SPIN(cond, bar) do { unsigned _sp = 0; while (cond) { __builtin_amdgcn_s_sleep(1); \
    if ((++_sp & 255u) == 0u) { if (xb_ld(&(bar)[XB_TMO])) break; if (_sp > XB_SPIN_CAP) { atomicAdd(&(bar)[XB_TMO], 1u); break; } } } } while (0)

struct XcdBarrier {
    unsigned* bar; unsigned x;
    volatile LAS unsigned* st;
};

__device__ __forceinline__ XcdBarrier xcd_barrier_post(unsigned* bar, volatile LAS unsigned* st) {
    XcdBarrier b; b.bar = bar; b.x = xb_xcc_id(); b.st = st;
    if (threadIdx.x == 0) (void)xb_add(&bar[XB_XCNT(b.x)], 1u);
    return b;
}
__device__ __forceinline__ void xcd_barrier_complete(unsigned* bar, unsigned x, unsigned& nloc, unsigned& nx) {
    const unsigned G = gridDim.x * gridDim.y * gridDim.z;
    unsigned sum, cnt, mine, sp = 0u;
    for (;;) {
        sum = 0u; cnt = 0u; mine = 0u;
#pragma unroll
        for (unsigned j = 0; j < 16; ++j) { const unsigned c = xb_ld(&bar[XB_XCNT(j)]); sum += c; cnt += (c > 0u) ? 1u : 0u; mine = (j == x) ? c : mine; }
        if (sum == G) break;
        __builtin_amdgcn_s_sleep(1);
        if ((++sp & 255u) == 0u) { if (xb_ld(&bar[XB_TMO])) break; if (sp > XB_SPIN_CAP) { atomicAdd(&bar[XB_TMO], 1u); break; } }
    }
    nloc = mine > 0u ? mine : 1u; nx = cnt > 0u ? cnt : 1u;
}

__device__ __forceinline__ void xcd_barrier(const XcdBarrier& b) {
    asm volatile("s_waitcnt vmcnt(0)" ::: "memory");
    __syncthreads();
    if (threadIdx.x == 0) {
        unsigned* bar = b.bar;
        __builtin_amdgcn_s_waitcnt(0);
        unsigned nloc = b.st[0], nx = b.st[1];
        if (nloc == 0u) { xcd_barrier_complete(bar, b.x, nloc, nx); b.st[0] = nloc; b.st[1] = nx; }
        const unsigned old = xb_add(&bar[XB_XSUB(b.x)], 1u);
        const unsigned gen = old / nloc;
        if (old + 1u == (gen + 1u) * nloc) {
            __builtin_amdgcn_fence(__ATOMIC_RELEASE, "agent");
            asm volatile("s_waitcnt vmcnt(0)" ::: "memory");
            const unsigned og = xb_add(&bar[XB_TOP], 1u);
            const unsigned tg = og / nx;
            if (og + 1u == (tg + 1u) * nx) xb_add(&bar[XB_TOPGEN], 1u);
            else XB_SPIN(xb_ld(&bar[XB_TOPGEN]) == tg, bar);
            __builtin_amdgcn_fence(__ATOMIC_ACQUIRE, "agent");
            xb_add(&bar[XB_XGEN(b.x)], 1u);
            asm volatile("s_waitcnt vmcnt(0)" ::: "memory");
        } else {
            XB_SPIN(xb_ld(&bar[XB_XGEN(b.x)]) == gen, bar);
            __builtin_amdgcn_fence(__ATOMIC_ACQUIRE, "agent");
            asm volatile("s_waitcnt vmcnt(0)" ::: "memory");
        }
    }
    __syncthreads();
}

constexpr int DM = 2048;
constexpr int NB_CTX = 16, S_CTX = 256, NB_LAT = 2, S_LAT = 4096, DEPTH = 4;
constexpr int R_CTX = NB_CTX * S_CTX;
constexpr int R_LAT = NB_LAT * S_LAT;
constexpr int MROWS = R_CTX + R_LAT;
constexpr int DIN = 5632, DFF = 5632, DGU = 2 * DFF;
constexpr float ALPHA = 1.6817928305074292f;
constexpr int C_AQ = 0, C_AK = 512, C_AV = 1024, C_BQ = 1536, C_BF = 2048, C_BB = 2560, C_BI = 3072, C_BG = 3584, C_CQ = 4096, C_CK = 5120, C_CV = 5376;
constexpr size_t O_YP = 0, O_YS = 8388608, O_DK = 25165824, O_DV = 33554432, O_SK = 41943040, O_SV = 46137344, O_ST = 50331648, O_END = 58720256;

constexpr size_t MiB = 1u << 20;
constexpr size_t WS_CTL = 0, CTL_ZERO_BYTES = 1 * MiB;
constexpr size_t WS_MODS = 1 * MiB;
constexpr size_t WS_MISC = 2 * MiB;
constexpr size_t WS_W = 4 * MiB, W_LAYER = 96 * MiB;
constexpr size_t WO_IN = 0, WO_OUT = 22 * MiB, WO_GU = 30 * MiB, WO_DN = 74 * MiB;
constexpr size_t WS_H = 388 * MiB;
constexpr size_t WS_CAT = 436 * MiB;
constexpr size_t WS_X1 = 484 * MiB;
constexpr size_t WS_OA = 580 * MiB, WS_OBF = 604 * MiB, WS_OBB = 628 * MiB;
constexpr size_t WS_P = 652 * MiB;
constexpr size_t WS_ACT = WS_P, WS_YPRE = WS_P + 132 * MiB;
constexpr size_t WS_C16 = 916 * MiB;
constexpr size_t WS_QKV = 922 * MiB;
constexpr int HP_LD = 2560;
constexpr int QKV_LD = 3072, Q_QD = 0, Q_KD = 512, Q_VD = 1024, Q_QS = 1536, Q_KS = 2560, Q_VS = 2816;
constexpr size_t WS_HQ = 994 * MiB;
constexpr size_t WS_HKM = 1018 * MiB;
constexpr size_t WS_HKP = 1042 * MiB;
constexpr size_t WS_HVT = 1066 * MiB;
constexpr size_t WS_HDEC = 1090 * MiB;
constexpr size_t WS_SLOC = 1094 * MiB;
constexpr size_t WS_DSEG = 1110 * MiB;
constexpr size_t WS_YPRE2 = 1111 * MiB;
constexpr size_t WS_END = 1143 * MiB;

constexpr int CW_BAR = 4096;

constexpr int RING_BYTES = 131072;
constexpr int LDSCTL_OFF = RING_BYTES, MISC_OFF = LDSCTL_OFF + 320;
constexpr int LDS_BYTES = 147456;

typedef unsigned v2u __attribute__((ext_vector_type(2)));
typedef GAS float gf32;
typedef GAS unsigned short gbf16;

__device__ __forceinline__ float silu_f(float a) { return a / (1.0f + __expf(-a)); }
__device__ __forceinline__ int mod_of_row(int row) { return row < R_CTX ? 0 : (row < R_CTX + S_LAT ? 1 : 2); }

constexpr float LOG2E = 1.4426950408889634f;
constexpr float QSC_D = 0.125f * LOG2E, QSC_S = 0.08838834764831845f * LOG2E;
struct EpiProj {
    static constexpr bool PERM = false, AFTER_DRAIN = false;
    gbf16* qkv; gf32* out; const gf32* tabD; const gf32* tabS; int l;
    gbf16* hq; gbf16* hkm; gbf16* hkp; gbf16* hvt; gf32* hdec; gbf16* hgate; const gf32* lb;
    template <int CTRL> static __device__ __forceinline__ float dppf(float x) { return __builtin_bit_cast(float, __builtin_amdgcn_update_dpp(0x3f800000, __builtin_bit_cast(int, x), CTRL, 0xf, 0xf, false)); }
    static __device__ __forceinline__ float scan_up(float x) { x *= dppf<0x111>(x); x *= dppf<0x112>(x); x *= dppf<0x114>(x); x *= dppf<0x118>(x); return x; }
    static __device__ __forceinline__ float scan_dn(float x) { x *= dppf<0x101>(x); x *= dppf<0x102>(x); x *= dppf<0x104>(x); x *= dppf<0x108>(x); return x; }
    static __device__ __forceinline__ float bperm(int byteaddr, float x) { return __builtin_bit_cast(float, __builtin_amdgcn_ds_bpermute(byteaddr, __builtin_bit_cast(int, x))); }
    __device__ __forceinline__ void hgrn_tile(const pg8::f32x4 (&acc)[2][2][4][2], int pm, int t, int wr, int wc, int fr, int fq) const {
        const int c = 64 * t + 16 * wc + 4 * fq;
        const pg8::f32x4 lbf = *(const GAS pg8::f32x4*)(lb + c), lbb = *(const GAS pg8::f32x4*)(lb + 512 + c);
        const int bp_hi = (fq * 16 + 15) * 4, bp_lo = fq * 16 * 4;
        constexpr size_t D1 = (size_t)MROWS * 512, T1 = (size_t)768 * 512 * 16, C1 = (size_t)768 * 512;
#pragma unroll
        for (int ai = 0; ai < 2; ++ai)
#pragma unroll
            for (int m = 0; m < 4; ++m) {
                const int row = pm * 256 + 128 * ai + 64 * wr + 16 * m + fr; const size_t grp = (size_t)(row >> 4);
                const pg8::f32x4 q = acc[ai][0][m][0], zf = acc[ai][0][m][1], zb = acc[ai][1][m][0], vv = acc[ai][1][m][1];
                float hqf[4], hqb[4], kmf[4], kmb[4], kpf[4], kpb[4]; pg8::f32x4 Lf4, Lb4;
#pragma unroll
                for (int j = 0; j < 4; ++j) {
                    const float ff = fmaxf(lbf[j], 1e-30f) + (1.0f - lbf[j]) * __builtin_amdgcn_rcpf(1.0f + __expf(-zf[j]));
                    const float fb = fmaxf(lbb[j], 1e-30f) + (1.0f - lbb[j]) * __builtin_amdgcn_rcpf(1.0f + __expf(-zb[j]));
                    const float Ef = scan_up(ff), Eb = scan_dn(fb);
                    const float Lf = bperm(bp_hi, Ef), Lb = bperm(bp_lo, Eb);
                    const float qv = q[j] * __builtin_amdgcn_rcpf(1.0f + __expf(-q[j]));
                    const float Efc = fmaxf(Ef, 1.8e-35f), Ebc = fmaxf(Eb, 1.8e-35f), Rf = __builtin_amdgcn_rcpf(Efc), Rb = __builtin_amdgcn_rcpf(Ebc), kf = 1.0f - ff, kb = 1.0f - fb;
                    hqf[j] = qv * Efc; hqb[j] = qv * Ebc; kmf[j] = kf * Rf; kmb[j] = kb * Rb; kpf[j] = kf * (Lf * Rf); kpb[j] = kb * (Lb * Rb); Lf4[j] = Lf; Lb4[j] = Lb;
                }
                const size_t ro = (size_t)row * 512 + c;
                *(GAS v2u*)(hq + ro) = (v2u){pg8::cvt_pk_bf16(hqf[0], hqf[1]), pg8::cvt_pk_bf16(hqf[2], hqf[3])}; *(GAS v2u*)(hq + D1 + ro) = (v2u){pg8::cvt_pk_bf16(hqb[0], hqb[1]), pg8::cvt_pk_bf16(hqb[2], hqb[3])};
                *(GAS v2u*)(hkm + ro) = (v2u){pg8::cvt_pk_bf16(kmf[0], kmf[1]), pg8::cvt_pk_bf16(kmf[2], kmf[3])}; *(GAS v2u*)(hkm + D1 + ro) = (v2u){pg8::cvt_pk_bf16(kmb[0], kmb[1]), pg8::cvt_pk_bf16(kmb[2], kmb[3])};
                const size_t to = (grp * 512 + c) * 16;
#pragma unroll
                for (int j = 0; j < 4; ++j) { const unsigned short vb = (unsigned short)f2bf(vv[j]);
                    hkp[to + j * 16 + fr] = (unsigned short)f2bf(kpf[j]); hkp[T1 + to + j * 16 + 15 - fr] = (unsigned short)f2bf(kpb[j]);
                    hvt[to + j * 16 + fr] = vb; hvt[T1 + to + j * 16 + 15 - fr] = vb; }
                if (fr == 0) { *(GAS pg8::f32x4*)(hdec + grp * 512 + c) = Lf4; *(GAS pg8::f32x4*)(hdec + C1 + grp * 512 + c) = Lb4; }
            }
    }
    __device__ __forceinline__ void operator()(const pg8::f32x4 (&acc)[2][2][4][2], const pg8::Unit& u, int wr, int wc, int fr, int fq) const {
        asm volatile("" : "+v"(fr), "+v"(fq));
        const int pn = u.pn, pm = u.pm, rbase = pm * 256 + wr * 64 + fr;
        if (pn >= 6 && pn < 14) { hgrn_tile(acc, pm, pn - 6, wr, wc, fr, fq); return; }
        if (pn >= 14 && pn < 16) {
#pragma unroll
            for (int ai = 0; ai < 2; ++ai)
#pragma unroll
                for (int m = 0; m < 4; ++m) { gbf16* rowp = hgate + (size_t)(rbase + ai * 128 + m * 16) * 512 + (pn - 14) * 256 + wc * 32 + 4 * fq;
#pragma unroll
                    for (int bj = 0; bj < 2; ++bj)
#pragma unroll
                        for (int n = 0; n < 2; ++n) { const pg8::f32x4 x = acc[ai][bj][m][n]; float y[4];
#pragma unroll
                            for (int j = 0; j < 4; ++j) y[j] = x[j] * __builtin_amdgcn_rcpf(1.0f + __expf(-x[j]));
                            *(GAS v2u*)(rowp + bj * 128 + n * 16) = (v2u){pg8::cvt_pk_bf16(y[0], y[1]), pg8::cvt_pk_bf16(y[2], y[3])}; } }
            return;
        }
        const bool lat = pm >= 16, swar = pn >= 16 && pn <= 20, isv = pn == 4 || pn == 5 || pn == 21, rope = lat && !isv;
        const float sc = pn < 2 ? QSC_D : (pn >= 16 && pn < 20 ? QSC_S : 1.0f);
        const int o1 = swar ? pn * 256 + 64 * (wc >> 1) + 16 * (wc & 1) + 4 * fq : pn * 256 + 32 * wc + 4 * fq, dn = swar ? 32 : 16;
        const int qoff = pn < 6 ? 0 : Q_QS - C_CQ;
        const int ppar = swar ? (wc >> 1) & 1 : wc & 1;
        const gf32* tab = swar ? tabS + (16 * (wc & 1) + 4 * fq) * 2 : tabD + 4 * fq * 2; const int tstr = swar ? 64 : 32;
        size_t cbase = 0; int nh = 0; bool tocache = false;
        if (!lat) { if (pn == 2 || pn == 3) { cbase = O_DK; nh = 4; tocache = true; } else if (pn == 4 || pn == 5) { cbase = O_DV; nh = 4; tocache = true; } else if (pn == 20) { cbase = O_SK; nh = 2; tocache = true; } else if (pn == 21) { cbase = O_SV; nh = 2; tocache = true; } }
        const int hd0 = (pn == 2 || pn == 3) ? 2 * (pn - 2) : ((pn == 4 || pn == 5) ? 2 * (pn - 4) : 0);
        const int cc1 = o1 & 127;
#pragma unroll
        for (int ai = 0; ai < 2; ++ai)
#pragma unroll
            for (int m = 0; m < 4; ++m) {
                const int row = rbase + ai * 128 + m * 16;
                pg8::f32x4 cs = {1.f, 1.f, 1.f, 1.f}, sn = {0.f, 0.f, 0.f, 0.f};
                if (rope) { const int t = (row - R_CTX) & (S_LAT - 1), pos = ppar ? (t & 63) : (t >> 6);
                    const pg8::f32x4 t0 = *(const GAS pg8::f32x4*)(tab + pos * tstr), t1 = *(const GAS pg8::f32x4*)(tab + pos * tstr + 4);
                    cs = (pg8::f32x4){t0[0], t0[2], t1[0], t1[2]}; sn = (pg8::f32x4){t0[1], t0[3], t1[1], t1[3]}; }
                gbf16* qrow = qkv + (size_t)row * QKV_LD + qoff + o1;
#pragma unroll
                for (int bj = 0; bj < 2; ++bj) {
                    const pg8::f32x4 x1 = acc[ai][bj][m][0], x2 = acc[ai][bj][m][1];
                    const pg8::f32x4 y1 = (x1 * cs - x2 * sn) * sc, y2 = (x2 * cs + x1 * sn) * sc;
                    *(GAS v2u*)(qrow + bj * 128) = (v2u){pg8::cvt_pk_bf16(y1[0], y1[1]), pg8::cvt_pk_bf16(y1[2], y1[3])};
                    *(GAS v2u*)(qrow + bj * 128 + dn) = (v2u){pg8::cvt_pk_bf16(y2[0], y2[1]), pg8::cvt_pk_bf16(y2[2], y2[3])};
                    if (tocache) { gf32* cp = out + cbase + ((((size_t)pm * 4 + l) * nh + hd0 + bj) * 256 + (row & 255)) * 128 + cc1;
                        *(GAS pg8::f32x4*)cp = x1; *(GAS pg8::f32x4*)(cp + dn) = x2; }
                }
            }
    }
};
#ifndef Y_BF16
#define Y_BF16 1
#endif
#if Y_BF16
typedef gbf16 gy_t;
#else
typedef gf32 gy_t;
#endif
__device__ __forceinline__ f32x4 bf2lo(unsigned a, unsigned b) { return (f32x4){__builtin_bit_cast(float, a << 16), __builtin_bit_cast(float, a & 0xffff0000u), __builtin_bit_cast(float, b << 16), __builtin_bit_cast(float, b & 0xffff0000u)}; }
struct G1Order : pg8::StaticOrder {
    __device__ __forceinline__ bool next(int i, pg8::Unit& u) const {
        if (!pg8::StaticOrder::next(i, u)) return false;
        constexpr unsigned long long LO = 6ull | (0ull << 5) | (1ull << 10) | (7ull << 15) | (2ull << 20) | (3ull << 25) | (4ull << 30) | (8ull << 35) | (5ull << 40) | (9ull << 45) | (14ull << 50) | (10ull << 55);
        constexpr unsigned long long HI = 15ull | (16ull << 5) | (11ull << 10) | (17ull << 15) | (18ull << 20) | (19ull << 25) | (12ull << 30) | (20ull << 35) | (13ull << 40) | (21ull << 45);
        const int o = u.pn; u.pn = (int)((o < 12 ? LO >> (5 * o) : HI >> (5 * (o - 12))) & 31ull); return true;
    }
};
struct EpiResid {
    static constexpr bool PERM = Y_BF16 != 0, AFTER_DRAIN = false;
    const gf32* xa; const gf32* xb;
    const gy_t* yprev; const gf32* stats; const gf32* lng; const gf32* lnb;
    const gf32* gates;
    gy_t* out; int pm_off; int gate_only; int mode;
    __device__ __forceinline__ void operator()(const pg8::f32x4 (&acc)[2][2][4][2], const pg8::Unit& u, int wr, int wc, int fr, int fq) const {
        asm volatile("" : "+v"(fr), "+v"(fq));
        const int pm = u.pm + pm_off, mod = pm >> 4;
        const int r0 = pm * 256 + wr * 64 + fr, or0 = (gate_only ? u.pm : pm) * 256 + wr * 64 + fr;
        const bool m1 = mode == 1 && !gate_only, m0 = mode == 0 && !gate_only;
        const gf32* xbase = (pm < 16) ? xa + (size_t)pm * 256 * DM : xb + (size_t)(pm - 16) * 256 * DM;
        float mu[2][4], rs[2][4];
#pragma unroll
        for (int ai = 0; ai < 2; ++ai)
#pragma unroll
            for (int m = 0; m < 4; ++m) { mu[ai][m] = 0.f; rs[ai][m] = 0.f;
                if (m1) { const pg8::f32x2 st = *(const GAS pg8::f32x2*)(stats + 2 * (size_t)(r0 + ai * 128 + m * 16)); mu[ai][m] = st[0]; rs[ai][m] = st[1] * ALPHA; } }
#pragma unroll
        for (int bj = 0; bj < 2; ++bj) {
            const int cb = u.pn * 256 + bj * 128 + wc * 32;
            const int c0 = cb + (PERM ? 8 * fq : 4 * fq), dn = PERM ? 4 : 16;
            pg8::f32x4 gv[2], ga[2], be[2];
#pragma unroll
            for (int n = 0; n < 2; ++n) { gv[n] = *(const GAS pg8::f32x4*)(gates + (size_t)mod * 6 * DM + c0 + n * dn);
                ga[n] = (pg8::f32x4){0.f, 0.f, 0.f, 0.f}; be[n] = ga[n];
                if (m1) { ga[n] = *(const GAS pg8::f32x4*)(lng + c0 + n * dn); be[n] = *(const GAS pg8::f32x4*)(lnb + c0 + n * dn) * ALPHA; } }
#pragma unroll
            for (int ai = 0; ai < 2; ++ai)
#pragma unroll
                for (int m = 0; m < 4; ++m) { const int rr = ai * 128 + m * 16;
                    pg8::f32x4 v0 = gv[0] * acc[ai][bj][m][0], v1 = gv[1] * acc[ai][bj][m][1];
                    if (m0) { const gf32* xp = xbase + (size_t)(wr * 64 + fr + rr) * DM + c0;
                        v0 += *(const GAS pg8::f32x4*)xp * ALPHA; v1 += *(const GAS pg8::f32x4*)(xp + dn) * ALPHA; }
                    if (m1) { const gy_t* yp = yprev + (size_t)(r0 + rr) * DM + c0; pg8::f32x4 y0, y1;
#if Y_BF16
                        const v4u w = *(const GAS v4u*)yp; y0 = bf2lo(w.x, w.y); y1 = bf2lo(w.z, w.w);
#else
                        y0 = *(const GAS pg8::f32x4*)yp; y1 = *(const GAS pg8::f32x4*)(yp + dn);
#endif
                        v0 += (y0 - mu[ai][m]) * rs[ai][m] * ga[0] + be[0]; v1 += (y1 - mu[ai][m]) * rs[ai][m] * ga[1] + be[1]; }
                    gy_t* op = out + (size_t)(or0 + rr) * DM + c0;
#if Y_BF16
                    pg8::u32x4 w; w.x = pg8::cvt_pk_bf16(v0[0], v0[1]); w.y = pg8::cvt_pk_bf16(v0[2], v0[3]); w.z = pg8::cvt_pk_bf16(v1[0], v1[1]); w.w = pg8::cvt_pk_bf16(v1[2], v1[3]);
                    *(GAS pg8::u32x4*)op = w;
#else
                    *(GAS pg8::f32x4*)op = v0; *(GAS pg8::f32x4*)(op + dn) = v1;
#endif
                }
        }
    }
};
struct EpiSwiGLU {
    static constexpr bool PERM = true, AFTER_DRAIN = false;
    gbf16* act;
    __device__ __forceinline__ void operator()(const pg8::f32x4 (&acc)[2][2][4][2], const pg8::Unit& u, int wr, int wc, int fr, int fq) const {
        const int row0 = u.pm * 256 + wr * 64 + fr, col0 = u.pn * 128 + wc * 32 + 8 * fq;
#pragma unroll
        for (int ai = 0; ai < 2; ++ai)
#pragma unroll
            for (int m = 0; m < 4; ++m) { gbf16* rowp = act + (size_t)(row0 + ai * 128 + m * 16) * DFF + col0;
                float r[8];
#pragma unroll
                for (int n = 0; n < 2; ++n)
#pragma unroll
                    for (int j = 0; j < 4; ++j) { const float g = acc[ai][0][m][n][j], up = acc[ai][1][m][n][j]; r[n * 4 + j] = silu_f(g) * up; }
                pg8::u32x4 w; w.x = pg8::cvt_pk_bf16(r[0], r[1]); w.y = pg8::cvt_pk_bf16(r[2], r[3]); w.z = pg8::cvt_pk_bf16(r[4], r[5]); w.w = pg8::cvt_pk_bf16(r[6], r[7]);
                *(GAS pg8::u32x4*)rowp = w; }
    }
};

struct Args { const float* in[24]; float* out; unsigned char* ws; int ph_lo, ph_hi, single, pad; };
enum { I_XP = 0, I_XS, I_CDK, I_CDV, I_CSK, I_CSV, I_ST, I_C, I_CCTX, I_WMOD, I_BMOD, I_WIN, I_WOUT, I_DLAM, I_DNG, I_LBL, I_HNG, I_SINK, I_LN1G, I_LN1B, I_LN2G, I_LN2B, I_WGU, I_WDN };

struct Ctx {
    LAS unsigned char* lds; int tid, lane, wave, G, bid;
    const Args* ap; gf32* out; GAS unsigned char* ws;
    __device__ __forceinline__ const gf32* inp(int i) const { return (const gf32*)ap->in[i]; }
    __device__ __forceinline__ gf32* mods() const { return (gf32*)(ws + WS_MODS); }
    __device__ __forceinline__ gf32* lball() const { return (gf32*)(ws + WS_MISC); }
    __device__ __forceinline__ gf32* lamv() const { return (gf32*)(ws + WS_MISC + 16384); }
    __device__ __forceinline__ gf32* tabD() const { return (gf32*)(ws + WS_MISC + 20480); }
    __device__ __forceinline__ gf32* tabS() const { return (gf32*)(ws + WS_MISC + 32768); }
    __device__ __forceinline__ gbf16* wT(int l, size_t off) const { return (gbf16*)(ws + WS_W + (size_t)l * W_LAYER + off); }
    __device__ __forceinline__ gbf16* hbuf() const { return (gbf16*)(ws + WS_H); }
    __device__ __forceinline__ gbf16* cat() const { return (gbf16*)(ws + WS_CAT); }
    __device__ __forceinline__ GAS void* ybuf(int i) const { return (GAS void*)(ws + (i == 0 ? WS_X1 : (i == 1 ? WS_YPRE : WS_YPRE2))); }
    __device__ __forceinline__ gf32* stats() const { return (gf32*)(ws + WS_MISC + 1 * MiB); }
    __device__ __forceinline__ gf32* oa() const { return (gf32*)(ws + WS_OA); }
    __device__ __forceinline__ gf32* obf() const { return (gf32*)(ws + WS_OBF); }
    __device__ __forceinline__ gf32* obb() const { return (gf32*)(ws + WS_OBB); }
    __device__ __forceinline__ gbf16* hgate() const { return (gbf16*)(ws + WS_P); }
    __device__ __forceinline__ gbf16* act() const { return (gbf16*)(ws + WS_ACT); }
    __device__ __forceinline__ gbf16* qkv() const { return (gbf16*)(ws + WS_QKV); }
    __device__ __forceinline__ gbf16* hq(int dir) const { return (gbf16*)(ws + WS_HQ) + (size_t)dir * MROWS * 512; }
    __device__ __forceinline__ gbf16* hkm(int dir) const { return (gbf16*)(ws + WS_HKM) + (size_t)dir * MROWS * 512; }
    __device__ __forceinline__ gbf16* hkp(int dir) const { return (gbf16*)(ws + WS_HKP) + (size_t)dir * 768 * 512 * 16; }
    __device__ __forceinline__ gbf16* hvt(int dir) const { return (gbf16*)(ws + WS_HVT) + (size_t)dir * 768 * 512 * 16; }
    __device__ __forceinline__ gf32* sloc() const { return (gf32*)(ws + WS_SLOC); }
    __device__ __forceinline__ gf32* dseg() const { return (gf32*)(ws + WS_DSEG); }
    __device__ __forceinline__ gf32* hdec(int dir) const { return (gf32*)(ws + WS_HDEC) + (size_t)dir * 768 * 512; }
    __device__ __forceinline__ gbf16* c16(size_t off) const { return (gbf16*)(ws + WS_C16 + off); }
};

template <int SWAP64  >
__device__ __forceinline__ void transpose_item(const gf32* W, int K, int N, gbf16* WT, int k0, int n0, int drow0, LAS float* scr, int lane) {
#pragma unroll 8
    for (int i = 0; i < 32; ++i) { const int kk = 2 * i + (lane >> 5); scr[kk * 33 + (lane & 31)] = W[(size_t)(k0 + kk) * N + n0 + (lane & 31)]; }
    LDS_WAIT(); asm volatile("" ::: "memory");
    const int c = lane & 7;
#pragma unroll
    for (int j = 0; j < 4; ++j) { const int n = (lane >> 3) + 8 * j; const LAS float* sp = scr + (8 * c) * 33 + n;
        int drow = drow0 + n;
        if (SWAP64 == 1) { const int o = (n0 & 63) + n, a = (o >> 4) & 1, nn = o >> 5, ii = o & 15; drow = (n0 & ~63) + 32 * a + 16 * nn + ii; }
        if (SWAP64 == 2) { const int rel = n0 + n - C_BQ, qn = rel >> 9, ch = rel & 511, r = ch & 63; drow = C_BQ + 256 * (ch >> 6) + 128 * (qn >> 1) + 32 * (r >> 4) + 16 * (qn & 1) + (r & 15); }
        v4u o4; o4.x = pk2(sp[0 * 33], sp[1 * 33]); o4.y = pk2(sp[2 * 33], sp[3 * 33]); o4.z = pk2(sp[4 * 33], sp[5 * 33]); o4.w = pk2(sp[6 * 33], sp[7 * 33]);
        *(GAS v4u*)(WT + (size_t)drow * K + k0 + 8 * c) = o4; }
    LDS_WAIT(); asm volatile("" ::: "memory");
}

constexpr int F_IN = 32 * 88, F_OUT = 32 * 32, F_GU = 32 * 176, F_DN = 88 * 32, F_L = F_IN + F_OUT + F_GU + F_DN, F_SPLIT = 7000;
__device__ __forceinline__ int w_in_row(int col) {
    if (col >= C_CQ && col < C_CV) { const int o = col & 63, a = (o >> 4) & 1, nn = o >> 5, ii = o & 15; return (col & ~63) + 32 * a + 16 * nn + ii; }
    if (col >= C_BQ && col < C_BG) { const int rel = col - C_BQ, qn = rel >> 9, ch = rel & 511, r = ch & 63; return C_BQ + 256 * (ch >> 6) + 128 * (qn >> 1) + 32 * (r >> 4) + 16 * (qn & 1) + (r & 15); }
    return col;
}
__device__ __forceinline__ void convert_fast(const Ctx& F, int lo, int hi, int gw, int NGW) {
    int lane_ = (int)__builtin_amdgcn_mbcnt_hi(~0u, __builtin_amdgcn_mbcnt_lo(~0u, 0u)); asm volatile("" : "+v"(lane_));
    const int lane = lane_;
    LAS unsigned char* tile = F.lds + F.wave * 16384;
    if (hi > DEPTH * F_L) hi = DEPTH * F_L;
    for (int it = lo + gw; it < hi; it += NGW) {
        const int l = it / F_L; int r = it % F_L;
        const gf32* W; gbf16* WT; int K, N, k0, n0, kind;
        if (r < F_IN) { W = F.inp(I_WIN) + (size_t)l * DM * DIN; K = DM; N = DIN; WT = F.wT(l, WO_IN); k0 = 64 * (r / 88); n0 = 64 * (r % 88); kind = 0; }
        else if ((r -= F_IN) < F_OUT) { W = F.inp(I_WOUT) + (size_t)l * DM * DM; K = DM; N = DM; WT = F.wT(l, WO_OUT); k0 = 64 * (r / 32); n0 = 64 * (r % 32); kind = 1; }
        else if ((r -= F_OUT) < F_GU) { W = F.inp(I_WGU) + (size_t)l * DM * DGU; K = DM; N = DGU; WT = F.wT(l, WO_GU); k0 = 64 * (r / 176); n0 = 64 * (r % 176); kind = 2; }
        else { r -= F_GU; W = F.inp(I_WDN) + (size_t)l * DFF * DM; K = DFF; N = DM; WT = F.wT(l, WO_DN); k0 = 64 * (r / 32); n0 = 64 * (r % 32); kind = 1; }
        asm volatile("s_waitcnt lgkmcnt(0)" ::: "memory");
#pragma unroll
        for (int q = 0; q < 16; ++q) { const int row = 4 * q + (lane >> 4), sp = (lane & 15) ^ ((row >> 3) & 7);
            __builtin_amdgcn_global_load_lds((const GAS unsigned*)(W + (size_t)(k0 + row) * N + n0 + 4 * sp), (LAS unsigned*)(tile + q * 1024), 16, 0, 0); }
        asm volatile("s_waitcnt vmcnt(0)" ::: "memory");
        const int kc = lane & 7;
#pragma unroll
        for (int jj = 0; jj < 8; ++jj) { const int n = (lane >> 3) + 8 * jj, c = n >> 2; float v[8];
#pragma unroll
            for (int i = 0; i < 8; ++i) v[i] = *(const LAS float*)(tile + (8 * kc + i) * 256 + ((c ^ kc) * 16) + (n & 3) * 4);
            const int col = n0 + n; int drow = col;
            if (kind == 0) drow = w_in_row(col);
            if (kind == 2) { const int j = col < DFF ? col : col - DFF; drow = 256 * (j >> 7) + (col < DFF ? 0 : 128) + (j & 127); }
            v4u o4; o4.x = pk2(v[0], v[1]); o4.y = pk2(v[2], v[3]); o4.z = pk2(v[4], v[5]); o4.w = pk2(v[6], v[7]);
            *(GAS v4u*)(WT + (size_t)drow * K + k0 + 8 * kc) = o4; }
    }
    asm volatile("s_waitcnt vmcnt(0) lgkmcnt(0)" ::: "memory");
}

__device__ __forceinline__ void p0_prologue(const Ctx& F) {
    {
        LAS float* sc = (LAS float*)F.lds;
        LAS float* red = (LAS float*)(F.lds + 24576);
        const gf32* c_ctx = F.inp(I_CCTX); const gf32* cc = F.inp(I_C);
        for (int i = F.tid; i < 3 * DM; i += 512) { const int mid = i / DM, k = i % DM; const float c = mid == 0 ? c_ctx[k] : cc[(mid - 1) * DM + k]; sc[i] = silu_f(c); }
        __syncthreads();
        for (int task = F.bid; task < DEPTH * 48; task += F.G) {
            const int l = task / 48, cb = task % 48, w = F.wave;
            const gf32* wp = F.inp(I_WMOD) + ((size_t)l * DM + 256 * w) * (6 * DM) + cb * 256 + F.lane * 4;
            f32x4 a0 = {0.f, 0.f, 0.f, 0.f}, a1 = a0, a2 = a0;
#pragma unroll 8
            for (int kk = 0; kk < 256; ++kk) { const f32x4 wv = *(const GAS f32x4*)(wp + (size_t)kk * (6 * DM));
                a0 += wv * sc[256 * w + kk]; a1 += wv * sc[DM + 256 * w + kk]; a2 += wv * sc[2 * DM + 256 * w + kk]; }
            *(LAS f32x4*)(red + (w * 3 + 0) * 256 + F.lane * 4) = a0; *(LAS f32x4*)(red + (w * 3 + 1) * 256 + F.lane * 4) = a1; *(LAS f32x4*)(red + (w * 3 + 2) * 256 + F.lane * 4) = a2;
            __syncthreads();
            for (int i = F.tid; i < 768; i += 512) { const int m = i >> 8, c = i & 255; float s = 0.f;
#pragma unroll
                for (int ww = 0; ww < 8; ++ww) s += red[(ww * 3 + m) * 256 + c];
                F.mods()[((size_t)l * 3 + m) * (6 * DM) + cb * 256 + c] = s + F.inp(I_BMOD)[(size_t)l * 6 * DM + cb * 256 + c]; }
            __syncthreads();
        }
    }
    if (F.bid == F.G - 1) {
        const gf32* lbl = F.inp(I_LBL);
        for (int i = F.tid; i < 1024; i += 512) { float lg[4], mx = -1e30f;
#pragma unroll
            for (int l = 0; l < 4; ++l) { lg[l] = lbl[l * 1024 + i]; mx = fmaxf(mx, lg[l]); }
            float s = 0.f;
#pragma unroll
            for (int l = 0; l < 4; ++l) { lg[l] = expf(lg[l] - mx); s += lg[l]; }
            const float w1 = lg[1] / s, w2 = lg[2] / s, w3 = lg[3] / s;
            F.lball()[0 * 1024 + i] = 0.f; F.lball()[1 * 1024 + i] = w1; F.lball()[2 * 1024 + i] = w1 + w2; F.lball()[3 * 1024 + i] = w1 + w2 + w3; }
        if (F.tid < 4) { const int l = F.tid; const gf32* lp = F.inp(I_DLAM) + l * 256; float s1 = 0.f, s2 = 0.f;
            for (int i = 0; i < 64; ++i) { s1 += lp[i] * lp[64 + i]; s2 += lp[128 + i] * lp[192 + i]; }
            const float li = 0.8f - 0.6f * expf(-0.3f * (float)l);
            F.lamv()[l * 2] = expf(s1) - expf(s2) + li; F.lamv()[l * 2 + 1] = li; }
        for (int i = F.tid; i < 64 * 16; i += 512) { const int pos = i / 16, j = i % 16; const float inv = powf(10000.f, -(float)j / 16.f), ang = (float)pos * inv; F.tabD()[i * 2] = cosf(ang); F.tabD()[i * 2 + 1] = sinf(ang); }
        for (int i = F.tid; i < 64 * 32; i += 512) { const int pos = i / 32, j = i % 32; const float inv = powf(10000.f, -(float)j / 32.f), ang = (float)pos * inv; F.tabS()[i * 2] = cosf(ang); F.tabS()[i * 2 + 1] = sinf(ang); }
    }
    {
        const gf32* src[4] = {F.inp(I_CDK), F.inp(I_CDV), F.inp(I_CSK), F.inp(I_CSV)};
        const size_t doff[4] = {0, 2 * MiB, 4 * MiB, 5 * MiB}; const int n8[4] = {131072, 131072, 65536, 65536};
#pragma unroll
        for (int a = 0; a < 4; ++a)
            for (int i = F.bid * 512 + F.tid; i < n8[a]; i += F.G * 512) { const f32x4 x0 = *(const GAS f32x4*)(src[a] + (size_t)i * 8), x1 = *(const GAS f32x4*)(src[a] + (size_t)i * 8 + 4);
                v4u o; o.x = pk2(x0[0], x0[1]); o.y = pk2(x0[2], x0[3]); o.z = pk2(x1[0], x1[1]); o.w = pk2(x1[2], x1[3]); *(GAS v4u*)(F.c16(doff[a]) + (size_t)i * 8) = o; }
    }
    {
        LAS float* scr = (LAS float*)(F.lds + 49152 + F.wave * 8448);
        const int gw = F.bid * 8 + F.wave, NGW = F.G * 8;
        constexpr int I_IN = 32 * 176, I_OUT = 32 * 64, I_GU = 32 * 352, I_DN = 88 * 64, I_L = I_IN + I_OUT + I_GU + I_DN;
        for (int it = gw; it < I_L; it += NGW) {
            const int l = it / I_L; int r = it % I_L;
            if (r < I_IN) { const int kb = r / 176, nb = r % 176, n0 = 32 * nb;
                if (n0 >= C_CQ && n0 < C_CV) transpose_item<1>(F.inp(I_WIN) + (size_t)l * DM * DIN, DM, DIN, F.wT(l, WO_IN), 64 * kb, n0, n0, scr, F.lane);
                else if (n0 >= C_BQ && n0 < C_BG) transpose_item<2>(F.inp(I_WIN) + (size_t)l * DM * DIN, DM, DIN, F.wT(l, WO_IN), 64 * kb, n0, n0, scr, F.lane);
                else transpose_item<0>(F.inp(I_WIN) + (size_t)l * DM * DIN, DM, DIN, F.wT(l, WO_IN), 64 * kb, n0, n0, scr, F.lane);
                continue; } r -= I_IN;
            if (r < I_OUT) { const int kb = r / 64, nb = r % 64; transpose_item<0>(F.inp(I_WOUT) + (size_t)l * DM * DM, DM, DM, F.wT(l, WO_OUT), 64 * kb, 32 * nb, 32 * nb, scr, F.lane); continue; } r -= I_OUT;
            if (r < I_GU) { const int kb = r / 352, nb = r % 352, n0 = 32 * nb; const int j = n0 < DFF ? n0 : n0 - DFF; const int drow = 256 * (j >> 7) + (n0 < DFF ? 0 : 128) + (j & 127);
                transpose_item<0>(F.inp(I_WGU) + (size_t)l * DM * DGU, DM, DGU, F.wT(l, WO_GU), 64 * kb, n0, drow, scr, F.lane); continue; } r -= I_GU;
            { const int kb = r / 64, nb = r % 64; transpose_item<0>(F.inp(I_WDN) + (size_t)l * DFF * DM, DFF, DM, F.wT(l, WO_DN), 64 * kb, 32 * nb, 32 * nb, scr, F.lane); }
        }
    }
}

__device__ __forceinline__ void p1_h0(const Ctx& F) {
    const gf32* xp = F.inp(I_XP); const gf32* xs = F.inp(I_XS);
    f32x4 A[8], B[8]; int curmod = -1;
    for (int row = F.bid * 8 + F.wave; row < MROWS; row += F.G * 8) {
        const int mod = mod_of_row(row);
        const gf32* xr = (row < R_CTX ? xp + (size_t)row * DM : xs + (size_t)(row - R_CTX) * DM) + F.lane * 8;
        f32x4 x[8];
#pragma unroll
        for (int j = 0; j < 8; ++j) x[j] = *(const GAS f32x4*)(xr + 512 * (j >> 1) + 4 * (j & 1));
        if (mod != curmod) { curmod = mod; const gf32* sh = F.mods() + (size_t)(0 * 3 + mod) * 6 * DM;
#pragma unroll
            for (int j = 0; j < 8; ++j) { const int c = F.lane * 8 + 512 * (j >> 1) + 4 * (j & 1); A[j] = *(const GAS f32x4*)(sh + DM + c) + 1.0f; B[j] = *(const GAS f32x4*)(sh + c); } }
#pragma unroll
        for (int jj = 0; jj < 4; ++jj) { const f32x4 h0 = x[2 * jj] * A[2 * jj] + B[2 * jj], h1 = x[2 * jj + 1] * A[2 * jj + 1] + B[2 * jj + 1];
            v4u o; o.x = pk2(h0[0], h0[1]); o.y = pk2(h0[2], h0[3]); o.z = pk2(h1[0], h1[1]); o.w = pk2(h1[2], h1[3]);
            *(GAS v4u*)(F.hbuf() + (size_t)row * DM + F.lane * 8 + 512 * jj) = o; }
    }
}

typedef float f32x16 __attribute__((ext_vector_type(16)));
typedef short s16x4 __attribute__((ext_vector_type(4)));
typedef __bf16 bf16x2_t __attribute__((ext_vector_type(2)));
typedef float f32x2_t __attribute__((ext_vector_type(2)));
__device__ __forceinline__ unsigned cvt2(float a, float b) { const f32x2_t f = {a, b}; return __builtin_bit_cast(unsigned, __builtin_convertvector(f, bf16x2_t)); }
#define MFMA32(a, b, c) __builtin_amdgcn_mfma_f32_32x32x16_bf16((a), (b), (c), 0, 0, 0)

struct AttnSeg { const gbf16* k; const gbf16* v; int stride; int ntiles; };
constexpr int AT_NS = 4, AT_SLOT = 32768;
constexpr float ATT_THR = 8.0f;
#define AT_VMWAIT(n) asm volatile("s_waitcnt vmcnt(" #n ")" ::: "memory")
__device__ __forceinline__ void glds16_asm(const GAS void* gsrc, unsigned lds_dst) {
    unsigned keep;
    asm volatile("s_mov_b32 %0, m0\n\ts_mov_b32 m0, %2\n\ts_nop 0\n\tglobal_load_lds_dwordx4 %1, off\n\ts_mov_b32 m0, %0" : "=&s"(keep) : "v"(gsrc), "s"(lds_dst) : "memory");
}

template <int DQK, bool DIFF>
__device__ __forceinline__ void attn_mfma(const Ctx& F, const gbf16* qptr, int kcol, const AttnSeg s0, const AttnSeg s1, bool band, int qpos, int kpos0,
                                          float m_init, float l_init, float lam, float post_scale, const gf32* gvec, gbf16* outp  ) {
    int lane_ = (int)__builtin_amdgcn_mbcnt_hi(~0u, __builtin_amdgcn_mbcnt_lo(~0u, 0u)); asm volatile("" : "+v"(lane_));
    const int lane = lane_, w = F.wave, r32 = lane & 31, h = lane >> 5;
    __syncthreads();
    bf16x8 qf[DQK / 16];
#pragma unroll
    for (int ks = 0; ks < DQK / 16; ++ks) qf[ks] = *(const GAS bf16x8*)(qptr + (size_t)r32 * QKV_LD + 16 * ks + 8 * h);
#pragma unroll
    for (int ks = 0; ks < DQK / 16; ++ks) asm volatile("" : "+v"(qf[ks]));
    __builtin_amdgcn_s_waitcnt(0);
    f32x16 o[4];
#pragma unroll
    for (int t = 0; t < 4; ++t)
#pragma unroll
        for (int r = 0; r < 16; ++r) o[t][r] = 0.f;
    float m = m_init, l = l_init;
    const int nt = s0.ntiles + s1.ntiles;
    const int srow0 = 8 * w + (lane >> 4), spc = lane & 15;
    const unsigned lds_base = (unsigned)(__UINTPTR_TYPE__)F.lds;
#define AT_ISSUE(tj) do { const int te_ = (tj) < nt ? (tj) : nt - 1; const bool s1_ = te_ >= s0.ntiles; const int tt_ = s1_ ? te_ - s0.ntiles : te_; \
        const GAS unsigned char* kb_ = (const GAS unsigned char*)(s1_ ? s1.k : s0.k); const GAS unsigned char* vb_ = (const GAS unsigned char*)(s1_ ? s1.v : s0.v); const int st_ = (s1_ ? s1.stride : s0.stride) * 2; \
        const unsigned sl_ = lds_base + (unsigned)(((tj) % AT_NS) * AT_SLOT + w * 2048); \
        _Pragma("unroll") for (int j_ = 0; j_ < 2; ++j_) { const int row_ = srow0 + 4 * j_; const size_t ro_ = (size_t)(tt_ * 64 + row_) * st_; \
            glds16_asm(kb_ + ro_ + ((spc ^ (row_ & 15)) * 16), sl_ + j_ * 1024); \
            glds16_asm(vb_ + ro_ + ((spc ^ ((row_ & 3) << 2)) * 16), sl_ + 16384 + j_ * 1024); } } while (0)
    const int kc0 = kcol / 8 + h;
    const int krow = r32 * 256, ksw = r32 & 15;
    const int vq = (lane & 15) >> 2, vp = lane & 3, vc16 = (lane >> 4) & 1;
    const int vrow = 16384 + (4 * h + vq) * 256 + 8 * (vp & 1);
    int vpo[4];
#pragma unroll
    for (int t = 0; t < 4; ++t) vpo[t] = ((4 * (t ^ vq) + 2 * vc16 + (vp >> 1)) * 16);
#pragma unroll
    for (int j = 0; j < AT_NS - 1; ++j) AT_ISSUE(j);
    for (int ti = 0; ti < nt; ++ti) {
        AT_VMWAIT(8);
        asm volatile("s_waitcnt lgkmcnt(0)" ::: "memory"); __builtin_amdgcn_s_barrier(); asm volatile("" ::: "memory");
        AT_ISSUE(ti + AT_NS - 1);
        unsigned sb_ = (unsigned)(ti % AT_NS) * AT_SLOT; asm volatile("" : "+s"(sb_));
        const LAS unsigned char* kb = F.lds + sb_;
        f32x16 st[2];
#pragma unroll
        for (int kt = 0; kt < 2; ++kt)
#pragma unroll
            for (int r = 0; r < 16; ++r) st[kt][r] = 0.f;
        {
            constexpr int NG = 2 * (DQK / 64);
            bf16x8 kfa[4], kfb[4];
#define ATT_LDK(dst, g) do { const int kt_ = (g) / (DQK / 64), k0_ = ((g) % (DQK / 64)) * 4; _Pragma("unroll") for (int j_ = 0; j_ < 4; ++j_) dst[j_] = *(const LAS bf16x8*)(kb + kt_ * 8192 + krow + (((kc0 + 2 * (k0_ + j_)) ^ ksw) * 16)); } while (0)
#define ATT_MMK(src, g) do { const int kt_ = (g) / (DQK / 64), k0_ = ((g) % (DQK / 64)) * 4; _Pragma("unroll") for (int j_ = 0; j_ < 4; ++j_) st[kt_] = MFMA32(src[j_], qf[k0_ + j_], st[kt_]); } while (0)
            ATT_LDK(kfa, 0); __builtin_amdgcn_sched_barrier(0);
#pragma unroll
            for (int g = 0; g < NG; g += 2) {
                ATT_LDK(kfb, g + 1); __builtin_amdgcn_sched_barrier(0);
                ATT_MMK(kfa, g);
                if (g + 2 < NG) { ATT_LDK(kfa, g + 2); __builtin_amdgcn_sched_barrier(0); }
                ATT_MMK(kfb, g + 1);
            }
#undef ATT_LDK
#undef ATT_MMK
        }
        if (band && ti < s0.ntiles) {
            const int kp = kpos0 + ti * 64 + 4 * h - (qpos + r32);
#pragma unroll
            for (int kt = 0; kt < 2; ++kt)
#pragma unroll
                for (int r = 0; r < 16; ++r) { const int d = kp + 32 * kt + (r & 3) + 8 * (r >> 2); if (d > 128 || d < -128) st[kt][r] = -1e30f; }
        }
        float mx = st[0][0];
#pragma unroll
        for (int kt = 0; kt < 2; ++kt)
#pragma unroll
            for (int r = 0; r < 16; ++r) mx = fmaxf(mx, st[kt][r]);
        mx = fmaxf(mx, __shfl_xor(mx, 32));
        if (__builtin_amdgcn_ballot_w64(mx > m + ATT_THR) != 0ull) {
            const float mn = fmaxf(m, mx), a = __builtin_amdgcn_exp2f(m - mn); l *= a; m = mn;
#pragma unroll
            for (int t = 0; t < 4; ++t)
#pragma unroll
                for (int r = 0; r < 16; ++r) o[t][r] *= a;
        }
        float rs = 0.f;
#pragma unroll
        for (int kt = 0; kt < 2; ++kt)
#pragma unroll
            for (int r = 0; r < 16; ++r) { const float p = __builtin_amdgcn_exp2f(st[kt][r] - m); st[kt][r] = p; rs += p; }
        rs += __shfl_xor(rs, 32); l += rs;
        {
            s16x4 va[8], vb[8];
#define ATT_LDV(dst, g) do { _Pragma("unroll") for (int t_ = 0; t_ < 4; ++t_) { dst[2 * t_] = __builtin_amdgcn_ds_read_tr16_b64_v4i16((LAS s16x4*)(kb + vrow + (16 * (g)) * 256 + vpo[t_])); \
                dst[2 * t_ + 1] = __builtin_amdgcn_ds_read_tr16_b64_v4i16((LAS s16x4*)(kb + vrow + (16 * (g) + 8) * 256 + vpo[t_])); } } while (0)
#define ATT_MMV(src, g) do { const int kt_ = (g) >> 1, s_ = (g) & 1; v4u pw_; pw_.x = cvt2(st[kt_][8 * s_], st[kt_][8 * s_ + 1]); pw_.y = cvt2(st[kt_][8 * s_ + 2], st[kt_][8 * s_ + 3]); pw_.z = cvt2(st[kt_][8 * s_ + 4], st[kt_][8 * s_ + 5]); pw_.w = cvt2(st[kt_][8 * s_ + 6], st[kt_][8 * s_ + 7]); \
            const bf16x8 pf_ = __builtin_bit_cast(bf16x8, pw_); _Pragma("unroll") for (int t_ = 0; t_ < 4; ++t_) o[t_] = MFMA32(__builtin_shufflevector(src[2 * t_], src[2 * t_ + 1], 0, 1, 2, 3, 4, 5, 6, 7), pf_, o[t_]); } while (0)
            ATT_LDV(va, 0); __builtin_amdgcn_sched_barrier(0);
            ATT_LDV(vb, 1); __builtin_amdgcn_sched_barrier(0);
            ATT_MMV(va, 0);
            ATT_LDV(va, 2); __builtin_amdgcn_sched_barrier(0);
            ATT_MMV(vb, 1);
            ATT_LDV(vb, 3); __builtin_amdgcn_sched_barrier(0);
            ATT_MMV(va, 2);
            ATT_MMV(vb, 3);
#undef ATT_LDV
#undef ATT_MMV
        }
    }
#undef AT_ISSUE
    AT_VMWAIT(0);
    __syncthreads();
    const float inv = 1.0f / l;
    if (DIFF) {
        LAS float* ex = (LAS float*)F.lds;
        if (F.wave >= 4) {
#pragma unroll
            for (int t = 0; t < 4; ++t)
#pragma unroll
                for (int r = 0; r < 16; ++r) ex[((F.wave - 4) * 64 + t * 16 + r) * 64 + lane] = o[t][r] * inv;
        }
        __syncthreads();
        if (F.wave < 4) {
            float ss = 0.f;
#pragma unroll
            for (int t = 0; t < 4; ++t)
#pragma unroll
                for (int r = 0; r < 16; ++r) { const float x = o[t][r] * inv - lam * ex[(F.wave * 64 + t * 16 + r) * 64 + lane]; o[t][r] = x; ss += x * x; }
            ss += __shfl_xor(ss, 32);
            const float sc = post_scale / sqrtf(ss * (1.0f / 128.0f) + 1e-6f);
            gbf16* op = outp + (size_t)r32 * DM;
#pragma unroll
            for (int t = 0; t < 4; ++t)
#pragma unroll
                for (int g4 = 0; g4 < 4; ++g4) { const int dv = 32 * t + 8 * g4 + 4 * h; const f32x4 gv = *(const GAS f32x4*)(gvec + dv);
                    v2u w2; w2.x = cvt2(o[t][4 * g4] * sc * gv[0], o[t][4 * g4 + 1] * sc * gv[1]); w2.y = cvt2(o[t][4 * g4 + 2] * sc * gv[2], o[t][4 * g4 + 3] * sc * gv[3]); *(GAS v2u*)(op + dv) = w2; }
        }
    } else {
        gbf16* op = outp + (size_t)r32 * DM;
#pragma unroll
        for (int t = 0; t < 4; ++t)
#pragma unroll
            for (int g4 = 0; g4 < 4; ++g4) { const int dv = 32 * t + 8 * g4 + 4 * h;
                v2u w2; w2.x = cvt2(o[t][4 * g4] * inv, o[t][4 * g4 + 1] * inv); w2.y = cvt2(o[t][4 * g4 + 2] * inv, o[t][4 * g4 + 3] * inv); *(GAS v2u*)(op + dv) = w2; }
    }
}

#define MFMA16(a, b, c) __builtin_amdgcn_mfma_f32_16x16x32_bf16((a), (b), (c), 0, 0, 0)
__device__ __forceinline__ bf16x8 frag2(v2u lo, v2u hi) { const v4u w = {lo.x, lo.y, hi.x, hi.y}; return __builtin_bit_cast(bf16x8, w); }
constexpr int HG_NS = 7, HG_SLOT = 17408;
#define HG_VMWAIT(n) asm volatile("s_waitcnt vmcnt(" #n ")" ::: "memory")
template <int MODE>
__device__ __forceinline__ void hgrn_mfma(const Ctx& F, int rb, int nchunks, int cc0, int ncc, int h, int dir, const gf32* s_in, gf32* s_out, gf32* ob, const gf32* fold_s, const gf32* fold_d, int nfold, gf32* d_out) {
    int lane_ = (int)__builtin_amdgcn_mbcnt_hi(~0u, __builtin_amdgcn_mbcnt_lo(~0u, 0u)); asm volatile("" : "+v"(lane_));
    const int lane = lane_, t16 = lane & 15, G = lane >> 4, w = F.wave, vcol = h * 128 + w * 16 + t16;
    __syncthreads();
    f32x4 S[8];
#pragma unroll
    for (int i = 0; i < 8; ++i)
#pragma unroll
        for (int r = 0; r < 4; ++r) S[i][r] = (MODE == 2) ? s_in[(size_t)(16 * i + 4 * G + r) * 128 + w * 16 + t16] : 0.f;
    if (MODE == 2) {
        for (int j = 0; j < nfold; ++j) {
#pragma unroll
            for (int i = 0; i < 8; ++i) { const f32x4 dj = *(const GAS f32x4*)(fold_d + (size_t)j * 128 + 16 * i + 4 * G);
#pragma unroll
                for (int r = 0; r < 4; ++r) S[i][r] = S[i][r] * dj[r] + fold_s[((size_t)j * 128 + 16 * i + 4 * G + r) * 128 + w * 16 + t16]; }
        }
    }
    f32x4 Dacc[8];
#pragma unroll
    for (int i = 0; i < 8; ++i) Dacc[i] = (f32x4){1.f, 1.f, 1.f, 1.f};
#pragma unroll
    for (int i = 0; i < 8; ++i) asm volatile("" : "+v"(S[i]));
    __builtin_amdgcn_s_waitcnt(0);
    const GAS unsigned char* srcA = (const GAS unsigned char*)((w < 4 ? F.hq(dir) : F.hkm(dir)) + h * 128);
    const GAS unsigned char* srcB = (const GAS unsigned char*)((w < 4 ? F.hkp(dir) : F.hvt(dir)) + (size_t)h * 128 * 16);
    const GAS unsigned char* srcC = (const GAS unsigned char*)(F.hdec(dir) + h * 128) + (lane & 31) * 16;
    const int rA = 4 * (w & 3) + (lane >> 4);
    const unsigned offA = (unsigned)((dir ? 15 - rA : rA) * 1024 + (((lane & 15) ^ rA) * 16));
    const int dB = 32 * (w & 3) + (lane >> 1);
    const unsigned offB = (unsigned)(dB * 32 + (((lane & 1) ^ ((dB >> 3) & 1)) * 16));
    const int dstA = (w < 4 ? 0 : 4096) + (w & 3) * 1024, dstB = (w < 4 ? 8192 : 12288) + (w & 3) * 1024;
#define HG_ISSUE(cj) do { const int ce_ = cc0 + ((cj) < ncc ? (cj) : ncc - 1); const int ch_ = dir ? nchunks - 1 - ce_ : ce_; const size_t gc_ = (size_t)(rb / 16 + ch_); \
        LAS unsigned char* sl_ = F.lds + ((cj) % HG_NS) * HG_SLOT; \
        if (MODE != 1) __builtin_amdgcn_global_load_lds((const GAS unsigned*)(srcA + (size_t)(rb + ch_ * 16) * 1024 + offA), (LAS unsigned*)(sl_ + dstA), 16, 0, 0); \
        __builtin_amdgcn_global_load_lds((const GAS unsigned*)(srcB + gc_ * 16384 + offB), (LAS unsigned*)(sl_ + dstB), 16, 0, 0); \
        if (w == 0) __builtin_amdgcn_global_load_lds((const GAS unsigned*)(srcC + gc_ * 2048), (LAS unsigned*)(sl_ + 16384), 16, 0, 0); } while (0)
    const int qoff = t16 * 256 + 8 * (G & 1);
    const int g1 = G >> 1;
    const int kpoff = 8192 + t16 * 32 + ((g1 ^ ((t16 >> 3) & 1)) * 16) + 8 * (G & 1);
    const int vtoff = 12288 + (w * 16 + t16) * 32 + ((g1 ^ ((t16 >> 3) & 1)) * 16) + 8 * (G & 1);
    const int dcoff = 16384 + 16 * G;
    const v2u z2 = {0u, 0u};
#pragma unroll
    for (int j = 0; j < HG_NS - 1; ++j) HG_ISSUE(j);
    for (int cc = 0; cc < ncc; ++cc) {
        if (MODE == 1) { if (w == 0) HG_VMWAIT(10); else HG_VMWAIT(5); }
        else if (cc < HG_NS - 1) { if (w == 0) HG_VMWAIT(15); else HG_VMWAIT(10); }
        else                     { if (w == 0) HG_VMWAIT(39); else HG_VMWAIT(34); }
        asm volatile("s_waitcnt lgkmcnt(0)" ::: "memory"); __builtin_amdgcn_s_barrier(); asm volatile("" ::: "memory");
        HG_ISSUE(cc + HG_NS - 1);
        unsigned hb_ = (unsigned)(cc % HG_NS) * HG_SLOT; asm volatile("" : "+s"(hb_));
        const LAS unsigned char* sl = F.lds + hb_;
        v2u q[8], k[8], kp[8]; f32x4 dec[8];
        if (MODE != 1) {
#pragma unroll
            for (int i = 0; i < 8; ++i) { const int po = (((2 * i + g1) ^ t16) * 16); q[i] = *(const LAS v2u*)(sl + qoff + po); k[i] = *(const LAS v2u*)(sl + 4096 + qoff + po); }
        }
        const v2u vt = *(const LAS v2u*)(sl + vtoff);
#pragma unroll
        for (int i = 0; i < 8; ++i) { kp[i] = *(const LAS v2u*)(sl + kpoff + i * 512); dec[i] = *(const LAS f32x4*)(sl + dcoff + i * 64); }
        __builtin_amdgcn_sched_barrier(0);
        const bf16x8 vb = frag2(vt, z2);
        if (MODE != 1) {
            f32x4 pt = {0.f, 0.f, 0.f, 0.f};
#pragma unroll
            for (int kk = 0; kk < 4; ++kk) pt = MFMA16(frag2(k[2 * kk], k[2 * kk + 1]), frag2(q[2 * kk], q[2 * kk + 1]), pt);
#pragma unroll
            for (int r = 0; r < 4; ++r) if (4 * G + r > t16) pt[r] = 0.f;
            const v2u pb = {cvt2(pt[0], pt[1]), cvt2(pt[2], pt[3])};
            f32x4 o = {0.f, 0.f, 0.f, 0.f};
            o = MFMA16(frag2(pb, z2), vb, o);
#pragma unroll
            for (int kk = 0; kk < 4; ++kk) { const v2u s0 = {cvt2(S[2 * kk][0], S[2 * kk][1]), cvt2(S[2 * kk][2], S[2 * kk][3])}, s1 = {cvt2(S[2 * kk + 1][0], S[2 * kk + 1][1]), cvt2(S[2 * kk + 1][2], S[2 * kk + 1][3])};
                o = MFMA16(frag2(q[2 * kk], q[2 * kk + 1]), frag2(s0, s1), o); }
            const int ce = cc0 + cc, ch = dir ? nchunks - 1 - ce : ce, crow = rb + ch * 16;
#pragma unroll
            for (int r = 0; r < 4; ++r) { const int pr_ = 4 * G + r; ob[(size_t)(crow + (dir ? 15 - pr_ : pr_)) * 512 + vcol] = o[r]; }
        }
#pragma unroll
        for (int i = 0; i < 8; ++i) { S[i] = S[i] * dec[i]; S[i] = MFMA16(frag2(kp[i], z2), vb, S[i]); if (MODE == 1) Dacc[i] = Dacc[i] * dec[i]; }
    }
#undef HG_ISSUE
    HG_VMWAIT(0);
    __syncthreads();
    if (MODE != 2) {
#pragma unroll
        for (int i = 0; i < 8; ++i)
#pragma unroll
            for (int r = 0; r < 4; ++r) s_out[(size_t)(16 * i + 4 * G + r) * 128 + w * 16 + t16] = S[i][r];
    }
    if (MODE == 1 && w == 0 && t16 == 0) {
#pragma unroll
        for (int i = 0; i < 8; ++i) *(GAS f32x4*)(d_out + 16 * i + 4 * G) = Dacc[i];
    }
}

__device__ __forceinline__ void hp_states(const Ctx& F, int l) {
    for (int i = F.bid; i < 256; i += F.G) {
        const int sq = i >> 4, seg = i & 15, b = sq >> 3, h = (sq >> 1) & 3, dir = sq & 1;
        if (seg == 15) continue;
        hgrn_mfma<1>(F, R_CTX + b * S_LAT, S_LAT / 16, seg * 16, 16, h, dir, nullptr, F.sloc() + ((size_t)sq * 16 + seg) * 16384, nullptr, nullptr, nullptr, 0, F.dseg() + ((size_t)sq * 16 + seg) * 128);
    }
}

__device__ __forceinline__ void mg_head(const Ctx& F, int l, int row0, int h) {
    asm volatile("s_waitcnt vmcnt(0)" ::: "memory");
    __syncthreads();
    const int sub = F.lane & 15, col0 = h * 128 + sub * 8;
    const gf32* g = F.inp(I_HNG) + l * 128 + sub * 8; const f32x4 g0 = *(const GAS f32x4*)g, g1 = *(const GAS f32x4*)(g + 4);
    for (int row = row0 + F.wave * 4 + (F.lane >> 4); row < row0 + 256; row += 32) {
        const f32x4 a0 = *(const GAS f32x4*)(F.obf() + (size_t)row * 512 + col0) + *(const GAS f32x4*)(F.obb() + (size_t)row * 512 + col0);
        const f32x4 a1 = *(const GAS f32x4*)(F.obf() + (size_t)row * 512 + col0 + 4) + *(const GAS f32x4*)(F.obb() + (size_t)row * 512 + col0 + 4);
        float ss = (a0[0] * a0[0] + a0[1] * a0[1]) + (a0[2] * a0[2] + a0[3] * a0[3]) + (a1[0] * a1[0] + a1[1] * a1[1]) + (a1[2] * a1[2] + a1[3] * a1[3]);
        ss += __shfl_xor(ss, 1); ss += __shfl_xor(ss, 2); ss += __shfl_xor(ss, 4); ss += __shfl_xor(ss, 8);
        const float rinv = 1.0f / sqrtf(ss * (1.0f / 128.0f) + 1e-6f);
        const v4u hw = *(const GAS v4u*)(F.hgate() + (size_t)row * 512 + col0);
        const f32x4 h0 = bf2lo(hw.x, hw.y), h1 = bf2lo(hw.z, hw.w);
        float y[8];
#pragma unroll
        for (int i = 0; i < 4; ++i) { y[i] = a0[i] * rinv * g0[i] * h0[i]; y[4 + i] = a1[i] * rinv * g1[i] * h1[i]; }
        v4u w; w.x = pk2(y[0], y[1]); w.y = pk2(y[2], y[3]); w.z = pk2(y[4], y[5]); w.w = pk2(y[6], y[7]);
        *(GAS v4u*)(F.cat() + (size_t)row * DM + 512 + col0) = w;
    }
}

#ifndef PROBE_MX_DUP
#define PROBE_MX_DUP 0
#endif
#define MXREP(cls) for (int rep_ = 0; rep_ < 1 + ((PROBE_MX_DUP >> (cls)) & 1); ++rep_)
__device__ __forceinline__ void mx_mixers(const Ctx& F, int l) {
    float lam = F.lamv()[l * 2], lam_init = F.lamv()[l * 2 + 1];
    asm volatile("" : "+v"(lam), "+v"(lam_init));
    const gbf16* qkv = F.qkv();
    constexpr int T_LH = 256, T_LD = 256, T_LB = 256;
    const AttnSeg none = {nullptr, nullptr, 0, 0};
    const int w = F.wave;
    const int B = F.bid, role = B < 128 ? 0 : (B < 192 ? 1 : 2);
    for (int step = 0; step < 6; ++step) {
        int i = -1, pw = B;
        if (step == 0) i = T_LH + B;
        else if (role == 0) { const int bb = B >> 6, h = (B >> 4) & 3, sgi = B & 15, sq = bb * 8 + h * 2;
            if (step == 1) i = sq * 16 + sgi; else if (step == 2) i = (sq + 1) * 16 + 15 - sgi; else if (step == 3) i = 2000; else if (step == 4 && B < 64) i = 768 + 384 + 64 + B; }
        else if (role == 1) { const int c = B - 128;
            if (step == 1) i = 768 + c * 2; else if (step == 2) i = 768 + c * 2 + 1; else if (step == 3) i = 2001; else if (step == 4) i = T_LH + T_LD + B; else i = 768 + 384 + c; }
        else { const int d = B - 192;
            if (step == 1) i = T_LH + T_LD + B; else if (step == 2) { i = T_LH + T_LD + d; pw = d; } else if (step == 3) { i = T_LH + T_LD + 64 + d; pw = 64 + d; } else if (step == 4) i = 768 + 128 + d; else i = 768 + 128 + 64 + d; }
        if (i < 0) continue;
        if (i == 2000) { mg_head(F, l, R_CTX + (B >> 6) * S_LAT + (B & 15) * 256, (B >> 4) & 3); continue; }
        if (i == 2001) { const int c = B - 128; mg_head(F, l, (c >> 2) * 256, c & 3); continue; }
        if (i >= T_LH && i < T_LH + T_LD + T_LB) i += ((pw & 7) * 32 + (pw >> 3)) - pw;
        if (i < T_LH) {
            const int sq = i >> 4, seg = i & 15, b = sq >> 3, h = (sq >> 1) & 3, dir = sq & 1;
            const gf32* sin_ = F.inp(I_ST) + ((((size_t)b * 4 + l) * 2 + dir) * 4 + h) * 128 * 128;
            MXREP(0) hgrn_mfma<2>(F, R_CTX + b * S_LAT, S_LAT / 16, seg * 16, 16, h, dir, sin_, nullptr, dir ? F.obb() : F.obf(), F.sloc() + (size_t)sq * 16 * 16384, F.dseg() + (size_t)sq * 16 * 128, seg, nullptr);
            continue; } i -= T_LH;
        if (i < T_LD) {
            const int b = i >> 7, h = (i >> 5) & 3, qt = i & 31, map = w >> 2; const int rb = R_CTX + b * S_LAT, wrow = rb + qt * 128 + 32 * (w & 3);
            const AttnSeg s0 = {qkv + (size_t)rb * QKV_LD + Q_KD + h * 128, qkv + (size_t)rb * QKV_LD + Q_VD + h * 128, QKV_LD, S_LAT / 64};
            const size_t co = (((size_t)b * 4 + l) * 4 + h) * 256 * 128;
            const AttnSeg s1 = {F.c16(0) + co, F.c16(2 * MiB) + co, 128, 4};
            MXREP(1) attn_mfma<64, true>(F, qkv + (size_t)wrow * QKV_LD + Q_QD + h * 128 + map * 64, map * 64, s0, s1, false, 0, 0, -1e30f, 0.f, lam, 1.0f - lam_init, F.inp(I_DNG) + l * 128, F.cat() + (size_t)wrow * DM + h * 128);
            continue; } i -= T_LD;
        if (i < T_LB) {
            const int b = i >> 7, kv = (i >> 6) & 1, qt = i & 63, hh = kv * 4 + (w >> 1); const int rb = R_CTX + b * S_LAT, t0 = qt * 64, wrow = rb + t0 + 32 * (w & 1);
            const int ks = t0 - 128 < 0 ? 0 : t0 - 128, ke = t0 + 192 > S_LAT ? S_LAT : t0 + 192;
            const AttnSeg s0 = {qkv + (size_t)(rb + ks) * QKV_LD + Q_KS + kv * 128, qkv + (size_t)(rb + ks) * QKV_LD + Q_VS + kv * 128, QKV_LD, (ke - ks) / 64};
            const size_t co = (((size_t)b * 4 + l) * 2 + kv) * 256 * 128;
            const AttnSeg s1 = {F.c16(4 * MiB) + co, F.c16(5 * MiB) + co, 128, 4};
            MXREP(2) attn_mfma<128, false>(F, qkv + (size_t)wrow * QKV_LD + Q_QS + hh * 128, 0, s0, s1, true, t0 + 32 * (w & 1), ks, F.inp(I_SINK)[l * 8 + hh] * LOG2E, 1.0f, 0.f, 1.0f, nullptr, F.cat() + (size_t)wrow * DM + 1024 + hh * 128);
            continue; } i -= T_LB;
        if (i < 128) {
            const int b = i >> 3, h = (i >> 1) & 3, dir = i & 1;
            gf32* sout = F.out + O_ST + ((((size_t)b * 4 + l) * 2 + dir) * 4 + h) * 128 * 128;
            MXREP(5) hgrn_mfma<0>(F, b * 256, 16, 0, 16, h, dir, nullptr, sout, dir ? F.obb() : F.obf(), nullptr, nullptr, 0, nullptr);
            continue; } i -= 128;
        if (i < 128) {
            const int b = i >> 3, h = (i >> 1) & 3, qt = i & 1, map = w >> 2, rb = b * 256, wrow = rb + qt * 128 + 32 * (w & 3);
            const AttnSeg s0 = {qkv + (size_t)rb * QKV_LD + Q_KD + h * 128, qkv + (size_t)rb * QKV_LD + Q_VD + h * 128, QKV_LD, 4};
            MXREP(3) attn_mfma<64, true>(F, qkv + (size_t)wrow * QKV_LD + Q_QD + h * 128 + map * 64, map * 64, s0, none, false, 0, 0, -1e30f, 0.f, lam, 1.0f - lam_init, F.inp(I_DNG) + l * 128, F.cat() + (size_t)wrow * DM + h * 128);
            continue; } i -= 128;
        if (i < 128) continue;
        i -= 128;
        {
            const int b = i >> 3, kv = (i >> 2) & 1, qt = i & 3, hh = kv * 4 + (w >> 1), rb = b * 256, wrow = rb + qt * 64 + 32 * (w & 1);
            const AttnSeg s0 = {qkv + (size_t)rb * QKV_LD + Q_KS + kv * 128, qkv + (size_t)rb * QKV_LD + Q_VS + kv * 128, QKV_LD, 4};
            MXREP(4) attn_mfma<128, false>(F, qkv + (size_t)wrow * QKV_LD + Q_QS + hh * 128, 0, s0, none, false, 0, 0, F.inp(I_SINK)[l * 8 + hh] * LOG2E, 1.0f, 0.f, 1.0f, nullptr, F.cat() + (size_t)wrow * DM + 1024 + hh * 128);
        }
    }
}

__device__ __forceinline__ void mg_merge(const Ctx& F, int l) {
    const int head = F.lane >> 4, sub = F.lane & 15, col0 = head * 128 + sub * 8;
    const gf32* g = F.inp(I_HNG) + l * 128 + sub * 8; const f32x4 g0 = *(const GAS f32x4*)g, g1 = *(const GAS f32x4*)(g + 4);
    for (int row = F.bid * 8 + F.wave; row < MROWS; row += F.G * 8) {
        const f32x4 a0 = *(const GAS f32x4*)(F.obf() + (size_t)row * 512 + col0) + *(const GAS f32x4*)(F.obb() + (size_t)row * 512 + col0);
        const f32x4 a1 = *(const GAS f32x4*)(F.obf() + (size_t)row * 512 + col0 + 4) + *(const GAS f32x4*)(F.obb() + (size_t)row * 512 + col0 + 4);
        float ss = (a0[0] * a0[0] + a0[1] * a0[1]) + (a0[2] * a0[2] + a0[3] * a0[3]) + (a1[0] * a1[0] + a1[1] * a1[1]) + (a1[2] * a1[2] + a1[3] * a1[3]);
        ss += __shfl_xor(ss, 1); ss += __shfl_xor(ss, 2); ss += __shfl_xor(ss, 4); ss += __shfl_xor(ss, 8);
        const float rinv = 1.0f / sqrtf(ss * (1.0f / 128.0f) + 1e-6f);
        const v4u hw = *(const GAS v4u*)(F.hgate() + (size_t)row * 512 + col0);
        const f32x4 h0 = bf2lo(hw.x, hw.y), h1 = bf2lo(hw.z, hw.w);
        float y[8];
#pragma unroll
        for (int i = 0; i < 4; ++i) { y[i] = a0[i] * rinv * g0[i] * h0[i]; y[4 + i] = a1[i] * rinv * g1[i] * h1[i]; }
        v4u w; w.x = pk2(y[0], y[1]); w.y = pk2(y[2], y[3]); w.z = pk2(y[4], y[5]); w.w = pk2(y[6], y[7]);
        *(GAS v4u*)(F.cat() + (size_t)row * DM + 512 + col0) = w;
    }
}

__device__ __forceinline__ void ln_phase(const Ctx& F, gy_t* Y, const gy_t* Y2, const gf32* g, const gf32* b, gf32* fout, const gf32* modsl  , int which_sh) {
    constexpr int SPLIT_ROW0 = 8192;
    f32x4 A[8], B[8]; int curmod = -1;
    for (int row = F.bid * 8 + F.wave; row < MROWS; row += F.G * 8) {
        f32x4 v[8]; float s = 0.f;
        const gy_t* yp = Y + (size_t)row * DM + F.lane * 8;
#if Y_BF16
        v4u w4[4], u4[4];
#pragma unroll
        for (int jj = 0; jj < 4; ++jj) w4[jj] = *(const GAS v4u*)(yp + 512 * jj);
        if (row >= SPLIT_ROW0) {
#pragma unroll
            for (int jj = 0; jj < 4; ++jj) u4[jj] = *(const GAS v4u*)(Y2 + (size_t)(row - SPLIT_ROW0) * DM + F.lane * 8 + 512 * jj);
        }
#endif
        const int mod = mod_of_row(row);
        if (mod != curmod) { curmod = mod;
            const gf32* sh = modsl ? modsl + ((size_t)mod * 6 + which_sh) * DM : nullptr;
#pragma unroll
            for (int j = 0; j < 8; ++j) { const int c = F.lane * 8 + 512 * (j >> 1) + 4 * (j & 1);
                A[j] = *(const GAS f32x4*)(g + c); B[j] = *(const GAS f32x4*)(b + c);
                if (modsl) { const f32x4 sc1 = *(const GAS f32x4*)(sh + DM + c) + 1.0f; A[j] = A[j] * sc1; B[j] = B[j] * sc1 + *(const GAS f32x4*)(sh + c); } }
        }
#if Y_BF16
#pragma unroll
        for (int jj = 0; jj < 4; ++jj) { v[2 * jj] = bf2lo(w4[jj].x, w4[jj].y); v[2 * jj + 1] = bf2lo(w4[jj].z, w4[jj].w); }
        if (row >= SPLIT_ROW0) {
#pragma unroll
            for (int jj = 0; jj < 4; ++jj) { v[2 * jj] += bf2lo(u4[jj].x, u4[jj].y); v[2 * jj + 1] += bf2lo(u4[jj].z, u4[jj].w);
                v4u o; o.x = pk2(v[2 * jj][0], v[2 * jj][1]); o.y = pk2(v[2 * jj][2], v[2 * jj][3]); o.z = pk2(v[2 * jj + 1][0], v[2 * jj + 1][1]); o.w = pk2(v[2 * jj + 1][2], v[2 * jj + 1][3]);
                *(GAS v4u*)(Y + (size_t)row * DM + F.lane * 8 + 512 * jj) = o; v[2 * jj] = bf2lo(o.x, o.y); v[2 * jj + 1] = bf2lo(o.z, o.w); }
        }
#else
#pragma unroll
        for (int jj = 0; jj < 4; ++jj) { v[2 * jj] = *(const GAS f32x4*)(yp + 512 * jj); v[2 * jj + 1] = *(const GAS f32x4*)(yp + 512 * jj + 4); }
        if (row >= SPLIT_ROW0) {
#pragma unroll
            for (int jj = 0; jj < 4; ++jj) { const gy_t* y2 = Y2 + (size_t)(row - SPLIT_ROW0) * DM + F.lane * 8 + 512 * jj; v[2 * jj] += *(const GAS f32x4*)y2; v[2 * jj + 1] += *(const GAS f32x4*)(y2 + 4);
                *(GAS f32x4*)(Y + (size_t)row * DM + F.lane * 8 + 512 * jj) = v[2 * jj]; *(GAS f32x4*)(Y + (size_t)row * DM + F.lane * 8 + 512 * jj + 4) = v[2 * jj + 1]; }
        }
#endif
#pragma unroll
        for (int j = 0; j < 8; ++j) s += (v[j][0] + v[j][1]) + (v[j][2] + v[j][3]);
#pragma unroll
        for (int o = 1; o < 64; o <<= 1) s += __shfl_xor(s, o);
        const float mean = s * (1.0f / DM); float s2 = 0.f;
#pragma unroll
        for (int j = 0; j < 8; ++j) { v[j] = v[j] - mean; s2 += (v[j][0] * v[j][0] + v[j][1] * v[j][1]) + (v[j][2] * v[j][2] + v[j][3] * v[j][3]); }
#pragma unroll
        for (int o = 1; o < 64; o <<= 1) s2 += __shfl_xor(s2, o);
        const float rstd = 1.0f / sqrtf(s2 * (1.0f / DM) + 1e-5f);
        if (F.lane == 0) *(GAS pg8::f32x2*)(F.stats() + 2 * (size_t)row) = (pg8::f32x2){mean, rstd};
#pragma unroll
        for (int jj = 0; jj < 4; ++jj) { const int c = F.lane * 8 + 512 * jj;
            const f32x4 x0 = v[2 * jj] * rstd * A[2 * jj] + B[2 * jj], x1 = v[2 * jj + 1] * rstd * A[2 * jj + 1] + B[2 * jj + 1];
            if (fout) { *(GAS f32x4*)(fout + (size_t)row * DM + c) = x0; *(GAS f32x4*)(fout + (size_t)row * DM + c + 4) = x1; }
            else { v4u w; w.x = pk2(x0[0], x0[1]); w.y = pk2(x0[2], x0[3]); w.z = pk2(x1[0], x1[1]); w.w = pk2(x1[2], x1[3]); *(GAS v4u*)(F.hbuf() + (size_t)row * DM + c) = w; } }
    }
}

constexpr int PH_PER_LAYER = 10, N_PHASES = 2 + DEPTH * PH_PER_LAYER;
__global__ void __launch_bounds__(512, 2) fwd_kernel(Args args) {
    extern __shared__ __attribute__((aligned(16))) unsigned char lds_raw[];
    Ctx F;
    F.lds = (LAS unsigned char*)lds_raw;
    F.tid = threadIdx.x; F.lane = F.tid & 63; F.wave = __builtin_amdgcn_readfirstlane(F.tid >> 6); F.G = gridDim.x; F.bid = blockIdx.x;
    F.ap = &args; F.out = (gf32*)args.out; F.ws = (GAS unsigned char*)args.ws;
    volatile LAS unsigned* MISC = (volatile LAS unsigned*)(F.lds + MISC_OFF);
    for (int u = F.tid; u < (LDS_BYTES - LDSCTL_OFF) / 4; u += 512) ((LAS unsigned*)(F.lds + LDSCTL_OFF))[u] = 0u;
    __syncthreads();
    XcdBarrier bar; bar.bar = (unsigned*)(args.ws + WS_CTL) + CW_BAR; bar.x = 0; bar.st = nullptr;
    if (args.single) bar = xcd_barrier_post((unsigned*)(args.ws + WS_CTL) + CW_BAR, MISC + 8);
    const int lo = args.ph_lo, hi = args.ph_hi;
#define IN(k) (lo <= (k) && (k) < hi)
#define FRESH() do { int ln_ = (int)__builtin_amdgcn_mbcnt_hi(~0u, __builtin_amdgcn_mbcnt_lo(~0u, 0u)); asm volatile("" : "+v"(ln_)); F.lane = ln_; asm volatile("" : "+s"(F.wave)); F.tid = F.wave * 64 + F.lane; \
    asm volatile("" : "+s"(F.bid), "+s"(F.G)); asm volatile("" : "+s"(F.ws), "+s"(F.out)); } while (0)
#define SEAM(k) do { if (IN((k) + 1)) xcd_barrier(bar); } while (0)

    if (IN(0)) { FRESH(); p0_prologue(F); SEAM(0); }
    if (IN(1)) { FRESH(); p1_h0(F); SEAM(1); }
    for (int l = 0; l < DEPTH; ++l) {
        const int k0 = 2 + l * PH_PER_LAYER;
        FRESH();
        gy_t* ya = (gy_t*)F.ybuf(0); gy_t* yb = (gy_t*)F.ybuf(1); gy_t* y2 = (gy_t*)F.ybuf(2);
        if (IN(k0 + 0)) {
            const int ncv = (F.G == 256 && l + 1 < DEPTH) ? 40 : 0, ng = F.G - ncv;
            if (F.bid < ng) { pg8::Gemm g{(const pg8::bf16_t*)F.hbuf(), (const pg8::bf16_t*)F.wT(l, WO_IN), MROWS, DIN, DM, DM}; G1Order S; S.init(MROWS, DIN, ng, F.bid);
                EpiProj E{F.qkv(), F.out, F.tabD(), F.tabS(), l, F.hq(0), F.hkm(0), F.hkp(0), F.hvt(0), F.hdec(0), F.hgate(), F.lball() + l * 1024};
                pg8::gemm_phase<EpiProj, G1Order, true, true>(F.lds, g, S, E, F.wave); }
            else convert_fast(F, (l + 1) * F_L, (l + 1) * F_L + F_SPLIT, (F.bid - ng) * 8 + F.wave, ncv * 8);
            if (F.G != 256 && l + 1 < DEPTH) { __syncthreads(); convert_fast(F, (l + 1) * F_L, (l + 1) * F_L + F_SPLIT, F.bid * 8 + F.wave, F.G * 8); }
            SEAM(k0 + 0); }
        if (IN(k0 + 2)) { FRESH(); hp_states(F, l); SEAM(k0 + 2); }
        if (IN(k0 + 3)) { FRESH(); mx_mixers(F, l); SEAM(k0 + 3); }
        if (IN(k0 + 5)) {
            EpiResid E{F.inp(I_XP), F.inp(I_XS), yb, F.stats(), F.inp(I_LN2G) + (l ? l - 1 : 0) * DM, F.inp(I_LN2B) + (l ? l - 1 : 0) * DM, F.mods() + ((size_t)l * 3 * 6 + 2) * DM, ya, 0, 0, l ? 1 : 0};
            { pg8::Gemm g{(const pg8::bf16_t*)F.cat(), (const pg8::bf16_t*)F.wT(l, WO_OUT), 8192, DM, DM, DM}; pg8::StaticOrder S; S.init(8192, DM, F.G, F.bid);
              pg8::gemm_phase<EpiResid, pg8::StaticOrder, true, true>(F.lds, g, S, E, F.wave); }
            __syncthreads();
            { const int kh = F.bid >> 7; pg8::Gemm g{(const pg8::bf16_t*)(F.cat() + (size_t)8192 * DM + kh * (DM / 2)), (const pg8::bf16_t*)(F.wT(l, WO_OUT) + kh * (DM / 2)), 4096, DM, DM / 2, DM}; pg8::StaticOrder S; S.init(4096, DM, 128, F.bid & 127);
              E.out = kh ? y2 : ya; E.pm_off = 32; E.gate_only = kh;
              pg8::gemm_phase<EpiResid, pg8::StaticOrder, true, true>(F.lds, g, S, E, F.wave); }
            SEAM(k0 + 5); }
        if (IN(k0 + 6)) { FRESH(); ln_phase(F, ya, y2, F.inp(I_LN1G) + l * DM, F.inp(I_LN1B) + l * DM, nullptr, F.mods() + (size_t)l * 3 * 6 * DM, 3); SEAM(k0 + 6); }
        if (IN(k0 + 7)) {
            const int ncv = (F.G == 256 && l + 1 < DEPTH) ? 16 : 0, ng = F.G - ncv;
            if (F.bid < ng) { pg8::Gemm g{(const pg8::bf16_t*)F.hbuf(), (const pg8::bf16_t*)F.wT(l, WO_GU), MROWS, DGU, DM, DM}; pg8::StaticOrder S; S.init(MROWS, DGU, ng, F.bid);
                EpiSwiGLU E{F.act()};
                pg8::gemm_phase<EpiSwiGLU, pg8::StaticOrder, true, true>(F.lds, g, S, E, F.wave); }
            else convert_fast(F, (l + 1) * F_L + F_SPLIT, (l + 2) * F_L, (F.bid - ng) * 8 + F.wave, ncv * 8);
            if (F.G != 256 && l + 1 < DEPTH) { __syncthreads(); convert_fast(F, (l + 1) * F_L + F_SPLIT, (l + 2) * F_L, F.bid * 8 + F.wave, F.G * 8); }
            SEAM(k0 + 7); }
        if (IN(k0 + 8)) {
            EpiResid E{nullptr, nullptr, ya, F.stats(), F.inp(I_LN1G) + l * DM, F.inp(I_LN1B) + l * DM, F.mods() + ((size_t)l * 3 * 6 + 5) * DM, yb, 0, 0, 1};
            { pg8::Gemm g{(const pg8::bf16_t*)F.act(), (const pg8::bf16_t*)F.wT(l, WO_DN), 8192, DM, DFF, DFF}; pg8::StaticOrder S; S.init(8192, DM, F.G, F.bid);
              pg8::gemm_phase<EpiResid, pg8::StaticOrder, true, true>(F.lds, g, S, E, F.wave); }
            __syncthreads();
            { const int kh = F.bid >> 7; pg8::Gemm g{(const pg8::bf16_t*)(F.act() + (size_t)8192 * DFF + kh * (DFF / 2)), (const pg8::bf16_t*)(F.wT(l, WO_DN) + kh * (DFF / 2)), 4096, DM, DFF / 2, DFF}; pg8::StaticOrder S; S.init(4096, DM, 128, F.bid & 127);
              E.out = kh ? y2 : yb; E.pm_off = 32; E.gate_only = kh;
              pg8::gemm_phase<EpiResid, pg8::StaticOrder, true, true>(F.lds, g, S, E, F.wave); }
            SEAM(k0 + 8); }
        if (IN(k0 + 9)) { FRESH(); ln_phase(F, yb, y2, F.inp(I_LN2G) + l * DM, F.inp(I_LN2B) + l * DM, l + 1 < DEPTH ? nullptr : F.out + O_YP, l + 1 < DEPTH ? F.mods() + (size_t)(l + 1) * 3 * 6 * DM : nullptr, 0); SEAM(k0 + 9); }
    }
#undef IN
#undef SEAM
#undef FRESH
}

#ifndef MK_SINGLE
#define MK_SINGLE 1
#endif
extern "C" void kernel_launch(void* const* d_in, const int* in_sizes, int n_in, void* d_out, int out_size, void* d_ws, size_t ws_size, hipStream_t stream) {
    static int grid = 0;
    if (grid == 0) {
        if (n_in != 24 || out_size != (int)O_END || ws_size < WS_END) { fprintf(stderr, "kernel_launch: unexpected sizes n_in %d out %d ws %zu\n", n_in, out_size, ws_size); grid = -1; return; }
        int dev = 0, cus = 0, per_cu = 0;
        if (hipGetDevice(&dev) != hipSuccess || hipDeviceGetAttribute(&cus, hipDeviceAttributeMultiprocessorCount, dev) != hipSuccess) { grid = -1; return; }
        if (hipFuncSetAttribute((const void*)fwd_kernel, hipFuncAttributeMaxDynamicSharedMemorySize, LDS_BYTES) != hipSuccess) { fprintf(stderr, "kernel_launch: hipFuncSetAttribute failed\n"); grid = -1; return; }
        if (hipOccupancyMaxActiveBlocksPerMultiprocessor(&per_cu, (const void*)fwd_kernel, 512, LDS_BYTES) != hipSuccess || per_cu < 1) fprintf(stderr, "kernel_launch: occupancy query says %d\n", per_cu);
        (void)hipGetLastError();
        grid = cus;
    }
    if (grid < 0) return;
    (void)hipMemsetAsync((char*)d_ws + WS_CTL, 0, CTL_ZERO_BYTES, stream);
    Args a{};
    for (int i = 0; i < 24; ++i) a.in[i] = (const float*)d_in[i];
    a.out = (float*)d_out; a.ws = (unsigned char*)d_ws; a.pad = 0;
#if MK_SINGLE
    a.ph_lo = 0; a.ph_hi = N_PHASES; a.single = 1;
    hipLaunchKernelGGL(fwd_kernel, dim3(grid), dim3(512), LDS_BYTES, stream, a);
#else
    a.single = 0;
    for (int p = 0; p < N_PHASES; ++p) { a.ph_lo = p; a.ph_hi = p + 1; hipLaunchKernelGGL(fwd_kernel, dim3(grid), dim3(512), LDS_BYTES, stream, a);
#ifdef PROBE_REP_MASK
        const int ty = p == 0 ? 10 : (p == 1 ? 11 : (p - 2) % PH_PER_LAYER);
        if ((PROBE_REP_MASK >> ty) & 1) for (int r = 0; r < PROBE_REP_N; ++r) hipLaunchKernelGGL(fwd_kernel, dim3(grid), dim3(512), LDS_BYTES, stream, a);
#endif
    }
#endif
}
```

```cpp
#include <hip/hip_runtime.h>
#include <cstdio>
#include <cstdint>
namespace pg8 {
#define PG8_LAS __attribute__((address_space(3)))
typedef unsigned short bf16_t;
typedef short bf16x8 __attribute__((ext_vector_type(8)));
typedef float f32x4 __attribute__((ext_vector_type(4)));
typedef unsigned u32x4 __attribute__((ext_vector_type(4)));
constexpr int BM = 256, BK = 64, HALF = 128, HTB = HALF * BK * 2  , STAGE_BYTES = 8 * HTB, NXCD = 8, WGM = 8;

__host__ __device__ __forceinline__ int lds_byte(int r, int c) { const int st = (r >> 4) * 2 + (c >> 5), rr = r & 15, cc = c & 31, ob = rr * 64 + cc * 2; return st * 1024 + (ob ^ (((ob >> 9) & 1) << 5)); }
__host__ __device__ __forceinline__ void stage_rc(int b, int& R, int& C) { const int st = b / 1024, sb = b % 1024, swz = sb ^ (((sb >> 9) & 1) << 5); R = (st >> 1) * 16 + swz / 64; C = (st & 1) * 32 + (swz % 64) / 2; }
__host__ __device__ __forceinline__ int perm32(int rho) { const int n = rho >> 4, i = rho & 15; return 8 * (i >> 2) + 4 * n + (i & 3); }

struct Unit { int pm, pn; };
struct Gemm { const bf16_t* A; const bf16_t* Bt; int M, N, K, ld; };

struct StaticOrder {
    int nM, nN, nwg, G, c;
    __host__ __device__ void init(int M, int N, int G_, int c_) { nM = M / BM; nN = N / BM; nwg = nM * nN; G = G_; c = c_; }
    __host__ __device__ bool next(int i, Unit& u) const {
        const long L = (long)i * G + c; if (L >= nwg) return false;
        int wgid = (int)L; { const int q = nwg / NXCD, r = nwg % NXCD, xcd = wgid % NXCD, off = wgid / NXCD; wgid = (xcd < r ? xcd * (q + 1) : r * (q + 1) + (xcd - r) * q) + off; }
        const int nig = WGM * nN, gid = wgid / nig, fm = gid * WGM, gsz = (nM - fm) < WGM ? (nM - fm) : WGM;
        u.pm = fm + ((wgid % nig) % gsz); u.pn = (wgid % nig) / gsz; return true;
    }
    __device__ __forceinline__ void a_ready(const Unit&) const {}
    __device__ __forceinline__ void done(const Unit&) const {}
};
__device__ __forceinline__ unsigned cvt_pk_bf16(float lo, float hi) { unsigned r; asm volatile("v_cvt_pk_bf16_f32 %0, %1, %2" : "=v"(r) : "v"(lo), "v"(hi)); return r; }
typedef float f32x2 __attribute__((ext_vector_type(2)));
template <class Epi, class Sched, bool ALIGN_EPI = false, bool SP2 = false>
__device__ __forceinline__ void gemm_phase(PG8_LAS unsigned char* lds, const Gemm g, const Sched& S, const Epi& E, int wid_in) {
    int lane_ = (int)__builtin_amdgcn_mbcnt_hi(~0u, __builtin_amdgcn_mbcnt_lo(~0u, 0u)); asm volatile("" : "+v"(lane_)); asm volatile("" : "+s"(wid_in));
    const int wid = wid_in, lane = lane_, tid = wid * 64 + lane, wr = wid >> 2, wc = wid & 3, fr = lane & 15, fq = lane >> 4;
    const int K = g.K, nt = K / BK, LD = g.ld;
    unsigned voffA[2], voffB[2];
#pragma unroll
    for (int i = 0; i < 2; ++i) { int R, C; stage_rc(tid * 16 + i * 8192, R, C); const int Rb = Epi::PERM ? ((R & ~31) + perm32(R & 31)) : R;
        voffA[i] = (unsigned)(R * LD + C) * 2u; voffB[i] = (unsigned)(Rb * LD + C) * 2u; }
    const size_t kstep = (size_t)(BK * 2);
    const size_t hstep = (size_t)HALF * LD * 2;
    const size_t tstep = 2 * hstep;
    const unsigned ldsw = (unsigned)wid * 1024u;
    const int aoff = lds_byte(wr * 64 + fr, fq * 8), boff = lds_byte(wc * 32 + fr, fq * 8);
#define PG8_SA(b, h) (((b) * 2 + (h)) * HTB)
#define PG8_SB(b, h) ((4 + (b) * 2 + (h)) * HTB)
#define PG8_STAGE(bufoff, gbase, voff) do { _Pragma("unroll") for (int _i = 0; _i < 2; ++_i) \
        __builtin_amdgcn_global_load_lds((const unsigned*)((const char*)(gbase) + (voff)[_i]), (PG8_LAS unsigned*)(lds + (bufoff) + ldsw + _i * 8192), 16, 0, 0); } while (0)
#define PG8_LDA(dst, b, h) do { _Pragma("unroll") for (int m = 0; m < 4; ++m) _Pragma("unroll") for (int k = 0; k < 2; ++k) dst[m][k] = *(const PG8_LAS bf16x8*)(lds + PG8_SA(b, h) + aoff + m * 2048 + k * 1024); } while (0)
#define PG8_LDB(dst, b, h) do { _Pragma("unroll") for (int n = 0; n < 2; ++n) _Pragma("unroll") for (int k = 0; k < 2; ++k) dst[n][k] = *(const PG8_LAS bf16x8*)(lds + PG8_SB(b, h) + boff + n * 2048 + k * 1024); } while (0)
#define PG8_MMA(ai, bj, At, Bt) do { __builtin_amdgcn_s_setprio(1); _Pragma("unroll") for (int m = 0; m < 4; ++m) _Pragma("unroll") for (int n = 0; n < 2; ++n) _Pragma("unroll") for (int k = 0; k < 2; ++k) \
        acc[ai][bj][m][n] = __builtin_amdgcn_mfma_f32_16x16x32_bf16(Bt[n][k], At[m][k], acc[ai][bj][m][n], 0, 0, 0); __builtin_amdgcn_s_setprio(0); } while (0)
#define PG8_WAIT_V(n) asm volatile("s_waitcnt vmcnt(" #n ")" ::: "memory")
#define PG8_WAIT_L(n) asm volatile("s_waitcnt lgkmcnt(" #n ")" ::: "memory")
#define PG8_BAR __builtin_amdgcn_s_barrier()
#define PG8_SCHED __builtin_amdgcn_sched_barrier(0)
    Unit cur, nxt; int ui = 0;
    if (!S.next(0, cur)) return;
    f32x4 acc[2][2][4][2];
#pragma unroll
    for (int a = 0; a < 2; ++a)
#pragma unroll
        for (int b = 0; b < 2; ++b)
#pragma unroll
            for (int m = 0; m < 4; ++m)
#pragma unroll
                for (int n = 0; n < 2; ++n) acc[a][b][m][n] = (f32x4){0.f, 0.f, 0.f, 0.f};
    bf16x8 At[4][2], B0[2][2], B1[2][2];
    const char* cA = (const char*)g.A + (size_t)cur.pm * tstep; const char* cB = (const char*)g.Bt + (size_t)cur.pn * tstep;
    S.a_ready(cur);
    if constexpr (SP2) {
        PG8_STAGE(PG8_SB(0, 0), cB, voffB); PG8_STAGE(PG8_SB(0, 1), cB + hstep, voffB); PG8_STAGE(PG8_SA(0, 0), cA, voffA); PG8_STAGE(PG8_SA(0, 1), cA + hstep, voffA);
        if (wr == 1) PG8_BAR;
        PG8_WAIT_V(2); PG8_BAR;
        PG8_STAGE(PG8_SB(1, 0), cB + kstep, voffB); PG8_STAGE(PG8_SA(1, 0), cA + kstep, voffA); PG8_STAGE(PG8_SB(1, 1), cB + hstep + kstep, voffB);
        PG8_WAIT_V(6); PG8_BAR;
    } else {
        PG8_STAGE(PG8_SB(0, 0), cB, voffB); PG8_STAGE(PG8_SA(0, 0), cA, voffA); PG8_STAGE(PG8_SB(0, 1), cB + hstep, voffB); PG8_STAGE(PG8_SA(0, 1), cA + hstep, voffA);
        if (wr == 1) PG8_BAR;
        PG8_WAIT_V(4); PG8_BAR;
        PG8_STAGE(PG8_SB(1, 0), cB + kstep, voffB); PG8_STAGE(PG8_SA(1, 0), cA + kstep, voffA); PG8_STAGE(PG8_SB(1, 1), cB + hstep + kstep, voffB);
        PG8_WAIT_V(6); PG8_BAR;
    }
    for (;;) {
        const bool has_next = S.next(ui + 1, nxt);
        const char* nA = has_next ? (const char*)g.A + (size_t)nxt.pm * tstep : cA; const char* nB = has_next ? (const char*)g.Bt + (size_t)nxt.pn * tstep : cB;
        for (int t = 0; t < nt; t += 2) {
            const bool last = (t == nt - 2);
            const char* a1 = cA + (size_t)(t + 1) * kstep;
            const char* a2 = last ? nA : cA + (size_t)(t + 2) * kstep; const char* b2 = last ? nB : cB + (size_t)(t + 2) * kstep;
            const char* a3 = a2 + kstep; const char* b3 = b2 + kstep;
            if (last && has_next) S.a_ready(nxt);
            if constexpr (SP2) {
            PG8_LDB(B0, 0, 0); PG8_LDB(B1, 0, 1); PG8_SCHED; PG8_LDA(At, 0, 0); PG8_STAGE(PG8_SA(1, 1), a1 + hstep, voffA);
            PG8_WAIT_V(8); PG8_WAIT_L(0); PG8_BAR; PG8_MMA(0, 0, At, B0); PG8_MMA(0, 1, At, B1); PG8_BAR; PG8_SCHED;
            PG8_LDA(At, 0, 1); PG8_STAGE(PG8_SB(0, 0), b2, voffB); PG8_STAGE(PG8_SB(0, 1), b2 + hstep, voffB); PG8_STAGE(PG8_SA(0, 0), a2, voffA);
            PG8_WAIT_V(8); PG8_WAIT_L(0); PG8_BAR; PG8_MMA(1, 0, At, B0); PG8_MMA(1, 1, At, B1); PG8_BAR; PG8_SCHED;
            PG8_LDB(B0, 1, 0); PG8_LDB(B1, 1, 1); PG8_SCHED; PG8_LDA(At, 1, 0); PG8_STAGE(PG8_SA(0, 1), a2 + hstep, voffA);
            PG8_WAIT_V(8); PG8_WAIT_L(0); PG8_BAR; PG8_MMA(0, 0, At, B0); PG8_MMA(0, 1, At, B1); PG8_BAR; PG8_SCHED;
            PG8_LDA(At, 1, 1); PG8_STAGE(PG8_SB(1, 0), b3, voffB); PG8_STAGE(PG8_SB(1, 1), b3 + hstep, voffB); PG8_STAGE(PG8_SA(1, 0), a3, voffA);
            PG8_WAIT_V(8); PG8_WAIT_L(0); PG8_BAR; PG8_MMA(1, 0, At, B0); PG8_MMA(1, 1, At, B1); PG8_BAR; PG8_SCHED;
            } else {
            PG8_LDB(B0, 0, 0); PG8_SCHED; PG8_LDA(At, 0, 0); PG8_STAGE(PG8_SA(1, 1), a1 + hstep, voffA);
            PG8_WAIT_L(8); PG8_BAR; PG8_WAIT_L(0); PG8_MMA(0, 0, At, B0); PG8_BAR; PG8_SCHED;
            PG8_LDB(B1, 0, 1); PG8_STAGE(PG8_SB(0, 0), b2, voffB);
            PG8_BAR; PG8_WAIT_L(0); PG8_MMA(0, 1, At, B1); PG8_BAR;
            PG8_LDA(At, 0, 1); PG8_STAGE(PG8_SA(0, 0), a2, voffA);
            PG8_BAR; PG8_WAIT_L(0); PG8_MMA(1, 0, At, B0); PG8_BAR; PG8_SCHED;
            PG8_STAGE(PG8_SB(0, 1), b2 + hstep, voffB);
            PG8_WAIT_V(6); PG8_BAR; PG8_MMA(1, 1, At, B1); PG8_BAR;
            PG8_LDB(B0, 1, 0); PG8_SCHED; PG8_LDA(At, 1, 0); PG8_STAGE(PG8_SA(0, 1), a2 + hstep, voffA);
            PG8_WAIT_L(8); PG8_BAR; PG8_WAIT_L(0); PG8_MMA(0, 0, At, B0); PG8_BAR; PG8_SCHED;
            PG8_LDB(B1, 1, 1); PG8_STAGE(PG8_SB(1, 0), b3, voffB);
            PG8_BAR; PG8_WAIT_L(0); PG8_MMA(0, 1, At, B1); PG8_BAR;
            PG8_LDA(At, 1, 1); PG8_STAGE(PG8_SA(1, 0), a3, voffA);
            PG8_BAR; PG8_WAIT_L(0); PG8_MMA(1, 0, At, B0); PG8_BAR; PG8_SCHED;
            PG8_STAGE(PG8_SB(1, 1), b3 + hstep, voffB);
            PG8_WAIT_V(6); PG8_BAR; PG8_MMA(1, 1, At, B1); PG8_BAR;
            }
        }
        if constexpr (ALIGN_EPI) { if (wr == 0) PG8_BAR; }
        if constexpr (!Epi::AFTER_DRAIN) { E(acc, cur, wr, wc, fr, fq); S.done(cur); }
        if (!has_next) break;
#pragma unroll
        for (int a = 0; a < 2; ++a)
#pragma unroll
            for (int b = 0; b < 2; ++b)
#pragma unroll
                for (int m = 0; m < 4; ++m)
#pragma unroll
                    for (int n = 0; n < 2; ++n) acc[a][b][m][n] = (f32x4){0.f, 0.f, 0.f, 0.f};
        cur = nxt; cA = nA; cB = nB; ++ui;
        if constexpr (ALIGN_EPI) { if (wr == 1) PG8_BAR; }
    }
    PG8_WAIT_V(0);
    if constexpr (!ALIGN_EPI) { if (wr == 0) PG8_BAR; }
    PG8_BAR;
    if constexpr (Epi::AFTER_DRAIN) { E.fused(acc, cur, wr, wc, fr, fq, lds, wid, lane); S.done(cur); }
#undef PG8_SA
#undef PG8_SB
#undef PG8_STAGE
#undef PG8_LDA
#undef PG8_LDB
#undef PG8_MMA
#undef PG8_WAIT_V
#undef PG8_WAIT_L
#undef PG8_BAR
#undef PG8_SCHED
}
}
#define GAS __attribute__((address_space(1)))
#define LAS __attribute__((address_space(3)))
typedef unsigned short bf16;
typedef unsigned v4u __attribute__((ext_vector_type(4)));
typedef float f32x4 __attribute__((ext_vector_type(4)));
typedef short bf16x8 __attribute__((ext_vector_type(8)));
typedef GAS unsigned gu32;
typedef GAS unsigned long long gu64;
#define RLX_AGENT __ATOMIC_RELAXED, __HIP_MEMORY_SCOPE_AGENT
#define LDS_WAIT() asm volatile("s_waitcnt lgkmcnt(0)" ::: "memory")
#define VM_WAIT() asm volatile("s_waitcnt vmcnt(0)" ::: "memory")
__device__ __forceinline__ unsigned long long rt() { return __builtin_amdgcn_s_memrealtime(); }
typedef __bf16 hw_bf16x2 __attribute__((ext_vector_type(2)));
typedef float hw_f32x2 __attribute__((ext_vector_type(2)));
__device__ __forceinline__ unsigned pk2(float lo, float hi) { const hw_f32x2 f = {lo, hi}; return __builtin_bit_cast(unsigned, __builtin_convertvector(f, hw_bf16x2)); }
__device__ __forceinline__ unsigned f2bf(float f) { return pk2(f, 0.f) & 0xffffu; }
#define XB_TMO      128
#define XB_XCNT(j)  (256  + 64 * (j))
#define XB_XSUB(j)  (1280 + 64 * (j))
#define XB_XGEN(j)  (2304 + 64 * (j))
#define XB_TOP      3328
#define XB_TOPGEN   3392
#define XCD_BAR_WORDS 3456
#define XB_SPIN_CAP (1u << 24)

__device__ __forceinline__ unsigned xb_ld(unsigned* p)              { return __hip_atomic_load(p, __ATOMIC_RELAXED, __HIP_MEMORY_SCOPE_AGENT); }
__device__ __forceinline__ unsigned xb_add(unsigned* p, unsigned v) { return __hip_atomic_fetch_add(p, v, __ATOMIC_RELAXED, __HIP_MEMORY_SCOPE_AGENT); }
__device__ __forceinline__ unsigned xb_xcc_id() { return (unsigned)__builtin_amdgcn_s_getreg((3 << 11) | 20) & 0xFu; }
#define XB_SPIN(cond, bar) do { unsigned _sp = 0; while (cond) { __builtin_amdgcn_s_sleep(1); \
    if ((++_sp & 255u) == 0u) { if (xb_ld(&(bar)[XB_TMO])) break; if (_sp > XB_SPIN_CAP) { atomicAdd(&(bar)[XB_TMO], 1u); break; } } } } while (0)

struct XcdBarrier {
    unsigned* bar; unsigned x;
    volatile LAS unsigned* st;
};

__device__ __forceinline__ XcdBarrier xcd_barrier_post(unsigned* bar, volatile LAS unsigned* st) {
    XcdBarrier b; b.bar = bar; b.x = xb_xcc_id(); b.st = st;
    if (threadIdx.x == 0) (void)xb_add(&bar[XB_XCNT(b.x)], 1u);
    return b;
}
__device__ __forceinline__ void xcd_barrier_complete(unsigned* bar, unsigned x, unsigned& nloc, unsigned& nx) {
    const unsigned G = gridDim.x * gridDim.y * gridDim.z;
    unsigned sum, cnt, mine, sp = 0u;
    for (;;) {
        sum = 0u; cnt = 0u; mine = 0u;
#pragma unroll
        for (unsigned j = 0; j < 16; ++j) { const unsigned c = xb_ld(&bar[XB_XCNT(j)]); sum += c; cnt += (c > 0u) ? 1u : 0u; mine = (j == x) ? c : mine; }
        if (sum == G) break;
        __builtin_amdgcn_s_sleep(1);
        if ((++sp & 255u) == 0u) { if (xb_ld(&bar[XB_TMO])) break; if (sp > XB_SPIN_CAP) { atomicAdd(&bar[XB_TMO], 1u); break; } }
    }
    nloc = mine > 0u ? mine : 1u; nx = cnt > 0u ? cnt : 1u;
}

__device__ __forceinline__ void xcd_barrier(const XcdBarrier& b) {
    asm volatile("s_waitcnt vmcnt(0)" ::: "memory");
    __syncthreads();
    if (threadIdx.x == 0) {
        unsigned* bar = b.bar;
        __builtin_amdgcn_s_waitcnt(0);
        unsigned nloc = b.st[0], nx = b.st[1];
        if (nloc == 0u) { xcd_barrier_complete(bar, b.x, nloc, nx); b.st[0] = nloc; b.st[1] = nx; }
        const unsigned old = xb_add(&bar[XB_XSUB(b.x)], 1u);
        const unsigned gen = old / nloc;
        if (old + 1u == (gen + 1u) * nloc) {
            __builtin_amdgcn_fence(__ATOMIC_RELEASE, "agent");
            asm volatile("s_waitcnt vmcnt(0)" ::: "memory");
            const unsigned og = xb_add(&bar[XB_TOP], 1u);
            const unsigned tg = og / nx;
            if (og + 1u == (tg + 1u) * nx) xb_add(&bar[XB_TOPGEN], 1u);
            else XB_SPIN(xb_ld(&bar[XB_TOPGEN]) == tg, bar);
            __builtin_amdgcn_fence(__ATOMIC_ACQUIRE, "agent");
            xb_add(&bar[XB_XGEN(b.x)], 1u);
            asm volatile("s_waitcnt vmcnt(0)" ::: "memory");
        } else {
            XB_SPIN(xb_ld(&bar[XB_XGEN(b.x)]) == gen, bar);
            __builtin_amdgcn_fence(__ATOMIC_ACQUIRE, "agent");
            asm volatile("s_waitcnt vmcnt(0)" ::: "memory");
        }
    }
    __syncthreads();
}

constexpr int DM = 2048;
constexpr int NB_CTX = 16, S_CTX = 256, NB_LAT = 2, S_LAT = 4096, DEPTH = 4;
constexpr int R_CTX = NB_CTX * S_CTX;
constexpr int R_LAT = NB_LAT * S_LAT;
constexpr int MROWS = R_CTX + R_LAT;
constexpr int DIN = 5632, DFF = 5632, DGU = 2 * DFF;
constexpr float ALPHA = 1.6817928305074292f;
constexpr int C_AQ = 0, C_AK = 512, C_AV = 1024, C_BQ = 1536, C_BF = 2048, C_BB = 2560, C_BI = 3072, C_BG = 3584, C_CQ = 4096, C_CK = 5120, C_CV = 5376;
constexpr size_t O_YP = 0, O_YS = 8388608, O_DK = 25165824, O_DV = 33554432, O_SK = 41943040, O_SV = 46137344, O_ST = 50331648, O_END = 58720256;

constexpr size_t MiB = 1u << 20;
constexpr size_t WS_CTL = 0, CTL_ZERO_BYTES = 1 * MiB;
constexpr size_t WS_MODS = 1 * MiB;
constexpr size_t WS_MISC = 2 * MiB;
constexpr size_t WS_W = 4 * MiB, W_LAYER = 96 * MiB;
constexpr size_t WO_IN = 0, WO_OUT = 22 * MiB, WO_GU = 30 * MiB, WO_DN = 74 * MiB;
constexpr size_t WS_H = 388 * MiB;
constexpr size_t WS_CAT = 436 * MiB;
constexpr size_t WS_X1 = 484 * MiB;
constexpr size_t WS_OA = 580 * MiB, WS_OBF = 604 * MiB, WS_OBB = 628 * MiB;
constexpr size_t WS_P = 652 * MiB;
constexpr size_t WS_ACT = WS_P, WS_YPRE = WS_P + 132 * MiB;
constexpr size_t WS_C16 = 916 * MiB;
constexpr size_t WS_QKV = 922 * MiB;
constexpr int HP_LD = 2560;
constexpr int QKV_LD = 3072, Q_QD = 0, Q_KD = 512, Q_VD = 1024, Q_QS = 1536, Q_KS = 2560, Q_VS = 2816;
constexpr size_t WS_HQ = 994 * MiB;
constexpr size_t WS_HKM = 1018 * MiB;
constexpr size_t WS_HKP = 1042 * MiB;
constexpr size_t WS_HVT = 1066 * MiB;
constexpr size_t WS_HDEC = 1090 * MiB;
constexpr size_t WS_SLOC = 1094 * MiB;
constexpr size_t WS_DSEG = 1110 * MiB;
constexpr size_t WS_YPRE2 = 1111 * MiB;
constexpr size_t WS_END = 1143 * MiB;

constexpr int CW_BAR = 4096;

constexpr int RING_BYTES = 131072;
constexpr int LDSCTL_OFF = RING_BYTES, MISC_OFF = LDSCTL_OFF + 320;
constexpr int LDS_BYTES = 147456;

typedef unsigned v2u __attribute__((ext_vector_type(2)));
typedef GAS float gf32;
typedef GAS unsigned short gbf16;

__device__ __forceinline__ float silu_f(float a) { return a / (1.0f + __expf(-a)); }
__device__ __forceinline__ int mod_of_row(int row) { return row < R_CTX ? 0 : (row < R_CTX + S_LAT ? 1 : 2); }

constexpr float LOG2E = 1.4426950408889634f;
constexpr float QSC_D = 0.125f * LOG2E, QSC_S = 0.08838834764831845f * LOG2E;
struct EpiProj {
    static constexpr bool PERM = false, AFTER_DRAIN = false;
    gbf16* qkv; gf32* out; const gf32* tabD; const gf32* tabS; int l;
    gbf16* hq; gbf16* hkm; gbf16* hkp; gbf16* hvt; gf32* hdec; gbf16* hgate; const gf32* lb;
    template <int CTRL> static __device__ __forceinline__ float dppf(float x) { return __builtin_bit_cast(float, __builtin_amdgcn_update_dpp(0x3f800000, __builtin_bit_cast(int, x), CTRL, 0xf, 0xf, false)); }
    static __device__ __forceinline__ float scan_up(float x) { asm("s_nop 1\n\tv_mul_f32_dpp %0, %0, %0 row_shr:1 row_mask:0xf bank_mask:0xf\n\ts_nop 1\n\tv_mul_f32_dpp %0, %0, %0 row_shr:2 row_mask:0xf bank_mask:0xf\n\ts_nop 1\n\tv_mul_f32_dpp %0, %0, %0 row_shr:4 row_mask:0xf bank_mask:0xf\n\ts_nop 1\n\tv_mul_f32_dpp %0, %0, %0 row_shr:8 row_mask:0xf bank_mask:0xf" : "+v"(x)); return x; }
    static __device__ __forceinline__ float scan_dn(float x) { asm("s_nop 1\n\tv_mul_f32_dpp %0, %0, %0 row_shl:1 row_mask:0xf bank_mask:0xf\n\ts_nop 1\n\tv_mul_f32_dpp %0, %0, %0 row_shl:2 row_mask:0xf bank_mask:0xf\n\ts_nop 1\n\tv_mul_f32_dpp %0, %0, %0 row_shl:4 row_mask:0xf bank_mask:0xf\n\ts_nop 1\n\tv_mul_f32_dpp %0, %0, %0 row_shl:8 row_mask:0xf bank_mask:0xf" : "+v"(x)); return x; }
    static __device__ __forceinline__ float bperm(int byteaddr, float x) { return __builtin_bit_cast(float, __builtin_amdgcn_ds_bpermute(byteaddr, __builtin_bit_cast(int, x))); }
    __device__ __forceinline__ void hgrn_tile(const pg8::f32x4 (&acc)[2][2][4][2], int pm, int t, int wr, int wc, int fr, int fq) const {
        const int c = 64 * t + 16 * wc + 4 * fq;
        const pg8::f32x4 lbf = *(const GAS pg8::f32x4*)(lb + c), lbb = *(const GAS pg8::f32x4*)(lb + 512 + c);
        const int bp_hi = (fq * 16 + 15) * 4, bp_lo = fq * 16 * 4;
        constexpr size_t D1 = (size_t)MROWS * 512, T1 = (size_t)768 * 512 * 16, C1 = (size_t)768 * 512;
#pragma unroll
        for (int ai = 0; ai < 2; ++ai)
#pragma unroll
            for (int m = 0; m < 4; ++m) {
                const int row = pm * 256 + 128 * ai + 64 * wr + 16 * m + fr; const size_t grp = (size_t)(row >> 4);
                const pg8::f32x4 q = acc[ai][0][m][0], zf = acc[ai][0][m][1], zb = acc[ai][1][m][0], vv = acc[ai][1][m][1];
                float hqf[4], hqb[4], kmf[4], kmb[4], kpf[4], kpb[4]; pg8::f32x4 Lf4, Lb4;
#pragma unroll
                for (int j = 0; j < 4; ++j) {
                    const float ff = fmaxf(lbf[j], 1e-30f) + (1.0f - lbf[j]) * __builtin_amdgcn_rcpf(1.0f + __expf(-zf[j]));
                    const float fb = fmaxf(lbb[j], 1e-30f) + (1.0f - lbb[j]) * __builtin_amdgcn_rcpf(1.0f + __expf(-zb[j]));
                    const float Ef = scan_up(ff), Eb = scan_dn(fb);
                    const float Lf = bperm(bp_hi, Ef), Lb = bperm(bp_lo, Eb);
                    const float qv = q[j] * __builtin_amdgcn_rcpf(1.0f + __expf(-q[j]));
                    const float Efc = fmaxf(Ef, 1.8e-35f), Ebc = fmaxf(Eb, 1.8e-35f), Rf = __builtin_amdgcn_rcpf(Efc), Rb = __builtin_amdgcn_rcpf(Ebc), kf = 1.0f - ff, kb = 1.0f - fb;
                    hqf[j] = qv * Efc; hqb[j] = qv * Ebc; kmf[j] = kf * Rf; kmb[j] = kb * Rb; kpf[j] = kf * (Lf * Rf); kpb[j] = kb * (Lb * Rb); Lf4[j] = Lf; Lb4[j] = Lb;
                }
                const size_t ro = (size_t)row * 512 + c;
                *(GAS v2u*)(hq + ro) = (v2u){pg8::cvt_pk_bf16(hqf[0], hqf[1]), pg8::cvt_pk_bf16(hqf[2], hqf[3])}; *(GAS v2u*)(hq + D1 + ro) = (v2u){pg8::cvt_pk_bf16(hqb[0], hqb[1]), pg8::cvt_pk_bf16(hqb[2], hqb[3])};
                *(GAS v2u*)(hkm + ro) = (v2u){pg8::cvt_pk_bf16(kmf[0], kmf[1]), pg8::cvt_pk_bf16(kmf[2], kmf[3])}; *(GAS v2u*)(hkm + D1 + ro) = (v2u){pg8::cvt_pk_bf16(kmb[0], kmb[1]), pg8::cvt_pk_bf16(kmb[2], kmb[3])};
                const size_t to = (grp * 512 + c) * 16;
#pragma unroll
                for (int j = 0; j < 4; ++j) { const unsigned short vb = (unsigned short)f2bf(vv[j]);
                    hkp[to + j * 16 + fr] = (unsigned short)f2bf(kpf[j]); hkp[T1 + to + j * 16 + 15 - fr] = (unsigned short)f2bf(kpb[j]);
                    hvt[to + j * 16 + fr] = vb; hvt[T1 + to + j * 16 + 15 - fr] = vb; }
                if (fr == 0) { *(GAS pg8::f32x4*)(hdec + grp * 512 + c) = Lf4; *(GAS pg8::f32x4*)(hdec + C1 + grp * 512 + c) = Lb4; }
            }
    }
    __device__ __forceinline__ void operator()(const pg8::f32x4 (&acc)[2][2][4][2], const pg8::Unit& u, int wr, int wc, int fr, int fq) const {
        asm volatile("" : "+v"(fr), "+v"(fq));
        const int pn = u.pn, pm = u.pm, rbase = pm * 256 + wr * 64 + fr;
        if (pn >= 6 && pn < 14) { hgrn_tile(acc, pm, pn - 6, wr, wc, fr, fq); return; }
        if (pn >= 14 && pn < 16) {
#pragma unroll
            for (int ai = 0; ai < 2; ++ai)
#pragma unroll
                for (int m = 0; m < 4; ++m) { gbf16* rowp = hgate + (size_t)(rbase + ai * 128 + m * 16) * 512 + (pn - 14) * 256 + wc * 32 + 4 * fq;
#pragma unroll
                    for (int bj = 0; bj < 2; ++bj)
#pragma unroll
                        for (int n = 0; n < 2; ++n) { const pg8::f32x4 x = acc[ai][bj][m][n]; float y[4];
#pragma unroll
                            for (int j = 0; j < 4; ++j) y[j] = x[j] * __builtin_amdgcn_rcpf(1.0f + __expf(-x[j]));
                            *(GAS v2u*)(rowp + bj * 128 + n * 16) = (v2u){pg8::cvt_pk_bf16(y[0], y[1]), pg8::cvt_pk_bf16(y[2], y[3])}; } }
            return;
        }
        const bool lat = pm >= 16, swar = pn >= 16 && pn <= 20, isv = pn == 4 || pn == 5 || pn == 21, rope = lat && !isv;
        const float sc = pn < 2 ? QSC_D : (pn >= 16 && pn < 20 ? QSC_S : 1.0f);
        const int o1 = swar ? pn * 256 + 64 * (wc >> 1) + 16 * (wc & 1) + 4 * fq : pn * 256 + 32 * wc + 4 * fq, dn = swar ? 32 : 16;
        const int qoff = pn < 6 ? 0 : Q_QS - C_CQ;
        const int ppar = swar ? (wc >> 1) & 1 : wc & 1;
        const gf32* tab = swar ? tabS + (16 * (wc & 1) + 4 * fq) * 2 : tabD + 4 * fq * 2; const int tstr = swar ? 64 : 32;
        size_t cbase = 0; int nh = 0; bool tocache = false;
        if (!lat) { if (pn == 2 || pn == 3) { cbase = O_DK; nh = 4; tocache = true; } else if (pn == 4 || pn == 5) { cbase = O_DV; nh = 4; tocache = true; } else if (pn == 20) { cbase = O_SK; nh = 2; tocache = true; } else if (pn == 21) { cbase = O_SV; nh = 2; tocache = true; } }
        const int hd0 = (pn == 2 || pn == 3) ? 2 * (pn - 2) : ((pn == 4 || pn == 5) ? 2 * (pn - 4) : 0);
        const int cc1 = o1 & 127;
#pragma unroll
        for (int ai = 0; ai < 2; ++ai) {
            pg8::f32x4 T0[4], T1[4];
#pragma unroll
            for (int m = 0; m < 4; ++m) { T0[m] = (pg8::f32x4){1.f, 0.f, 1.f, 0.f}; T1[m] = T0[m]; }
            if (rope) {
#pragma unroll
                for (int m = 0; m < 4; ++m) { const int t = (rbase + ai * 128 + m * 16 - R_CTX) & (S_LAT - 1), pos = ppar ? (t & 63) : (t >> 6);
                    T0[m] = *(const GAS pg8::f32x4*)(tab + pos * tstr); T1[m] = *(const GAS pg8::f32x4*)(tab + pos * tstr + 4); }
            }
#pragma unroll
            for (int m = 0; m < 4; ++m) asm volatile("" : "+v"(T0[m]), "+v"(T1[m]));
#pragma unroll
            for (int m = 0; m < 4; ++m) {
                const int row = rbase + ai * 128 + m * 16;
                const pg8::f32x4 cs = {T0[m][0], T0[m][2], T1[m][0], T1[m][2]}, sn = {T0[m][1], T0[m][3], T1[m][1], T1[m][3]};
                gbf16* qrow = qkv + (size_t)row * QKV_LD + qoff + o1;
#pragma unroll
                for (int bj = 0; bj < 2; ++bj) {
                    const pg8::f32x4 x1 = acc[ai][bj][m][0], x2 = acc[ai][bj][m][1];
                    const pg8::f32x4 y1 = (x1 * cs - x2 * sn) * sc, y2 = (x2 * cs + x1 * sn) * sc;
                    *(GAS v2u*)(qrow + bj * 128) = (v2u){pg8::cvt_pk_bf16(y1[0], y1[1]), pg8::cvt_pk_bf16(y1[2], y1[3])};
                    *(GAS v2u*)(qrow + bj * 128 + dn) = (v2u){pg8::cvt_pk_bf16(y2[0], y2[1]), pg8::cvt_pk_bf16(y2[2], y2[3])};
                    if (tocache) { gf32* cp = out + cbase + ((((size_t)pm * 4 + l) * nh + hd0 + bj) * 256 + (row & 255)) * 128 + cc1;
                        *(GAS pg8::f32x4*)cp = x1; *(GAS pg8::f32x4*)(cp + dn) = x2; }
                }
            }
        }
    }
};
#ifndef Y_BF16
#define Y_BF16 1
#endif
#if Y_BF16
typedef gbf16 gy_t;
#else
typedef gf32 gy_t;
#endif
__device__ __forceinline__ f32x4 bf2lo(unsigned a, unsigned b) { return (f32x4){__builtin_bit_cast(float, a << 16), __builtin_bit_cast(float, a & 0xffff0000u), __builtin_bit_cast(float, b << 16), __builtin_bit_cast(float, b & 0xffff0000u)}; }
struct G1Order : pg8::StaticOrder {
    __device__ __forceinline__ bool next(int i, pg8::Unit& u) const {
        if (!pg8::StaticOrder::next(i, u)) return false;
        constexpr unsigned long long LO = 6ull | (0ull << 5) | (1ull << 10) | (7ull << 15) | (2ull << 20) | (3ull << 25) | (4ull << 30) | (8ull << 35) | (5ull << 40) | (9ull << 45) | (14ull << 50) | (10ull << 55);
        constexpr unsigned long long HI = 15ull | (16ull << 5) | (11ull << 10) | (17ull << 15) | (18ull << 20) | (19ull << 25) | (12ull << 30) | (20ull << 35) | (13ull << 40) | (21ull << 45);
        constexpr unsigned long long LO2 = 0ull | (6ull << 5) | (7ull << 10) | (1ull << 15) | (2ull << 20) | (3ull << 25) | (8ull << 30) | (9ull << 35) | (4ull << 40) | (5ull << 45) | (14ull << 50) | (15ull << 55);
        constexpr unsigned long long HI2 = 16ull | (17ull << 5) | (10ull << 10) | (11ull << 15) | (18ull << 20) | (19ull << 25) | (20ull << 30) | (12ull << 35) | (13ull << 40) | (21ull << 45);
        const int o = u.pn; const unsigned long long lo = G == 216 ? LO2 : LO, hi = G == 216 ? HI2 : HI;
        u.pn = (int)((o < 12 ? lo >> (5 * o) : hi >> (5 * (o - 12))) & 31ull); return true;
    }
};
struct EpiResid {
    static constexpr bool PERM = Y_BF16 != 0, AFTER_DRAIN = false;
    const gf32* xa; const gf32* xb;
    const gy_t* yprev; const gf32* stats; const gf32* lng; const gf32* lnb;
    const gf32* gates;
    gy_t* out; int pm_off; int gate_only; int mode;
    static __device__ __forceinline__ void store8(gy_t* base, unsigned off, pg8::f32x4 v0, pg8::f32x4 v1) {
#if Y_BF16
        pg8::u32x4 w; w.x = pg8::cvt_pk_bf16(v0[0], v0[1]); w.y = pg8::cvt_pk_bf16(v0[2], v0[3]); w.z = pg8::cvt_pk_bf16(v1[0], v1[1]); w.w = pg8::cvt_pk_bf16(v1[2], v1[3]);
        *(GAS pg8::u32x4*)((GAS char*)base + off) = w;
#else
        *(GAS pg8::f32x4*)((GAS char*)base + off) = v0; *(GAS pg8::f32x4*)((GAS char*)base + off + 64) = v1;
#endif
    }
    template <class T> static __device__ __forceinline__ T ldo(const GAS void* base, unsigned off) { return *(const GAS T*)((const GAS char*)base + off); }
    __device__ __forceinline__ void operator()(const pg8::f32x4 (&acc)[2][2][4][2], const pg8::Unit& u, int wr, int wc, int fr, int fq) const {
        asm volatile("" : "+v"(fr), "+v"(fq));
        const int pm = u.pm + pm_off, mod = pm >> 4;
        const int r0 = pm * 256 + wr * 64 + fr, or0 = (gate_only ? u.pm : pm) * 256 + wr * 64 + fr;
        constexpr int dn = PERM ? 4 : 16;
        constexpr unsigned YB = sizeof(*out), RS = DM * YB;
        const int cq = PERM ? 8 * fq : 4 * fq;
        const gf32* gp = gates + (size_t)mod * 6 * DM;
        if (gate_only) {
#pragma unroll
            for (int bj = 0; bj < 2; ++bj) { const int c0 = u.pn * 256 + bj * 128 + wc * 32 + cq; const unsigned oo = (unsigned)(or0 * DM + c0) * YB;
                const pg8::f32x4 g0 = ldo<pg8::f32x4>(gp, c0 * 4u), g1 = ldo<pg8::f32x4>(gp, (c0 + dn) * 4u);
#pragma unroll
                for (int ai = 0; ai < 2; ++ai)
#pragma unroll
                    for (int m = 0; m < 4; ++m) store8(out, oo + (unsigned)(ai * 128 + m * 16) * RS, g0 * acc[ai][bj][m][0], g1 * acc[ai][bj][m][1]); }
            return;
        }
        if (mode == 0) {
            const gf32* xbase = (pm < 16) ? xa + (size_t)pm * 256 * DM : xb + (size_t)(pm - 16) * 256 * DM;
#pragma unroll
            for (int bj = 0; bj < 2; ++bj) { const int c0 = u.pn * 256 + bj * 128 + wc * 32 + cq; const unsigned oo = (unsigned)(or0 * DM + c0) * YB, xo = (unsigned)((wr * 64 + fr) * DM + c0) * 4u;
                const pg8::f32x4 g0 = ldo<pg8::f32x4>(gp, c0 * 4u), g1 = ldo<pg8::f32x4>(gp, (c0 + dn) * 4u);
#pragma unroll
                for (int ai = 0; ai < 2; ++ai)
#pragma unroll
                    for (int mh = 0; mh < 4; mh += 2) { pg8::f32x4 x0[2], x1[2];
#pragma unroll
                        for (int m = 0; m < 2; ++m) { const unsigned o_ = xo + (unsigned)(ai * 128 + (mh + m) * 16) * (DM * 4u); x0[m] = ldo<pg8::f32x4>(xbase, o_); x1[m] = ldo<pg8::f32x4>(xbase, o_ + dn * 4u); }
#pragma unroll
                        for (int m = 0; m < 2; ++m) asm volatile("" : "+v"(x0[m]), "+v"(x1[m]));
#pragma unroll
                        for (int m = 0; m < 2; ++m) store8(out, oo + (unsigned)(ai * 128 + (mh + m) * 16) * RS, g0 * acc[ai][bj][mh + m][0] + x0[m] * ALPHA, g1 * acc[ai][bj][mh + m][1] + x1[m] * ALPHA); } }
            return;
        }
        pg8::f32x2 st[8];
#pragma unroll
        for (int q = 0; q < 8; ++q) st[q] = ldo<pg8::f32x2>(stats, (unsigned)(r0 + (q >> 2) * 128 + (q & 3) * 16) * 8u);
#pragma unroll
        for (int bj = 0; bj < 2; ++bj) { const int c0 = u.pn * 256 + bj * 128 + wc * 32 + cq; const unsigned oo = (unsigned)(or0 * DM + c0) * YB, yo = (unsigned)(r0 * DM + c0) * YB;
            const pg8::f32x4 g0 = ldo<pg8::f32x4>(gp, c0 * 4u), g1 = ldo<pg8::f32x4>(gp, (c0 + dn) * 4u);
            const pg8::f32x4 ga0 = ldo<pg8::f32x4>(lng, c0 * 4u), ga1 = ldo<pg8::f32x4>(lng, (c0 + dn) * 4u), be0 = ldo<pg8::f32x4>(lnb, c0 * 4u) * ALPHA, be1 = ldo<pg8::f32x4>(lnb, (c0 + dn) * 4u) * ALPHA;
#pragma unroll
            for (int ai = 0; ai < 2; ++ai) {
#if Y_BF16
                v4u yw[4];
#pragma unroll
                for (int m = 0; m < 4; ++m) yw[m] = ldo<v4u>(yprev, yo + (unsigned)(ai * 128 + m * 16) * RS);
#pragma unroll
                for (int m = 0; m < 4; ++m) asm volatile("" : "+v"(yw[m]));
#pragma unroll
                for (int m = 0; m < 4; ++m) { const float mu = st[ai * 4 + m][0], rs = st[ai * 4 + m][1] * ALPHA;
                    const pg8::f32x4 y0 = bf2lo(yw[m].x, yw[m].y), y1 = bf2lo(yw[m].z, yw[m].w);
                    store8(out, oo + (unsigned)(ai * 128 + m * 16) * RS, g0 * acc[ai][bj][m][0] + ((y0 - mu) * rs * ga0 + be0), g1 * acc[ai][bj][m][1] + ((y1 - mu) * rs * ga1 + be1)); }
#else
                pg8::f32x4 y0[4], y1[4];
#pragma unroll
                for (int m = 0; m < 4; ++m) { const unsigned o_ = yo + (unsigned)(ai * 128 + m * 16) * RS; y0[m] = ldo<pg8::f32x4>(yprev, o_); y1[m] = ldo<pg8::f32x4>(yprev, o_ + 64); }
#pragma unroll
                for (int m = 0; m < 4; ++m) asm volatile("" : "+v"(y0[m]), "+v"(y1[m]));
#pragma unroll
                for (int m = 0; m < 4; ++m) { const float mu = st[ai * 4 + m][0], rs = st[ai * 4 + m][1] * ALPHA;
                    store8(out, oo + (unsigned)(ai * 128 + m * 16) * RS, g0 * acc[ai][bj][m][0] + ((y0[m] - mu) * rs * ga0 + be0), g1 * acc[ai][bj][m][1] + ((y1[m] - mu) * rs * ga1 + be1)); }
#endif
            }
        }
    }
};
struct EpiSwiGLU {
    static constexpr bool PERM = true, AFTER_DRAIN = false;
    gbf16* act;
    __device__ __forceinline__ void operator()(const pg8::f32x4 (&acc)[2][2][4][2], const pg8::Unit& u, int wr, int wc, int fr, int fq) const {
        const int row0 = u.pm * 256 + wr * 64 + fr, col0 = u.pn * 128 + wc * 32 + 8 * fq;
#pragma unroll
        for (int ai = 0; ai < 2; ++ai)
#pragma unroll
            for (int m = 0; m < 4; ++m) { gbf16* rowp = act + (size_t)(row0 + ai * 128 + m * 16) * DFF + col0;
                float r[8];
#pragma unroll
                for (int n = 0; n < 2; ++n)
#pragma unroll
                    for (int j = 0; j < 4; ++j) { const float g = acc[ai][0][m][n][j], up = acc[ai][1][m][n][j]; r[n * 4 + j] = g * __builtin_amdgcn_rcpf(1.0f + __expf(-g)) * up; }
                pg8::u32x4 w; w.x = pg8::cvt_pk_bf16(r[0], r[1]); w.y = pg8::cvt_pk_bf16(r[2], r[3]); w.z = pg8::cvt_pk_bf16(r[4], r[5]); w.w = pg8::cvt_pk_bf16(r[6], r[7]);
                *(GAS pg8::u32x4*)rowp = w; }
    }
};

struct Args { const float* in[24]; float* out; unsigned char* ws; int ph_lo, ph_hi, single, pad; };
enum { I_XP = 0, I_XS, I_CDK, I_CDV, I_CSK, I_CSV, I_ST, I_C, I_CCTX, I_WMOD, I_BMOD, I_WIN, I_WOUT, I_DLAM, I_DNG, I_LBL, I_HNG, I_SINK, I_LN1G, I_LN1B, I_LN2G, I_LN2B, I_WGU, I_WDN };

struct Ctx {
    LAS unsigned char* lds; int tid, lane, wave, G, bid;
    const Args* ap; gf32* out; GAS unsigned char* ws;
    __device__ __forceinline__ const gf32* inp(int i) const { return (const gf32*)ap->in[i]; }
    __device__ __forceinline__ gf32* mods() const { return (gf32*)(ws + WS_MODS); }
    __device__ __forceinline__ gf32* lball() const { return (gf32*)(ws + WS_MISC); }
    __device__ __forceinline__ gf32* lamv() const { return (gf32*)(ws + WS_MISC + 16384); }
    __device__ __forceinline__ gf32* tabD() const { return (gf32*)(ws + WS_MISC + 20480); }
    __device__ __forceinline__ gf32* tabS() const { return (gf32*)(ws + WS_MISC + 32768); }
    __device__ __forceinline__ gbf16* wT(int l, size_t off) const { return (gbf16*)(ws + WS_W + (size_t)l * W_LAYER + off); }
    __device__ __forceinline__ gbf16* hbuf() const { return (gbf16*)(ws + WS_H); }
    __device__ __forceinline__ gbf16* cat() const { return (gbf16*)(ws + WS_CAT); }
    __device__ __forceinline__ GAS void* ybuf(int i) const { return (GAS void*)(ws + (i == 0 ? WS_X1 : (i == 1 ? WS_YPRE : WS_YPRE2))); }
    __device__ __forceinline__ gf32* stats() const { return (gf32*)(ws + WS_MISC + 1 * MiB); }
    __device__ __forceinline__ gf32* oa() const { return (gf32*)(ws + WS_OA); }
    __device__ __forceinline__ gf32* obf() const { return (gf32*)(ws + WS_OBF); }
    __device__ __forceinline__ gf32* obb() const { return (gf32*)(ws + WS_OBB); }
    __device__ __forceinline__ gbf16* hgate() const { return (gbf16*)(ws + WS_P); }
    __device__ __forceinline__ gbf16* act() const { return (gbf16*)(ws + WS_ACT); }
    __device__ __forceinline__ gbf16* qkv() const { return (gbf16*)(ws + WS_QKV); }
    __device__ __forceinline__ gbf16* hq(int dir) const { return (gbf16*)(ws + WS_HQ) + (size_t)dir * MROWS * 512; }
    __device__ __forceinline__ gbf16* hkm(int dir) const { return (gbf16*)(ws + WS_HKM) + (size_t)dir * MROWS * 512; }
    __device__ __forceinline__ gbf16* hkp(int dir) const { return (gbf16*)(ws + WS_HKP) + (size_t)dir * 768 * 512 * 16; }
    __device__ __forceinline__ gbf16* hvt(int dir) const { return (gbf16*)(ws + WS_HVT) + (size_t)dir * 768 * 512 * 16; }
    __device__ __forceinline__ gf32* sloc() const { return (gf32*)(ws + WS_SLOC); }
    __device__ __forceinline__ gf32* dseg() const { return (gf32*)(ws + WS_DSEG); }
    __device__ __forceinline__ gf32* hdec(int dir) const { return (gf32*)(ws + WS_HDEC) + (size_t)dir * 768 * 512; }
    __device__ __forceinline__ gbf16* c16(size_t off) const { return (gbf16*)(ws + WS_C16 + off); }
};

template <int SWAP64  >
__device__ __forceinline__ void transpose_item(const gf32* W, int K, int N, gbf16* WT, int k0, int n0, int drow0, LAS float* scr, int lane) {
#pragma unroll 8
    for (int i = 0; i < 32; ++i) { const int kk = 2 * i + (lane >> 5); scr[kk * 33 + (lane & 31)] = __builtin_nontemporal_load(W + (size_t)(k0 + kk) * N + n0 + (lane & 31)); }
    LDS_WAIT(); asm volatile("" ::: "memory");
    const int c = lane & 7;
#pragma unroll
    for (int j = 0; j < 4; ++j) { const int n = (lane >> 3) + 8 * j; const LAS float* sp = scr + (8 * c) * 33 + n;
        int drow = drow0 + n;
        if (SWAP64 == 1) { const int o = (n0 & 63) + n, a = (o >> 4) & 1, nn = o >> 5, ii = o & 15; drow = (n0 & ~63) + 32 * a + 16 * nn + ii; }
        if (SWAP64 == 2) { const int rel = n0 + n - C_BQ, qn = rel >> 9, ch = rel & 511, r = ch & 63; drow = C_BQ + 256 * (ch >> 6) + 128 * (qn >> 1) + 32 * (r >> 4) + 16 * (qn & 1) + (r & 15); }
        v4u o4; o4.x = pk2(sp[0 * 33], sp[1 * 33]); o4.y = pk2(sp[2 * 33], sp[3 * 33]); o4.z = pk2(sp[4 * 33], sp[5 * 33]); o4.w = pk2(sp[6 * 33], sp[7 * 33]);
        *(GAS v4u*)(WT + (size_t)drow * K + k0 + 8 * c) = o4; }
    LDS_WAIT(); asm volatile("" ::: "memory");
}

constexpr int F_IN = 32 * 88, F_OUT = 32 * 32, F_GU = 32 * 176, F_DN = 88 * 32, F_L = F_IN + F_OUT + F_GU + F_DN, F_SPLIT = 7000;
__device__ __forceinline__ int w_in_row(int col) {
    if (col >= C_CQ && col < C_CV) { const int o = col & 63, a = (o >> 4) & 1, nn = o >> 5, ii = o & 15; return (col & ~63) + 32 * a + 16 * nn + ii; }
    if (col >= C_BQ && col < C_BG) { const int rel = col - C_BQ, qn = rel >> 9, ch = rel & 511, r = ch & 63; return C_BQ + 256 * (ch >> 6) + 128 * (qn >> 1) + 32 * (r >> 4) + 16 * (qn & 1) + (r & 15); }
    return col;
}
__device__ __forceinline__ void convert_fast(const Ctx& F, int lo, int hi, int gw, int NGW) {
    int lane_ = (int)__builtin_amdgcn_mbcnt_hi(~0u, __builtin_amdgcn_mbcnt_lo(~0u, 0u)); asm volatile("" : "+v"(lane_));
    const int lane = lane_;
    LAS unsigned char* tile = F.lds + F.wave * 16384;
    if (hi > DEPTH * F_L) hi = DEPTH * F_L;
    for (int it = lo + gw; it < hi; it += NGW) {
        const int l = it / F_L; int r = it % F_L;
        const gf32* W; gbf16* WT; int K, N, k0, n0, kind;
        if (r < F_IN) { W = F.inp(I_WIN) + (size_t)l * DM * DIN; K = DM; N = DIN; WT = F.wT(l, WO_IN); k0 = 64 * (r / 88); n0 = 64 * (r % 88); kind = 0; }
        else if ((r -= F_IN) < F_OUT) { W = F.inp(I_WOUT) + (size_t)l * DM * DM; K = DM; N = DM; WT = F.wT(l, WO_OUT); k0 = 64 * (r / 32); n0 = 64 * (r % 32); kind = 1; }
        else if ((r -= F_OUT) < F_GU) { W = F.inp(I_WGU) + (size_t)l * DM * DGU; K = DM; N = DGU; WT = F.wT(l, WO_GU); k0 = 64 * (r / 176); n0 = 64 * (r % 176); kind = 2; }
        else { r -= F_GU; W = F.inp(I_WDN) + (size_t)l * DFF * DM; K = DFF; N = DM; WT = F.wT(l, WO_DN); k0 = 64 * (r / 32); n0 = 64 * (r % 32); kind = 1; }
        asm volatile("s_waitcnt lgkmcnt(0)" ::: "memory");
#pragma unroll
        for (int q = 0; q < 16; ++q) { const int row = 4 * q + (lane >> 4), sp = (lane & 15) ^ ((row >> 3) & 7);
            __builtin_amdgcn_global_load_lds((const GAS unsigned*)(W + (size_t)(k0 + row) * N + n0 + 4 * sp), (LAS unsigned*)(tile + q * 1024), 16, 0, 2); }
        asm volatile("s_waitcnt vmcnt(0)" ::: "memory");
        const int kc = lane & 7;
#pragma unroll
        for (int jj = 0; jj < 8; ++jj) { const int n = (lane >> 3) + 8 * jj, c = n >> 2; float v[8];
#pragma unroll
            for (int i = 0; i < 8; ++i) v[i] = *(const LAS float*)(tile + (8 * kc + i) * 256 + ((c ^ kc) * 16) + (n & 3) * 4);
            const int col = n0 + n; int drow = col;
            if (kind == 0) drow = w_in_row(col);
            if (kind == 2) { const int j = col < DFF ? col : col - DFF; drow = 256 * (j >> 7) + (col < DFF ? 0 : 128) + (j & 127); }
            v4u o4; o4.x = pk2(v[0], v[1]); o4.y = pk2(v[2], v[3]); o4.z = pk2(v[4], v[5]); o4.w = pk2(v[6], v[7]);
            *(GAS v4u*)(WT + (size_t)drow * K + k0 + 8 * kc) = o4; }
    }
    asm volatile("s_waitcnt vmcnt(0) lgkmcnt(0)" ::: "memory");
}

__device__ __forceinline__ void p0_prologue(const Ctx& F) {
    {
        LAS float* sc = (LAS float*)F.lds;
        LAS float* red = (LAS float*)(F.lds + 24576);
        const gf32* c_ctx = F.inp(I_CCTX); const gf32* cc = F.inp(I_C);
        for (int i = F.tid; i < 3 * DM; i += 512) { const int mid = i / DM, k = i % DM; const float c = mid == 0 ? c_ctx[k] : cc[(mid - 1) * DM + k]; sc[i] = silu_f(c); }
        __syncthreads();
        for (int task = F.bid; task < DEPTH * 48; task += F.G) {
            const int l = task / 48, cb = task % 48, w = F.wave;
            const gf32* wp = F.inp(I_WMOD) + ((size_t)l * DM + 256 * w) * (6 * DM) + cb * 256 + F.lane * 4;
            f32x4 a0 = {0.f, 0.f, 0.f, 0.f}, a1 = a0, a2 = a0;
#pragma unroll 8
            for (int kk = 0; kk < 256; ++kk) { const f32x4 wv = __builtin_nontemporal_load((const GAS f32x4*)(wp + (size_t)kk * (6 * DM)));
                a0 += wv * sc[256 * w + kk]; a1 += wv * sc[DM + 256 * w + kk]; a2 += wv * sc[2 * DM + 256 * w + kk]; }
            *(LAS f32x4*)(red + (w * 3 + 0) * 256 + F.lane * 4) = a0; *(LAS f32x4*)(red + (w * 3 + 1) * 256 + F.lane * 4) = a1; *(LAS f32x4*)(red + (w * 3 + 2) * 256 + F.lane * 4) = a2;
            __syncthreads();
            for (int i = F.tid; i < 768; i += 512) { const int m = i >> 8, c = i & 255; float s = 0.f;
#pragma unroll
                for (int ww = 0; ww < 8; ++ww) s += red[(ww * 3 + m) * 256 + c];
                F.mods()[((size_t)l * 3 + m) * (6 * DM) + cb * 256 + c] = s + F.inp(I_BMOD)[(size_t)l * 6 * DM + cb * 256 + c]; }
            __syncthreads();
        }
    }
    if (F.bid == F.G - 1) {
        const gf32* lbl = F.inp(I_LBL);
        for (int i = F.tid; i < 1024; i += 512) { float lg[4], mx = -1e30f;
#pragma unroll
            for (int l = 0; l < 4; ++l) { lg[l] = lbl[l * 1024 + i]; mx = fmaxf(mx, lg[l]); }
            float s = 0.f;
#pragma unroll
            for (int l = 0; l < 4; ++l) { lg[l] = expf(lg[l] - mx); s += lg[l]; }
            const float w1 = lg[1] / s, w2 = lg[2] / s, w3 = lg[3] / s;
            F.lball()[0 * 1024 + i] = 0.f; F.lball()[1 * 1024 + i] = w1; F.lball()[2 * 1024 + i] = w1 + w2; F.lball()[3 * 1024 + i] = w1 + w2 + w3; }
        if (F.tid < 4) { const int l = F.tid; const gf32* lp = F.inp(I_DLAM) + l * 256; float s1 = 0.f, s2 = 0.f;
            for (int i = 0; i < 64; ++i) { s1 += lp[i] * lp[64 + i]; s2 += lp[128 + i] * lp[192 + i]; }
            const float li = 0.8f - 0.6f * expf(-0.3f * (float)l);
            F.lamv()[l * 2] = expf(s1) - expf(s2) + li; F.lamv()[l * 2 + 1] = li; }
        for (int i = F.tid; i < 64 * 16; i += 512) { const int pos = i / 16, j = i % 16; const float inv = powf(10000.f, -(float)j / 16.f), ang = (float)pos * inv; F.tabD()[i * 2] = cosf(ang); F.tabD()[i * 2 + 1] = sinf(ang); }
        for (int i = F.tid; i < 64 * 32; i += 512) { const int pos = i / 32, j = i % 32; const float inv = powf(10000.f, -(float)j / 32.f), ang = (float)pos * inv; F.tabS()[i * 2] = cosf(ang); F.tabS()[i * 2 + 1] = sinf(ang); }
    }
    {
        const gf32* src[4] = {F.inp(I_CDK), F.inp(I_CDV), F.inp(I_CSK), F.inp(I_CSV)};
        const size_t doff[4] = {0, 2 * MiB, 4 * MiB, 5 * MiB}; const int n8[4] = {131072, 131072, 65536, 65536};
#pragma unroll
        for (int a = 0; a < 4; ++a)
            for (int i = F.bid * 512 + F.tid; i < n8[a]; i += F.G * 512) { const f32x4 x0 = *(const GAS f32x4*)(src[a] + (size_t)i * 8), x1 = *(const GAS f32x4*)(src[a] + (size_t)i * 8 + 4);
                v4u o; o.x = pk2(x0[0], x0[1]); o.y = pk2(x0[2], x0[3]); o.z = pk2(x1[0], x1[1]); o.w = pk2(x1[2], x1[3]); *(GAS v4u*)(F.c16(doff[a]) + (size_t)i * 8) = o; }
    }
    {
        LAS float* scr = (LAS float*)(F.lds + 49152 + F.wave * 8448);
        const int gw = F.bid * 8 + F.wave, NGW = F.G * 8;
        constexpr int I_IN = 32 * 176, I_OUT = 32 * 64, I_GU = 32 * 352, I_DN = 88 * 64, I_L = I_IN + I_OUT + I_GU + I_DN;
        for (int it = gw; it < I_L; it += NGW) {
            const int l = it / I_L; int r = it % I_L;
            if (r < I_IN) { const int kb = r / 176, nb = r % 176, n0 = 32 * nb;
                if (n0 >= C_CQ && n0 < C_CV) transpose_item<1>(F.inp(I_WIN) + (size_t)l * DM * DIN, DM, DIN, F.wT(l, WO_IN), 64 * kb, n0, n0, scr, F.lane);
                else if (n0 >= C_BQ && n0 < C_BG) transpose_item<2>(F.inp(I_WIN) + (size_t)l * DM * DIN, DM, DIN, F.wT(l, WO_IN), 64 * kb, n0, n0, scr, F.lane);
                else transpose_item<0>(F.inp(I_WIN) + (size_t)l * DM * DIN, DM, DIN, F.wT(l, WO_IN), 64 * kb, n0, n0, scr, F.lane);
                continue; } r -= I_IN;
            if (r < I_OUT) { const int kb = r / 64, nb = r % 64; transpose_item<0>(F.inp(I_WOUT) + (size_t)l * DM * DM, DM, DM, F.wT(l, WO_OUT), 64 * kb, 32 * nb, 32 * nb, scr, F.lane); continue; } r -= I_OUT;
            if (r < I_GU) { const int kb = r / 352, nb = r % 352, n0 = 32 * nb; const int j = n0 < DFF ? n0 : n0 - DFF; const int drow = 256 * (j >> 7) + (n0 < DFF ? 0 : 128) + (j & 127);
                transpose_item<0>(F.inp(I_WGU) + (size_t)l * DM * DGU, DM, DGU, F.wT(l, WO_GU), 64 * kb, n0, drow, scr, F.lane); continue; } r -= I_GU;
            { const int kb = r / 64, nb = r % 64; transpose_item<0>(F.inp(I_WDN) + (size_t)l * DFF * DM, DFF, DM, F.wT(l, WO_DN), 64 * kb, 32 * nb, 32 * nb, scr, F.lane); }
        }
    }
}

__device__ __forceinline__ void p1_h0(const Ctx& F) {
    const gf32* xp = F.inp(I_XP); const gf32* xs = F.inp(I_XS);
    f32x4 A[8], B[8]; int curmod = -1;
    for (int row = F.bid * 8 + F.wave; row < MROWS; row += F.G * 8) {
        const int mod = mod_of_row(row);
        const gf32* xr = (row < R_CTX ? xp + (size_t)row * DM : xs + (size_t)(row - R_CTX) * DM) + F.lane * 8;
        f32x4 x[8];
#pragma unroll
        for (int j = 0; j < 8; ++j) x[j] = *(const GAS f32x4*)(xr + 512 * (j >> 1) + 4 * (j & 1));
        if (mod != curmod) { curmod = mod; const gf32* sh = F.mods() + (size_t)(0 * 3 + mod) * 6 * DM;
#pragma unroll
            for (int j = 0; j < 8; ++j) { const int c = F.lane * 8 + 512 * (j >> 1) + 4 * (j & 1); A[j] = *(const GAS f32x4*)(sh + DM + c); B[j] = *(const GAS f32x4*)(sh + c); }
#pragma unroll
            for (int j = 0; j < 8; ++j) asm volatile("" : "+v"(A[j]), "+v"(B[j]));
#pragma unroll
            for (int j = 0; j < 8; ++j) A[j] = A[j] + 1.0f; }
#pragma unroll
        for (int jj = 0; jj < 4; ++jj) { const f32x4 h0 = x[2 * jj] * A[2 * jj] + B[2 * jj], h1 = x[2 * jj + 1] * A[2 * jj + 1] + B[2 * jj + 1];
            v4u o; o.x = pk2(h0[0], h0[1]); o.y = pk2(h0[2], h0[3]); o.z = pk2(h1[0], h1[1]); o.w = pk2(h1[2], h1[3]);
            *(GAS v4u*)(F.hbuf() + (size_t)row * DM + F.lane * 8 + 512 * jj) = o; }
    }
}

typedef float f32x16 __attribute__((ext_vector_type(16)));
typedef short s16x4 __attribute__((ext_vector_type(4)));
typedef __bf16 bf16x2_t __attribute__((ext_vector_type(2)));
typedef float f32x2_t __attribute__((ext_vector_type(2)));
__device__ __forceinline__ unsigned cvt2(float a, float b) { const f32x2_t f = {a, b}; return __builtin_bit_cast(unsigned, __builtin_convertvector(f, bf16x2_t)); }
#define MFMA32(a, b, c) __builtin_amdgcn_mfma_f32_32x32x16_bf16((a), (b), (c), 0, 0, 0)

struct AttnSeg { const gbf16* k; const gbf16* v; int stride; int ntiles; };
constexpr int AT_NS = 4, AT_SLOT = 32768;
constexpr float ATT_THR = 8.0f;
#define AT_VMWAIT(n) asm volatile("s_waitcnt vmcnt(" #n ")" ::: "memory")
__device__ __forceinline__ void glds16_asm(const GAS void* gsrc, unsigned lds_dst) {
    unsigned keep;
    asm volatile("s_mov_b32 %0, m0\n\ts_mov_b32 m0, %2\n\ts_nop 0\n\tglobal_load_lds_dwordx4 %1, off\n\ts_mov_b32 m0, %0" : "=&s"(keep) : "v"(gsrc), "s"(lds_dst) : "memory");
}

template <int DQK, bool DIFF>
__device__ __forceinline__ void attn_mfma(const Ctx& F, const gbf16* qptr, int kcol, const AttnSeg s0, const AttnSeg s1, bool band, int qpos, int kpos0,
                                          float m_init, float l_init, float lam, float post_scale, const gf32* gvec, gbf16* outp  ) {
    int lane_ = (int)__builtin_amdgcn_mbcnt_hi(~0u, __builtin_amdgcn_mbcnt_lo(~0u, 0u)); asm volatile("" : "+v"(lane_));
    const int lane = lane_, w = F.wave, r32 = lane & 31, h = lane >> 5;
    __syncthreads();
    bf16x8 qf[DQK / 16];
#pragma unroll
    for (int ks = 0; ks < DQK / 16; ++ks) qf[ks] = *(const GAS bf16x8*)(qptr + (size_t)r32 * QKV_LD + 16 * ks + 8 * h);
#pragma unroll
    for (int ks = 0; ks < DQK / 16; ++ks) asm volatile("" : "+v"(qf[ks]));
    __builtin_amdgcn_s_waitcnt(0);
    f32x16 o[4];
#pragma unroll
    for (int t = 0; t < 4; ++t)
#pragma unroll
        for (int r = 0; r < 16; ++r) o[t][r] = 0.f;
    float m = m_init, l = h == 0 ? l_init : 0.f;
    const int nt = s0.ntiles + s1.ntiles;
    const int srow0 = 8 * w + (lane >> 4), spc = lane & 15;
    const unsigned lds_base = (unsigned)(__UINTPTR_TYPE__)F.lds;
#define AT_ISSUE(tj) do { const int te_ = (tj) < nt ? (tj) : nt - 1; const bool s1_ = te_ >= s0.ntiles; const int tt_ = s1_ ? te_ - s0.ntiles : te_; \
        const GAS unsigned char* kb_ = (const GAS unsigned char*)(s1_ ? s1.k : s0.k); const GAS unsigned char* vb_ = (const GAS unsigned char*)(s1_ ? s1.v : s0.v); const int st_ = (s1_ ? s1.stride : s0.stride) * 2; \
        const unsigned sl_ = lds_base + (unsigned)(((tj) % AT_NS) * AT_SLOT + w * 2048); \
        _Pragma("unroll") for (int j_ = 0; j_ < 2; ++j_) { const int row_ = srow0 + 4 * j_; const size_t ro_ = (size_t)(tt_ * 64 + row_) * st_; \
            glds16_asm(kb_ + ro_ + ((spc ^ (row_ & 15)) * 16), sl_ + j_ * 1024); \
            glds16_asm(vb_ + ro_ + ((spc ^ ((row_ & 3) << 2)) * 16), sl_ + 16384 + j_ * 1024); } } while (0)
    const int kc0 = kcol / 8 + h;
    const int krow = r32 * 256, ksw = r32 & 15;
    const int vq = (lane & 15) >> 2, vp = lane & 3, vc16 = (lane >> 4) & 1;
    const int vrow = 16384 + (4 * h + vq) * 256 + 8 * (vp & 1);
    int vpo[4];
#pragma unroll
    for (int t = 0; t < 4; ++t) vpo[t] = ((4 * (t ^ vq) + 2 * vc16 + (vp >> 1)) * 16);
#pragma unroll
    for (int j = 0; j < AT_NS - 1; ++j) AT_ISSUE(j);
    for (int ti = 0; ti < nt; ++ti) {
        AT_VMWAIT(8);
        asm volatile("s_waitcnt lgkmcnt(0)" ::: "memory"); __builtin_amdgcn_s_barrier(); asm volatile("" ::: "memory");
        AT_ISSUE(ti + AT_NS - 1);
        const LAS unsigned char* kb = F.lds + (ti % AT_NS) * AT_SLOT;
        const float base = m > -1e29f ? -m : 0.f;
        f32x16 st[2];
#pragma unroll
        for (int kt = 0; kt < 2; ++kt)
#pragma unroll
            for (int r = 0; r < 16; ++r) st[kt][r] = base;
        {
            constexpr int NG = 2 * (DQK / 64);
            bf16x8 kfa[4], kfb[4];
#define ATT_LDK(dst, g) do { const int kt_ = (g) / (DQK / 64), k0_ = ((g) % (DQK / 64)) * 4; _Pragma("unroll") for (int j_ = 0; j_ < 4; ++j_) dst[j_] = *(const LAS bf16x8*)(kb + kt_ * 8192 + krow + (((kc0 + 2 * (k0_ + j_)) ^ ksw) * 16)); } while (0)
#define ATT_MMK(src, g) do { const int kt_ = (g) / (DQK / 64), k0_ = ((g) % (DQK / 64)) * 4; _Pragma("unroll") for (int j_ = 0; j_ < 4; ++j_) st[kt_] = MFMA32(src[j_], qf[k0_ + j_], st[kt_]); } while (0)
            ATT_LDK(kfa, 0); __builtin_amdgcn_sched_barrier(0);
#pragma unroll
            for (int g = 0; g < NG; g += 2) {
                ATT_LDK(kfb, g + 1); __builtin_amdgcn_sched_barrier(0);
                ATT_MMK(kfa, g);
                if (g + 2 < NG) { ATT_LDK(kfa, g + 2); __builtin_amdgcn_sched_barrier(0); }
                ATT_MMK(kfb, g + 1);
            }
#undef ATT_LDK
#undef ATT_MMK
        }
        if (band && ti < s0.ntiles) {
            const int kp = kpos0 + ti * 64 + 4 * h - (qpos + r32);
#pragma unroll
            for (int kt = 0; kt < 2; ++kt)
#pragma unroll
                for (int r = 0; r < 16; ++r) { const int d = kp + 32 * kt + (r & 3) + 8 * (r >> 2); if (d > 128 || d < -128) st[kt][r] = -1e30f; }
        }
        float mx = st[0][0];
#pragma unroll
        for (int kt = 0; kt < 2; ++kt)
#pragma unroll
            for (int r = 0; r < 16; ++r) mx = fmaxf(mx, st[kt][r]);
        mx -= base;
        if (__builtin_amdgcn_ballot_w64(mx > m + ATT_THR) != 0ull) {
            mx = fmaxf(mx, __shfl_xor(mx, 32));
            const float mn = fmaxf(m, mx), a = __builtin_amdgcn_exp2f(m - mn); l *= a; m = mn;
#pragma unroll
            for (int t = 0; t < 4; ++t)
#pragma unroll
                for (int r = 0; r < 16; ++r) o[t][r] *= a;
            const float d = mn + base;
#pragma unroll
            for (int kt = 0; kt < 2; ++kt)
#pragma unroll
                for (int r = 0; r < 16; ++r) st[kt][r] -= d;
        }
        float rs = 0.f;
#pragma unroll
        for (int kt = 0; kt < 2; ++kt)
#pragma unroll
            for (int r = 0; r < 16; ++r) { const float p = __builtin_amdgcn_exp2f(st[kt][r]); st[kt][r] = p; rs += p; }
        l += rs;
        {
            s16x4 va[8], vb[8];
#define ATT_LDV(dst, g) do { _Pragma("unroll") for (int t_ = 0; t_ < 4; ++t_) { dst[2 * t_] = __builtin_amdgcn_ds_read_tr16_b64_v4i16((LAS s16x4*)(kb + vrow + (16 * (g)) * 256 + vpo[t_])); \
                dst[2 * t_ + 1] = __builtin_amdgcn_ds_read_tr16_b64_v4i16((LAS s16x4*)(kb + vrow + (16 * (g) + 8) * 256 + vpo[t_])); } } while (0)
#define ATT_MMV(src, g) do { const int kt_ = (g) >> 1, s_ = (g) & 1; v4u pw_; pw_.x = cvt2(st[kt_][8 * s_], st[kt_][8 * s_ + 1]); pw_.y = cvt2(st[kt_][8 * s_ + 2], st[kt_][8 * s_ + 3]); pw_.z = cvt2(st[kt_][8 * s_ + 4], st[kt_][8 * s_ + 5]); pw_.w = cvt2(st[kt_][8 * s_ + 6], st[kt_][8 * s_ + 7]); \
            const bf16x8 pf_ = __builtin_bit_cast(bf16x8, pw_); _Pragma("unroll") for (int t_ = 0; t_ < 4; ++t_) o[t_] = MFMA32(__builtin_shufflevector(src[2 * t_], src[2 * t_ + 1], 0, 1, 2, 3, 4, 5, 6, 7), pf_, o[t_]); } while (0)
            ATT_LDV(va, 0); __builtin_amdgcn_sched_barrier(0);
            ATT_LDV(vb, 1); __builtin_amdgcn_sched_barrier(0);
            ATT_MMV(va, 0);
            ATT_LDV(va, 2); __builtin_amdgcn_sched_barrier(0);
            ATT_MMV(vb, 1);
            ATT_LDV(vb, 3); __builtin_amdgcn_sched_barrier(0);
            ATT_MMV(va, 2);
            ATT_MMV(vb, 3);
#undef ATT_LDV
#undef ATT_MMV
        }
    }
#undef AT_ISSUE
    AT_VMWAIT(0);
    __syncthreads();
    l += __shfl_xor(l, 32);
    const float inv = 1.0f / l;
    if (DIFF) {
        LAS float* ex = (LAS float*)F.lds;
        if (F.wave >= 4) {
#pragma unroll
            for (int t = 0; t < 4; ++t)
#pragma unroll
                for (int r = 0; r < 16; ++r) ex[((F.wave - 4) * 64 + t * 16 + r) * 64 + lane] = o[t][r] * inv;
        }
        __syncthreads();
        if (F.wave < 4) {
            float ss = 0.f;
#pragma unroll
            for (int t = 0; t < 4; ++t)
#pragma unroll
                for (int r = 0; r < 16; ++r) { const float x = o[t][r] * inv - lam * ex[(F.wave * 64 + t * 16 + r) * 64 + lane]; o[t][r] = x; ss += x * x; }
            ss += __shfl_xor(ss, 32);
            const float sc = post_scale / sqrtf(ss * (1.0f / 128.0f) + 1e-6f);
            gbf16* op = outp + (size_t)r32 * DM;
#pragma unroll
            for (int t = 0; t < 4; ++t) {
                f32x4 gv[4];
#pragma unroll
                for (int g4 = 0; g4 < 4; ++g4) gv[g4] = *(const GAS f32x4*)(gvec + 32 * t + 8 * g4 + 4 * h);
#pragma unroll
                for (int g4 = 0; g4 < 4; ++g4) asm volatile("" : "+v"(gv[g4]));
#pragma unroll
                for (int g4 = 0; g4 < 4; ++g4) { const int dv = 32 * t + 8 * g4 + 4 * h;
                    v2u w2; w2.x = cvt2(o[t][4 * g4] * sc * gv[g4][0], o[t][4 * g4 + 1] * sc * gv[g4][1]); w2.y = cvt2(o[t][4 * g4 + 2] * sc * gv[g4][2], o[t][4 * g4 + 3] * sc * gv[g4][3]); *(GAS v2u*)(op + dv) = w2; }
            }
        }
    } else {
        gbf16* op = outp + (size_t)r32 * DM;
#pragma unroll
        for (int t = 0; t < 4; ++t)
#pragma unroll
            for (int g4 = 0; g4 < 4; ++g4) { const int dv = 32 * t + 8 * g4 + 4 * h;
                v2u w2; w2.x = cvt2(o[t][4 * g4] * inv, o[t][4 * g4 + 1] * inv); w2.y = cvt2(o[t][4 * g4 + 2] * inv, o[t][4 * g4 + 3] * inv); *(GAS v2u*)(op + dv) = w2; }
    }
}

#define MFMA16(a, b, c) __builtin_amdgcn_mfma_f32_16x16x32_bf16((a), (b), (c), 0, 0, 0)
__device__ __forceinline__ bf16x8 frag2(v2u lo, v2u hi) { const v4u w = {lo.x, lo.y, hi.x, hi.y}; return __builtin_bit_cast(bf16x8, w); }
constexpr int HG_NS = 7, HG_SLOT = 17408;
#define HG_VMWAIT(n) asm volatile("s_waitcnt vmcnt(" #n ")" ::: "memory")
template <int MODE>
__device__ __forceinline__ void hgrn_mfma(const Ctx& F, int rb, int nchunks, int cc0, int ncc, int h, int dir, const gf32* s_in, gf32* s_out, gf32* ob, const gf32* fold_s, const gf32* fold_d, int nfold, gf32* d_out) {
    int lane_ = (int)__builtin_amdgcn_mbcnt_hi(~0u, __builtin_amdgcn_mbcnt_lo(~0u, 0u)); asm volatile("" : "+v"(lane_));
    const int lane = lane_, t16 = lane & 15, G = lane >> 4, w = F.wave, vcol = h * 128 + w * 16 + t16;
    __syncthreads();
    f32x4 S[8];
#pragma unroll
    for (int i = 0; i < 8; ++i)
#pragma unroll
        for (int r = 0; r < 4; ++r) S[i][r] = (MODE == 2) ? s_in[(size_t)(16 * i + 4 * G + r) * 128 + w * 16 + t16] : 0.f;
    if (MODE == 2) {
        for (int j = 0; j < nfold; j += 2) {
            f32x4 d_[2][8], s_[2][8];
#pragma unroll
            for (int q = 0; q < 2; ++q) { const int jq = j + q < nfold ? j + q : nfold - 1;
#pragma unroll
                for (int i = 0; i < 8; ++i) { d_[q][i] = *(const GAS f32x4*)(fold_d + (size_t)jq * 128 + 16 * i + 4 * G); s_[q][i] = *(const GAS f32x4*)(fold_s + (size_t)jq * 16384 + ((i * 8 + w) * 64 + lane) * 4); } }
#pragma unroll
            for (int q = 0; q < 2; ++q) if (j + q < nfold) {
#pragma unroll
                for (int i = 0; i < 8; ++i) S[i] = S[i] * d_[q][i] + s_[q][i]; }
        }
    }
    f32x4 Dacc[8];
#pragma unroll
    for (int i = 0; i < 8; ++i) Dacc[i] = (f32x4){1.f, 1.f, 1.f, 1.f};
#pragma unroll
    for (int i = 0; i < 8; ++i) asm volatile("" : "+v"(S[i]));
    __builtin_amdgcn_s_waitcnt(0);
    const GAS unsigned char* srcA = (const GAS unsigned char*)((w < 4 ? F.hq(dir) : F.hkm(dir)) + h * 128);
    const GAS unsigned char* srcB = (const GAS unsigned char*)((w < 4 ? F.hkp(dir) : F.hvt(dir)) + (size_t)h * 128 * 16);
    const GAS unsigned char* srcC = (const GAS unsigned char*)(F.hdec(dir) + h * 128) + (lane & 31) * 16;
    const int rA = 4 * (w & 3) + (lane >> 4);
    const unsigned offA = (unsigned)((dir ? 15 - rA : rA) * 1024 + (((lane & 15) ^ rA) * 16));
    const int dB = 32 * (w & 3) + (lane >> 1);
    const unsigned offB = (unsigned)(dB * 32 + (((lane & 1) ^ ((dB >> 3) & 1)) * 16));
    const int dstA = (w < 4 ? 0 : 4096) + (w & 3) * 1024, dstB = (w < 4 ? 8192 : 12288) + (w & 3) * 1024;
#define HG_ISSUE(cj) do { const int ce_ = cc0 + ((cj) < ncc ? (cj) : ncc - 1); const int ch_ = dir ? nchunks - 1 - ce_ : ce_; const size_t gc_ = (size_t)(rb / 16 + ch_); \
        LAS unsigned char* sl_ = F.lds + ((cj) % HG_NS) * HG_SLOT; \
        if (MODE != 1) __builtin_amdgcn_global_load_lds((const GAS unsigned*)(srcA + (size_t)(rb + ch_ * 16) * 1024 + offA), (LAS unsigned*)(sl_ + dstA), 16, 0, 0); \
        __builtin_amdgcn_global_load_lds((const GAS unsigned*)(srcB + gc_ * 16384 + offB), (LAS unsigned*)(sl_ + dstB), 16, 0, 0); \
        if (w == 0) __builtin_amdgcn_global_load_lds((const GAS unsigned*)(srcC + gc_ * 2048), (LAS unsigned*)(sl_ + 16384), 16, 0, 0); } while (0)
    const int qoff = t16 * 256 + 8 * (G & 1);
    const int g1 = G >> 1;
    const int kpoff = 8192 + t16 * 32 + ((g1 ^ ((t16 >> 3) & 1)) * 16) + 8 * (G & 1);
    const int vtoff = 12288 + (w * 16 + t16) * 32 + ((g1 ^ ((t16 >> 3) & 1)) * 16) + 8 * (G & 1);
    const int dcoff = 16384 + 16 * G;
    const v2u z2 = {0u, 0u};
#pragma unroll
    for (int j = 0; j < HG_NS - 1; ++j) HG_ISSUE(j);
    for (int cc = 0; cc < ncc; ++cc) {
        if (MODE == 1) { if (w == 0) HG_VMWAIT(10); else HG_VMWAIT(5); }
        else if (cc < HG_NS - 1) { if (w == 0) HG_VMWAIT(15); else HG_VMWAIT(10); }
        else                     { if (w == 0) HG_VMWAIT(39); else HG_VMWAIT(34); }
        asm volatile("s_waitcnt lgkmcnt(0)" ::: "memory"); __builtin_amdgcn_s_barrier(); asm volatile("" ::: "memory");
        HG_ISSUE(cc + HG_NS - 1);
        const LAS unsigned char* sl = F.lds + (cc % HG_NS) * HG_SLOT;
        v2u q[8], k[8], kp[8]; f32x4 dec[8];
        if (MODE != 1) {
#pragma unroll
            for (int i = 0; i < 8; ++i) { const int po = (((2 * i + g1) ^ t16) * 16); q[i] = *(const LAS v2u*)(sl + qoff + po); k[i] = *(const LAS v2u*)(sl + 4096 + qoff + po); }
        }
        const v2u vt = *(const LAS v2u*)(sl + vtoff);
#pragma unroll
        for (int i = 0; i < 8; ++i) { kp[i] = *(const LAS v2u*)(sl + kpoff + i * 512); dec[i] = *(const LAS f32x4*)(sl + dcoff + i * 64); }
        __builtin_amdgcn_sched_barrier(0);
        const bf16x8 vb = frag2(vt, z2);
        if (MODE != 1) {
            f32x4 pt = {0.f, 0.f, 0.f, 0.f};
#pragma unroll
            for (int kk = 0; kk < 4; ++kk) pt = MFMA16(frag2(k[2 * kk], k[2 * kk + 1]), frag2(q[2 * kk], q[2 * kk + 1]), pt);
#pragma unroll
            for (int r = 0; r < 4; ++r) if (4 * G + r > t16) pt[r] = 0.f;
            const v2u pb = {cvt2(pt[0], pt[1]), cvt2(pt[2], pt[3])};
            f32x4 o = {0.f, 0.f, 0.f, 0.f};
            o = MFMA16(frag2(pb, z2), vb, o);
#pragma unroll
            for (int kk = 0; kk < 4; ++kk) { const v2u s0 = {cvt2(S[2 * kk][0], S[2 * kk][1]), cvt2(S[2 * kk][2], S[2 * kk][3])}, s1 = {cvt2(S[2 * kk + 1][0], S[2 * kk + 1][1]), cvt2(S[2 * kk + 1][2], S[2 * kk + 1][3])};
                o = MFMA16(frag2(q[2 * kk], q[2 * kk + 1]), frag2(s0, s1), o); }
            const int ce = cc0 + cc, ch = dir ? nchunks - 1 - ce : ce, crow = rb + ch * 16;
#pragma unroll
            for (int r = 0; r < 4; ++r) { const int pr_ = 4 * G + r; ob[(size_t)(crow + (dir ? 15 - pr_ : pr_)) * 512 + vcol] = o[r]; }
        }
#pragma unroll
        for (int i = 0; i < 8; ++i) { S[i] = S[i] * dec[i]; S[i] = MFMA16(frag2(kp[i], z2), vb, S[i]); if (MODE == 1) Dacc[i] = Dacc[i] * dec[i]; }
    }
#undef HG_ISSUE
    HG_VMWAIT(0);
    __syncthreads();
    if (MODE == 0) {
#pragma unroll
        for (int i = 0; i < 8; ++i)
#pragma unroll
            for (int r = 0; r < 4; ++r) s_out[(size_t)(16 * i + 4 * G + r) * 128 + w * 16 + t16] = S[i][r];
    }
    if (MODE == 1) {
#pragma unroll
        for (int i = 0; i < 8; ++i) *(GAS f32x4*)(s_out + ((i * 8 + w) * 64 + lane) * 4) = S[i];
    }
    if (MODE == 1 && w == 0 && t16 == 0) {
#pragma unroll
        for (int i = 0; i < 8; ++i) *(GAS f32x4*)(d_out + 16 * i + 4 * G) = Dacc[i];
    }
}

__device__ __forceinline__ void hp_states(const Ctx& F, int l) {
    for (int i = F.bid; i < 256; i += F.G) {
        const int sq = i >> 4, seg = i & 15, b = sq >> 3, h = (sq >> 1) & 3, dir = sq & 1;
        if (seg == 15) continue;
        hgrn_mfma<1>(F, R_CTX + b * S_LAT, S_LAT / 16, seg * 16, 16, h, dir, nullptr, F.sloc() + ((size_t)sq * 16 + seg) * 16384, nullptr, nullptr, nullptr, 0, F.dseg() + ((size_t)sq * 16 + seg) * 128);
    }
}

__device__ __forceinline__ void mg_head(const Ctx& F, int l, int row0, int h) {
    asm volatile("s_waitcnt vmcnt(0)" ::: "memory");
    __syncthreads();
    const int sub = F.lane & 15, col0 = h * 128 + sub * 8;
    const gf32* g = F.inp(I_HNG) + l * 128 + sub * 8; const f32x4 g0 = *(const GAS f32x4*)g, g1 = *(const GAS f32x4*)(g + 4);
    for (int row = row0 + F.wave * 4 + (F.lane >> 4); row < row0 + 256; row += 32) {
        const f32x4 a0 = *(const GAS f32x4*)(F.obf() + (size_t)row * 512 + col0) + *(const GAS f32x4*)(F.obb() + (size_t)row * 512 + col0);
        const f32x4 a1 = *(const GAS f32x4*)(F.obf() + (size_t)row * 512 + col0 + 4) + *(const GAS f32x4*)(F.obb() + (size_t)row * 512 + col0 + 4);
        float ss = (a0[0] * a0[0] + a0[1] * a0[1]) + (a0[2] * a0[2] + a0[3] * a0[3]) + (a1[0] * a1[0] + a1[1] * a1[1]) + (a1[2] * a1[2] + a1[3] * a1[3]);
        ss += __shfl_xor(ss, 1); ss += __shfl_xor(ss, 2); ss += __shfl_xor(ss, 4); ss += __shfl_xor(ss, 8);
        const float rinv = 1.0f / sqrtf(ss * (1.0f / 128.0f) + 1e-6f);
        const v4u hw = *(const GAS v4u*)(F.hgate() + (size_t)row * 512 + col0);
        const f32x4 h0 = bf2lo(hw.x, hw.y), h1 = bf2lo(hw.z, hw.w);
        float y[8];
#pragma unroll
        for (int i = 0; i < 4; ++i) { y[i] = a0[i] * rinv * g0[i] * h0[i]; y[4 + i] = a1[i] * rinv * g1[i] * h1[i]; }
        v4u w; w.x = pk2(y[0], y[1]); w.y = pk2(y[2], y[3]); w.z = pk2(y[4], y[5]); w.w = pk2(y[6], y[7]);
        *(GAS v4u*)(F.cat() + (size_t)row * DM + 512 + col0) = w;
    }
}

#ifndef PROBE_MX_DUP
#define PROBE_MX_DUP 0
#endif
#define MXREP(cls) for (int rep_ = 0; rep_ < 1 + ((PROBE_MX_DUP >> (cls)) & 1); ++rep_)
__device__ __forceinline__ void mx_mixers(const Ctx& F, int l) {
    float lam = F.lamv()[l * 2], lam_init = F.lamv()[l * 2 + 1];
    asm volatile("" : "+v"(lam), "+v"(lam_init));
    const gbf16* qkv = F.qkv();
    constexpr int T_LH = 256, T_LD = 256, T_LB = 256;
    const AttnSeg none = {nullptr, nullptr, 0, 0};
    const int w = F.wave;
    const int B = F.bid, role = B < 128 ? 0 : (B < 192 ? 1 : 2);
    for (int step = 0; step < 6; ++step) {
        int i = -1, pw = B;
        if (step == 0) i = T_LH + B;
        else if (role == 0) { const int bb = B >> 6, h = (B >> 4) & 3, sgi = B & 15, sq = bb * 8 + h * 2;
            if (step == 1) i = sq * 16 + sgi; else if (step == 2) i = (sq + 1) * 16 + 15 - sgi; else if (step == 3) i = 2000; else if (step == 4 && B < 64) i = 768 + 384 + 64 + B; }
        else if (role == 1) { const int c = B - 128;
            if (step == 1) i = 768 + c * 2; else if (step == 2) i = 768 + c * 2 + 1; else if (step == 3) i = 2001; else if (step == 4) i = T_LH + T_LD + B; else i = 768 + 384 + c; }
        else { const int d = B - 192;
            if (step == 1) i = T_LH + T_LD + B; else if (step == 2) { i = T_LH + T_LD + d; pw = d; } else if (step == 3) { i = T_LH + T_LD + 64 + d; pw = 64 + d; } else if (step == 4) i = 768 + 128 + d; else i = 768 + 128 + 64 + d; }
        if (i < 0) continue;
        if (i == 2000) { mg_head(F, l, R_CTX + (B >> 6) * S_LAT + (B & 15) * 256, (B >> 4) & 3); continue; }
        if (i == 2001) { const int c = B - 128; mg_head(F, l, (c >> 2) * 256, c & 3); continue; }
        if (i >= T_LH && i < T_LH + T_LD + T_LB) i += ((pw & 7) * 32 + (pw >> 3)) - pw;
        if (i < T_LH) {
            const int sq = i >> 4, seg = i & 15, b = sq >> 3, h = (sq >> 1) & 3, dir = sq & 1;
            const gf32* sin_ = F.inp(I_ST) + ((((size_t)b * 4 + l) * 2 + dir) * 4 + h) * 128 * 128;
            MXREP(0) hgrn_mfma<2>(F, R_CTX + b * S_LAT, S_LAT / 16, seg * 16, 16, h, dir, sin_, nullptr, dir ? F.obb() : F.obf(), F.sloc() + (size_t)sq * 16 * 16384, F.dseg() + (size_t)sq * 16 * 128, seg, nullptr);
            continue; } i -= T_LH;
        if (i < T_LD) {
            const int b = i >> 7, h = (i >> 5) & 3, qt = i & 31, map = w >> 2; const int rb = R_CTX + b * S_LAT, wrow = rb + qt * 128 + 32 * (w & 3);
            const AttnSeg s0 = {qkv + (size_t)rb * QKV_LD + Q_KD + h * 128, qkv + (size_t)rb * QKV_LD + Q_VD + h * 128, QKV_LD, S_LAT / 64};
            const size_t co = (((size_t)b * 4 + l) * 4 + h) * 256 * 128;
            const AttnSeg s1 = {F.c16(0) + co, F.c16(2 * MiB) + co, 128, 4};
            MXREP(1) attn_mfma<64, true>(F, qkv + (size_t)wrow * QKV_LD + Q_QD + h * 128 + map * 64, map * 64, s0, s1, false, 0, 0, -1e30f, 0.f, lam, 1.0f - lam_init, F.inp(I_DNG) + l * 128, F.cat() + (size_t)wrow * DM + h * 128);
            continue; } i -= T_LD;
        if (i < T_LB) {
            const int b = i >> 7, kv = (i >> 6) & 1, qt = i & 63, hh = kv * 4 + (w >> 1); const int rb = R_CTX + b * S_LAT, t0 = qt * 64, wrow = rb + t0 + 32 * (w & 1);
            const int ks = t0 - 128 < 0 ? 0 : t0 - 128, ke = t0 + 192 > S_LAT ? S_LAT : t0 + 192;
            const AttnSeg s0 = {qkv + (size_t)(rb + ks) * QKV_LD + Q_KS + kv * 128, qkv + (size_t)(rb + ks) * QKV_LD + Q_VS + kv * 128, QKV_LD, (ke - ks) / 64};
            const size_t co = (((size_t)b * 4 + l) * 2 + kv) * 256 * 128;
            const AttnSeg s1 = {F.c16(4 * MiB) + co, F.c16(5 * MiB) + co, 128, 4};
            MXREP(2) attn_mfma<128, false>(F, qkv + (size_t)wrow * QKV_LD + Q_QS + hh * 128, 0, s0, s1, true, t0 + 32 * (w & 1), ks, F.inp(I_SINK)[l * 8 + hh] * LOG2E, 1.0f, 0.f, 1.0f, nullptr, F.cat() + (size_t)wrow * DM + 1024 + hh * 128);
            continue; } i -= T_LB;
        if (i < 128) {
            const int b = i >> 3, h = (i >> 1) & 3, dir = i & 1;
            gf32* sout = F.out + O_ST + ((((size_t)b * 4 + l) * 2 + dir) * 4 + h) * 128 * 128;
            MXREP(5) hgrn_mfma<0>(F, b * 256, 16, 0, 16, h, dir, nullptr, sout, dir ? F.obb() : F.obf(), nullptr, nullptr, 0, nullptr);
            continue; } i -= 128;
        if (i < 128) {
            const int b = i >> 3, h = (i >> 1) & 3, qt = i & 1, map = w >> 2, rb = b * 256, wrow = rb + qt * 128 + 32 * (w & 3);
            const AttnSeg s0 = {qkv + (size_t)rb * QKV_LD + Q_KD + h * 128, qkv + (size_t)rb * QKV_LD + Q_VD + h * 128, QKV_LD, 4};
            MXREP(3) attn_mfma<64, true>(F, qkv + (size_t)wrow * QKV_LD + Q_QD + h * 128 + map * 64, map * 64, s0, none, false, 0, 0, -1e30f, 0.f, lam, 1.0f - lam_init, F.inp(I_DNG) + l * 128, F.cat() + (size_t)wrow * DM + h * 128);
            continue; } i -= 128;
        if (i < 128) continue;
        i -= 128;
        {
            const int b = i >> 3, kv = (i >> 2) & 1, qt = i & 3, hh = kv * 4 + (w >> 1), rb = b * 256, wrow = rb + qt * 64 + 32 * (w & 1);
            const AttnSeg s0 = {qkv + (size_t)rb * QKV_LD + Q_KS + kv * 128, qkv + (size_t)rb * QKV_LD + Q_VS + kv * 128, QKV_LD, 4};
            MXREP(4) attn_mfma<128, false>(F, qkv + (size_t)wrow * QKV_LD + Q_QS + hh * 128, 0, s0, none, false, 0, 0, F.inp(I_SINK)[l * 8 + hh] * LOG2E, 1.0f, 0.f, 1.0f, nullptr, F.cat() + (size_t)wrow * DM + 1024 + hh * 128);
        }
    }
}

__device__ __forceinline__ void mg_merge(const Ctx& F, int l) {
    const int head = F.lane >> 4, sub = F.lane & 15, col0 = head * 128 + sub * 8;
    const gf32* g = F.inp(I_HNG) + l * 128 + sub * 8; const f32x4 g0 = *(const GAS f32x4*)g, g1 = *(const GAS f32x4*)(g + 4);
    for (int row = F.bid * 8 + F.wave; row < MROWS; row += F.G * 8) {
        const f32x4 a0 = *(const GAS f32x4*)(F.obf() + (size_t)row * 512 + col0) + *(const GAS f32x4*)(F.obb() + (size_t)row * 512 + col0);
        const f32x4 a1 = *(const GAS f32x4*)(F.obf() + (size_t)row * 512 + col0 + 4) + *(const GAS f32x4*)(F.obb() + (size_t)row * 512 + col0 + 4);
        float ss = (a0[0] * a0[0] + a0[1] * a0[1]) + (a0[2] * a0[2] + a0[3] * a0[3]) + (a1[0] * a1[0] + a1[1] * a1[1]) + (a1[2] * a1[2] + a1[3] * a1[3]);
        ss += __shfl_xor(ss, 1); ss += __shfl_xor(ss, 2); ss += __shfl_xor(ss, 4); ss += __shfl_xor(ss, 8);
        const float rinv = 1.0f / sqrtf(ss * (1.0f / 128.0f) + 1e-6f);
        const v4u hw = *(const GAS v4u*)(F.hgate() + (size_t)row * 512 + col0);
        const f32x4 h0 = bf2lo(hw.x, hw.y), h1 = bf2lo(hw.z, hw.w);
        float y[8];
#pragma unroll
        for (int i = 0; i < 4; ++i) { y[i] = a0[i] * rinv * g0[i] * h0[i]; y[4 + i] = a1[i] * rinv * g1[i] * h1[i]; }
        v4u w; w.x = pk2(y[0], y[1]); w.y = pk2(y[2], y[3]); w.z = pk2(y[4], y[5]); w.w = pk2(y[6], y[7]);
        *(GAS v4u*)(F.cat() + (size_t)row * DM + 512 + col0) = w;
    }
}

__device__ __forceinline__ void ln_phase(const Ctx& F, gy_t* Y, const gy_t* Y2, const gf32* g, const gf32* b, gf32* fout, const gf32* modsl  , int which_sh) {
    constexpr int SPLIT_ROW0 = 8192;
    f32x4 A[8], B[8]; int curmod = -1;
    for (int row = F.bid * 8 + F.wave; row < MROWS; row += F.G * 8) {
        f32x4 v[8]; float s = 0.f;
        const gy_t* yp = Y + (size_t)row * DM + F.lane * 8;
#if Y_BF16
        v4u w4[4], u4[4];
#pragma unroll
        for (int jj = 0; jj < 4; ++jj) w4[jj] = *(const GAS v4u*)(yp + 512 * jj);
        if (row >= SPLIT_ROW0) {
#pragma unroll
            for (int jj = 0; jj < 4; ++jj) u4[jj] = *(const GAS v4u*)(Y2 + (size_t)(row - SPLIT_ROW0) * DM + F.lane * 8 + 512 * jj);
        }
#endif
        const int mod = mod_of_row(row);
        if (mod != curmod) { curmod = mod;
            const gf32* sh = modsl ? modsl + ((size_t)mod * 6 + which_sh) * DM : nullptr;
#pragma unroll
            for (int j = 0; j < 8; ++j) { const int c = F.lane * 8 + 512 * (j >> 1) + 4 * (j & 1); A[j] = *(const GAS f32x4*)(g + c); B[j] = *(const GAS f32x4*)(b + c); }
            if (modsl) {
#pragma unroll
                for (int jh = 0; jh < 8; jh += 4) { f32x4 s1[4], s0[4];
#pragma unroll
                    for (int j = 0; j < 4; ++j) { const int c = F.lane * 8 + 512 * ((jh + j) >> 1) + 4 * ((jh + j) & 1); s1[j] = *(const GAS f32x4*)(sh + DM + c); s0[j] = *(const GAS f32x4*)(sh + c); }
#pragma unroll
                    for (int j = 0; j < 4; ++j) asm volatile("" : "+v"(s1[j]), "+v"(s0[j]));
#pragma unroll
                    for (int j = 0; j < 4; ++j) { const f32x4 sc1 = s1[j] + 1.0f; A[jh + j] = A[jh + j] * sc1; B[jh + j] = B[jh + j] * sc1 + s0[j]; } }
            }
        }
#if Y_BF16
#pragma unroll
        for (int jj = 0; jj < 4; ++jj) { v[2 * jj] = bf2lo(w4[jj].x, w4[jj].y); v[2 * jj + 1] = bf2lo(w4[jj].z, w4[jj].w); }
        if (row >= SPLIT_ROW0) {
#pragma unroll
            for (int jj = 0; jj < 4; ++jj) { v[2 * jj] += bf2lo(u4[jj].x, u4[jj].y); v[2 * jj + 1] += bf2lo(u4[jj].z, u4[jj].w);
                v4u o; o.x = pk2(v[2 * jj][0], v[2 * jj][1]); o.y = pk2(v[2 * jj][2], v[2 * jj][3]); o.z = pk2(v[2 * jj + 1][0], v[2 * jj + 1][1]); o.w = pk2(v[2 * jj + 1][2], v[2 * jj + 1][3]);
                *(GAS v4u*)(Y + (size_t)row * DM + F.lane * 8 + 512 * jj) = o; v[2 * jj] = bf2lo(o.x, o.y); v[2 * jj + 1] = bf2lo(o.z, o.w); }
        }
#else
#pragma unroll
        for (int jj = 0; jj < 4; ++jj) { v[2 * jj] = *(const GAS f32x4*)(yp + 512 * jj); v[2 * jj + 1] = *(const GAS f32x4*)(yp + 512 * jj + 4); }
        if (row >= SPLIT_ROW0) {
#pragma unroll
            for (int jj = 0; jj < 4; ++jj) { const gy_t* y2 = Y2 + (size_t)(row - SPLIT_ROW0) * DM + F.lane * 8 + 512 * jj; v[2 * jj] += *(const GAS f32x4*)y2; v[2 * jj + 1] += *(const GAS f32x4*)(y2 + 4);
                *(GAS f32x4*)(Y + (size_t)row * DM + F.lane * 8 + 512 * jj) = v[2 * jj]; *(GAS f32x4*)(Y + (size_t)row * DM + F.lane * 8 + 512 * jj + 4) = v[2 * jj + 1]; }
        }
#endif
#pragma unroll
        for (int j = 0; j < 8; ++j) s += (v[j][0] + v[j][1]) + (v[j][2] + v[j][3]);
#pragma unroll
        for (int o = 1; o < 64; o <<= 1) s += __shfl_xor(s, o);
        const float mean = s * (1.0f / DM); float s2 = 0.f;
#pragma unroll
        for (int j = 0; j < 8; ++j) { v[j] = v[j] - mean; s2 += (v[j][0] * v[j][0] + v[j][1] * v[j][1]) + (v[j][2] * v[j][2] + v[j][3] * v[j][3]); }
#pragma unroll
        for (int o = 1; o < 64; o <<= 1) s2 += __shfl_xor(s2, o);
        const float rstd = 1.0f / sqrtf(s2 * (1.0f / DM) + 1e-5f);
        if (F.lane == 0) *(GAS pg8::f32x2*)(F.stats() + 2 * (size_t)row) = (pg8::f32x2){mean, rstd};
#pragma unroll
        for (int jj = 0; jj < 4; ++jj) { const int c = F.lane * 8 + 512 * jj;
            const f32x4 x0 = v[2 * jj] * rstd * A[2 * jj] + B[2 * jj], x1 = v[2 * jj + 1] * rstd * A[2 * jj + 1] + B[2 * jj + 1];
            if (fout) { *(GAS f32x4*)(fout + (size_t)row * DM + c) = x0; *(GAS f32x4*)(fout + (size_t)row * DM + c + 4) = x1; }
            else { v4u w; w.x = pk2(x0[0], x0[1]); w.y = pk2(x0[2], x0[3]); w.z = pk2(x1[0], x1[1]); w.w = pk2(x1[2], x1[3]); *(GAS v4u*)(F.hbuf() + (size_t)row * DM + c) = w; } }
    }
}

constexpr int PH_PER_LAYER = 10, N_PHASES = 2 + DEPTH * PH_PER_LAYER;
__global__ void __launch_bounds__(512, 2) fwd_kernel(Args args) {
    extern __shared__ __attribute__((aligned(16))) unsigned char lds_raw[];
    Ctx F;
    F.lds = (LAS unsigned char*)lds_raw;
    F.tid = threadIdx.x; F.lane = F.tid & 63; F.wave = __builtin_amdgcn_readfirstlane(F.tid >> 6); F.G = gridDim.x; F.bid = blockIdx.x;
    F.ap = &args; F.out = (gf32*)args.out; F.ws = (GAS unsigned char*)args.ws;
    volatile LAS unsigned* MISC = (volatile LAS unsigned*)(F.lds + MISC_OFF);
    for (int u = F.tid; u < (LDS_BYTES - LDSCTL_OFF) / 4; u += 512) ((LAS unsigned*)(F.lds + LDSCTL_OFF))[u] = 0u;
    __syncthreads();
    XcdBarrier bar; bar.bar = (unsigned*)(args.ws + WS_CTL) + CW_BAR; bar.x = 0; bar.st = nullptr;
    if (args.single) bar = xcd_barrier_post((unsigned*)(args.ws + WS_CTL) + CW_BAR, MISC + 8);
    const int lo = args.ph_lo, hi = args.ph_hi;
#define IN(k) (lo <= (k) && (k) < hi)
#define FRESH() do { int ln_ = (int)__builtin_amdgcn_mbcnt_hi(~0u, __builtin_amdgcn_mbcnt_lo(~0u, 0u)); asm volatile("" : "+v"(ln_)); F.lane = ln_; asm volatile("" : "+s"(F.wave)); F.tid = F.wave * 64 + F.lane; \
    asm volatile("" : "+s"(F.bid), "+s"(F.G)); asm volatile("" : "+s"(F.ws), "+s"(F.out)); } while (0)
#define SEAM(k) do { if (IN((k) + 1)) xcd_barrier(bar); } while (0)

    if (IN(0)) { FRESH(); p0_prologue(F); SEAM(0); }
    if (IN(1)) { FRESH(); p1_h0(F); SEAM(1); }
    for (int l = 0; l < DEPTH; ++l) {
        const int k0 = 2 + l * PH_PER_LAYER;
        FRESH();
        gy_t* ya = (gy_t*)F.ybuf(0); gy_t* yb = (gy_t*)F.ybuf(1); gy_t* y2 = (gy_t*)F.ybuf(2);
        if (IN(k0 + 0)) {
            const int ncv = (F.G == 256 && l + 1 < DEPTH) ? 40 : 0, ng = F.G - ncv;
            if (F.bid < ng) { pg8::Gemm g{(const pg8::bf16_t*)F.hbuf(), (const pg8::bf16_t*)F.wT(l, WO_IN), MROWS, DIN, DM, DM}; G1Order S; S.init(MROWS, DIN, ng, F.bid);
                EpiProj E{F.qkv(), F.out, F.tabD(), F.tabS(), l, F.hq(0), F.hkm(0), F.hkp(0), F.hvt(0), F.hdec(0), F.hgate(), F.lball() + l * 1024};
                pg8::gemm_phase<EpiProj, G1Order, true, true>(F.lds, g, S, E, F.wave); }
            else convert_fast(F, (l + 1) * F_L, (l + 1) * F_L + F_SPLIT, (F.bid - ng) * 8 + F.wave, ncv * 8);
            if (F.G != 256 && l + 1 < DEPTH) { __syncthreads(); convert_fast(F, (l + 1) * F_L, (l + 1) * F_L + F_SPLIT, F.bid * 8 + F.wave, F.G * 8); }
            SEAM(k0 + 0); }
        if (IN(k0 + 2)) { FRESH(); hp_states(F, l); SEAM(k0 + 2); }
        if (IN(k0 + 3)) { FRESH(); mx_mixers(F, l); SEAM(k0 + 3); }
        if (IN(k0 + 5)) {
            EpiResid E{F.inp(I_XP), F.inp(I_XS), yb, F.stats(), F.inp(I_LN2G) + (l ? l - 1 : 0) * DM, F.inp(I_LN2B) + (l ? l - 1 : 0) * DM, F.mods() + ((size_t)l * 3 * 6 + 2) * DM, ya, 0, 0, l ? 1 : 0};
            { pg8::Gemm g{(const pg8::bf16_t*)F.cat(), (const pg8::bf16_t*)F.wT(l, WO_OUT), 8192, DM, DM, DM}; pg8::StaticOrder S; S.init(8192, DM, F.G, F.bid);
              pg8::gemm_phase<EpiResid, pg8::StaticOrder, true, true>(F.lds, g, S, E, F.wave); }
            __syncthreads();
            { const int kh = F.bid >> 7; pg8::Gemm g{(const pg8::bf16_t*)(F.cat() + (size_t)8192 * DM + kh * (DM / 2)), (const pg8::bf16_t*)(F.wT(l, WO_OUT) + kh * (DM / 2)), 4096, DM, DM / 2, DM}; pg8::StaticOrder S; S.init(4096, DM, 128, F.bid & 127);
              E.out = kh ? y2 : ya; E.pm_off = 32; E.gate_only = kh;
              pg8::gemm_phase<EpiResid, pg8::StaticOrder, true, true>(F.lds, g, S, E, F.wave); }
            SEAM(k0 + 5); }
        if (IN(k0 + 6)) { FRESH(); ln_phase(F, ya, y2, F.inp(I_LN1G) + l * DM, F.inp(I_LN1B) + l * DM, nullptr, F.mods() + (size_t)l * 3 * 6 * DM, 3); SEAM(k0 + 6); }
        if (IN(k0 + 7)) {
            const int ncv = (F.G == 256 && l + 1 < DEPTH) ? 16 : 0, ng = F.G - ncv;
            if (F.bid < ng) { pg8::Gemm g{(const pg8::bf16_t*)F.hbuf(), (const pg8::bf16_t*)F.wT(l, WO_GU), MROWS, DGU, DM, DM}; pg8::StaticOrder S; S.init(MROWS, DGU, ng, F.bid);
                EpiSwiGLU E{F.act()};
                pg8::gemm_phase<EpiSwiGLU, pg8::StaticOrder, true, true>(F.lds, g, S, E, F.wave); }
            else convert_fast(F, (l + 1) * F_L + F_SPLIT, (l + 2) * F_L, (F.bid - ng) * 8 + F.wave, ncv * 8);
            if (F.G != 256 && l + 1 < DEPTH) { __syncthreads(); convert_fast(F, (l + 1) * F_L + F_SPLIT, (l + 2) * F_L, F.bid * 8 + F.wave, F.G * 8); }
            SEAM(k0 + 7); }
        if (IN(k0 + 8)) {
            EpiResid E{nullptr, nullptr, ya, F.stats(), F.inp(I_LN1G) + l * DM, F.inp(I_LN1B) + l * DM, F.mods() + ((size_t)l * 3 * 6 + 5) * DM, yb, 0, 0, 1};
            { pg8::Gemm g{(const pg8::bf16_t*)F.act(), (const pg8::bf16_t*)F.wT(l, WO_DN), 8192, DM, DFF, DFF}; pg8::StaticOrder S; S.init(8192, DM, F.G, F.bid);
              pg8::gemm_phase<EpiResid, pg8::StaticOrder, true, true>(F.lds, g, S, E, F.wave); }
            __syncthreads();
            { const int kh = F.bid >> 7; pg8::Gemm g{(const pg8::bf16_t*)(F.act() + (size_t)8192 * DFF + kh * (DFF / 2)), (const pg8::bf16_t*)(F.wT(l, WO_DN) + kh * (DFF / 2)), 4096, DM, DFF / 2, DFF}; pg8::StaticOrder S; S.init(4096, DM, 128, F.bid & 127);
              E.out = kh ? y2 : yb; E.pm_off = 32; E.gate_only = kh;
              pg8::gemm_phase<EpiResid, pg8::StaticOrder, true, true>(F.lds, g, S, E, F.wave); }
            SEAM(k0 + 8); }
        if (IN(k0 + 9)) { FRESH(); ln_phase(F, yb, y2, F.inp(I_LN2G) + l * DM, F.inp(I_LN2B) + l * DM, l + 1 < DEPTH ? nullptr : F.out + O_YP, l + 1 < DEPTH ? F.mods() + (size_t)(l + 1) * 3 * 6 * DM : nullptr, 0); SEAM(k0 + 9); }
    }
#undef IN
#undef SEAM
#undef FRESH
}

#ifndef MK_SINGLE
#define MK_SINGLE 1
#endif
extern "C" void kernel_launch(void* const* d_in, const int* in_sizes, int n_in, void* d_out, int out_size, void* d_ws, size_t ws_size, hipStream_t stream) {
    static int grid = 0;
    if (grid == 0) {
        if (n_in != 24 || out_size != (int)O_END || ws_size < WS_END) { fprintf(stderr, "kernel_launch: unexpected sizes n_in %d out %d ws %zu\n", n_in, out_size, ws_size); grid = -1; return; }
        int dev = 0, cus = 0, per_cu = 0;
        if (hipGetDevice(&dev) != hipSuccess || hipDeviceGetAttribute(&cus, hipDeviceAttributeMultiprocessorCount, dev) != hipSuccess) { grid = -1; return; }
        if (hipFuncSetAttribute((const void*)fwd_kernel, hipFuncAttributeMaxDynamicSharedMemorySize, LDS_BYTES) != hipSuccess) { fprintf(stderr, "kernel_launch: hipFuncSetAttribute failed\n"); grid = -1; return; }
        if (hipOccupancyMaxActiveBlocksPerMultiprocessor(&per_cu, (const void*)fwd_kernel, 512, LDS_BYTES) != hipSuccess || per_cu < 1) fprintf(stderr, "kernel_launch: occupancy query says %d\n", per_cu);
        (void)hipGetLastError();
        grid = cus;
    }
    if (grid < 0) return;
    (void)hipMemsetAsync((char*)d_ws + WS_CTL, 0, CTL_ZERO_BYTES, stream);
    Args a{};
    for (int i = 0; i < 24; ++i) a.in[i] = (const float*)d_in[i];
    a.out = (float*)d_out; a.ws = (unsigned char*)d_ws; a.pad = 0;
#if MK_SINGLE
    a.ph_lo = 0; a.ph_hi = N_PHASES; a.single = 1;
    hipLaunchKernelGGL(fwd_kernel, dim3(grid), dim3(512), LDS_BYTES, stream, a);
#else
    a.single = 0;
    for (int p = 0; p < N_PHASES; ++p) { a.ph_lo = p; a.ph_hi = p + 1; hipLaunchKernelGGL(fwd_kernel, dim3(grid), dim3(512), LDS_BYTES, stream, a);
#ifdef PROBE_REP_MASK
        const int ty = p == 0 ? 10 : (p == 1 ? 11 : (p - 2) % PH_PER_LAYER);
        if ((PROBE_REP_MASK >> ty) & 1) for (int r = 0; r < PROBE_REP_N; ++r) hipLaunchKernelGGL(fwd_kernel, dim3(grid), dim3(512), LDS_BYTES, stream, a);
#endif
    }
#endif
}
```
